# Optimizing an MI355X kernel written in HIP

```python
import math
import jax, jax.numpy as jnp
from jax import lax
import numpy as np

D_MODEL = 2048
BATCH = 16
SEQ = 256
DEPTH = 2
DEC_BATCH = 2
DEC_SEQ = 1024
PAST_LEN = 512

GRID_W = 64
N_EVEN = (DEPTH + 1) // 2
N_ODD = DEPTH // 2
N_DIR = 2
N_MOD = 9
EPS = 1e-6
D_FF = 5632

S5_WIDTH = D_MODEL // 2
S5_GROUP = 16
S5_GROUPS = S5_WIDTH // S5_GROUP
S5_STATE = 64
S5_DT_MIN = 1e-3
S5_DT_MAX = 1e-1

GLA_HEADS = 4
GLA_V = D_MODEL // 2
GLA_QK = GLA_V // 2
GLA_HEAD_K = GLA_QK // GLA_HEADS
GLA_HEAD_V = GLA_V // GLA_HEADS
GLA_RANK = 16
GLA_TAU = 16.0
GLA_CHUNK = 64

EV_IN = S5_WIDTH + 2 * GLA_QK + 2 * GLA_V + N_DIR * GLA_RANK
EV_MIX = S5_WIDTH + GLA_V

LRU_WIDTH = D_MODEL
LRU_HEADS = 8
LRU_BLOCK = LRU_WIDTH // LRU_HEADS
LRU_C = 8.0
CONV_W = 4
CONV_LEFT = 2

kernel_name = 'hybrid_s5_gla_rglru_diffusion_step'


def rmsnorm(x, g):
    xf = x.astype(jnp.float32)
    y = xf * lax.rsqrt(jnp.mean(xf * xf, axis=-1, keepdims=True) + EPS)
    return (y * g.astype(jnp.float32)).astype(x.dtype)


def swiglu(h, w_in, w_out):
    a, b = jnp.split(h @ w_in, 2, axis=-1)
    return (jax.nn.silu(a) * b) @ w_out


def flip(t):
    return t[:, ::-1]


def _cplx_combine(e1, e2):
    a1r, a1i, b1r, b1i = e1
    a2r, a2i, b2r, b2i = e2
    return (a2r * a1r - a2i * a1i,
            a2r * a1i + a2i * a1r,
            a2r * b1r - a2i * b1i + b2r,
            a2r * b1i + a2i * b1r + b2i)


def _real_combine(e1, e2):
    a1, b1 = e1
    a2, b2 = e2
    return a1 * a2, a2 * b1 + b2


def s5_direction(u, lam_re, lam_im, log_step, b_re, b_im, c_re, c_im, h0_re, h0_im):
    dt = jnp.exp(log_step)[:, None]
    z_re, z_im = lam_re * dt, lam_im * dt
    mag = jnp.exp(z_re)
    ab_re, ab_im = mag * jnp.cos(z_im), mag * jnp.sin(z_im)
    den = lam_re * lam_re + lam_im * lam_im
    n_re = ab_re - 1.0
    f_re = (n_re * lam_re + ab_im * lam_im) / den
    f_im = (ab_im * lam_re - n_re * lam_im) / den
    bb_re = f_re[..., None] * b_re - f_im[..., None] * b_im
    bb_im = f_re[..., None] * b_im + f_im[..., None] * b_re
    bu_re = jnp.einsum('gpn,blgn->blgp', bb_re, u)
    bu_im = jnp.einsum('gpn,blgn->blgp', bb_im, u)
    bu_re = bu_re.at[:, 0].add(ab_re * h0_re - ab_im * h0_im)
    bu_im = bu_im.at[:, 0].add(ab_re * h0_im + ab_im * h0_re)
    a_re = jnp.broadcast_to(ab_re, bu_re.shape)
    a_im = jnp.broadcast_to(ab_im, bu_im.shape)
    _, _, h_re, h_im = lax.associative_scan(_cplx_combine, (a_re, a_im, bu_re, bu_im), axis=1)
    y = jnp.einsum('gnp,blgp->blgn', c_re, h_re) - jnp.einsum('gnp,blgp->blgn', c_im, h_im)
    return y, h_re[:, -1], h_im[:, -1]


def gla_direction(q, k, v, log_a, s0):
    bsz, L, H, _ = q.shape
    n = L // GLA_CHUNK

    def chunks(t):
        return t.reshape(bsz, n, GLA_CHUNK, H, t.shape[-1]).transpose(1, 0, 3, 2, 4)

    qc, kc, vc, gc = chunks(q), chunks(k), chunks(v), chunks(log_a)
    bcum = jnp.cumsum(gc, axis=3)
    blast = bcum[:, :, :, -1:, :]
    q_t = qc * jnp.exp(bcum)
    k_t = kc * jnp.exp(-bcum)
    k_end = kc * jnp.exp(blast - bcum)
    mask = jnp.tril(jnp.ones((GLA_CHUNK, GLA_CHUNK), dtype=bool))
    att = jnp.where(mask, jnp.einsum('nbhid,nbhjd->nbhij', q_t, k_t), 0.0)
    o_intra = jnp.einsum('nbhij,nbhjv->nbhiv', att, vc)
    kv_chunk = jnp.einsum('nbhjd,nbhjv->nbhdv', k_end, vc)
    decay_chunk = jnp.exp(blast[:, :, :, 0, :])

    def step(s, inp):
        qt, kv, dec = inp
        o_inter = jnp.einsum('bhid,bhdv->bhiv', qt, s)
        return dec[..., None] * s + kv, o_inter

    s_fin, o_inter = lax.scan(step, s0, (q_t, kv_chunk, decay_chunk))
    o = (o_intra + o_inter).transpose(1, 0, 3, 2, 4).reshape(bsz, L, H, v.shape[-1])
    return o, s_fin


def even_mixer(h, p, e, s5_h0_re, s5_h0_im, gla_s0):
    f32 = jnp.float32
    bsz, L, _ = h.shape
    cuts = [S5_WIDTH, S5_WIDTH + GLA_QK, S5_WIDTH + 2 * GLA_QK,
            S5_WIDTH + 2 * GLA_QK + GLA_V, S5_WIDTH + 2 * GLA_QK + 2 * GLA_V]
    u, q, k, v, g, glr = jnp.split(h @ p['ev_w_in'][e], cuts, axis=-1)

    uf = u.astype(f32)
    ug = uf.reshape(bsz, L, S5_GROUPS, S5_GROUP)
    y_s5 = 0.0
    s5_re, s5_im = [], []
    for d in range(N_DIR):
        orient = (lambda t: t) if d == 0 else flip
        y, hr, hi = s5_direction(orient(ug),
                                 p['s5_lam_re'][e, d].astype(f32), p['s5_lam_im'][e, d].astype(f32),
                                 p['s5_log_step'][e, d].astype(f32),
                                 p['s5_b_re'][e, d].astype(f32), p['s5_b_im'][e, d].astype(f32),
                                 p['s5_c_re'][e, d].astype(f32), p['s5_c_im'][e, d].astype(f32),
                                 s5_h0_re[:, d].astype(f32), s5_h0_im[:, d].astype(f32))
        y_s5 = y_s5 + orient(y)
        s5_re.append(hr)
        s5_im.append(hi)
    y_s5 = y_s5.reshape(bsz, L, S5_WIDTH) + p['s5_d'][e].astype(f32) * uf
    y_s5 = jax.nn.gelu(y_s5)
    y_s5 = y_s5 * jax.nn.sigmoid(y_s5 @ p['s5_glu_w'][e].astype(f32) + p['s5_glu_b'][e].astype(f32))

    qh = q.astype(f32).reshape(bsz, L, GLA_HEADS, GLA_HEAD_K) * (GLA_HEAD_K ** -0.5)
    kh = k.astype(f32).reshape(bsz, L, GLA_HEADS, GLA_HEAD_K)
    vh = v.astype(f32).reshape(bsz, L, GLA_HEADS, GLA_HEAD_V)
    glr = glr.astype(f32).reshape(bsz, L, N_DIR, GLA_RANK)
    o_sum = 0.0
    gla_s = []
    for d in range(N_DIR):
        orient = (lambda t: t) if d == 0 else flip
        log_a = jax.nn.log_sigmoid(glr[:, :, d] @ p['gla_gate_w2'][e, d].astype(f32)
                                   + p['gla_gate_b'][e, d].astype(f32)) / GLA_TAU
        log_a = log_a.reshape(bsz, L, GLA_HEADS, GLA_HEAD_K)
        o, s = gla_direction(orient(qh), orient(kh), orient(vh), orient(log_a), gla_s0[:, d].astype(f32))
        o_sum = o_sum + orient(o)
        gla_s.append(s)
    o = o_sum * lax.rsqrt(jnp.mean(o_sum * o_sum, axis=-1, keepdims=True) + EPS) * p['gla_norm_g'][e].astype(f32)
    o = o.reshape(bsz, L, GLA_V) * jax.nn.silu(g.astype(f32))

    y = jnp.concatenate([y_s5, o], axis=-1).astype(h.dtype) @ p['ev_w_out'][e]
    return (y, jnp.stack(s5_re, 1).astype(h.dtype), jnp.stack(s5_im, 1).astype(h.dtype),
            jnp.stack(gla_s, 1).astype(h.dtype))


def depthwise_conv(x, w, b):
    y = lax.conv_general_dilated(x, w[:, None, :], window_strides=(1,),
                                 padding=[(CONV_LEFT, CONV_W - 1 - CONV_LEFT)],
                                 dimension_numbers=('NWC', 'WIO', 'NWC'),
                                 feature_group_count=x.shape[-1])
    return y + b


def rglru_direction(x, wa, ba, wx, bx, lam, h0):
    bsz, L, W = x.shape
    xb = x.reshape(bsz, L, LRU_HEADS, LRU_BLOCK)
    r = jax.nn.sigmoid(jnp.einsum('blhi,hij->blhj', xb, wa).reshape(bsz, L, W) + ba)
    i = jax.nn.sigmoid(jnp.einsum('blhi,hij->blhj', xb, wx).reshape(bsz, L, W) + bx)
    log_a = -LRU_C * r * jax.nn.softplus(-lam)
    a = jnp.exp(log_a)
    b = jnp.sqrt(-jnp.expm1(2.0 * log_a)) * (i * x)
    b = b.at[:, 0].add(a[:, 0] * h0)
    _, hs = lax.associative_scan(_real_combine, (a, b), axis=1)
    return hs, hs[:, -1]


def odd_mixer(h, p, o, lru_h0, grid):
    f32 = jnp.float32
    bsz, L, _ = h.shape
    gate_br, x_br = jnp.split(h @ p['od_w_in'][o], 2, axis=-1)
    cw = p['lru_conv_w'][o].astype(f32)
    cb = p['lru_conv_b'][o].astype(f32)
    xf = x_br.astype(f32)
    if grid:
        rows = L // GRID_W
        xc = depthwise_conv(xf.reshape(bsz * rows, GRID_W, LRU_WIDTH), cw, cb).reshape(bsz, L, LRU_WIDTH)
    else:
        xc = depthwise_conv(xf, cw, cb)
    hsum = 0.0
    states = []
    for d in range(N_DIR):
        orient = (lambda t: t) if d == 0 else flip
        hs, s = rglru_direction(orient(xc),
                                p['lru_wa'][o, d].astype(f32), p['lru_ba'][o, d].astype(f32),
                                p['lru_wx'][o, d].astype(f32), p['lru_bx'][o, d].astype(f32),
                                p['lru_lam'][o, d].astype(f32), lru_h0[:, d].astype(f32))
        hsum = hsum + orient(hs)
        states.append(s)
    y = (hsum * jax.nn.gelu(gate_br.astype(f32))).astype(h.dtype) @ p['od_w_out'][o]
    return y, jnp.stack(states, 1).astype(h.dtype)


def trunk(x, cond, s5_re0, s5_im0, gla0, lru0, p, grid):
    cond_act = jax.nn.silu(cond)
    s5_re_out, s5_im_out, gla_out, lru_out = [], [], [], []
    for l in range(DEPTH):
        mod = (cond_act @ p['ada_w'][l] + p['ada_b'][l]).reshape(cond.shape[0], 1, N_MOD, D_MODEL)
        sh1, sc1, g1, sh2, sc2, g2, sh3, sc3, g3 = [mod[:, :, j] for j in range(N_MOD)]
        hm = rmsnorm(x, p['norm_g'][l, 0]) * (1.0 + sc1) + sh1
        x = x + 0.5 * g1 * swiglu(hm, p['ffn_w_in'][l, 0], p['ffn_w_out'][l, 0])
        hm = rmsnorm(x, p['norm_g'][l, 1]) * (1.0 + sc2) + sh2
        if l % 2 == 0:
            e = l // 2
            y, sr, si, sg = even_mixer(hm, p, e, s5_re0[:, e], s5_im0[:, e], gla0[:, e])
            s5_re_out.append(sr)
            s5_im_out.append(si)
            gla_out.append(sg)
        else:
            o = l // 2
            y, sl = odd_mixer(hm, p, o, lru0[:, o], grid)
            lru_out.append(sl)
        x = x + g2 * y
        hm = rmsnorm(x, p['norm_g'][l, 2]) * (1.0 + sc3) + sh3
        x = x + 0.5 * g3 * swiglu(hm, p['ffn_w_in'][l, 1], p['ffn_w_out'][l, 1])
    return (rmsnorm(x, p['final_norm_g']), jnp.stack(s5_re_out, 1), jnp.stack(s5_im_out, 1),
            jnp.stack(gla_out, 1), jnp.stack(lru_out, 1))


def setup_inputs(seed: int = 0) -> dict:
    key = jax.random.key(seed)
    ks = iter(jax.random.split(key, 48))
    f32 = jnp.float32

    def nrm(shape, scale):
        return scale * jax.random.normal(next(ks), shape, f32)

    def unif(shape, lo, hi):
        return jax.random.uniform(next(ks), shape, f32, lo, hi)

    lam_im_base = jnp.pi * jnp.arange(S5_STATE, dtype=f32)
    lru_s = unif((N_ODD, N_DIR, LRU_WIDTH), 0.9, 0.999) ** (1.0 / LRU_C)
    return {
        'x_prompt': nrm((BATCH, SEQ, D_MODEL), 1.0),
        'x_sample': nrm((DEC_BATCH, DEC_SEQ, D_MODEL), 1.0),
        'state_s5_re': nrm((DEC_BATCH, N_EVEN, N_DIR, S5_GROUPS, S5_STATE), 0.5),
        'state_s5_im': nrm((DEC_BATCH, N_EVEN, N_DIR, S5_GROUPS, S5_STATE), 0.5),
        'state_gla': nrm((DEC_BATCH, N_EVEN, N_DIR, GLA_HEADS, GLA_HEAD_K, GLA_HEAD_V), 1.0),
        'state_lru': nrm((DEC_BATCH, N_ODD, N_DIR, LRU_WIDTH), 0.5),
        'c': nrm((DEC_BATCH, D_MODEL), 1.0),
        'c_ctx': nrm((D_MODEL,), 1.0),
        'norm_g': 1.0 + nrm((DEPTH, 3, D_MODEL), 0.02),
        'ada_w': nrm((DEPTH, D_MODEL, N_MOD * D_MODEL), 0.5 * D_MODEL ** -0.5),
        'ada_b': nrm((DEPTH, N_MOD * D_MODEL), 0.02),
        'ffn_w_in': nrm((DEPTH, 2, D_MODEL, 2 * D_FF), D_MODEL ** -0.5),
        'ffn_w_out': nrm((DEPTH, 2, D_FF, D_MODEL), D_FF ** -0.5),
        'final_norm_g': 1.0 + nrm((D_MODEL,), 0.02),
        'ev_w_in': nrm((N_EVEN, D_MODEL, EV_IN), D_MODEL ** -0.5),
        'ev_w_out': nrm((N_EVEN, EV_MIX, D_MODEL), EV_MIX ** -0.5),
        's5_lam_re': -0.5 + nrm((N_EVEN, N_DIR, S5_GROUPS, S5_STATE), 0.01),
        's5_lam_im': lam_im_base + nrm((N_EVEN, N_DIR, S5_GROUPS, S5_STATE), 0.01),
        's5_log_step': unif((N_EVEN, N_DIR, S5_GROUPS), math.log(S5_DT_MIN), math.log(S5_DT_MAX)),
        's5_b_re': nrm((N_EVEN, N_DIR, S5_GROUPS, S5_STATE, S5_GROUP), (2 * S5_GROUP) ** -0.5),
        's5_b_im': nrm((N_EVEN, N_DIR, S5_GROUPS, S5_STATE, S5_GROUP), (2 * S5_GROUP) ** -0.5),
        's5_c_re': nrm((N_EVEN, N_DIR, S5_GROUPS, S5_GROUP, S5_STATE), S5_STATE ** -0.5),
        's5_c_im': nrm((N_EVEN, N_DIR, S5_GROUPS, S5_GROUP, S5_STATE), S5_STATE ** -0.5),
        's5_d': nrm((N_EVEN, S5_WIDTH), 0.5),
        's5_glu_w': nrm((N_EVEN, S5_WIDTH, S5_WIDTH), S5_WIDTH ** -0.5),
        's5_glu_b': nrm((N_EVEN, S5_WIDTH), 0.02),
        'gla_gate_w2': nrm((N_EVEN, N_DIR, GLA_RANK, GLA_QK), GLA_RANK ** -0.5),
        'gla_gate_b': nrm((N_EVEN, N_DIR, GLA_QK), 0.1),
        'gla_norm_g': 1.0 + nrm((N_EVEN, GLA_HEAD_V), 0.02),
        'od_w_in': nrm((N_ODD, D_MODEL, 2 * LRU_WIDTH), D_MODEL ** -0.5),
        'od_w_out': nrm((N_ODD, LRU_WIDTH, D_MODEL), LRU_WIDTH ** -0.5),
        'lru_conv_w': nrm((N_ODD, CONV_W, LRU_WIDTH), CONV_W ** -0.5),
        'lru_conv_b': nrm((N_ODD, LRU_WIDTH), 0.02),
        'lru_wa': nrm((N_ODD, N_DIR, LRU_HEADS, LRU_BLOCK, LRU_BLOCK), LRU_BLOCK ** -0.5),
        'lru_ba': nrm((N_ODD, N_DIR, LRU_WIDTH), 0.02),
        'lru_wx': nrm((N_ODD, N_DIR, LRU_HEADS, LRU_BLOCK, LRU_BLOCK), LRU_BLOCK ** -0.5),
        'lru_bx': nrm((N_ODD, N_DIR, LRU_WIDTH), 0.02),
        'lru_lam': jnp.log(lru_s) - jnp.log1p(-lru_s),
    }


def reference(x_prompt, x_sample, state_s5_re, state_s5_im, state_gla, state_lru, c, c_ctx,
              norm_g, ada_w, ada_b, ffn_w_in, ffn_w_out, final_norm_g,
              ev_w_in, ev_w_out, s5_lam_re, s5_lam_im, s5_log_step, s5_b_re, s5_b_im, s5_c_re, s5_c_im,
              s5_d, s5_glu_w, s5_glu_b, gla_gate_w2, gla_gate_b, gla_norm_g,
              od_w_in, od_w_out, lru_conv_w, lru_conv_b, lru_wa, lru_ba, lru_wx, lru_bx, lru_lam):
    p = dict(norm_g=norm_g, ada_w=ada_w, ada_b=ada_b, ffn_w_in=ffn_w_in, ffn_w_out=ffn_w_out,
             final_norm_g=final_norm_g, ev_w_in=ev_w_in, ev_w_out=ev_w_out,
             s5_lam_re=s5_lam_re, s5_lam_im=s5_lam_im, s5_log_step=s5_log_step,
             s5_b_re=s5_b_re, s5_b_im=s5_b_im, s5_c_re=s5_c_re, s5_c_im=s5_c_im,
             s5_d=s5_d, s5_glu_w=s5_glu_w, s5_glu_b=s5_glu_b,
             gla_gate_w2=gla_gate_w2, gla_gate_b=gla_gate_b, gla_norm_g=gla_norm_g,
             od_w_in=od_w_in, od_w_out=od_w_out, lru_conv_w=lru_conv_w, lru_conv_b=lru_conv_b,
             lru_wa=lru_wa, lru_ba=lru_ba, lru_wx=lru_wx, lru_bx=lru_bx, lru_lam=lru_lam)
    bsz = x_prompt.shape[0]
    dt = x_prompt.dtype
    y_prompt, new_s5_re, new_s5_im, new_gla, new_lru = trunk(
        x_prompt, c_ctx[None, :],
        jnp.zeros((bsz, N_EVEN, N_DIR, S5_GROUPS, S5_STATE), dt),
        jnp.zeros((bsz, N_EVEN, N_DIR, S5_GROUPS, S5_STATE), dt),
        jnp.zeros((bsz, N_EVEN, N_DIR, GLA_HEADS, GLA_HEAD_K, GLA_HEAD_V), dt),
        jnp.zeros((bsz, N_ODD, N_DIR, LRU_WIDTH), dt),
        p, False)
    y_sample, _, _, _, _ = trunk(x_sample, c, state_s5_re, state_s5_im, state_gla, state_lru, p, True)
    return (y_prompt, y_sample, new_s5_re, new_s5_im, new_gla, new_lru)
```

```cpp
#include <hip/hip_runtime.h>
#include <hip/hip_cooperative_groups.h>
#include <cstdio>
namespace cg = cooperative_groups;

#ifndef MEGA
#define MEGA 1
#endif

#define LAS __attribute__((address_space(3)))
typedef unsigned short bf16_t;
typedef short bf16x8 __attribute__((ext_vector_type(8)));
typedef float f32x4 __attribute__((ext_vector_type(4)));
typedef float f32x2 __attribute__((ext_vector_type(2)));

constexpr int D = 2048, DFF = 5632, MTOK = 6144, TCTX = 4096;
constexpr int EVINP = 4352;
constexpr int NPH = 27;
constexpr int LDS_MAIN = 131072;
constexpr int LDS_BYTES = LDS_MAIN + 64;
constexpr float EPS = 1e-6f;

constexpr size_t al256(size_t x) { return (x + 255) & ~(size_t)255; }
constexpr size_t WS_MOD = 0;
constexpr size_t MOD_BYTES = (size_t)2 * 3 * 9 * 2048 * 4;
constexpr size_t WS_BAR = al256(WS_MOD + MOD_BYTES);
constexpr size_t BAR_BYTES = 3456 * 4;
constexpr size_t ZERO_BYTES = WS_BAR + BAR_BYTES;
constexpr size_t WS_X = al256(WS_BAR + BAR_BYTES);
constexpr size_t WS_HM = WS_X + (size_t)MTOK * D * 4;
constexpr size_t WS_H = WS_HM + (size_t)MTOK * D * 2;
constexpr size_t WS_PROJ = WS_H + (size_t)MTOK * DFF * 2;
constexpr size_t WS_WFI = WS_PROJ + (size_t)MTOK * EVINP * 4;
constexpr size_t WS_WFO = WS_WFI + (size_t)4 * 11264 * 2048 * 2;
constexpr size_t WS_WEI = WS_WFO + (size_t)4 * 2048 * 5632 * 2;
constexpr size_t WS_WEO = WS_WEI + (size_t)EVINP * 2048 * 2;
constexpr size_t WS_WGLU = WS_WEO + (size_t)2048 * 2048 * 2;
constexpr size_t WS_WOI = WS_WGLU + (size_t)1024 * 1024 * 2;
constexpr size_t WS_WOO = WS_WOI + (size_t)4096 * 2048 * 2;
constexpr size_t WS_WLRU = WS_WOO + (size_t)2048 * 2048 * 2;
constexpr size_t WS_YS5 = WS_WLRU + (size_t)2 * 8 * 2 * 256 * 256 * 2;
constexpr size_t WS_OGLA = WS_YS5 + (size_t)2 * MTOK * 1024 * 4;
constexpr size_t WS_YS32 = WS_OGLA + (size_t)2 * MTOK * 1024 * 4;
constexpr size_t WS_YSB = WS_YS32 + (size_t)MTOK * 1024 * 4;
constexpr size_t WS_CAT = WS_YSB + (size_t)MTOK * 1024 * 2;
constexpr size_t WS_XC32 = WS_CAT + (size_t)MTOK * D * 2;
constexpr size_t WS_XCB = WS_XC32 + (size_t)MTOK * D * 4;
constexpr size_t WS_LA = WS_XCB + (size_t)MTOK * D * 2;
constexpr size_t WS_LB = WS_LA + (size_t)2 * MTOK * D * 4;
constexpr size_t WS_SP = WS_LB + (size_t)2 * MTOK * D * 4;
constexpr size_t WS_LSUM = WS_SP + (size_t)2 * D * 4;
constexpr size_t WS_END = WS_LSUM + (size_t)2 * 2 * 384 * D * 4;

constexpr size_t OUT_Y = 0;
constexpr size_t OUT_S5RE = (size_t)MTOK * D;
constexpr size_t OUT_S5IM = OUT_S5RE + 16 * 2 * 64 * 64;
constexpr size_t OUT_GLA = OUT_S5IM + 16 * 2 * 64 * 64;
constexpr size_t OUT_LRU = OUT_GLA + (size_t)16 * 2 * 4 * 128 * 256;

struct Params { const float* in[38]; float* out; unsigned char* ws; int ph_lo, ph_hi; };
typedef const __attribute__((address_space(4))) Params* PP;
__device__ __forceinline__ int tidx() { int t = threadIdx.x; asm volatile("" : "+v"(t)); return t; }
__device__ __forceinline__ int bidx() { int b = blockIdx.x; asm volatile("" : "+s"(b)); return b; }
__device__ __forceinline__ int gdim() { int g = gridDim.x; asm volatile("" : "+s"(g)); return g; }
__device__ __forceinline__ PP get_pp() { PP kp = (PP)__builtin_amdgcn_kernarg_segment_ptr(); asm volatile("" : "+s"(kp)); return kp; }
enum { I_XP = 0, I_XS, I_S5RE, I_S5IM, I_SGLA, I_SLRU, I_C, I_CCTX, I_NORMG, I_ADAW, I_ADAB, I_FWI, I_FWO, I_FNG, I_EVWI, I_EVWO,
       I_LAMRE, I_LAMIM, I_LOGSTEP, I_BRE, I_BIM, I_CRE, I_CIM, I_S5D, I_GLUW, I_GLUB, I_GW2, I_GB, I_GNG, I_ODWI, I_ODWO,
       I_CONVW, I_CONVB, I_LWA, I_LBA, I_LWX, I_LBX, I_LLAM };

__device__ __forceinline__ unsigned cvt_pk_bf16(float lo, float hi) { unsigned r; asm("v_cvt_pk_bf16_f32 %0, %1, %2" : "=v"(r) : "v"(lo), "v"(hi)); return r; }
__device__ __forceinline__ bf16_t f2bf(float x) { return (bf16_t)(cvt_pk_bf16(x, 0.f) & 0xffffu); }
__device__ __forceinline__ float bf2f_(bf16_t v) { return __builtin_bit_cast(float, (unsigned)v << 16); }
__device__ __forceinline__ float lo_bf(unsigned w) { return __builtin_bit_cast(float, w << 16); }
__device__ __forceinline__ float hi_bf(unsigned w) { return __builtin_bit_cast(float, w & 0xffff0000u); }
__device__ __forceinline__ f32x4 unpack4(uint2 w) { return (f32x4){lo_bf(w.x), hi_bf(w.x), lo_bf(w.y), hi_bf(w.y)}; }
__device__ __forceinline__ float sigmoidf_(float x) { return __builtin_amdgcn_rcpf(1.f + __expf(-x)); }
__device__ __forceinline__ float siluf_(float x) { return x * __builtin_amdgcn_rcpf(1.f + __expf(-x)); }
__device__ __forceinline__ float geluf_(float x) { return x * sigmoidf_(1.5957691216f * (x + 0.044715f * x * x * x)); }
__device__ __forceinline__ float softplusf_(float x) { return fmaxf(x, 0.f) + log1pf(__expf(-fabsf(x))); }
__device__ __forceinline__ float neg_expm1_(float x) {
    const float pl = -x * (1.f + x * (0.5f + x * (0.16666667f + x * (0.041666668f + x * (0.0083333338f + x * 0.0013888889f))))); return x > -0.25f ? pl : 1.f - __expf(x); }
__device__ __forceinline__ int cond_of_pm(int pm) { return pm < 16 ? 0 : 1 + ((pm - 16) >> 2); }
__device__ __forceinline__ int cond_of_row(int r) { return r < TCTX ? 0 : 1 + ((r - TCTX) >> 10); }
__device__ __forceinline__ bf16x8 pack8(f32x4 a, f32x4 b) {
    typedef unsigned u32x4 __attribute__((ext_vector_type(4)));
    u32x4 u; u[0] = cvt_pk_bf16(a[0], a[1]); u[1] = cvt_pk_bf16(a[2], a[3]); u[2] = cvt_pk_bf16(b[0], b[1]); u[3] = cvt_pk_bf16(b[2], b[3]);
    return __builtin_bit_cast(bf16x8, u);
}

#define XB_TMO      128
#define XB_XCNT(j)  (256  + 64 * (j))
#define XB_XSUB(j)  (1280 + 64 * (j))
#define XB_XGEN(j)  (2304 + 64 * (j))
#define XB_TOP      3328
#define XB_TOPGEN   3392
#define XCD_BAR_WORDS 3456
#define XB_SPIN_CAP (1u << 18)

__device__ __forceinline__ unsigned xb_ld(unsigned* p)              { return __hip_atomic_load(p, __ATOMIC_RELAXED, __HIP_MEMORY_SCOPE_AGENT); }
__device__ __forceinline__ unsigned xb_add(unsigned* p, unsigned v) { return __hip_atomic_fetch_add(p, v, __ATOMIC_RELAXED, __HIP_MEMORY_SCOPE_AGENT); }
__device__ __forceinline__ unsigned xb_xcc_id() { return (unsigned)__builtin_amdgcn_s_getreg((3 << 11) | 20) & 0xFu; }
#define XB_SPIN(cond, bar) do { unsigned _sp = 0; while (cond) { __builtin_amdgcn_s_sleep(1); \
    if ((++_sp & 255u) == 0u) { if (xb_ld(&(bar)[XB_TMO])) break; if (_sp > XB_SPIN_CAP) { atomicAdd(&(bar)[XB_TMO], 1u); break; } } } } while (0)

struct XcdBarrier {
    unsigned* bar; unsigned x;
    volatile LAS unsigned* st;
};

__device__ __forceinline__ XcdBarrier xcd_barrier_post(unsigned* bar, volatile LAS unsigned* st) {
    XcdBarrier b; b.bar = bar; b.x = xb_xcc_id(); b.st = st;
    if (threadIdx.x == 0) (void)xb_add(&bar[XB_XCNT(b.x)], 1u);
    return b;
}
__device__ __forceinline__ void xcd_barrier_complete(unsigned* bar, unsigned x, unsigned& nloc, unsigned& nx) {
    const unsigned G = gridDim.x * gridDim.y * gridDim.z;
    unsigned sum, cnt, mine, sp = 0u;
    for (;;) {
        sum = 0u; cnt = 0u; mine = 0u;
#pragma unroll
        for (unsigned j = 0; j < 16; ++j) { const unsigned c = xb_ld(&bar[XB_XCNT(j)]); sum += c; cnt += (c > 0u) ? 1u : 0u; mine = (j == x) ? c : mine; }
        if (sum == G) break;
        __builtin_amdgcn_s_sleep(1);
        if ((++sp & 255u) == 0u) { if (xb_ld(&bar[XB_TMO])) break; if (sp > XB_SPIN_CAP) { atomicAdd(&bar[XB_TMO], 1u); break; } }
    }
    nloc = mine > 0u ? mine : 1u; nx = cnt > 0u ? cnt : 1u;
}

__device__ __forceinline__ void xcd_barrier(const XcdBarrier& b) {
    asm volatile("s_waitcnt vmcnt(0)" ::: "memory");
    __syncthreads();
    if (threadIdx.x == 0) {
        unsigned* bar = b.bar;
        __builtin_amdgcn_s_waitcnt(0);
        unsigned nloc = b.st[0], nx = b.st[1];
        if (nloc == 0u) { xcd_barrier_complete(bar, b.x, nloc, nx); b.st[0] = nloc; b.st[1] = nx; }
        const unsigned old = xb_add(&bar[XB_XSUB(b.x)], 1u);
        const unsigned gen = old / nloc;
        if (old + 1u == (gen + 1u) * nloc) {
            __builtin_amdgcn_fence(__ATOMIC_RELEASE, "agent");
            asm volatile("s_waitcnt vmcnt(0)" ::: "memory");
            const unsigned og = xb_add(&bar[XB_TOP], 1u);
            const unsigned tg = og / nx;
            if (og + 1u == (tg + 1u) * nx) xb_add(&bar[XB_TOPGEN], 1u);
            else XB_SPIN(xb_ld(&bar[XB_TOPGEN]) == tg, bar);
            __builtin_amdgcn_fence(__ATOMIC_ACQUIRE, "agent");
            xb_add(&bar[XB_XGEN(b.x)], 1u);
            asm volatile("s_waitcnt vmcnt(0)" ::: "memory");
        } else {
            XB_SPIN(xb_ld(&bar[XB_XGEN(b.x)]) == gen, bar);
            __builtin_amdgcn_fence(__ATOMIC_ACQUIRE, "agent");
            asm volatile("s_waitcnt vmcnt(0)" ::: "memory");
        }
    }
    __syncthreads();
}


namespace pg8 {
constexpr int BM = 256, BK = 64, HALF = 128, HTB = HALF * BK * 2, NXCD = 8, WGM = 8;
__device__ __forceinline__ int lds_byte(int r, int c) { const int st = (r >> 4) * 2 + (c >> 5), rr = r & 15, cc = c & 31, ob = rr * 64 + cc * 2; return st * 1024 + (ob ^ (((ob >> 9) & 1) << 5)); }
__device__ __forceinline__ void stage_rc(int b, int& R, int& C) { const int st = b / 1024, sb = b % 1024, swz = sb ^ (((sb >> 9) & 1) << 5); R = (st >> 1) * 16 + swz / 64; C = (st & 1) * 32 + (swz % 64) / 2; }
struct Unit { int pm, pn; };
struct Order {
    int nM, nN, nwg, G, c;
    __device__ __forceinline__ bool next(int i, Unit& u) const {
        const long L = (long)i * G + c; if (L >= nwg) return false;
        int wgid = (int)L; { const int q = nwg / NXCD, r = nwg % NXCD, xcd = wgid % NXCD, off = wgid / NXCD; wgid = (xcd < r ? xcd * (q + 1) : r * (q + 1) + (xcd - r) * q) + off; }
        const int nig = WGM * nN, gid = wgid / nig, fm = gid * WGM, gsz = (nM - fm) < WGM ? (nM - fm) : WGM;
        u.pm = fm + ((wgid % nig) % gsz); u.pn = (wgid % nig) / gsz; return true;
    }
};

template <class Epi, bool LRU>
__device__ __forceinline__ void gemm_phase(LAS unsigned char* lds, const bf16_t* A, int lda, const bf16_t* Bt, int ldb, int nM, int nN, int K, const Epi& E) {
    const int tid = tidx(), wid = __builtin_amdgcn_readfirstlane(tid >> 6), lane = tid & 63, wr = wid >> 2, wc = wid & 3, fr = lane & 15, fq = lane >> 4;
    const int nt = K / BK;
    Order S; S.nM = nM; S.nN = nN; S.nwg = nM * nN; S.G = gdim(); S.c = bidx();
    unsigned voffA[2], voffB[2];
#pragma unroll
    for (int i = 0; i < 2; ++i) { int R, C; stage_rc(tid * 16 + i * 8192, R, C); voffA[i] = (unsigned)(R * lda + C) * 2u; voffB[i] = (unsigned)(R * ldb + C) * 2u; }
    const size_t kstep = (size_t)(BK * 2);
    const size_t hstepA = (size_t)HALF * lda * 2, hstepB = (size_t)HALF * ldb * 2;
    const size_t tstepA = 2 * hstepA, tstepB = 2 * hstepB;
    const unsigned ldsw = (unsigned)wid * 1024u;
    const int aoff = lds_byte(wr * 64 + fr, fq * 8), boff = lds_byte(wc * 32 + fr, fq * 8);
#define PG8_SA(b, h) (((b) * 2 + (h)) * HTB)
#define PG8_SB(b, h) ((4 + (b) * 2 + (h)) * HTB)
#define PG8_STAGE(bufoff, gbase, voff) do { _Pragma("unroll") for (int _i = 0; _i < 2; ++_i) \
        __builtin_amdgcn_global_load_lds((const unsigned*)((const char*)(gbase) + (voff)[_i]), (LAS unsigned*)(lds + (bufoff) + ldsw + _i * 8192), 16, 0, 0); } while (0)
#define PG8_LDA(dst, b, h) do { _Pragma("unroll") for (int m = 0; m < 4; ++m) _Pragma("unroll") for (int k = 0; k < 2; ++k) dst[m][k] = *(const LAS bf16x8*)(lds + PG8_SA(b, h) + aoff + m * 2048 + k * 1024); } while (0)
#define PG8_LDB(dst, b, h) do { _Pragma("unroll") for (int n = 0; n < 2; ++n) _Pragma("unroll") for (int k = 0; k < 2; ++k) dst[n][k] = *(const LAS bf16x8*)(lds + PG8_SB(b, h) + boff + n * 2048 + k * 1024); } while (0)
#define PG8_MMA(ai, bj, At, Bt_) do { __builtin_amdgcn_s_setprio(1); _Pragma("unroll") for (int m = 0; m < 4; ++m) _Pragma("unroll") for (int n = 0; n < 2; ++n) _Pragma("unroll") for (int k = 0; k < 2; ++k) \
        acc[ai][bj][m][n] = __builtin_amdgcn_mfma_f32_16x16x32_bf16(Bt_[n][k], At[m][k], acc[ai][bj][m][n], 0, 0, 0); __builtin_amdgcn_s_setprio(0); } while (0)
#define PG8_WAIT_V(n) asm volatile("s_waitcnt vmcnt(" #n ")" ::: "memory")
#define PG8_WAIT_L(n) asm volatile("s_waitcnt lgkmcnt(" #n ")" ::: "memory")
#define PG8_BAR __builtin_amdgcn_s_barrier()
#define PG8_SCHED __builtin_amdgcn_sched_barrier(0)
#define PG8_APTR(u) ((const char*)A + (size_t)(u).pm * tstepA + (LRU ? (size_t)((((u).pn >> 1) & 7) * 512) : (size_t)0))
#define PG8_BPTR(u) ((const char*)Bt + (size_t)(u).pn * tstepB)
    Unit cur, nxt; int ui = 0;
    if (!S.next(0, cur)) return;
    f32x4 acc[2][2][4][2];
#pragma unroll
    for (int a = 0; a < 2; ++a)
#pragma unroll
        for (int b = 0; b < 2; ++b)
#pragma unroll
            for (int m = 0; m < 4; ++m)
#pragma unroll
                for (int n = 0; n < 2; ++n) acc[a][b][m][n] = (f32x4){0.f, 0.f, 0.f, 0.f};
    bf16x8 At[4][2], B0[2][2], B1[2][2];
    const char* cA = PG8_APTR(cur); const char* cB = PG8_BPTR(cur);
    PG8_STAGE(PG8_SB(0, 0), cB, voffB); PG8_STAGE(PG8_SA(0, 0), cA, voffA); PG8_STAGE(PG8_SB(0, 1), cB + hstepB, voffB); PG8_STAGE(PG8_SA(0, 1), cA + hstepA, voffA);
    if (wr == 1) PG8_BAR;
    PG8_WAIT_V(4); PG8_BAR;
    PG8_STAGE(PG8_SB(1, 0), cB + kstep, voffB); PG8_STAGE(PG8_SA(1, 0), cA + kstep, voffA); PG8_STAGE(PG8_SB(1, 1), cB + hstepB + kstep, voffB);
    PG8_WAIT_V(6); PG8_BAR;
    for (;;) {
        const bool has_next = S.next(ui + 1, nxt);
        const char* nA = has_next ? PG8_APTR(nxt) : cA; const char* nB = has_next ? PG8_BPTR(nxt) : cB;
        for (int t = 0; t < nt; t += 2) {
            const bool last = (t == nt - 2);
            const char* a1 = cA + (size_t)(t + 1) * kstep;
            const char* a2 = last ? nA : cA + (size_t)(t + 2) * kstep; const char* b2 = last ? nB : cB + (size_t)(t + 2) * kstep;
            const char* a3 = a2 + kstep; const char* b3 = b2 + kstep;
            PG8_LDB(B0, 0, 0); PG8_SCHED; PG8_LDA(At, 0, 0); PG8_STAGE(PG8_SA(1, 1), a1 + hstepA, voffA);
            PG8_WAIT_L(8); PG8_BAR; PG8_WAIT_L(0); PG8_MMA(0, 0, At, B0); PG8_BAR; PG8_SCHED;
            PG8_LDB(B1, 0, 1); PG8_STAGE(PG8_SB(0, 0), b2, voffB);
            PG8_BAR; PG8_WAIT_L(0); PG8_MMA(0, 1, At, B1); PG8_BAR;
            PG8_LDA(At, 0, 1); PG8_STAGE(PG8_SA(0, 0), a2, voffA);
            PG8_BAR; PG8_WAIT_L(0); PG8_MMA(1, 0, At, B0); PG8_BAR; PG8_SCHED;
            PG8_STAGE(PG8_SB(0, 1), b2 + hstepB, voffB);
            PG8_WAIT_V(6); PG8_BAR; PG8_MMA(1, 1, At, B1); PG8_BAR;
            PG8_LDB(B0, 1, 0); PG8_SCHED; PG8_LDA(At, 1, 0); PG8_STAGE(PG8_SA(0, 1), a2 + hstepA, voffA);
            PG8_WAIT_L(8); PG8_BAR; PG8_WAIT_L(0); PG8_MMA(0, 0, At, B0); PG8_BAR; PG8_SCHED;
            PG8_LDB(B1, 1, 1); PG8_STAGE(PG8_SB(1, 0), b3, voffB);
            PG8_BAR; PG8_WAIT_L(0); PG8_MMA(0, 1, At, B1); PG8_BAR;
            PG8_LDA(At, 1, 1); PG8_STAGE(PG8_SA(1, 0), a3, voffA);
            PG8_BAR; PG8_WAIT_L(0); PG8_MMA(1, 0, At, B0); PG8_BAR; PG8_SCHED;
            PG8_STAGE(PG8_SB(1, 1), b3 + hstepB, voffB);
            PG8_WAIT_V(6); PG8_BAR; PG8_MMA(1, 1, At, B1); PG8_BAR;
        }
        E(acc, cur, wr, wc, fr, fq);
        if (!has_next) break;
#pragma unroll
        for (int a = 0; a < 2; ++a)
#pragma unroll
            for (int b = 0; b < 2; ++b)
#pragma unroll
                for (int m = 0; m < 4; ++m)
#pragma unroll
                    for (int n = 0; n < 2; ++n) acc[a][b][m][n] = (f32x4){0.f, 0.f, 0.f, 0.f};
        cur = nxt; cA = nA; cB = nB; ++ui;
    }
    PG8_WAIT_V(0);
    if (wr == 0) PG8_BAR;
    PG8_BAR;
#undef PG8_SA
#undef PG8_SB
#undef PG8_STAGE
#undef PG8_LDA
#undef PG8_LDB
#undef PG8_MMA
#undef PG8_WAIT_V
#undef PG8_WAIT_L
#undef PG8_BAR
#undef PG8_SCHED
#undef PG8_APTR
#undef PG8_BPTR
}
}
using pg8::Unit;

struct EpiSwiglu {
    bf16_t* H;
    __device__ __forceinline__ void operator()(const f32x4 (&acc)[2][2][4][2], const Unit& u, int wr, int wc, int fr, int fq) const {
        const int loff = (wr * 64 + fr) * DFF + wc * 32 + 4 * fq;
        bf16_t* ub = H + (size_t)u.pm * 256 * DFF + u.pn * 128;
#pragma unroll
        for (int ai = 0; ai < 2; ++ai)
#pragma unroll
            for (int m = 0; m < 4; ++m) { bf16_t* rb = ub + (size_t)(ai * 128 + m * 16) * DFF;
#pragma unroll
                for (int n = 0; n < 2; ++n) { const f32x4 a = acc[ai][0][m][n], b = acc[ai][1][m][n];
                    uint2 pk; pk.x = cvt_pk_bf16(siluf_(a[0]) * b[0], siluf_(a[1]) * b[1]); pk.y = cvt_pk_bf16(siluf_(a[2]) * b[2], siluf_(a[3]) * b[3]);
                    *(uint2*)(rb + loff + n * 16) = pk; } }
    }
};
struct EpiResid {
    float* X; const float* G; float coef; const float* XinC; const float* XinL;
    __device__ __forceinline__ void operator()(const f32x4 (&acc)[2][2][4][2], const Unit& u, int wr, int wc, int fr, int fq) const {
        const int lcol = wc * 32 + 4 * fq, loff = (wr * 64 + fr) * D + lcol;
        const float* g = G + (size_t)cond_of_pm(u.pm) * (9 * 2048) + u.pn * 256;
        float* ub = X + (size_t)u.pm * 256 * D + u.pn * 256;
        const float* ib = (u.pm < 16 ? XinC : XinL) + (size_t)u.pm * 256 * D + u.pn * 256;
        f32x4 gv[2][2];
#pragma unroll
        for (int bj = 0; bj < 2; ++bj)
#pragma unroll
            for (int n = 0; n < 2; ++n) gv[bj][n] = *(const f32x4*)(g + lcol + bj * 128 + n * 16) * coef;
#pragma unroll
        for (int ai = 0; ai < 2; ++ai)
#pragma unroll
            for (int m = 0; m < 4; ++m) { float* rb = ub + (size_t)(ai * 128 + m * 16) * D; const float* ir = ib + (size_t)(ai * 128 + m * 16) * D;
#pragma unroll
                for (int bj = 0; bj < 2; ++bj)
#pragma unroll
                    for (int n = 0; n < 2; ++n) { *(f32x4*)(rb + loff + bj * 128 + n * 16) = *(const f32x4*)(ir + loff + bj * 128 + n * 16) + gv[bj][n] * acc[ai][bj][m][n]; }
                __builtin_amdgcn_sched_barrier(0); }
    }
};
struct EpiF32 {
    float* C; int ldc;
    __device__ __forceinline__ void operator()(const f32x4 (&acc)[2][2][4][2], const Unit& u, int wr, int wc, int fr, int fq) const {
        const int loff = (wr * 64 + fr) * ldc + wc * 32 + 4 * fq;
        float* ub = C + (size_t)u.pm * 256 * ldc + u.pn * 256;
#pragma unroll
        for (int ai = 0; ai < 2; ++ai)
#pragma unroll
            for (int m = 0; m < 4; ++m) { float* rb = ub + (size_t)(ai * 128 + m * 16) * ldc;
#pragma unroll
                for (int bj = 0; bj < 2; ++bj)
#pragma unroll
                    for (int n = 0; n < 2; ++n) *(f32x4*)(rb + loff + bj * 128 + n * 16) = acc[ai][bj][m][n]; }
    }
};
struct EpiBf16 {
    bf16_t* C; int ldc;
    __device__ __forceinline__ void operator()(const f32x4 (&acc)[2][2][4][2], const Unit& u, int wr, int wc, int fr, int fq) const {
        const int loff = (wr * 64 + fr) * ldc + wc * 32 + 4 * fq;
        bf16_t* ub = C + (size_t)u.pm * 256 * ldc + u.pn * 256;
#pragma unroll
        for (int ai = 0; ai < 2; ++ai)
#pragma unroll
            for (int m = 0; m < 4; ++m) { bf16_t* rb = ub + (size_t)(ai * 128 + m * 16) * ldc;
#pragma unroll
                for (int bj = 0; bj < 2; ++bj)
#pragma unroll
                    for (int n = 0; n < 2; ++n) { const f32x4 v = acc[ai][bj][m][n]; uint2 pk; pk.x = cvt_pk_bf16(v[0], v[1]); pk.y = cvt_pk_bf16(v[2], v[3]); *(uint2*)(rb + loff + bj * 128 + n * 16) = pk; } }
    }
};
struct EpiGlu {
    bf16_t* CAT; const bf16_t* YS; const float* bias;
    __device__ __forceinline__ void operator()(const f32x4 (&acc)[2][2][4][2], const Unit& u, int wr, int wc, int fr, int fq) const {
        const int lcol = wc * 32 + 4 * fq, loffY = (wr * 64 + fr) * 1024 + lcol, loffC = (wr * 64 + fr) * D + lcol;
        const float* bb = bias + u.pn * 256; const bf16_t* yb = YS + (size_t)u.pm * 256 * 1024 + u.pn * 256; bf16_t* cb = CAT + (size_t)u.pm * 256 * D + u.pn * 256;
        f32x4 bv[2][2];
#pragma unroll
        for (int bj = 0; bj < 2; ++bj)
#pragma unroll
            for (int n = 0; n < 2; ++n) bv[bj][n] = *(const f32x4*)(bb + lcol + bj * 128 + n * 16);
#pragma unroll
        for (int ai = 0; ai < 2; ++ai)
#pragma unroll
            for (int m = 0; m < 4; ++m) { const bf16_t* yr = yb + (size_t)(ai * 128 + m * 16) * 1024; bf16_t* cr = cb + (size_t)(ai * 128 + m * 16) * D;
#pragma unroll
                for (int bj = 0; bj < 2; ++bj)
#pragma unroll
                    for (int n = 0; n < 2; ++n) { const f32x4 ys = unpack4(*(const uint2*)(yr + loffY + bj * 128 + n * 16)); const f32x4 z = acc[ai][bj][m][n] + bv[bj][n];
                        uint2 pk; pk.x = cvt_pk_bf16(ys[0] * sigmoidf_(z[0]), ys[1] * sigmoidf_(z[1])); pk.y = cvt_pk_bf16(ys[2] * sigmoidf_(z[2]), ys[3] * sigmoidf_(z[3]));
                        *(uint2*)(cr + loffC + bj * 128 + n * 16) = pk; }
                __builtin_amdgcn_sched_barrier(0); }
    }
};
struct EpiLru {
    unsigned* LAB; const bf16_t* XC; const float* ba; const float* bx; const float* sp;
    __device__ __forceinline__ void operator()(const f32x4 (&acc)[2][2][4][2], const Unit& u, int wr, int wc, int fr, int fq) const {
        const int d = u.pn >> 4, h = (u.pn >> 1) & 7, half = u.pn & 1;
        const int chu = h * 256 + half * 128;
        const int lcol = wc * 32 + 4 * fq, loff = (wr * 64 + fr) * D + lcol;
        const bf16_t* xb = XC + (size_t)u.pm * 256 * D + chu; unsigned* lab = LAB + ((size_t)d * MTOK + u.pm * 256) * D + chu;
        f32x4 bav[2], bxv[2], spv[2];
#pragma unroll
        for (int n = 0; n < 2; ++n) { bav[n] = *(const f32x4*)(ba + d * D + chu + lcol + n * 16); bxv[n] = *(const f32x4*)(bx + d * D + chu + lcol + n * 16); spv[n] = *(const f32x4*)(sp + d * D + chu + lcol + n * 16); }
#pragma unroll
        for (int ai = 0; ai < 2; ++ai)
#pragma unroll
            for (int m = 0; m < 4; ++m) { const size_t ro = (size_t)(ai * 128 + m * 16) * D;
#pragma unroll
                for (int n = 0; n < 2; ++n) { const f32x4 xc = unpack4(*(const uint2*)(xb + ro + loff + n * 16));
                    const f32x4 rp = acc[ai][0][m][n] + bav[n], ip = acc[ai][1][m][n] + bxv[n]; uint4 w;
                    unsigned wv[4];
#pragma unroll
                    for (int e = 0; e < 4; ++e) { const float la = spv[n][e] * sigmoidf_(rp[e]); const float bb = __builtin_amdgcn_sqrtf(fmaxf(neg_expm1_(2.f * la), 0.f)) * (sigmoidf_(ip[e]) * xc[e]); wv[e] = cvt_pk_bf16(la, bb); }
                    w.x = wv[0]; w.y = wv[1]; w.z = wv[2]; w.w = wv[3];
                    *(uint4*)(lab + ro + loff + n * 16) = w; __builtin_amdgcn_sched_barrier(0); } }
    }
};

struct CvtT { const float* src; bf16_t* dst; int K, ldsrc, Nsrc, n_dst0, n_src0, k0; };
__device__ __forceinline__ void cvt_decode(PP p, unsigned char* ws, int t, int total, CvtT& c) {
    constexpr int T_FI = 176 * 32, T_FO = 32 * 88, T_EI = 68 * 32, T_EO = 32 * 32, T_GLU = 16 * 16, T_OI = 64 * 32, T_OO = 32 * 32, T_LRU = 4 * 4;
    if (t >= total) { c.src = nullptr; c.dst = nullptr; c.K = c.ldsrc = c.Nsrc = c.n_dst0 = c.n_src0 = c.k0 = 0; return; }
    if (t < 4 * T_FI) { const int w = t / T_FI; t %= T_FI; const int nt_ = t / 32, kt = t % 32; c.K = 2048; c.ldsrc = 11264; c.Nsrc = 11264; c.src = p->in[I_FWI] + (size_t)w * 2048 * 11264; c.dst = (bf16_t*)(ws + WS_WFI) + (size_t)w * 11264 * 2048;
        c.n_dst0 = nt_ * 64; const int j = c.n_dst0 >> 8, rr = c.n_dst0 & 255; c.n_src0 = rr < 128 ? j * 128 + rr : 5632 + j * 128 + (rr - 128); c.k0 = kt * 64; }
    else if ((t -= 4 * T_FI) < 4 * T_FO) { const int w = t / T_FO; t %= T_FO; const int nt_ = t / 88, kt = t % 88; c.K = 5632; c.ldsrc = 2048; c.Nsrc = 2048; c.src = p->in[I_FWO] + (size_t)w * 5632 * 2048; c.dst = (bf16_t*)(ws + WS_WFO) + (size_t)w * 2048 * 5632; c.n_dst0 = c.n_src0 = nt_ * 64; c.k0 = kt * 64; }
    else if ((t -= 4 * T_FO) < T_EI) { const int nt_ = t / 32, kt = t % 32; c.K = 2048; c.ldsrc = 4128; c.Nsrc = 4128; c.src = p->in[I_EVWI]; c.dst = (bf16_t*)(ws + WS_WEI); c.n_dst0 = c.n_src0 = nt_ * 64; c.k0 = kt * 64; }
    else if ((t -= T_EI) < T_EO) { const int nt_ = t / 32, kt = t % 32; c.K = 2048; c.ldsrc = 2048; c.Nsrc = 2048; c.src = p->in[I_EVWO]; c.dst = (bf16_t*)(ws + WS_WEO); c.n_dst0 = c.n_src0 = nt_ * 64; c.k0 = kt * 64; }
    else if ((t -= T_EO) < T_GLU) { const int nt_ = t / 16, kt = t % 16; c.K = 1024; c.ldsrc = 1024; c.Nsrc = 1024; c.src = p->in[I_GLUW]; c.dst = (bf16_t*)(ws + WS_WGLU); c.n_dst0 = c.n_src0 = nt_ * 64; c.k0 = kt * 64; }
    else if ((t -= T_GLU) < T_OI) { const int nt_ = t / 32, kt = t % 32; c.K = 2048; c.ldsrc = 4096; c.Nsrc = 4096; c.src = p->in[I_ODWI]; c.dst = (bf16_t*)(ws + WS_WOI); c.n_dst0 = c.n_src0 = nt_ * 64; c.k0 = kt * 64; }
    else if ((t -= T_OI) < T_OO) { const int nt_ = t / 32, kt = t % 32; c.K = 2048; c.ldsrc = 2048; c.Nsrc = 2048; c.src = p->in[I_ODWO]; c.dst = (bf16_t*)(ws + WS_WOO); c.n_dst0 = c.n_src0 = nt_ * 64; c.k0 = kt * 64; }
    else { t -= T_OO; const int mi = t / T_LRU; t %= T_LRU; const int which = mi >> 4, dh = mi & 15;
        const int nt_ = t / 4, kt = t % 4; c.K = 256; c.ldsrc = 256; c.Nsrc = 256; c.src = (which ? p->in[I_LWX] : p->in[I_LWA]) + (size_t)dh * 65536; c.dst = (bf16_t*)(ws + WS_WLRU) + (size_t)dh * 2 * 65536;
        c.n_src0 = nt_ * 64; const int half = c.n_src0 >> 7; c.n_dst0 = half * 256 + which * 128 + (c.n_src0 & 127); c.k0 = kt * 64; }
}
constexpr int CV_FI = 176 * 32, CV_FO = 32 * 88, CV_TOTAL = 4 * CV_FI + 4 * CV_FO + 68 * 32 + 32 * 32 + 16 * 16 + 64 * 32 + 32 * 32 + 32 * 16;
__device__ __forceinline__ void cvt_range(PP p, unsigned char* lds, int t_lo, int t_hi, int rank, int n) {
    const int tid = tidx(); unsigned char* ws = p->ws; float* tile = (float*)lds;
    for (int g0 = t_lo + rank * 4; g0 < t_hi; g0 += n * 4) {
        f32x4 v[4][2];
#pragma unroll
        for (int q = 0; q < 4; ++q) { CvtT c; cvt_decode(p, ws, g0 + q, t_hi, c);
#pragma unroll
            for (int h = 0; h < 2; ++h) { const int kk = (tid >> 4) + h * 32, n4 = (tid & 15) * 4; const int ns = c.n_src0 + n4;
                v[q][h] = (f32x4){0.f, 0.f, 0.f, 0.f}; if (ns < c.Nsrc) v[q][h] = __builtin_nontemporal_load((const f32x4*)(c.src + (size_t)(c.k0 + kk) * c.ldsrc + ns)); } }
        __syncthreads();
#pragma unroll
        for (int q = 0; q < 4; ++q)
#pragma unroll
            for (int h = 0; h < 2; ++h) { const int kk = (tid >> 4) + h * 32, n4 = (tid & 15) * 4; float* tp = tile + q * 4160 + kk * 65 + n4; tp[0] = v[q][h][0]; tp[1] = v[q][h][1]; tp[2] = v[q][h][2]; tp[3] = v[q][h][3]; }
        __syncthreads();
#pragma unroll
        for (int q = 0; q < 4; ++q) { CvtT c; cvt_decode(p, ws, g0 + q, t_hi, c);
            if (c.dst) { const int nn = tid >> 3, k8 = (tid & 7) * 8; f32x4 a, b2; const float* tp = tile + q * 4160;
#pragma unroll
                for (int j = 0; j < 4; ++j) { a[j] = tp[(k8 + j) * 65 + nn]; b2[j] = tp[(k8 + 4 + j) * 65 + nn]; }
                *(bf16x8*)(c.dst + (size_t)(c.n_dst0 + nn) * c.K + c.k0 + k8) = pack8(a, b2); } }
    }
}
__device__ __forceinline__ void mod_items(PP p, unsigned char* lds, int it_lo, int it_hi, int rank, int n) {
    const int tid = tidx(); unsigned char* ws = p->ws;
    float* sc = (float*)lds;
    __syncthreads();
    for (int i = tid; i < 3 * 2048; i += 512) { const int ci = i >> 11, k = i & 2047; const float v = ci == 0 ? p->in[I_CCTX][k] : p->in[I_C][(ci - 1) * 2048 + k]; sc[i] = siluf_(v); }
    __syncthreads();
    float* MOD = (float*)(ws + WS_MOD);
    for (int it = it_lo + rank; it < it_hi; it += n) { const int l = it / 288, r = it % 288, chunk = r / 32, ks = r % 32; const int col = chunk * 2048 + tid * 4;
        const float* W = p->in[I_ADAW] + (size_t)l * 2048 * 18432 + (size_t)(ks * 64) * 18432 + col;
        f32x4 a0 = (f32x4){0.f, 0.f, 0.f, 0.f}, a1 = a0, a2 = a0;
#pragma unroll 8
        for (int k = 0; k < 64; ++k) { const f32x4 w = __builtin_nontemporal_load((const f32x4*)(W + (size_t)k * 18432)); const int kk = ks * 64 + k; a0 += w * sc[kk]; a1 += w * sc[2048 + kk]; a2 += w * sc[4096 + kk]; }
        if (ks == 0) { const f32x4 bb = *(const f32x4*)(p->in[I_ADAB] + (size_t)l * 18432 + col); a0 += bb; a1 += bb; a2 += bb; }
        float* m0 = MOD + (size_t)(l * 3) * 18432 + col;
#pragma unroll
        for (int e = 0; e < 4; ++e) { atomicAdd(m0 + e, a0[e]); atomicAdd(m0 + 18432 + e, a1[e]); atomicAdd(m0 + 2 * 18432 + e, a2[e]); } }
    __syncthreads();
}
__device__ void phase_prep(PP p, LAS unsigned char* ldsr, int skip_mod) {
    unsigned char* lds = (unsigned char*)ldsr;
    const int tid = tidx(), bid = bidx(), nb = gdim();
    unsigned char* ws = p->ws;
    if (!skip_mod) mod_items(p, lds, 0, 96, bid, nb);
    cvt_range(p, lds, 0, CV_FI, bid, nb);
}
__device__ void bg_convert(PP p, LAS unsigned char* ldsr, int ph) {
    unsigned char* lds = (unsigned char*)ldsr; const int bid = bidx();
    constexpr int S0 = 4 * CV_FI + 4 * CV_FO, S_EI = S0, S_EO = S_EI + 2176, S_OI = S_EO + 1024 + 256, S_OO = S_OI + 2048;
    __syncthreads();
    if (ph == 2) { if (bid >= 32) { mod_items(p, lds, 96, 160, bid - 32, 224); cvt_range(p, lds, 4 * CV_FI, 4 * CV_FI + CV_FO, bid - 32, 224); cvt_range(p, lds, S_EI, S_EO, bid - 32, 224); } }
    else if (ph == 3) { if (bid >= 192) cvt_range(p, lds, CV_FI, 2 * CV_FI, bid - 192, 64); }
    else if (ph == 6) { if (bid >= 32) mod_items(p, lds, 160, 288, bid - 32, 224); }
    else if (ph == 5) { if (bid >= 152) cvt_range(p, lds, S_EO, S_OO, bid - 152, 104); }
    else if (ph == 8) { if (bid >= 96) cvt_range(p, lds, 4 * CV_FI + CV_FO, 4 * CV_FI + 2 * CV_FO, bid - 96, 160); }
    else if (ph == 9) { if (bid >= 192) cvt_range(p, lds, S_OO, CV_TOTAL, bid - 192, 64); }
    else if (ph == 11) { if (bid >= 32) cvt_range(p, lds, 2 * CV_FI, 3 * CV_FI, bid - 32, 224); }
    else if (ph == 12) { if (bid >= 192) { mod_items(p, lds, 288, 448, bid - 192, 64); cvt_range(p, lds, 4 * CV_FI + 2 * CV_FO, 4 * CV_FI + 3 * CV_FO, bid - 192, 64); } }
    else if (ph == 14) { if (bid >= 32) cvt_range(p, lds, 3 * CV_FI, 4 * CV_FI, bid - 32, 224); }
    else if (ph == 15) { if (bid >= 192) { cvt_range(p, lds, 4 * CV_FI + 3 * CV_FO, 4 * CV_FI + 4 * CV_FO, bid - 192, 64); mod_items(p, lds, 448, 576, bid - 192, 64); } }
}

__device__ void phase_norm(PP p, int l, int j  ) {
    const int tid = tidx(), lane = tid & 63, wid = tid >> 6; const int gw = bidx() * 8 + wid, nw = gdim() * 8;
    const float* X = (const float*)(p->ws + WS_X); bf16_t* HM = (bf16_t*)(p->ws + WS_HM);
    const float* g = j < 0 ? p->in[I_FNG] : p->in[I_NORMG] + (size_t)(l * 3 + j) * D;
    const bool from_in = (l == 0 && j == 0);
    for (int r = gw; r < MTOK; r += nw) {
        const float* xr = from_in ? (r < TCTX ? p->in[I_XP] + (size_t)r * D : p->in[I_XS] + (size_t)(r - TCTX) * D) : X + (size_t)r * D; f32x4 v[8]; float ss = 0.f;
#pragma unroll
        for (int i = 0; i < 8; ++i) { v[i] = *(const f32x4*)(xr + lane * 4 + i * 256); ss += v[i][0] * v[i][0] + v[i][1] * v[i][1] + v[i][2] * v[i][2] + v[i][3] * v[i][3]; }
#pragma unroll
        for (int o = 32; o >= 1; o >>= 1) ss += __shfl_xor(ss, o);
        const float rinv = rsqrtf(ss * (1.f / D) + EPS);
        if (j < 0) { float* o = p->out + OUT_Y + (size_t)r * D;
#pragma unroll
            for (int i = 0; i < 8; ++i) { const int c = lane * 4 + i * 256; const f32x4 gg = *(const f32x4*)(g + c); *(f32x4*)(o + c) = v[i] * rinv * gg; } }
        else { const float* mod = (const float*)(p->ws + WS_MOD) + (size_t)(l * 3 + cond_of_row(r)) * 18432; const float* sh = mod + (3 * j) * 2048; const float* scl = mod + (3 * j + 1) * 2048;
#pragma unroll
            for (int i = 0; i < 8; ++i) { const int c = lane * 4 + i * 256; const f32x4 gg = *(const f32x4*)(g + c), s1 = *(const f32x4*)(scl + c), s0 = *(const f32x4*)(sh + c);
                const f32x4 y = (v[i] * rinv * gg) * (s1 + 1.f) + s0; uint2 pk; pk.x = cvt_pk_bf16(y[0], y[1]); pk.y = cvt_pk_bf16(y[2], y[3]); *(uint2*)(HM + (size_t)r * D + c) = pk; } }
    }
}

__device__ __forceinline__ void seq_info(int s, int& L, int& row0) { if (s < 16) { L = 256; row0 = s * 256; } else { L = 1024; row0 = TCTX + (s - 16) * 1024; } }

#define WAVE_LDS_SYNC() asm volatile("s_waitcnt lgkmcnt(0)" ::: "memory")
__device__ __forceinline__ void s5_item(PP p, unsigned char* lds, int s, int d, int gg) {
    const int tid = tidx(), lane = tid & 63, wid = tid >> 6, fr = lane & 15, fq = lane >> 4; const int g = gg * 8 + wid;
    int L, row0; seq_info(s, L, row0);
    float* HS = (float*)(lds + wid * 8448);
    const bf16_t* PROJ = (const bf16_t*)(p->ws + WS_PROJ); float* Y = (float*)(p->ws + WS_YS5) + (size_t)d * MTOK * 1024;
    const int pg0 = (d * 64 + g) * 64, pg = pg0 + lane;
    const float lre = p->in[I_LAMRE][pg], lim = p->in[I_LAMIM][pg], dt = expf(p->in[I_LOGSTEP][d * 64 + g]);
    const float mag = expf(lre * dt); float sn, cs; sincosf(lim * dt, &sn, &cs);
    const float abr = mag * cs, abi = mag * sn, den = lre * lre + lim * lim, nre = abr - 1.f;
    const float fre = (nre * lre + abi * lim) / den, fim = (abi * lre - nre * lim) / den;
    bf16x8 af[8];
#pragma unroll
    for (int tq = 0; tq < 4; ++tq) { const int src = tq * 16 + fr; const float f_r = __shfl(fre, src), f_i = __shfl(fim, src);
        f32x4 r0 = (f32x4){0.f, 0.f, 0.f, 0.f}, r1 = r0, i0 = r0, i1 = r0;
        if (fq < 2) { const float* br = p->in[I_BRE] + (size_t)(pg0 + src) * 16 + fq * 8; const float* bi = p->in[I_BIM] + (size_t)(pg0 + src) * 16 + fq * 8;
            r0 = *(const f32x4*)br; r1 = *(const f32x4*)(br + 4); i0 = *(const f32x4*)bi; i1 = *(const f32x4*)(bi + 4); }
        af[tq] = pack8(r0 * f_r - i0 * f_i, r1 * f_r - i1 * f_i); af[tq + 4] = pack8(i0 * f_r + r0 * f_i, i1 * f_r + r1 * f_i); }
    bf16x8 cf[4];
#pragma unroll
    for (int kk = 0; kk < 4; ++kk) { const float* cp = (kk < 2 ? p->in[I_CRE] : p->in[I_CIM]) + ((size_t)(d * 64 + g) * 16 + fr) * 64 + (kk & 1) * 32 + fq * 8;
        f32x4 a = *(const f32x4*)cp, b = *(const f32x4*)(cp + 4); if (kk >= 2) { a = -a; b = -b; } cf[kk] = pack8(a, b); }
    float hr = 0.f, hi = 0.f;
    if (s >= 16) { const size_t o = ((size_t)((s - 16) * 2 + d) * 64 + g) * 64 + lane; hr = p->in[I_S5RE][o]; hi = p->in[I_S5IM][o]; }
    const f32x4 z4 = (f32x4){0.f, 0.f, 0.f, 0.f};
    bf16x8 un = (bf16x8){0, 0, 0, 0, 0, 0, 0, 0};
#define S5_LOADU(c0_) do { if (fq < 2) { const int row_ = row0 + (d ? L - 1 - ((c0_) + fr) : (c0_) + fr); un = *(const bf16x8*)(PROJ + (size_t)row_ * EVINP + g * 16 + fq * 8); } } while (0)
    S5_LOADU(0);
    __syncthreads();
    for (int c0 = 0; c0 < L; c0 += 16) {
        const bf16x8 ub = un;
        if (c0 + 16 < L) S5_LOADU(c0 + 16);
#pragma unroll
        for (int t8 = 0; t8 < 8; ++t8) { const f32x4 bu = __builtin_amdgcn_mfma_f32_16x16x32_bf16(af[t8], ub, z4, 0, 0, 0); *(f32x4*)(HS + fr * 132 + t8 * 16 + fq * 4) = bu; }
        WAVE_LDS_SYNC();
#pragma unroll
        for (int i = 0; i < 16; ++i) { const float bur = HS[i * 132 + lane], bui = HS[i * 132 + 64 + lane];
            const float nr = abr * hr - abi * hi + bur, ni = abr * hi + abi * hr + bui; hr = nr; hi = ni;
            HS[i * 132 + lane] = hr; HS[i * 132 + 64 + lane] = hi; }
        WAVE_LDS_SYNC();
        { f32x4 acc = z4;
#pragma unroll
          for (int kk = 0; kk < 4; ++kk) { const float* hp = HS + fr * 132 + kk * 32 + fq * 8; const bf16x8 hb = pack8(*(const f32x4*)hp, *(const f32x4*)(hp + 4));
              acc = __builtin_amdgcn_mfma_f32_16x16x32_bf16(cf[kk], hb, acc, 0, 0, 0); }
          const int row = row0 + (d ? L - 1 - (c0 + fr) : c0 + fr);
          *(f32x4*)(Y + (size_t)row * 1024 + g * 16 + fq * 4) = acc; }
        WAVE_LDS_SYNC();
    }
#undef S5_LOADU
    if (s < 16) { const size_t o = ((size_t)(s * 2 + d) * 64 + g) * 64 + lane; p->out[OUT_S5RE + o] = hr; p->out[OUT_S5IM + o] = hi; }
}

template <int NK32> __device__ __forceinline__ f32x4 mma_lds(f32x4 acc, const bf16_t* X, int ldx, const bf16_t* Y, int ldy, int lane) {
    const bf16_t* xp = X + (lane & 15) * ldx + (lane >> 4) * 8; const bf16_t* yp = Y + (lane & 15) * ldy + (lane >> 4) * 8;
#pragma unroll
    for (int kk = 0; kk < NK32; ++kk) acc = __builtin_amdgcn_mfma_f32_16x16x32_bf16(*(const bf16x8*)(xp + kk * 32), *(const bf16x8*)(yp + kk * 32), acc, 0, 0, 0);
    return acc;
}

__device__ __forceinline__ void gla_item(PP p, unsigned char* lds, int s, int h, int d, int vh) {
    const int tid = tidx(), lane = tid & 63, wid = tid >> 6, fr = lane & 15, fq = lane >> 4;
    int L, row0; seq_info(s, L, row0);
    bf16_t* QT = (bf16_t*)(lds);
    bf16_t* KT = (bf16_t*)(lds + 17408);
    bf16_t* KE = (bf16_t*)(lds + 34816);
    bf16_t* VT = (bf16_t*)(lds + 53248);
    bf16_t* ATT = (bf16_t*)(lds + 71680);
    bf16_t* ST = (bf16_t*)(lds + 80896);
    float* LOGA = (float*)(lds + 80896);
    float* SEG = (float*)(lds + 115712);
    float* GLR = (float*)(lds + 117760);
    float* W2S = (float*)(lds + 121856);
    float* GBS = (float*)(lds + 130048);
    float* DEC = (float*)(lds + 130560);
    const bf16_t* PROJ = (const bf16_t*)(p->ws + WS_PROJ); float* O = (float*)(p->ws + WS_OGLA) + (size_t)d * MTOK * 1024;
    __syncthreads();
    for (int i = tid; i < 16 * 128; i += 512) W2S[i] = p->in[I_GW2][(size_t)(d * 16 + (i >> 7)) * 512 + h * 128 + (i & 127)];
    if (tid < 128) GBS[tid] = p->in[I_GB][d * 512 + h * 128 + tid];
    f32x4 sacc[8];
#pragma unroll
    for (int tn = 0; tn < 8; ++tn) { sacc[tn] = (f32x4){0.f, 0.f, 0.f, 0.f};
        if (s >= 16) { const float* sp = p->in[I_SGLA] + ((size_t)(((s - 16) * 2 + d) * 4 + h) * 128 + wid * 16 + fq * 4) * 256 + vh * 128 + tn * 16 + fr;
#pragma unroll
            for (int e = 0; e < 4; ++e) sacc[tn][e] = sp[(size_t)e * 256]; } }
    const float qscale = 0.08838834764831845f;
    const int nch = L >> 6;
    const int c = tid & 127, ig = tid >> 7;
#define GROW(n_, i) (row0 + (d ? L - 1 - ((n_) * 64 + (i)) : (n_) * 64 + (i)))
    f32x4 glr4 = (f32x4){0.f, 0.f, 0.f, 0.f}; float qv[16], kv[16], vv[16];
#define GLA_PREFETCH(n_) do { \
        if (tid < 256) glr4 = unpack4(*(const uint2*)(PROJ + (size_t)GROW(n_, tid >> 2) * EVINP + 4096 + d * 16 + (tid & 3) * 4)); \
        _Pragma("unroll") for (int ii = 0; ii < 16; ++ii) { const size_t ro = (size_t)GROW(n_, ig * 16 + ii) * EVINP; \
            qv[ii] = bf2f_(PROJ[ro + 1024 + h * 128 + c]); kv[ii] = bf2f_(PROJ[ro + 1536 + h * 128 + c]); vv[ii] = bf2f_(PROJ[ro + 2048 + h * 256 + vh * 128 + c]); } } while (0)
    GLA_PREFETCH(0);
    for (int n = 0; n < nch; ++n) {
        __syncthreads();
        if (tid < 256) *(f32x4*)(GLR + (tid >> 2) * 16 + (tid & 3) * 4) = glr4;
        __syncthreads();
        { float run = 0.f; const float gb = GBS[c];
          float w2[16];
#pragma unroll
          for (int r = 0; r < 16; ++r) w2[r] = W2S[r * 128 + c];
          for (int ii = 0; ii < 16; ++ii) { const int i = ig * 16 + ii; float z = gb;
#pragma unroll
              for (int q = 0; q < 4; ++q) { const f32x4 g4 = *(const f32x4*)(GLR + i * 16 + q * 4);
#pragma unroll
                  for (int e = 0; e < 4; ++e) z += g4[e] * w2[q * 4 + e]; }
              run -= (fmaxf(-z, 0.f) + __logf(1.f + __expf(-fabsf(z)))) * (1.f / 16.f); LOGA[i * 128 + c] = run; }
          SEG[ig * 128 + c] = run; }
        __syncthreads();
        { float pre = 0.f, tot = 0.f;
#pragma unroll
          for (int q = 0; q < 4; ++q) { const float sg = SEG[q * 128 + c]; tot += sg; if (q < ig) pre += sg; }
          if (ig == 0) DEC[c] = __expf(tot);
#pragma unroll
          for (int ii = 0; ii < 16; ++ii) { const int i = ig * 16 + ii; const float bc = LOGA[i * 128 + c] + pre;
              QT[i * 136 + c] = f2bf(qv[ii] * qscale * __expf(bc)); KT[i * 136 + c] = f2bf(kv[ii] * __expf(-bc)); KE[c * 72 + i] = f2bf(kv[ii] * __expf(tot - bc)); VT[c * 72 + i] = f2bf(vv[ii]); } }
        __syncthreads();
        if (n + 1 < nch) GLA_PREFETCH(n + 1);
#pragma unroll
        for (int q = 0; q < 2; ++q) { const int tile = wid * 2 + q, ti = tile >> 2, tj = tile & 3; f32x4 a = (f32x4){0.f, 0.f, 0.f, 0.f};
            if (tj <= ti) a = mma_lds<4>(a, QT + ti * 16 * 136, 136, KT + tj * 16 * 136, 136, lane);
#pragma unroll
            for (int e = 0; e < 4; ++e) { const int i = ti * 16 + fq * 4 + e, jx = tj * 16 + fr; ATT[i * 72 + jx] = f2bf(jx <= i ? a[e] : 0.f); } }
#pragma unroll
        for (int tn = 0; tn < 8; ++tn) { uint2 pk; pk.x = cvt_pk_bf16(sacc[tn][0], sacc[tn][1]); pk.y = cvt_pk_bf16(sacc[tn][2], sacc[tn][3]); *(uint2*)(ST + (tn * 16 + fr) * 136 + wid * 16 + fq * 4) = pk; }
        __syncthreads();
#pragma unroll
        for (int ti = 0; ti < 4; ++ti) { f32x4 o = (f32x4){0.f, 0.f, 0.f, 0.f};
            o = mma_lds<2>(o, ATT + ti * 16 * 72, 72, VT + wid * 16 * 72, 72, lane);
            o = mma_lds<4>(o, QT + ti * 16 * 136, 136, ST + wid * 16 * 136, 136, lane);
#pragma unroll
            for (int e = 0; e < 4; ++e) { const int i = ti * 16 + fq * 4 + e; O[(size_t)GROW(n, i) * 1024 + h * 256 + vh * 128 + wid * 16 + fr] = o[e]; } }
        { f32x4 dc;
#pragma unroll
          for (int e = 0; e < 4; ++e) dc[e] = DEC[wid * 16 + fq * 4 + e];
#pragma unroll
          for (int tn = 0; tn < 8; ++tn) { sacc[tn] = sacc[tn] * dc; sacc[tn] = mma_lds<2>(sacc[tn], KE + wid * 16 * 72, 72, VT + tn * 16 * 72, 72, lane); } }
    }
#undef GROW
#undef GLA_PREFETCH
    if (s < 16) {
#pragma unroll
        for (int tn = 0; tn < 8; ++tn) { float* sp = p->out + OUT_GLA + ((size_t)((s * 2 + d) * 4 + h) * 128 + wid * 16 + fq * 4) * 256 + vh * 128 + tn * 16 + fr;
#pragma unroll
            for (int e = 0; e < 4; ++e) sp[(size_t)e * 256] = sacc[tn][e]; } }
}

__device__ void phase_s5gla(PP p, LAS unsigned char* ldsr) {
    unsigned char* lds = (unsigned char*)ldsr; const int bid = bidx(), nb = gdim();
    if (nb >= 64) {
        if (bid < 32) { gla_item(p, lds, 16 + (bid >> 4), (bid >> 2) & 3, (bid >> 1) & 1, bid & 1); return; }
        for (int it = bid - 32; it < 544; it += nb - 32) {
            if (it < 32) s5_item(p, lds, 16 + (it >> 4), (it >> 3) & 1, it & 7);
            else if (it < 288) { const int q = it - 32; s5_item(p, lds, q >> 4, (q >> 3) & 1, q & 7); }
            else { const int q = it - 288; gla_item(p, lds, q >> 4, (q >> 2) & 3, (q >> 1) & 1, q & 1); }
        }
    } else {
        for (int it = bid; it < 576; it += nb) {
            if (it < 32) { gla_item(p, lds, 16 + (it >> 4), (it >> 2) & 3, (it >> 1) & 1, it & 1); }
            else if (it < 64) { const int q = it - 32; s5_item(p, lds, 16 + (q >> 4), (q >> 3) & 1, q & 7); }
            else if (it < 320) { const int q = it - 64; s5_item(p, lds, q >> 4, (q >> 3) & 1, q & 7); }
            else { const int q = it - 320; gla_item(p, lds, q >> 4, (q >> 2) & 3, (q >> 1) & 1, q & 1); }
        }
    }
}

__device__ void phase_evpost(PP p) {
    const int tid = tidx(), lane = tid & 63, wid = tid >> 6; const int gw = bidx() * 8 + wid, nw = gdim() * 8;
    const bf16_t* PROJ = (const bf16_t*)(p->ws + WS_PROJ); const float* Y0 = (const float*)(p->ws + WS_YS5); const float* Y1 = Y0 + (size_t)MTOK * 1024;
    const float* O0 = (const float*)(p->ws + WS_OGLA); const float* O1 = O0 + (size_t)MTOK * 1024;
    bf16_t* YSB = (bf16_t*)(p->ws + WS_YSB); bf16_t* CAT = (bf16_t*)(p->ws + WS_CAT);
    for (int r = gw; r < MTOK; r += nw) {
#pragma unroll
        for (int i = 0; i < 4; ++i) { const int c = lane * 4 + i * 256; const f32x4 y0 = *(const f32x4*)(Y0 + (size_t)r * 1024 + c), y1 = *(const f32x4*)(Y1 + (size_t)r * 1024 + c);
            const f32x4 u = unpack4(*(const uint2*)(PROJ + (size_t)r * EVINP + c)), dd = *(const f32x4*)(p->in[I_S5D] + c); f32x4 v = y0 + y1 + dd * u;
#pragma unroll
            for (int e = 0; e < 4; ++e) v[e] = geluf_(v[e]);
            uint2 pk; pk.x = cvt_pk_bf16(v[0], v[1]); pk.y = cvt_pk_bf16(v[2], v[3]); *(uint2*)(YSB + (size_t)r * 1024 + c) = pk; }
        { const int c0 = lane * 16; f32x4 o[4]; float ss = 0.f;
#pragma unroll
          for (int i = 0; i < 4; ++i) { o[i] = *(const f32x4*)(O0 + (size_t)r * 1024 + c0 + i * 4) + *(const f32x4*)(O1 + (size_t)r * 1024 + c0 + i * 4); ss += o[i][0] * o[i][0] + o[i][1] * o[i][1] + o[i][2] * o[i][2] + o[i][3] * o[i][3]; }
#pragma unroll
          for (int m = 8; m >= 1; m >>= 1) ss += __shfl_xor(ss, m);
          const float rinv = rsqrtf(ss * (1.f / 256.f) + EPS);
#pragma unroll
          for (int i = 0; i < 4; ++i) { const int c = c0 + i * 4; const f32x4 ng = *(const f32x4*)(p->in[I_GNG] + (c & 255)), gt = unpack4(*(const uint2*)(PROJ + (size_t)r * EVINP + 3072 + c)); f32x4 v;
#pragma unroll
              for (int e = 0; e < 4; ++e) v[e] = o[i][e] * rinv * ng[e] * siluf_(gt[e]);
              uint2 pk; pk.x = cvt_pk_bf16(v[0], v[1]); pk.y = cvt_pk_bf16(v[2], v[3]); *(uint2*)(CAT + (size_t)r * D + 1024 + c) = pk; } }
    }
}

__device__ void phase_conv(PP p) {
    const bf16_t* PROJ = (const bf16_t*)(p->ws + WS_PROJ); bf16_t* XCB = (bf16_t*)(p->ws + WS_XCB);
    const float* cw = p->in[I_CONVW]; const float* cb = p->in[I_CONVB];
    const size_t total = (size_t)MTOK * 512;
    { const int gi = bidx() * 512 + tidx(); if (gi < 2 * D) ((float*)(p->ws + WS_SP))[gi] = -8.f * softplusf_(-p->in[I_LLAM][gi]); }
    for (size_t i = (size_t)bidx() * 512 + tidx(); i < total; i += (size_t)gdim() * 512) {
        const int r = (int)(i >> 9), c = (int)(i & 511) * 4; const int seg = r < TCTX ? 256 : 64; const int pos = r & (seg - 1);
        f32x4 acc = *(const f32x4*)(cb + c);
#pragma unroll
        for (int j = 0; j < 4; ++j) { const int pp = pos + j - 2; if (pp >= 0 && pp < seg) acc += *(const f32x4*)(cw + j * D + c) * unpack4(*(const uint2*)(PROJ + (size_t)(r + j - 2) * 4096 + 2048 + c)); }
        uint2 pk; pk.x = cvt_pk_bf16(acc[0], acc[1]); pk.y = cvt_pk_bf16(acc[2], acc[3]); *(uint2*)(XCB + (size_t)r * D + c) = pk;
    }
}
__device__ void phase_lruscan1(PP p) {
    const int tid = tidx(), lane = tid & 63, wid = tid >> 6; const int nb = gdim();
    float* SUM = (float*)(p->ws + WS_LSUM);
    for (int it = bidx() * 8 + wid; it < 384 * 64; it += 8 * nb) {
        const int q = it >> 6, d = (it >> 5) & 1, c = (it & 31) * 64 + lane; const int row0 = q * 16;
        const unsigned* LAB = (const unsigned*)(p->ws + WS_LA) + ((size_t)d * MTOK + row0) * D + c;
        unsigned wv[16];
#pragma unroll
        for (int j = 0; j < 16; ++j) wv[j] = LAB[(size_t)j * D];
        float S = 0.f, h = 0.f;
        if (d == 0) {
#pragma unroll
            for (int j = 0; j < 16; ++j) { const float la = lo_bf(wv[j]); h = __expf(la) * h + hi_bf(wv[j]); S += la; } }
        else {
#pragma unroll
            for (int j = 15; j >= 0; --j) { const float la = lo_bf(wv[j]); h = __expf(la) * h + hi_bf(wv[j]); S += la; } }
        SUM[((size_t)d * 384 + q) * D + c] = __expf(S); SUM[((size_t)(2 + d) * 384 + q) * D + c] = h;
    }
}
__device__ void phase_lruscan2(PP p) {
    const int tid = tidx(), lane = tid & 63, wid = tid >> 6; const int nb = gdim();
    const float* SUM = (const float*)(p->ws + WS_LSUM); const bf16_t* PROJ = (const bf16_t*)(p->ws + WS_PROJ); bf16_t* CAT = (bf16_t*)(p->ws + WS_CAT);
    for (int it0 = bidx() * 8 + wid; it0 < 384 * 32; it0 += 8 * nb) {
        const int it = it0 < 128 * 32 ? it0 + 256 * 32 : it0 - 128 * 32;
        const int q = it >> 5, c = (it & 31) * 64 + lane; const int row0 = q * 16;
        int qs, ql, s; if (q < 256) { s = q >> 4; qs = s * 16; ql = qs + 15; } else { s = 16 + ((q - 256) >> 6); qs = 256 + (s - 16) * 64; ql = qs + 63; }
        float h0 = 0.f, h1 = 0.f;
        if (s >= 16) { h0 = p->in[I_SLRU][(size_t)((s - 16) * 2 + 0) * D + c]; h1 = p->in[I_SLRU][(size_t)((s - 16) * 2 + 1) * D + c]; }
        const float* P0 = SUM + c; const float* H0 = SUM + (size_t)2 * 384 * D + c; const float* P1 = SUM + (size_t)384 * D + c; const float* H1 = SUM + (size_t)3 * 384 * D + c;
        { int j = qs;
          for (; j + 8 <= q; j += 8) { float pv[8], hv[8];
#pragma unroll
              for (int e = 0; e < 8; ++e) { pv[e] = P0[(size_t)(j + e) * D]; hv[e] = H0[(size_t)(j + e) * D]; }
#pragma unroll
              for (int e = 0; e < 8; ++e) h0 = pv[e] * h0 + hv[e]; }
          for (; j < q; ++j) h0 = P0[(size_t)j * D] * h0 + H0[(size_t)j * D]; }
        { int j = ql;
          for (; j - 8 >= q; j -= 8) { float pv[8], hv[8];
#pragma unroll
              for (int e = 0; e < 8; ++e) { pv[e] = P1[(size_t)(j - e) * D]; hv[e] = H1[(size_t)(j - e) * D]; }
#pragma unroll
              for (int e = 0; e < 8; ++e) h1 = pv[e] * h1 + hv[e]; }
          for (; j > q; --j) h1 = P1[(size_t)j * D] * h1 + H1[(size_t)j * D]; }
        const unsigned* W0 = (const unsigned*)(p->ws + WS_LA) + (size_t)row0 * D + c; const unsigned* W1 = W0 + (size_t)MTOK * D; const bf16_t* GT = PROJ + (size_t)row0 * 4096 + c;
        unsigned w0[16], w1[16]; float b0[16], gt[16];
#pragma unroll
        for (int j = 0; j < 16; ++j) { w0[j] = W0[(size_t)j * D]; w1[j] = W1[(size_t)j * D]; gt[j] = bf2f_(GT[(size_t)j * 4096]); }
#pragma unroll
        for (int j = 0; j < 16; ++j) { h0 = __expf(lo_bf(w0[j])) * h0 + hi_bf(w0[j]); b0[j] = h0; }
#pragma unroll
        for (int j = 15; j >= 0; --j) { h1 = __expf(lo_bf(w1[j])) * h1 + hi_bf(w1[j]); CAT[(size_t)(row0 + j) * D + c] = f2bf((b0[j] + h1) * geluf_(gt[j])); }
        if (s < 16) { if (q == ql) p->out[OUT_LRU + (size_t)(s * 2 + 0) * D + c] = h0; if (q == qs) p->out[OUT_LRU + (size_t)(s * 2 + 1) * D + c] = h1; }
    }
}

#ifndef PHMASK
#define PHMASK 0xFFFFFFFFu
#endif
#define PHON(k) ((PHMASK >> (k)) & 1u)
#ifndef DUPMASK
#define DUPMASK 0u
#endif
enum { K_PREP = 0, K_NORM, K_SWIGLU, K_RESID, K_F32, K_S5GLA, K_EVPOST, K_GLU, K_CONV, K_LRUG, K_LRUSCAN, K_LRUCOMB };
__global__ void __launch_bounds__(512, 2) mega(Params p) {
    extern __shared__ __attribute__((aligned(16))) unsigned char shm[];
    LAS unsigned char* lds = (LAS unsigned char*)shm;
    cg::grid_group grid = cg::this_grid();
    const int ph_lo = p.ph_lo, ph_hi = p.ph_hi;
    int rep = 0;
    volatile LAS unsigned* bst = (volatile LAS unsigned*)(lds + LDS_MAIN);
    if (threadIdx.x < 16) bst[threadIdx.x] = 0u;
    __syncthreads();
    XcdBarrier xbar = xcd_barrier_post((unsigned*)(p.ws + WS_BAR), bst);
    for (int ph = ph_lo; ph < ph_hi; ++ph) {
        PP pp = get_pp();
        unsigned char* ws = pp->ws;
        const float* MOD = (const float*)(ws + WS_MOD);
        int kind, l = 0, a0 = 0;
        if (ph == 0) kind = K_PREP;
        else if (ph == 26) { kind = K_NORM; a0 = -1; }
        else { l = ph > 12 ? 1 : 0; const int q = ph - 1 - 12 * l;
            if (q == 0) { kind = K_NORM; a0 = 0; }
            else if (q == 1) { kind = K_SWIGLU; a0 = 0; }
            else if (q == 2) { kind = K_RESID; a0 = 0; }
            else if (q == 3) { kind = K_NORM; a0 = 1; }
            else if (q == 4) kind = K_F32;
            else if (l == 0) { if (q == 5) kind = K_S5GLA; else if (q == 6) kind = K_EVPOST; else if (q == 7) kind = K_GLU; else if (q == 8) { kind = K_RESID; a0 = 2; } else if (q == 9) { kind = K_NORM; a0 = 2; } else if (q == 10) { kind = K_SWIGLU; a0 = 1; } else { kind = K_RESID; a0 = 1; } }
            else { if (q == 5) kind = K_CONV; else if (q == 6) kind = K_LRUG; else if (q == 7) kind = K_LRUSCAN; else if (q == 8) kind = K_LRUCOMB; else if (q == 9) { kind = K_RESID; a0 = 2; } else if (q == 10) { kind = K_NORM; a0 = 2; } else if (q == 11) { kind = K_SWIGLU; a0 = 1; } else { kind = K_RESID; a0 = 1; } }
        }
        const bf16_t* HM = (const bf16_t*)(ws + WS_HM);
        if (kind == K_PREP) { if (PHON(0)) phase_prep(pp, lds, rep); }
        else if (kind == K_NORM) { if (PHON(1)) phase_norm(pp, l, a0); }
        else if (kind == K_SWIGLU) { if (PHON(2)) { EpiSwiglu E{(bf16_t*)(ws + WS_H)}; pg8::gemm_phase<EpiSwiglu, false>(lds, HM, D, (const bf16_t*)(ws + WS_WFI) + (size_t)(l * 2 + a0) * 11264 * 2048, D, 24, 44, D, E); if (!rep) bg_convert(pp, lds, ph); } }
        else if (kind == K_RESID) { if (PHON(3)) {
            const bf16_t* A; const bf16_t* B; int K; int gj; float coef;
            if (a0 < 2) { A = (const bf16_t*)(ws + WS_H); B = (const bf16_t*)(ws + WS_WFO) + (size_t)(l * 2 + a0) * 2048 * 5632; K = DFF; gj = a0 == 0 ? 2 : 8; coef = 0.5f; }
            else { A = (const bf16_t*)(ws + WS_CAT); B = (const bf16_t*)(ws + (l == 0 ? WS_WEO : WS_WOO)); K = D; gj = 5; coef = 1.0f; }
            const bool first = (ph == 3);
            const float* xc_ = first ? pp->in[I_XP] : (const float*)(ws + WS_X); const float* xl_ = first ? pp->in[I_XS] - (size_t)TCTX * D : (const float*)(ws + WS_X);
            EpiResid E{(float*)(ws + WS_X), MOD + (size_t)(l * 3) * 18432 + gj * 2048, coef, xc_, xl_}; pg8::gemm_phase<EpiResid, false>(lds, A, K, B, K, 24, 8, K, E); if (!rep) bg_convert(pp, lds, ph); } }
        else if (kind == K_F32) { if (PHON(4)) {
            { const int nN = l == 0 ? 17 : 16; EpiBf16 E{(bf16_t*)(ws + WS_PROJ), nN * 256}; pg8::gemm_phase<EpiBf16, false>(lds, HM, D, (const bf16_t*)(ws + (l == 0 ? WS_WEI : WS_WOI)), D, 24, nN, D, E); }
            if (!rep) bg_convert(pp, lds, ph); } }
        else if (kind == K_S5GLA) { if (PHON(5)) { phase_s5gla(pp, lds); if (!rep) bg_convert(pp, lds, ph); } }
        else if (kind == K_EVPOST) { if (PHON(6)) phase_evpost(pp); }
        else if (kind == K_GLU) { if (PHON(7)) { EpiGlu E{(bf16_t*)(ws + WS_CAT), (const bf16_t*)(ws + WS_YSB), pp->in[I_GLUB]}; pg8::gemm_phase<EpiGlu, false>(lds, (const bf16_t*)(ws + WS_YSB), 1024, (const bf16_t*)(ws + WS_WGLU), 1024, 24, 4, 1024, E); if (!rep) bg_convert(pp, lds, ph); } }
        else if (kind == K_CONV) { if (PHON(8)) phase_conv(pp); }
        else if (kind == K_LRUG) { if (PHON(9)) { EpiLru E{(unsigned*)(ws + WS_LA), (const bf16_t*)(ws + WS_XCB), pp->in[I_LBA], pp->in[I_LBX], (const float*)(ws + WS_SP)};
            int kk = 256; asm volatile("" : "+s"(kk));
            pg8::gemm_phase<EpiLru, true>(lds, (const bf16_t*)(ws + WS_XCB), D, (const bf16_t*)(ws + WS_WLRU), kk, 24, 32, kk, E); } }
        else if (kind == K_LRUSCAN) { if (PHON(10)) phase_lruscan1(pp); }
        else { if (PHON(11)) phase_lruscan2(pp); }
#if DUPMASK
        if (rep == 0 && ((DUPMASK >> kind) & 1u)) { xcd_barrier(xbar); rep = 1; --ph; continue; }
        rep = 0;
#endif
        if (ph + 1 < ph_hi) { if (ph == 0) grid.sync(); else xcd_barrier(xbar); }
    }
}

extern "C" void kernel_launch(void* const* d_in, const int* in_sizes, int n_in, void* d_out, int out_size, void* d_ws, size_t ws_size, hipStream_t stream) {
    static int grid = 0;
    if (grid == 0) {
        if (n_in != 38 || ws_size < WS_END) { fprintf(stderr, "kernel_launch: expected 38 inputs and >= %zu bytes of workspace (got %d, %zu)\n", (size_t)WS_END, n_in, ws_size); grid = -1; return; }
        int dev = 0, cus = 0, per_cu = 0;
        hipGetDevice(&dev); hipDeviceGetAttribute(&cus, hipDeviceAttributeMultiprocessorCount, dev);
        hipFuncSetAttribute((const void*)mega, hipFuncAttributeMaxDynamicSharedMemorySize, LDS_BYTES);
        hipOccupancyMaxActiveBlocksPerMultiprocessor(&per_cu, (const void*)mega, 512, LDS_BYTES);
        if (per_cu < 1) { fprintf(stderr, "kernel_launch: occupancy query says %d blocks per CU\n", per_cu); grid = -1; return; }
        grid = cus;
    }
    if (grid < 0) return;
    (void)hipMemsetAsync((char*)d_ws + WS_MOD, 0, ZERO_BYTES, stream);
    Params p{};
    for (int i = 0; i < 38; ++i) p.in[i] = (const float*)d_in[i];
    p.out = (float*)d_out; p.ws = (unsigned char*)d_ws;
#if MEGA
    p.ph_lo = 0; p.ph_hi = NPH;
    void* args[] = {&p};
    hipError_t e = hipLaunchCooperativeKernel((const void*)mega, dim3(grid), dim3(512), args, LDS_BYTES, stream);
    if (e != hipSuccess) fprintf(stderr, "cooperative launch failed: %s (grid %d)\n", hipGetErrorString(e), grid);
#else
    for (int ph = 0; ph < NPH; ++ph) { p.ph_lo = ph; p.ph_hi = ph + 1; hipLaunchKernelGGL(mega, dim3(grid), dim3(512), LDS_BYTES, stream, p); }
#endif
}
```

```cpp
#include <hip/hip_runtime.h>
#include <hip/hip_cooperative_groups.h>
#include <cstdio>
namespace cg = cooperative_groups;

#ifndef MEGA
#define MEGA 1
#endif

#define LAS __attribute__((address_space(3)))
typedef unsigned short bf16_t;
typedef short bf16x8 __attribute__((ext_vector_type(8)));
typedef float f32x4 __attribute__((ext_vector_type(4)));
typedef float f32x2 __attribute__((ext_vector_type(2)));

constexpr int D = 2048, DFF = 5632, MTOK = 6144, TCTX = 4096;
constexpr int EVINP = 4352;
constexpr int NPH = 27;
constexpr int LDS_MAIN = 131072;
constexpr int LDS_BYTES = LDS_MAIN + 64;
constexpr float EPS = 1e-6f;

constexpr size_t al256(size_t x) { return (x + 255) & ~(size_t)255; }
constexpr size_t WS_MOD = 0;
constexpr size_t MOD_BYTES = (size_t)2 * 3 * 9 * 2048 * 4;
constexpr size_t WS_BAR = al256(WS_MOD + MOD_BYTES);
constexpr size_t BAR_BYTES = 3456 * 4;
constexpr size_t ZERO_BYTES = WS_BAR + BAR_BYTES;
constexpr size_t WS_X = al256(WS_BAR + BAR_BYTES);
constexpr size_t WS_HM = WS_X + (size_t)MTOK * D * 4;
constexpr size_t WS_H = WS_HM + (size_t)MTOK * D * 2;
constexpr size_t WS_PROJ = WS_H + (size_t)MTOK * DFF * 2;
constexpr size_t WS_WFI = WS_PROJ + (size_t)MTOK * EVINP * 4;
constexpr size_t WS_WFO = WS_WFI + (size_t)4 * 11264 * 2048 * 2;
constexpr size_t WS_WEI = WS_WFO + (size_t)4 * 2048 * 5632 * 2;
constexpr size_t WS_WEO = WS_WEI + (size_t)EVINP * 2048 * 2;
constexpr size_t WS_WGLU = WS_WEO + (size_t)2048 * 2048 * 2;
constexpr size_t WS_WOI = WS_WGLU + (size_t)1024 * 1024 * 2;
constexpr size_t WS_WOO = WS_WOI + (size_t)4096 * 2048 * 2;
constexpr size_t WS_WLRU = WS_WOO + (size_t)2048 * 2048 * 2;
constexpr size_t WS_YS5 = WS_WLRU + (size_t)2 * 8 * 2 * 256 * 256 * 2;
constexpr size_t WS_OGLA = WS_YS5 + (size_t)2 * MTOK * 1024 * 4;
constexpr size_t WS_YS32 = WS_OGLA + (size_t)2 * MTOK * 1024 * 4;
constexpr size_t WS_YSB = WS_YS32 + (size_t)MTOK * 1024 * 4;
constexpr size_t WS_CAT = WS_YSB + (size_t)MTOK * 1024 * 2;
constexpr size_t WS_XC32 = WS_CAT + (size_t)MTOK * D * 2;
constexpr size_t WS_XCB = WS_XC32 + (size_t)MTOK * D * 4;
constexpr size_t WS_LA = WS_XCB + (size_t)MTOK * D * 2;
constexpr size_t WS_LB = WS_LA + (size_t)2 * MTOK * D * 4;
constexpr size_t WS_SP = WS_LB + (size_t)2 * MTOK * D * 4;
constexpr size_t WS_LSUM = WS_SP + (size_t)2 * D * 4;
constexpr size_t WS_END = WS_LSUM + (size_t)2 * 2 * 384 * D * 4;

constexpr size_t OUT_Y = 0;
constexpr size_t OUT_S5RE = (size_t)MTOK * D;
constexpr size_t OUT_S5IM = OUT_S5RE + 16 * 2 * 64 * 64;
constexpr size_t OUT_GLA = OUT_S5IM + 16 * 2 * 64 * 64;
constexpr size_t OUT_LRU = OUT_GLA + (size_t)16 * 2 * 4 * 128 * 256;

struct Params { const float* in[38]; float* out; unsigned char* ws; int ph_lo, ph_hi; };
typedef const __attribute__((address_space(4))) Params* PP;
__device__ __forceinline__ int tidx() { int t = threadIdx.x; asm volatile("" : "+v"(t)); return t; }
__device__ __forceinline__ int bidx() { int b = blockIdx.x; asm volatile("" : "+s"(b)); return b; }
__device__ __forceinline__ int gdim() { int g = gridDim.x; asm volatile("" : "+s"(g)); return g; }
__device__ __forceinline__ PP get_pp() { PP kp = (PP)__builtin_amdgcn_kernarg_segment_ptr(); asm volatile("" : "+s"(kp)); return kp; }
enum { I_XP = 0, I_XS, I_S5RE, I_S5IM, I_SGLA, I_SLRU, I_C, I_CCTX, I_NORMG, I_ADAW, I_ADAB, I_FWI, I_FWO, I_FNG, I_EVWI, I_EVWO,
       I_LAMRE, I_LAMIM, I_LOGSTEP, I_BRE, I_BIM, I_CRE, I_CIM, I_S5D, I_GLUW, I_GLUB, I_GW2, I_GB, I_GNG, I_ODWI, I_ODWO,
       I_CONVW, I_CONVB, I_LWA, I_LBA, I_LWX, I_LBX, I_LLAM };

__device__ __forceinline__ unsigned cvt_pk_bf16(float lo, float hi) { unsigned r; asm("v_cvt_pk_bf16_f32 %0, %1, %2" : "=v"(r) : "v"(lo), "v"(hi)); return r; }
__device__ __forceinline__ bf16_t f2bf(float x) { return (bf16_t)(cvt_pk_bf16(x, 0.f) & 0xffffu); }
__device__ __forceinline__ float bf2f_(bf16_t v) { return __builtin_bit_cast(float, (unsigned)v << 16); }
__device__ __forceinline__ float lo_bf(unsigned w) { return __builtin_bit_cast(float, w << 16); }
__device__ __forceinline__ float hi_bf(unsigned w) { return __builtin_bit_cast(float, w & 0xffff0000u); }
__device__ __forceinline__ f32x4 unpack4(uint2 w) { return (f32x4){lo_bf(w.x), hi_bf(w.x), lo_bf(w.y), hi_bf(w.y)}; }
__device__ __forceinline__ float sigmoidf_(float x) { return __builtin_amdgcn_rcpf(1.f + __expf(-x)); }
__device__ __forceinline__ float siluf_(float x) { return x * __builtin_amdgcn_rcpf(1.f + __expf(-x)); }
__device__ __forceinline__ float geluf_(float x) { return x * sigmoidf_(1.5957691216f * (x + 0.044715f * x * x * x)); }
__device__ __forceinline__ float softplusf_(float x) { return fmaxf(x, 0.f) + log1pf(__expf(-fabsf(x))); }
__device__ __forceinline__ float neg_expm1_(float x) {
    const float pl = -x * (1.f + x * (0.5f + x * (0.16666667f + x * (0.041666668f + x * (0.0083333338f + x * 0.0013888889f))))); return x > -0.25f ? pl : 1.f - __expf(x); }
__device__ __forceinline__ int cond_of_pm(int pm) { return pm < 16 ? 0 : 1 + ((pm - 16) >> 2); }
__device__ __forceinline__ int cond_of_row(int r) { return r < TCTX ? 0 : 1 + ((r - TCTX) >> 10); }
__device__ __forceinline__ bf16x8 pack8(f32x4 a, f32x4 b) {
    typedef unsigned u32x4 __attribute__((ext_vector_type(4)));
    u32x4 u; u[0] = cvt_pk_bf16(a[0], a[1]); u[1] = cvt_pk_bf16(a[2], a[3]); u[2] = cvt_pk_bf16(b[0], b[1]); u[3] = cvt_pk_bf16(b[2], b[3]);
    return __builtin_bit_cast(bf16x8, u);
}

#define XB_TMO      128
#define XB_XCNT(j)  (256  + 64 * (j))
#define XB_XSUB(j)  (1280 + 64 * (j))
#define XB_XGEN(j)  (2304 + 64 * (j))
#define XB_TOP      3328
#define XB_TOPGEN   3392
#define XCD_BAR_WORDS 3456
#define XB_SPIN_CAP (1u << 18)

__device__ __forceinline__ unsigned xb_ld(unsigned* p)              { return __hip_atomic_load(p, __ATOMIC_RELAXED, __HIP_MEMORY_SCOPE_AGENT); }
__device__ __forceinline__ unsigned xb_add(unsigned* p, unsigned v) { return __hip_atomic_fetch_add(p, v, __ATOMIC_RELAXED, __HIP_MEMORY_SCOPE_AGENT); }
__device__ __forceinline__ unsigned xb_xcc_id() { return (unsigned)__builtin_amdgcn_s_getreg((3 << 11) | 20) & 0xFu; }
#define XB_SPIN(cond, bar) do { unsigned _sp = 0; while (cond) { __builtin_amdgcn_s_sleep(1); \
    if ((++_sp & 255u) == 0u) { if (xb_ld(&(bar)[XB_TMO])) break; if (_sp > XB_SPIN_CAP) { atomicAdd(&(bar)[XB_TMO], 1u); break; } } } } while (0)

struct XcdBarrier {
    unsigned* bar; unsigned x;
    volatile LAS unsigned* st;
};

__device__ __forceinline__ XcdBarrier xcd_barrier_post(unsigned* bar, volatile LAS unsigned* st) {
    XcdBarrier b; b.bar = bar; b.x = xb_xcc_id(); b.st = st;
    if (threadIdx.x == 0) (void)xb_add(&bar[XB_XCNT(b.x)], 1u);
    return b;
}
__device__ __forceinline__ void xcd_barrier_complete(unsigned* bar, unsigned x, unsigned& nloc, unsigned& nx) {
    const unsigned G = gridDim.x * gridDim.y * gridDim.z;
    unsigned sum, cnt, mine, sp = 0u;
    for (;;) {
        sum = 0u; cnt = 0u; mine = 0u;
#pragma unroll
        for (unsigned j = 0; j < 16; ++j) { const unsigned c = xb_ld(&bar[XB_XCNT(j)]); sum += c; cnt += (c > 0u) ? 1u : 0u; mine = (j == x) ? c : mine; }
        if (sum == G) break;
        __builtin_amdgcn_s_sleep(1);
        if ((++sp & 255u) == 0u) { if (xb_ld(&bar[XB_TMO])) break; if (sp > XB_SPIN_CAP) { atomicAdd(&bar[XB_TMO], 1u); break; } }
    }
    nloc = mine > 0u ? mine : 1u; nx = cnt > 0u ? cnt : 1u;
}

__device__ __forceinline__ void xcd_barrier(const XcdBarrier& b) {
    asm volatile("s_waitcnt vmcnt(0)" ::: "memory");
    __syncthreads();
    if (threadIdx.x == 0) {
        unsigned* bar = b.bar;
        __builtin_amdgcn_s_waitcnt(0);
        unsigned nloc = b.st[0], nx = b.st[1];
        if (nloc == 0u) { xcd_barrier_complete(bar, b.x, nloc, nx); b.st[0] = nloc; b.st[1] = nx; }
        const unsigned old = xb_add(&bar[XB_XSUB(b.x)], 1u);
        const unsigned gen = old / nloc;
        if (old + 1u == (gen + 1u) * nloc) {
            __builtin_amdgcn_fence(__ATOMIC_RELEASE, "agent");
            asm volatile("s_waitcnt vmcnt(0)" ::: "memory");
            const unsigned og = xb_add(&bar[XB_TOP], 1u);
            const unsigned tg = og / nx;
            if (og + 1u == (tg + 1u) * nx) xb_add(&bar[XB_TOPGEN], 1u);
            else XB_SPIN(xb_ld(&bar[XB_TOPGEN]) == tg, bar);
            __builtin_amdgcn_fence(__ATOMIC_ACQUIRE, "agent");
            xb_add(&bar[XB_XGEN(b.x)], 1u);
            asm volatile("s_waitcnt vmcnt(0)" ::: "memory");
        } else {
            XB_SPIN(xb_ld(&bar[XB_XGEN(b.x)]) == gen, bar);
            __builtin_amdgcn_fence(__ATOMIC_ACQUIRE, "agent");
            asm volatile("s_waitcnt vmcnt(0)" ::: "memory");
        }
    }
    __syncthreads();
}


namespace pg8 {
constexpr int BM = 256, BK = 64, HALF = 128, HTB = HALF * BK * 2, NXCD = 8, WGM = 8;
__device__ __forceinline__ int lds_byte(int r, int c) { const int st = (r >> 4) * 2 + (c >> 5), rr = r & 15, cc = c & 31, ob = rr * 64 + cc * 2; return st * 1024 + (ob ^ (((ob >> 9) & 1) << 5)); }
__device__ __forceinline__ void stage_rc(int b, int& R, int& C) { const int st = b / 1024, sb = b % 1024, swz = sb ^ (((sb >> 9) & 1) << 5); R = (st >> 1) * 16 + swz / 64; C = (st & 1) * 32 + (swz % 64) / 2; }
struct Unit { int pm, pn; };
struct Order {
    int nM, nN, nwg, G, c;
    __device__ __forceinline__ bool next(int i, Unit& u) const {
        const long L = (long)i * G + c; if (L >= nwg) return false;
        int wgid = (int)L; { const int q = nwg / NXCD, r = nwg % NXCD, xcd = wgid % NXCD, off = wgid / NXCD; wgid = (xcd < r ? xcd * (q + 1) : r * (q + 1) + (xcd - r) * q) + off; }
        const int nig = WGM * nN, gid = wgid / nig, fm = gid * WGM, gsz = (nM - fm) < WGM ? (nM - fm) : WGM;
        u.pm = fm + ((wgid % nig) % gsz); u.pn = (wgid % nig) / gsz; return true;
    }
};

template <class Epi, bool LRU>
__device__ __forceinline__ void gemm_phase(LAS unsigned char* lds, const bf16_t* A, int lda, const bf16_t* Bt, int ldb, int nM, int nN, int K, const Epi& E) {
    const int tid = tidx(), wid = __builtin_amdgcn_readfirstlane(tid >> 6), lane = tid & 63, wr = wid >> 2, wc = wid & 3, fr = lane & 15, fq = lane >> 4;
    const int nt = K / BK;
    Order S; S.nM = nM; S.nN = nN; S.nwg = nM * nN; S.G = gdim(); S.c = bidx();
    unsigned voffA[2], voffB[2];
#pragma unroll
    for (int i = 0; i < 2; ++i) { int R, C; stage_rc(tid * 16 + i * 8192, R, C); voffA[i] = (unsigned)(R * lda + C) * 2u; voffB[i] = (unsigned)(R * ldb + C) * 2u; }
    const size_t kstep = (size_t)(BK * 2);
    const size_t hstepA = (size_t)HALF * lda * 2, hstepB = (size_t)HALF * ldb * 2;
    const size_t tstepA = 2 * hstepA, tstepB = 2 * hstepB;
    const unsigned ldsw = (unsigned)wid * 1024u;
    const int aoff = lds_byte(wr * 64 + fr, fq * 8), boff = lds_byte(wc * 32 + fr, fq * 8);
#define PG8_SA(b, h) (((b) * 2 + (h)) * HTB)
#define PG8_SB(b, h) ((4 + (b) * 2 + (h)) * HTB)
#define PG8_STAGE(bufoff, gbase, voff) do { _Pragma("unroll") for (int _i = 0; _i < 2; ++_i) \
        __builtin_amdgcn_global_load_lds((const unsigned*)((const char*)(gbase) + (voff)[_i]), (LAS unsigned*)(lds + (bufoff) + ldsw + _i * 8192), 16, 0, 0); } while (0)
#define PG8_LDA(dst, b, h) do { _Pragma("unroll") for (int m = 0; m < 4; ++m) _Pragma("unroll") for (int k = 0; k < 2; ++k) dst[m][k] = *(const LAS bf16x8*)(lds + PG8_SA(b, h) + aoff + m * 2048 + k * 1024); } while (0)
#define PG8_LDB(dst, b, h) do { _Pragma("unroll") for (int n = 0; n < 2; ++n) _Pragma("unroll") for (int k = 0; k < 2; ++k) dst[n][k] = *(const LAS bf16x8*)(lds + PG8_SB(b, h) + boff + n * 2048 + k * 1024); } while (0)
#define PG8_MMA(ai, bj, At, Bt_) do { __builtin_amdgcn_s_setprio(1); _Pragma("unroll") for (int m = 0; m < 4; ++m) _Pragma("unroll") for (int n = 0; n < 2; ++n) _Pragma("unroll") for (int k = 0; k < 2; ++k) \
        acc[ai][bj][m][n] = __builtin_amdgcn_mfma_f32_16x16x32_bf16(Bt_[n][k], At[m][k], acc[ai][bj][m][n], 0, 0, 0); __builtin_amdgcn_s_setprio(0); } while (0)
#define PG8_WAIT_V(n) asm volatile("s_waitcnt vmcnt(" #n ")" ::: "memory")
#define PG8_WAIT_L(n) asm volatile("s_waitcnt lgkmcnt(" #n ")" ::: "memory")
#define PG8_BAR __builtin_amdgcn_s_barrier()
#define PG8_SCHED __builtin_amdgcn_sched_barrier(0)
#define PG8_APTR(u) ((const char*)A + (size_t)(u).pm * tstepA + (LRU ? (size_t)((((u).pn >> 1) & 7) * 512) : (size_t)0))
#define PG8_BPTR(u) ((const char*)Bt + (size_t)(u).pn * tstepB)
    Unit cur, nxt; int ui = 0;
    if (!S.next(0, cur)) return;
    f32x4 acc[2][2][4][2];
#pragma unroll
    for (int a = 0; a < 2; ++a)
#pragma unroll
        for (int b = 0; b < 2; ++b)
#pragma unroll
            for (int m = 0; m < 4; ++m)
#pragma unroll
                for (int n = 0; n < 2; ++n) acc[a][b][m][n] = (f32x4){0.f, 0.f, 0.f, 0.f};
    bf16x8 At[4][2], B0[2][2], B1[2][2];
    const char* cA = PG8_APTR(cur); const char* cB = PG8_BPTR(cur);
    PG8_STAGE(PG8_SB(0, 0), cB, voffB); PG8_STAGE(PG8_SA(0, 0), cA, voffA); PG8_STAGE(PG8_SB(0, 1), cB + hstepB, voffB); PG8_STAGE(PG8_SA(0, 1), cA + hstepA, voffA);
    if (wr == 1) PG8_BAR;
    PG8_WAIT_V(4); PG8_BAR;
    PG8_STAGE(PG8_SB(1, 0), cB + kstep, voffB); PG8_STAGE(PG8_SA(1, 0), cA + kstep, voffA); PG8_STAGE(PG8_SB(1, 1), cB + hstepB + kstep, voffB);
    PG8_WAIT_V(6); PG8_BAR;
    for (;;) {
        const bool has_next = S.next(ui + 1, nxt);
        const char* nA = has_next ? PG8_APTR(nxt) : cA; const char* nB = has_next ? PG8_BPTR(nxt) : cB;
        for (int t = 0; t < nt; t += 2) {
            const bool last = (t == nt - 2);
            const char* a1 = cA + (size_t)(t + 1) * kstep;
            const char* a2 = last ? nA : cA + (size_t)(t + 2) * kstep; const char* b2 = last ? nB : cB + (size_t)(t + 2) * kstep;
            const char* a3 = a2 + kstep; const char* b3 = b2 + kstep;
            PG8_LDB(B0, 0, 0); PG8_SCHED; PG8_LDA(At, 0, 0); PG8_STAGE(PG8_SA(1, 1), a1 + hstepA, voffA);
            PG8_WAIT_L(8); PG8_BAR; PG8_WAIT_L(0); PG8_MMA(0, 0, At, B0); PG8_BAR; PG8_SCHED;
            PG8_LDB(B1, 0, 1); PG8_STAGE(PG8_SB(0, 0), b2, voffB);
            PG8_BAR; PG8_WAIT_L(0); PG8_MMA(0, 1, At, B1); PG8_BAR;
            PG8_LDA(At, 0, 1); PG8_STAGE(PG8_SA(0, 0), a2, voffA);
            PG8_BAR; PG8_WAIT_L(0); PG8_MMA(1, 0, At, B0); PG8_BAR; PG8_SCHED;
            PG8_STAGE(PG8_SB(0, 1), b2 + hstepB, voffB);
            PG8_WAIT_V(6); PG8_BAR; PG8_MMA(1, 1, At, B1); PG8_BAR;
            PG8_LDB(B0, 1, 0); PG8_SCHED; PG8_LDA(At, 1, 0); PG8_STAGE(PG8_SA(0, 1), a2 + hstepA, voffA);
            PG8_WAIT_L(8); PG8_BAR; PG8_WAIT_L(0); PG8_MMA(0, 0, At, B0); PG8_BAR; PG8_SCHED;
            PG8_LDB(B1, 1, 1); PG8_STAGE(PG8_SB(1, 0), b3, voffB);
            PG8_BAR; PG8_WAIT_L(0); PG8_MMA(0, 1, At, B1); PG8_BAR;
            PG8_LDA(At, 1, 1); PG8_STAGE(PG8_SA(1, 0), a3, voffA);
            PG8_BAR; PG8_WAIT_L(0); PG8_MMA(1, 0, At, B0); PG8_BAR; PG8_SCHED;
            PG8_STAGE(PG8_SB(1, 1), b3 + hstepB, voffB);
            PG8_WAIT_V(6); PG8_BAR; PG8_MMA(1, 1, At, B1); PG8_BAR;
        }
        E(acc, cur, wr, wc, fr, fq);
        if (!has_next) break;
#pragma unroll
        for (int a = 0; a < 2; ++a)
#pragma unroll
            for (int b = 0; b < 2; ++b)
#pragma unroll
                for (int m = 0; m < 4; ++m)
#pragma unroll
                    for (int n = 0; n < 2; ++n) acc[a][b][m][n] = (f32x4){0.f, 0.f, 0.f, 0.f};
        cur = nxt; cA = nA; cB = nB; ++ui;
    }
    PG8_WAIT_V(0);
    if (wr == 0) PG8_BAR;
    PG8_BAR;
#undef PG8_SA
#undef PG8_SB
#undef PG8_STAGE
#undef PG8_LDA
#undef PG8_LDB
#undef PG8_MMA
#undef PG8_WAIT_V
#undef PG8_WAIT_L
#undef PG8_BAR
#undef PG8_SCHED
#undef PG8_APTR
#undef PG8_BPTR
}
}
using pg8::Unit;

struct EpiSwiglu {
    bf16_t* H;
    __device__ __forceinline__ void operator()(const f32x4 (&acc)[2][2][4][2], const Unit& u, int wr, int wc, int fr, int fq) const {
        const int loff = (wr * 64 + fr) * DFF + wc * 32 + 4 * fq;
        bf16_t* ub = H + (size_t)u.pm * 256 * DFF + u.pn * 128;
#pragma unroll
        for (int ai = 0; ai < 2; ++ai)
#pragma unroll
            for (int m = 0; m < 4; ++m) { bf16_t* rb = ub + (size_t)(ai * 128 + m * 16) * DFF;
#pragma unroll
                for (int n = 0; n < 2; ++n) { const f32x4 a = acc[ai][0][m][n], b = acc[ai][1][m][n];
                    uint2 pk; pk.x = cvt_pk_bf16(siluf_(a[0]) * b[0], siluf_(a[1]) * b[1]); pk.y = cvt_pk_bf16(siluf_(a[2]) * b[2], siluf_(a[3]) * b[3]);
                    *(uint2*)(rb + loff + n * 16) = pk; } }
    }
};
struct EpiResid {
    float* X; const float* G; float coef; const float* XinC; const float* XinL;
    __device__ __forceinline__ void operator()(const f32x4 (&acc)[2][2][4][2], const Unit& u, int wr, int wc, int fr, int fq) const {
        const int lcol = wc * 32 + 4 * fq, loff = (wr * 64 + fr) * D + lcol;
        const float* g = G + (size_t)cond_of_pm(u.pm) * (9 * 2048) + u.pn * 256;
        float* ub = X + (size_t)u.pm * 256 * D + u.pn * 256;
        const float* ib = (u.pm < 16 ? XinC : XinL) + (size_t)u.pm * 256 * D + u.pn * 256;
        f32x4 gv[2][2];
#pragma unroll
        for (int bj = 0; bj < 2; ++bj)
#pragma unroll
            for (int n = 0; n < 2; ++n) gv[bj][n] = *(const f32x4*)(g + lcol + bj * 128 + n * 16) * coef;
#pragma unroll
        for (int ai = 0; ai < 2; ++ai)
#pragma unroll
            for (int m = 0; m < 4; ++m) { float* rb = ub + (size_t)(ai * 128 + m * 16) * D; const float* ir = ib + (size_t)(ai * 128 + m * 16) * D;
#pragma unroll
                for (int bj = 0; bj < 2; ++bj)
#pragma unroll
                    for (int n = 0; n < 2; ++n) { *(f32x4*)(rb + loff + bj * 128 + n * 16) = *(const f32x4*)(ir + loff + bj * 128 + n * 16) + gv[bj][n] * acc[ai][bj][m][n]; }
                __builtin_amdgcn_sched_barrier(0); }
    }
};
struct EpiF32 {
    float* C; int ldc;
    __device__ __forceinline__ void operator()(const f32x4 (&acc)[2][2][4][2], const Unit& u, int wr, int wc, int fr, int fq) const {
        const int loff = (wr * 64 + fr) * ldc + wc * 32 + 4 * fq;
        float* ub = C + (size_t)u.pm * 256 * ldc + u.pn * 256;
#pragma unroll
        for (int ai = 0; ai < 2; ++ai)
#pragma unroll
            for (int m = 0; m < 4; ++m) { float* rb = ub + (size_t)(ai * 128 + m * 16) * ldc;
#pragma unroll
                for (int bj = 0; bj < 2; ++bj)
#pragma unroll
                    for (int n = 0; n < 2; ++n) *(f32x4*)(rb + loff + bj * 128 + n * 16) = acc[ai][bj][m][n]; }
    }
};
struct EpiBf16 {
    bf16_t* C; int ldc;
    __device__ __forceinline__ void operator()(const f32x4 (&acc)[2][2][4][2], const Unit& u, int wr, int wc, int fr, int fq) const {
        const int loff = (wr * 64 + fr) * ldc + wc * 32 + 4 * fq;
        bf16_t* ub = C + (size_t)u.pm * 256 * ldc + u.pn * 256;
#pragma unroll
        for (int ai = 0; ai < 2; ++ai)
#pragma unroll
            for (int m = 0; m < 4; ++m) { bf16_t* rb = ub + (size_t)(ai * 128 + m * 16) * ldc;
#pragma unroll
                for (int bj = 0; bj < 2; ++bj)
#pragma unroll
                    for (int n = 0; n < 2; ++n) { const f32x4 v = acc[ai][bj][m][n]; uint2 pk; pk.x = cvt_pk_bf16(v[0], v[1]); pk.y = cvt_pk_bf16(v[2], v[3]); *(uint2*)(rb + loff + bj * 128 + n * 16) = pk; } }
    }
};
struct EpiGlu {
    bf16_t* CAT; const bf16_t* YS; const float* bias;
    __device__ __forceinline__ void operator()(const f32x4 (&acc)[2][2][4][2], const Unit& u, int wr, int wc, int fr, int fq) const {
        const int lcol = wc * 32 + 4 * fq, loffY = (wr * 64 + fr) * 1024 + lcol, loffC = (wr * 64 + fr) * D + lcol;
        const float* bb = bias + u.pn * 256; const bf16_t* yb = YS + (size_t)u.pm * 256 * 1024 + u.pn * 256; bf16_t* cb = CAT + (size_t)u.pm * 256 * D + u.pn * 256;
        f32x4 bv[2][2];
#pragma unroll
        for (int bj = 0; bj < 2; ++bj)
#pragma unroll
            for (int n = 0; n < 2; ++n) bv[bj][n] = *(const f32x4*)(bb + lcol + bj * 128 + n * 16);
#pragma unroll
        for (int ai = 0; ai < 2; ++ai)
#pragma unroll
            for (int m = 0; m < 4; ++m) { const bf16_t* yr = yb + (size_t)(ai * 128 + m * 16) * 1024; bf16_t* cr = cb + (size_t)(ai * 128 + m * 16) * D;
#pragma unroll
                for (int bj = 0; bj < 2; ++bj)
#pragma unroll
                    for (int n = 0; n < 2; ++n) { const f32x4 ys = unpack4(*(const uint2*)(yr + loffY + bj * 128 + n * 16)); const f32x4 z = acc[ai][bj][m][n] + bv[bj][n];
                        uint2 pk; pk.x = cvt_pk_bf16(ys[0] * sigmoidf_(z[0]), ys[1] * sigmoidf_(z[1])); pk.y = cvt_pk_bf16(ys[2] * sigmoidf_(z[2]), ys[3] * sigmoidf_(z[3]));
                        *(uint2*)(cr + loffC + bj * 128 + n * 16) = pk; }
                __builtin_amdgcn_sched_barrier(0); }
    }
};
struct EpiLru {
    unsigned* LAB; const bf16_t* XC; const float* ba; const float* bx; const float* sp;
    __device__ __forceinline__ void operator()(const f32x4 (&acc)[2][2][4][2], const Unit& u, int wr, int wc, int fr, int fq) const {
        const int d = u.pn >> 4, h = (u.pn >> 1) & 7, half = u.pn & 1;
        const int chu = h * 256 + half * 128;
        const int lcol = wc * 32 + 4 * fq, loff = (wr * 64 + fr) * D + lcol;
        const bf16_t* xb = XC + (size_t)u.pm * 256 * D + chu; unsigned* lab = LAB + ((size_t)d * MTOK + u.pm * 256) * D + chu;
        f32x4 bav[2], bxv[2], spv[2];
#pragma unroll
        for (int n = 0; n < 2; ++n) { bav[n] = *(const f32x4*)(ba + d * D + chu + lcol + n * 16); bxv[n] = *(const f32x4*)(bx + d * D + chu + lcol + n * 16); spv[n] = *(const f32x4*)(sp + d * D + chu + lcol + n * 16); }
#pragma unroll
        for (int ai = 0; ai < 2; ++ai)
#pragma unroll
            for (int m = 0; m < 4; ++m) { const size_t ro = (size_t)(ai * 128 + m * 16) * D;
#pragma unroll
                for (int n = 0; n < 2; ++n) { const f32x4 xc = unpack4(*(const uint2*)(xb + ro + loff + n * 16));
                    const f32x4 rp = acc[ai][0][m][n] + bav[n], ip = acc[ai][1][m][n] + bxv[n]; uint4 w;
                    unsigned wv[4];
#pragma unroll
                    for (int e = 0; e < 4; ++e) { const float la = spv[n][e] * sigmoidf_(rp[e]); const float bb = __builtin_amdgcn_sqrtf(fmaxf(neg_expm1_(2.f * la), 0.f)) * (sigmoidf_(ip[e]) * xc[e]); wv[e] = cvt_pk_bf16(la, bb); }
                    w.x = wv[0]; w.y = wv[1]; w.z = wv[2]; w.w = wv[3];
                    *(uint4*)(lab + ro + loff + n * 16) = w; __builtin_amdgcn_sched_barrier(0); } }
    }
};

struct CvtT { const float* src; bf16_t* dst; int K, ldsrc, Nsrc, n_dst0, n_src0, k0; };
__device__ __forceinline__ void cvt_decode(PP p, unsigned char* ws, int t, int total, CvtT& c) {
    constexpr int T_FI = 176 * 32, T_FO = 32 * 88, T_EI = 68 * 32, T_EO = 32 * 32, T_GLU = 16 * 16, T_OI = 64 * 32, T_OO = 32 * 32, T_LRU = 4 * 4;
    if (t >= total) { c.src = nullptr; c.dst = nullptr; c.K = c.ldsrc = c.Nsrc = c.n_dst0 = c.n_src0 = c.k0 = 0; return; }
    if (t < 4 * T_FI) { const int w = t / T_FI; t %= T_FI; const int nt_ = t / 32, kt = t % 32; c.K = 2048; c.ldsrc = 11264; c.Nsrc = 11264; c.src = p->in[I_FWI] + (size_t)w * 2048 * 11264; c.dst = (bf16_t*)(ws + WS_WFI) + (size_t)w * 11264 * 2048;
        c.n_dst0 = nt_ * 64; const int j = c.n_dst0 >> 8, rr = c.n_dst0 & 255; c.n_src0 = rr < 128 ? j * 128 + rr : 5632 + j * 128 + (rr - 128); c.k0 = kt * 64; }
    else if ((t -= 4 * T_FI) < 4 * T_FO) { const int w = t / T_FO; t %= T_FO; const int nt_ = t / 88, kt = t % 88; c.K = 5632; c.ldsrc = 2048; c.Nsrc = 2048; c.src = p->in[I_FWO] + (size_t)w * 5632 * 2048; c.dst = (bf16_t*)(ws + WS_WFO) + (size_t)w * 2048 * 5632; c.n_dst0 = c.n_src0 = nt_ * 64; c.k0 = kt * 64; }
    else if ((t -= 4 * T_FO) < T_EI) { const int nt_ = t / 32, kt = t % 32; c.K = 2048; c.ldsrc = 4128; c.Nsrc = 4128; c.src = p->in[I_EVWI]; c.dst = (bf16_t*)(ws + WS_WEI); c.n_dst0 = c.n_src0 = nt_ * 64; c.k0 = kt * 64; }
    else if ((t -= T_EI) < T_EO) { const int nt_ = t / 32, kt = t % 32; c.K = 2048; c.ldsrc = 2048; c.Nsrc = 2048; c.src = p->in[I_EVWO]; c.dst = (bf16_t*)(ws + WS_WEO); c.n_dst0 = c.n_src0 = nt_ * 64; c.k0 = kt * 64; }
    else if ((t -= T_EO) < T_GLU) { const int nt_ = t / 16, kt = t % 16; c.K = 1024; c.ldsrc = 1024; c.Nsrc = 1024; c.src = p->in[I_GLUW]; c.dst = (bf16_t*)(ws + WS_WGLU); c.n_dst0 = c.n_src0 = nt_ * 64; c.k0 = kt * 64; }
    else if ((t -= T_GLU) < T_OI) { const int nt_ = t / 32, kt = t % 32; c.K = 2048; c.ldsrc = 4096; c.Nsrc = 4096; c.src = p->in[I_ODWI]; c.dst = (bf16_t*)(ws + WS_WOI); c.n_dst0 = c.n_src0 = nt_ * 64; c.k0 = kt * 64; }
    else if ((t -= T_OI) < T_OO) { const int nt_ = t / 32, kt = t % 32; c.K = 2048; c.ldsrc = 2048; c.Nsrc = 2048; c.src = p->in[I_ODWO]; c.dst = (bf16_t*)(ws + WS_WOO); c.n_dst0 = c.n_src0 = nt_ * 64; c.k0 = kt * 64; }
    else { t -= T_OO; const int mi = t / T_LRU; t %= T_LRU; const int which = mi >> 4, dh = mi & 15;
        const int nt_ = t / 4, kt = t % 4; c.K = 256; c.ldsrc = 256; c.Nsrc = 256; c.src = (which ? p->in[I_LWX] : p->in[I_LWA]) + (size_t)dh * 65536; c.dst = (bf16_t*)(ws + WS_WLRU) + (size_t)dh * 2 * 65536;
        c.n_src0 = nt_ * 64; const int half = c.n_src0 >> 7; c.n_dst0 = half * 256 + which * 128 + (c.n_src0 & 127); c.k0 = kt * 64; }
}
constexpr int CV_FI = 176 * 32, CV_FO = 32 * 88, CV_TOTAL = 4 * CV_FI + 4 * CV_FO + 68 * 32 + 32 * 32 + 16 * 16 + 64 * 32 + 32 * 32 + 32 * 16;
__device__ __forceinline__ void cvt_range(PP p, unsigned char* lds, int t_lo, int t_hi, int rank, int n) {
    const int tid = tidx(); unsigned char* ws = p->ws; float* tile = (float*)lds;
    for (int g0 = t_lo + rank * 4; g0 < t_hi; g0 += n * 4) {
        f32x4 v[4][2];
#pragma unroll
        for (int q = 0; q < 4; ++q) { CvtT c; cvt_decode(p, ws, g0 + q, t_hi, c);
#pragma unroll
            for (int h = 0; h < 2; ++h) { const int kk = (tid >> 4) + h * 32, n4 = (tid & 15) * 4; const int ns = c.n_src0 + n4;
                v[q][h] = (f32x4){0.f, 0.f, 0.f, 0.f}; if (ns < c.Nsrc) v[q][h] = __builtin_nontemporal_load((const f32x4*)(c.src + (size_t)(c.k0 + kk) * c.ldsrc + ns)); } }
        __syncthreads();
#pragma unroll
        for (int q = 0; q < 4; ++q)
#pragma unroll
            for (int h = 0; h < 2; ++h) { const int kk = (tid >> 4) + h * 32, n4 = (tid & 15) * 4; float* tp = tile + q * 4160 + kk * 65 + n4; tp[0] = v[q][h][0]; tp[1] = v[q][h][1]; tp[2] = v[q][h][2]; tp[3] = v[q][h][3]; }
        __syncthreads();
#pragma unroll
        for (int q = 0; q < 4; ++q) { CvtT c; cvt_decode(p, ws, g0 + q, t_hi, c);
            if (c.dst) { const int nn = tid >> 3, k8 = (tid & 7) * 8; f32x4 a, b2; const float* tp = tile + q * 4160;
#pragma unroll
                for (int j = 0; j < 4; ++j) { a[j] = tp[(k8 + j) * 65 + nn]; b2[j] = tp[(k8 + 4 + j) * 65 + nn]; }
                *(bf16x8*)(c.dst + (size_t)(c.n_dst0 + nn) * c.K + c.k0 + k8) = pack8(a, b2); } }
    }
}
__device__ __forceinline__ void mod_items(PP p, unsigned char* lds, int it_lo, int it_hi, int rank, int n) {
    const int tid = tidx(); unsigned char* ws = p->ws;
    float* sc = (float*)lds;
    __syncthreads();
    for (int i = tid; i < 3 * 2048; i += 512) { const int ci = i >> 11, k = i & 2047; const float v = ci == 0 ? p->in[I_CCTX][k] : p->in[I_C][(ci - 1) * 2048 + k]; sc[i] = siluf_(v); }
    __syncthreads();
    float* MOD = (float*)(ws + WS_MOD);
    for (int it = it_lo + rank; it < it_hi; it += n) { const int l = it / 288, r = it % 288, chunk = r / 32, ks = r % 32; const int col = chunk * 2048 + tid * 4;
        const float* W = p->in[I_ADAW] + (size_t)l * 2048 * 18432 + (size_t)(ks * 64) * 18432 + col;
        f32x4 a0 = (f32x4){0.f, 0.f, 0.f, 0.f}, a1 = a0, a2 = a0;
#pragma unroll 8
        for (int k = 0; k < 64; ++k) { const f32x4 w = __builtin_nontemporal_load((const f32x4*)(W + (size_t)k * 18432)); const int kk = ks * 64 + k; a0 += w * sc[kk]; a1 += w * sc[2048 + kk]; a2 += w * sc[4096 + kk]; }
        if (ks == 0) { const f32x4 bb = *(const f32x4*)(p->in[I_ADAB] + (size_t)l * 18432 + col); a0 += bb; a1 += bb; a2 += bb; }
        float* m0 = MOD + (size_t)(l * 3) * 18432 + col;
#pragma unroll
        for (int e = 0; e < 4; ++e) { atomicAdd(m0 + e, a0[e]); atomicAdd(m0 + 18432 + e, a1[e]); atomicAdd(m0 + 2 * 18432 + e, a2[e]); } }
    __syncthreads();
}
__device__ void phase_prep(PP p, LAS unsigned char* ldsr, int skip_mod) {
    unsigned char* lds = (unsigned char*)ldsr;
    const int tid = tidx(), bid = bidx(), nb = gdim();
    unsigned char* ws = p->ws;
    if (!skip_mod) mod_items(p, lds, 0, 288, bid, nb);
    cvt_range(p, lds, 0, CV_FI, bid, nb);
}
__device__ void bg_convert(PP p, LAS unsigned char* ldsr, int ph) {
    unsigned char* lds = (unsigned char*)ldsr; const int bid = bidx();
    constexpr int S0 = 4 * CV_FI + 4 * CV_FO, S_EI = S0, S_EO = S_EI + 2176, S_OI = S_EO + 1024 + 256, S_OO = S_OI + 2048;
    __syncthreads();
    if (ph == 2) { if (bid >= 32) { cvt_range(p, lds, 4 * CV_FI, 4 * CV_FI + CV_FO, bid - 32, 224); cvt_range(p, lds, S_EI, S_EO, bid - 32, 224); } }
    else if (ph == 3) { if (bid >= 192) cvt_range(p, lds, CV_FI, 2 * CV_FI, bid - 192, 64); }
    else if (ph == 5) { if (bid >= 152) cvt_range(p, lds, S_EO, S_OO, bid - 152, 104); }
    else if (ph == 8) { if (bid >= 96) cvt_range(p, lds, 4 * CV_FI + CV_FO, 4 * CV_FI + 2 * CV_FO, bid - 96, 160); }
    else if (ph == 9) { if (bid >= 192) cvt_range(p, lds, S_OO, CV_TOTAL, bid - 192, 64); }
    else if (ph == 11) { if (bid >= 32) cvt_range(p, lds, 2 * CV_FI, 3 * CV_FI, bid - 32, 224); }
    else if (ph == 12) { if (bid >= 192) { mod_items(p, lds, 288, 448, bid - 192, 64); cvt_range(p, lds, 4 * CV_FI + 2 * CV_FO, 4 * CV_FI + 3 * CV_FO, bid - 192, 64); } }
    else if (ph == 14) { if (bid >= 32) cvt_range(p, lds, 3 * CV_FI, 4 * CV_FI, bid - 32, 224); }
    else if (ph == 15) { if (bid >= 192) { cvt_range(p, lds, 4 * CV_FI + 3 * CV_FO, 4 * CV_FI + 4 * CV_FO, bid - 192, 64); mod_items(p, lds, 448, 576, bid - 192, 64); } }
}

__device__ void phase_norm(PP p, int l, int j  ) {
    const int tid = tidx(), lane = tid & 63, wid = tid >> 6; const int gw = bidx() * 8 + wid, nw = gdim() * 8;
    const float* X = (const float*)(p->ws + WS_X); bf16_t* HM = (bf16_t*)(p->ws + WS_HM);
    const float* g = j < 0 ? p->in[I_FNG] : p->in[I_NORMG] + (size_t)(l * 3 + j) * D;
    const bool from_in = (l == 0 && j == 0);
    for (int r0 = gw; r0 < MTOK; r0 += 3 * nw) {
        f32x4 v[3][8]; float ss[3];
#pragma unroll
        for (int k = 0; k < 3; ++k) { const int r = r0 + k * nw; ss[k] = 0.f;
            if (r < MTOK) { const float* xr = from_in ? (r < TCTX ? p->in[I_XP] + (size_t)r * D : p->in[I_XS] + (size_t)(r - TCTX) * D) : X + (size_t)r * D;
#pragma unroll
                for (int i = 0; i < 8; ++i) v[k][i] = *(const f32x4*)(xr + lane * 4 + i * 256); } }
#pragma unroll
        for (int k = 0; k < 3; ++k) { const int r = r0 + k * nw; if (r >= MTOK) continue;
#pragma unroll
            for (int i = 0; i < 8; ++i) ss[k] += v[k][i][0] * v[k][i][0] + v[k][i][1] * v[k][i][1] + v[k][i][2] * v[k][i][2] + v[k][i][3] * v[k][i][3];
#pragma unroll
            for (int o = 32; o >= 1; o >>= 1) ss[k] += __shfl_xor(ss[k], o);
            const float rinv = rsqrtf(ss[k] * (1.f / D) + EPS);
            if (j < 0) { float* o = p->out + OUT_Y + (size_t)r * D;
#pragma unroll
                for (int i = 0; i < 8; ++i) { const int c = lane * 4 + i * 256; const f32x4 gg = *(const f32x4*)(g + c); *(f32x4*)(o + c) = v[k][i] * rinv * gg; } }
            else { const float* mod = (const float*)(p->ws + WS_MOD) + (size_t)(l * 3 + cond_of_row(r)) * 18432; const float* sh = mod + (3 * j) * 2048; const float* scl = mod + (3 * j + 1) * 2048;
#pragma unroll
                for (int i = 0; i < 8; ++i) { const int c = lane * 4 + i * 256; const f32x4 gg = *(const f32x4*)(g + c), s1 = *(const f32x4*)(scl + c), s0 = *(const f32x4*)(sh + c);
                    const f32x4 y = (v[k][i] * rinv * gg) * (s1 + 1.f) + s0; uint2 pk; pk.x = cvt_pk_bf16(y[0], y[1]); pk.y = cvt_pk_bf16(y[2], y[3]); *(uint2*)(HM + (size_t)r * D + c) = pk; } } }
    }
}

__device__ __forceinline__ void seq_info(int s, int& L, int& row0) { if (s < 16) { L = 256; row0 = s * 256; } else { L = 1024; row0 = TCTX + (s - 16) * 1024; } }

#define WAVE_LDS_SYNC() asm volatile("s_waitcnt lgkmcnt(0)" ::: "memory")
__device__ __forceinline__ void s5_item(PP p, unsigned char* lds, int s, int d, int gg) {
    const int tid = tidx(), lane = tid & 63, wid = tid >> 6, fr = lane & 15, fq = lane >> 4; const int g = gg * 8 + wid;
    int L, row0; seq_info(s, L, row0);
    float* HS = (float*)(lds + wid * 8448);
    const bf16_t* PROJ = (const bf16_t*)(p->ws + WS_PROJ); float* Y = (float*)(p->ws + WS_YS5) + (size_t)d * MTOK * 1024;
    const int pg0 = (d * 64 + g) * 64, pg = pg0 + lane;
    const float lre = p->in[I_LAMRE][pg], lim = p->in[I_LAMIM][pg], dt = expf(p->in[I_LOGSTEP][d * 64 + g]);
    const float mag = expf(lre * dt); float sn, cs; sincosf(lim * dt, &sn, &cs);
    const float abr = mag * cs, abi = mag * sn, den = lre * lre + lim * lim, nre = abr - 1.f;
    const float fre = (nre * lre + abi * lim) / den, fim = (abi * lre - nre * lim) / den;
    bf16x8 af[8];
#pragma unroll
    for (int tq = 0; tq < 4; ++tq) { const int src = tq * 16 + fr; const float f_r = __shfl(fre, src), f_i = __shfl(fim, src);
        f32x4 r0 = (f32x4){0.f, 0.f, 0.f, 0.f}, r1 = r0, i0 = r0, i1 = r0;
        if (fq < 2) { const float* br = p->in[I_BRE] + (size_t)(pg0 + src) * 16 + fq * 8; const float* bi = p->in[I_BIM] + (size_t)(pg0 + src) * 16 + fq * 8;
            r0 = *(const f32x4*)br; r1 = *(const f32x4*)(br + 4); i0 = *(const f32x4*)bi; i1 = *(const f32x4*)(bi + 4); }
        af[tq] = pack8(r0 * f_r - i0 * f_i, r1 * f_r - i1 * f_i); af[tq + 4] = pack8(i0 * f_r + r0 * f_i, i1 * f_r + r1 * f_i); }
    bf16x8 cf[4];
#pragma unroll
    for (int kk = 0; kk < 4; ++kk) { const float* cp = (kk < 2 ? p->in[I_CRE] : p->in[I_CIM]) + ((size_t)(d * 64 + g) * 16 + fr) * 64 + (kk & 1) * 32 + fq * 8;
        f32x4 a = *(const f32x4*)cp, b = *(const f32x4*)(cp + 4); if (kk >= 2) { a = -a; b = -b; } cf[kk] = pack8(a, b); }
    float hr = 0.f, hi = 0.f;
    if (s >= 16) { const size_t o = ((size_t)((s - 16) * 2 + d) * 64 + g) * 64 + lane; hr = p->in[I_S5RE][o]; hi = p->in[I_S5IM][o]; }
    const f32x4 z4 = (f32x4){0.f, 0.f, 0.f, 0.f};
    bf16x8 un = (bf16x8){0, 0, 0, 0, 0, 0, 0, 0};
#define S5_LOADU(c0_) do { if (fq < 2) { const int row_ = row0 + (d ? L - 1 - ((c0_) + fr) : (c0_) + fr); un = *(const bf16x8*)(PROJ + (size_t)row_ * EVINP + g * 16 + fq * 8); } } while (0)
    S5_LOADU(0);
    __syncthreads();
    for (int c0 = 0; c0 < L; c0 += 16) {
        const bf16x8 ub = un;
        if (c0 + 16 < L) S5_LOADU(c0 + 16);
#pragma unroll
        for (int t8 = 0; t8 < 8; ++t8) { const f32x4 bu = __builtin_amdgcn_mfma_f32_16x16x32_bf16(af[t8], ub, z4, 0, 0, 0); *(f32x4*)(HS + fr * 132 + t8 * 16 + fq * 4) = bu; }
        WAVE_LDS_SYNC();
#pragma unroll
        for (int i = 0; i < 16; ++i) { const float bur = HS[i * 132 + lane], bui = HS[i * 132 + 64 + lane];
            const float nr = abr * hr - abi * hi + bur, ni = abr * hi + abi * hr + bui; hr = nr; hi = ni;
            HS[i * 132 + lane] = hr; HS[i * 132 + 64 + lane] = hi; }
        WAVE_LDS_SYNC();
        { f32x4 acc = z4;
#pragma unroll
          for (int kk = 0; kk < 4; ++kk) { const float* hp = HS + fr * 132 + kk * 32 + fq * 8; const bf16x8 hb = pack8(*(const f32x4*)hp, *(const f32x4*)(hp + 4));
              acc = __builtin_amdgcn_mfma_f32_16x16x32_bf16(cf[kk], hb, acc, 0, 0, 0); }
          const int row = row0 + (d ? L - 1 - (c0 + fr) : c0 + fr);
          *(f32x4*)(Y + (size_t)row * 1024 + g * 16 + fq * 4) = acc; }
        WAVE_LDS_SYNC();
    }
#undef S5_LOADU
    if (s < 16) { const size_t o = ((size_t)(s * 2 + d) * 64 + g) * 64 + lane; p->out[OUT_S5RE + o] = hr; p->out[OUT_S5IM + o] = hi; }
}

template <int NK32> __device__ __forceinline__ f32x4 mma_lds(f32x4 acc, const bf16_t* X, int ldx, const bf16_t* Y, int ldy, int lane) {
    const bf16_t* xp = X + (lane & 15) * ldx + (lane >> 4) * 8; const bf16_t* yp = Y + (lane & 15) * ldy + (lane >> 4) * 8;
#pragma unroll
    for (int kk = 0; kk < NK32; ++kk) acc = __builtin_amdgcn_mfma_f32_16x16x32_bf16(*(const bf16x8*)(xp + kk * 32), *(const bf16x8*)(yp + kk * 32), acc, 0, 0, 0);
    return acc;
}

__device__ __forceinline__ void gla_item(PP p, unsigned char* lds, int s, int h, int d, int vh) {
    const int tid = tidx(), lane = tid & 63, wid = tid >> 6, fr = lane & 15, fq = lane >> 4;
    int L, row0; seq_info(s, L, row0);
    bf16_t* QT = (bf16_t*)(lds);
    bf16_t* KT = (bf16_t*)(lds + 17408);
    bf16_t* KE = (bf16_t*)(lds + 34816);
    bf16_t* VT = (bf16_t*)(lds + 53248);
    bf16_t* ATT = (bf16_t*)(lds + 71680);
    bf16_t* ST = (bf16_t*)(lds + 80896);
    float* LOGA = (float*)(lds + 80896);
    float* SEG = (float*)(lds + 115712);
    float* GLR = (float*)(lds + 117760);
    float* W2S = (float*)(lds + 121856);
    float* GBS = (float*)(lds + 130048);
    float* DEC = (float*)(lds + 130560);
    const bf16_t* PROJ = (const bf16_t*)(p->ws + WS_PROJ); float* O = (float*)(p->ws + WS_OGLA) + (size_t)d * MTOK * 1024;
    __syncthreads();
    for (int i = tid; i < 16 * 128; i += 512) W2S[i] = p->in[I_GW2][(size_t)(d * 16 + (i >> 7)) * 512 + h * 128 + (i & 127)];
    if (tid < 128) GBS[tid] = p->in[I_GB][d * 512 + h * 128 + tid];
    f32x4 sacc[8];
#pragma unroll
    for (int tn = 0; tn < 8; ++tn) { sacc[tn] = (f32x4){0.f, 0.f, 0.f, 0.f};
        if (s >= 16) { const float* sp = p->in[I_SGLA] + ((size_t)(((s - 16) * 2 + d) * 4 + h) * 128 + wid * 16 + fq * 4) * 256 + vh * 128 + tn * 16 + fr;
#pragma unroll
            for (int e = 0; e < 4; ++e) sacc[tn][e] = sp[(size_t)e * 256]; } }
    const float qscale = 0.08838834764831845f;
    const int nch = L >> 6;
    const int c = tid & 127, ig = tid >> 7;
#define GROW(n_, i) (row0 + (d ? L - 1 - ((n_) * 64 + (i)) : (n_) * 64 + (i)))
    f32x4 glr4 = (f32x4){0.f, 0.f, 0.f, 0.f}; float qv[16], kv[16], vv[16];
#define GLA_PREFETCH(n_) do { \
        if (tid < 256) glr4 = unpack4(*(const uint2*)(PROJ + (size_t)GROW(n_, tid >> 2) * EVINP + 4096 + d * 16 + (tid & 3) * 4)); \
        _Pragma("unroll") for (int ii = 0; ii < 16; ++ii) { const size_t ro = (size_t)GROW(n_, ig * 16 + ii) * EVINP; \
            qv[ii] = bf2f_(PROJ[ro + 1024 + h * 128 + c]); kv[ii] = bf2f_(PROJ[ro + 1536 + h * 128 + c]); vv[ii] = bf2f_(PROJ[ro + 2048 + h * 256 + vh * 128 + c]); } } while (0)
    GLA_PREFETCH(0);
    for (int n = 0; n < nch; ++n) {
        __syncthreads();
        if (tid < 256) *(f32x4*)(GLR + (tid >> 2) * 16 + (tid & 3) * 4) = glr4;
        __syncthreads();
        { float run = 0.f; const float gb = GBS[c];
          float w2[16];
#pragma unroll
          for (int r = 0; r < 16; ++r) w2[r] = W2S[r * 128 + c];
          for (int ii = 0; ii < 16; ++ii) { const int i = ig * 16 + ii; float z = gb;
#pragma unroll
              for (int q = 0; q < 4; ++q) { const f32x4 g4 = *(const f32x4*)(GLR + i * 16 + q * 4);
#pragma unroll
                  for (int e = 0; e < 4; ++e) z += g4[e] * w2[q * 4 + e]; }
              run -= (fmaxf(-z, 0.f) + __logf(1.f + __expf(-fabsf(z)))) * (1.f / 16.f); LOGA[i * 128 + c] = run; }
          SEG[ig * 128 + c] = run; }
        __syncthreads();
        { float pre = 0.f, tot = 0.f;
#pragma unroll
          for (int q = 0; q < 4; ++q) { const float sg = SEG[q * 128 + c]; tot += sg; if (q < ig) pre += sg; }
          if (ig == 0) DEC[c] = __expf(tot);
#pragma unroll
          for (int ii = 0; ii < 16; ++ii) { const int i = ig * 16 + ii; const float bc = LOGA[i * 128 + c] + pre;
              QT[i * 136 + c] = f2bf(qv[ii] * qscale * __expf(bc)); KT[i * 136 + c] = f2bf(kv[ii] * __expf(-bc)); KE[c * 72 + i] = f2bf(kv[ii] * __expf(tot - bc)); VT[c * 72 + i] = f2bf(vv[ii]); } }
        __syncthreads();
        if (n + 1 < nch) GLA_PREFETCH(n + 1);
#pragma unroll
        for (int q = 0; q < 2; ++q) { const int tile = wid * 2 + q, ti = tile >> 2, tj = tile & 3; f32x4 a = (f32x4){0.f, 0.f, 0.f, 0.f};
            if (tj <= ti) a = mma_lds<4>(a, QT + ti * 16 * 136, 136, KT + tj * 16 * 136, 136, lane);
#pragma unroll
            for (int e = 0; e < 4; ++e) { const int i = ti * 16 + fq * 4 + e, jx = tj * 16 + fr; ATT[i * 72 + jx] = f2bf(jx <= i ? a[e] : 0.f); } }
#pragma unroll
        for (int tn = 0; tn < 8; ++tn) { uint2 pk; pk.x = cvt_pk_bf16(sacc[tn][0], sacc[tn][1]); pk.y = cvt_pk_bf16(sacc[tn][2], sacc[tn][3]); *(uint2*)(ST + (tn * 16 + fr) * 136 + wid * 16 + fq * 4) = pk; }
        __syncthreads();
#pragma unroll
        for (int ti = 0; ti < 4; ++ti) { f32x4 o = (f32x4){0.f, 0.f, 0.f, 0.f};
            o = mma_lds<2>(o, ATT + ti * 16 * 72, 72, VT + wid * 16 * 72, 72, lane);
            o = mma_lds<4>(o, QT + ti * 16 * 136, 136, ST + wid * 16 * 136, 136, lane);
#pragma unroll
            for (int e = 0; e < 4; ++e) { const int i = ti * 16 + fq * 4 + e; O[(size_t)GROW(n, i) * 1024 + h * 256 + vh * 128 + wid * 16 + fr] = o[e]; } }
        { f32x4 dc;
#pragma unroll
          for (int e = 0; e < 4; ++e) dc[e] = DEC[wid * 16 + fq * 4 + e];
#pragma unroll
          for (int tn = 0; tn < 8; ++tn) { sacc[tn] = sacc[tn] * dc; sacc[tn] = mma_lds<2>(sacc[tn], KE + wid * 16 * 72, 72, VT + tn * 16 * 72, 72, lane); } }
    }
#undef GROW
#undef GLA_PREFETCH
    if (s < 16) {
#pragma unroll
        for (int tn = 0; tn < 8; ++tn) { float* sp = p->out + OUT_GLA + ((size_t)((s * 2 + d) * 4 + h) * 128 + wid * 16 + fq * 4) * 256 + vh * 128 + tn * 16 + fr;
#pragma unroll
            for (int e = 0; e < 4; ++e) sp[(size_t)e * 256] = sacc[tn][e]; } }
}

__device__ void phase_s5gla(PP p, LAS unsigned char* ldsr) {
    unsigned char* lds = (unsigned char*)ldsr; const int bid = bidx(), nb = gdim();
    if (nb >= 64) {
        if (bid < 32) { gla_item(p, lds, 16 + (bid >> 4), (bid >> 2) & 3, (bid >> 1) & 1, bid & 1); return; }
        for (int it = bid - 32; it < 544; it += nb - 32) {
            if (it < 32) s5_item(p, lds, 16 + (it >> 4), (it >> 3) & 1, it & 7);
            else if (it < 288) { const int q = it - 32; s5_item(p, lds, q >> 4, (q >> 3) & 1, q & 7); }
            else { const int q = it - 288; gla_item(p, lds, q >> 4, (q >> 2) & 3, (q >> 1) & 1, q & 1); }
        }
    } else {
        for (int it = bid; it < 576; it += nb) {
            if (it < 32) { gla_item(p, lds, 16 + (it >> 4), (it >> 2) & 3, (it >> 1) & 1, it & 1); }
            else if (it < 64) { const int q = it - 32; s5_item(p, lds, 16 + (q >> 4), (q >> 3) & 1, q & 7); }
            else if (it < 320) { const int q = it - 64; s5_item(p, lds, q >> 4, (q >> 3) & 1, q & 7); }
            else { const int q = it - 320; gla_item(p, lds, q >> 4, (q >> 2) & 3, (q >> 1) & 1, q & 1); }
        }
    }
}

__device__ void phase_evpost(PP p) {
    const int tid = tidx(), lane = tid & 63, wid = tid >> 6; const int gw = bidx() * 8 + wid, nw = gdim() * 8;
    const bf16_t* PROJ = (const bf16_t*)(p->ws + WS_PROJ); const float* Y0 = (const float*)(p->ws + WS_YS5); const float* Y1 = Y0 + (size_t)MTOK * 1024;
    const float* O0 = (const float*)(p->ws + WS_OGLA); const float* O1 = O0 + (size_t)MTOK * 1024;
    bf16_t* YSB = (bf16_t*)(p->ws + WS_YSB); bf16_t* CAT = (bf16_t*)(p->ws + WS_CAT);
    for (int r = gw; r < MTOK; r += nw) {
#pragma unroll
        for (int i = 0; i < 4; ++i) { const int c = lane * 4 + i * 256; const f32x4 y0 = *(const f32x4*)(Y0 + (size_t)r * 1024 + c), y1 = *(const f32x4*)(Y1 + (size_t)r * 1024 + c);
            const f32x4 u = unpack4(*(const uint2*)(PROJ + (size_t)r * EVINP + c)), dd = *(const f32x4*)(p->in[I_S5D] + c); f32x4 v = y0 + y1 + dd * u;
#pragma unroll
            for (int e = 0; e < 4; ++e) v[e] = geluf_(v[e]);
            uint2 pk; pk.x = cvt_pk_bf16(v[0], v[1]); pk.y = cvt_pk_bf16(v[2], v[3]); *(uint2*)(YSB + (size_t)r * 1024 + c) = pk; }
        { const int c0 = lane * 16; f32x4 o[4]; float ss = 0.f;
#pragma unroll
          for (int i = 0; i < 4; ++i) { o[i] = *(const f32x4*)(O0 + (size_t)r * 1024 + c0 + i * 4) + *(const f32x4*)(O1 + (size_t)r * 1024 + c0 + i * 4); ss += o[i][0] * o[i][0] + o[i][1] * o[i][1] + o[i][2] * o[i][2] + o[i][3] * o[i][3]; }
#pragma unroll
          for (int m = 8; m >= 1; m >>= 1) ss += __shfl_xor(ss, m);
          const float rinv = rsqrtf(ss * (1.f / 256.f) + EPS);
#pragma unroll
          for (int i = 0; i < 4; ++i) { const int c = c0 + i * 4; const f32x4 ng = *(const f32x4*)(p->in[I_GNG] + (c & 255)), gt = unpack4(*(const uint2*)(PROJ + (size_t)r * EVINP + 3072 + c)); f32x4 v;
#pragma unroll
              for (int e = 0; e < 4; ++e) v[e] = o[i][e] * rinv * ng[e] * siluf_(gt[e]);
              uint2 pk; pk.x = cvt_pk_bf16(v[0], v[1]); pk.y = cvt_pk_bf16(v[2], v[3]); *(uint2*)(CAT + (size_t)r * D + 1024 + c) = pk; } }
    }
}

__device__ void phase_conv(PP p) {
    const bf16_t* PROJ = (const bf16_t*)(p->ws + WS_PROJ); bf16_t* XCB = (bf16_t*)(p->ws + WS_XCB);
    const float* cw = p->in[I_CONVW]; const float* cb = p->in[I_CONVB];
    const size_t total = (size_t)MTOK * 512;
    { const int gi = bidx() * 512 + tidx(); if (gi < 2 * D) ((float*)(p->ws + WS_SP))[gi] = -8.f * softplusf_(-p->in[I_LLAM][gi]); }
    for (size_t i = (size_t)bidx() * 512 + tidx(); i < total; i += (size_t)gdim() * 512) {
        const int r = (int)(i >> 9), c = (int)(i & 511) * 4; const int seg = r < TCTX ? 256 : 64; const int pos = r & (seg - 1);
        f32x4 acc = *(const f32x4*)(cb + c);
#pragma unroll
        for (int j = 0; j < 4; ++j) { const int pp = pos + j - 2; if (pp >= 0 && pp < seg) acc += *(const f32x4*)(cw + j * D + c) * unpack4(*(const uint2*)(PROJ + (size_t)(r + j - 2) * 4096 + 2048 + c)); }
        uint2 pk; pk.x = cvt_pk_bf16(acc[0], acc[1]); pk.y = cvt_pk_bf16(acc[2], acc[3]); *(uint2*)(XCB + (size_t)r * D + c) = pk;
    }
}
__device__ void phase_lruscan1(PP p) {
    const int tid = tidx(), lane = tid & 63, wid = tid >> 6; const int nb = gdim();
    float* SUM = (float*)(p->ws + WS_LSUM);
    for (int it = bidx() * 8 + wid; it < 384 * 64; it += 8 * nb) {
        const int q = it >> 6, d = (it >> 5) & 1, c = (it & 31) * 64 + lane; const int row0 = q * 16;
        const unsigned* LAB = (const unsigned*)(p->ws + WS_LA) + ((size_t)d * MTOK + row0) * D + c;
        unsigned wv[16];
#pragma unroll
        for (int j = 0; j < 16; ++j) wv[j] = LAB[(size_t)j * D];
        float S = 0.f, h = 0.f;
        if (d == 0) {
#pragma unroll
            for (int j = 0; j < 16; ++j) { const float la = lo_bf(wv[j]); h = __expf(la) * h + hi_bf(wv[j]); S += la; } }
        else {
#pragma unroll
            for (int j = 15; j >= 0; --j) { const float la = lo_bf(wv[j]); h = __expf(la) * h + hi_bf(wv[j]); S += la; } }
        SUM[((size_t)d * 384 + q) * D + c] = __expf(S); SUM[((size_t)(2 + d) * 384 + q) * D + c] = h;
    }
}
__device__ void phase_lruscan2(PP p) {
    const int tid = tidx(), lane = tid & 63, wid = tid >> 6; const int nb = gdim();
    const float* SUM = (const float*)(p->ws + WS_LSUM); const bf16_t* PROJ = (const bf16_t*)(p->ws + WS_PROJ); bf16_t* CAT = (bf16_t*)(p->ws + WS_CAT);
    for (int it0 = bidx() * 8 + wid; it0 < 384 * 32; it0 += 8 * nb) {
        const int it = it0 < 128 * 32 ? it0 + 256 * 32 : it0 - 128 * 32;
        const int q = it >> 5, c = (it & 31) * 64 + lane; const int row0 = q * 16;
        int qs, ql, s; if (q < 256) { s = q >> 4; qs = s * 16; ql = qs + 15; } else { s = 16 + ((q - 256) >> 6); qs = 256 + (s - 16) * 64; ql = qs + 63; }
        float h0 = 0.f, h1 = 0.f;
        if (s >= 16) { h0 = p->in[I_SLRU][(size_t)((s - 16) * 2 + 0) * D + c]; h1 = p->in[I_SLRU][(size_t)((s - 16) * 2 + 1) * D + c]; }
        const float* P0 = SUM + c; const float* H0 = SUM + (size_t)2 * 384 * D + c; const float* P1 = SUM + (size_t)384 * D + c; const float* H1 = SUM + (size_t)3 * 384 * D + c;
        { int j = qs;
          for (; j + 8 <= q; j += 8) { float pv[8], hv[8];
#pragma unroll
              for (int e = 0; e < 8; ++e) { pv[e] = P0[(size_t)(j + e) * D]; hv[e] = H0[(size_t)(j + e) * D]; }
#pragma unroll
              for (int e = 0; e < 8; ++e) h0 = pv[e] * h0 + hv[e]; }
          for (; j < q; ++j) h0 = P0[(size_t)j * D] * h0 + H0[(size_t)j * D]; }
        { int j = ql;
          for (; j - 8 >= q; j -= 8) { float pv[8], hv[8];
#pragma unroll
              for (int e = 0; e < 8; ++e) { pv[e] = P1[(size_t)(j - e) * D]; hv[e] = H1[(size_t)(j - e) * D]; }
#pragma unroll
              for (int e = 0; e < 8; ++e) h1 = pv[e] * h1 + hv[e]; }
          for (; j > q; --j) h1 = P1[(size_t)j * D] * h1 + H1[(size_t)j * D]; }
        const unsigned* W0 = (const unsigned*)(p->ws + WS_LA) + (size_t)row0 * D + c; const unsigned* W1 = W0 + (size_t)MTOK * D; const bf16_t* GT = PROJ + (size_t)row0 * 4096 + c;
        unsigned w0[16], w1[16]; float b0[16], gt[16];
#pragma unroll
        for (int j = 0; j < 16; ++j) { w0[j] = W0[(size_t)j * D]; w1[j] = W1[(size_t)j * D]; gt[j] = bf2f_(GT[(size_t)j * 4096]); }
#pragma unroll
        for (int j = 0; j < 16; ++j) { h0 = __expf(lo_bf(w0[j])) * h0 + hi_bf(w0[j]); b0[j] = h0; }
#pragma unroll
        for (int j = 15; j >= 0; --j) { h1 = __expf(lo_bf(w1[j])) * h1 + hi_bf(w1[j]); CAT[(size_t)(row0 + j) * D + c] = f2bf((b0[j] + h1) * geluf_(gt[j])); }
        if (s < 16) { if (q == ql) p->out[OUT_LRU + (size_t)(s * 2 + 0) * D + c] = h0; if (q == qs) p->out[OUT_LRU + (size_t)(s * 2 + 1) * D + c] = h1; }
    }
}

#ifndef PHMASK
#define PHMASK 0xFFFFFFFFu
#endif
#define PHON(k) ((PHMASK >> (k)) & 1u)
#ifndef DUPMASK
#define DUPMASK 0u
#endif
enum { K_PREP = 0, K_NORM, K_SWIGLU, K_RESID, K_F32, K_S5GLA, K_EVPOST, K_GLU, K_CONV, K_LRUG, K_LRUSCAN, K_LRUCOMB };
__global__ void __launch_bounds__(512, 2) mega(Params p) {
    extern __shared__ __attribute__((aligned(16))) unsigned char shm[];
    LAS unsigned char* lds = (LAS unsigned char*)shm;
    cg::grid_group grid = cg::this_grid();
    const int ph_lo = p.ph_lo, ph_hi = p.ph_hi;
    int rep = 0;
    volatile LAS unsigned* bst = (volatile LAS unsigned*)(lds + LDS_MAIN);
    if (threadIdx.x < 16) bst[threadIdx.x] = 0u;
    __syncthreads();
    XcdBarrier xbar = xcd_barrier_post((unsigned*)(p.ws + WS_BAR), bst);
    for (int ph = ph_lo; ph < ph_hi; ++ph) {
        PP pp = get_pp();
        unsigned char* ws = pp->ws;
        const float* MOD = (const float*)(ws + WS_MOD);
        int kind, l = 0, a0 = 0;
        if (ph == 0) kind = K_PREP;
        else if (ph == 26) { kind = K_NORM; a0 = -1; }
        else { l = ph > 12 ? 1 : 0; const int q = ph - 1 - 12 * l;
            if (q == 0) { kind = K_NORM; a0 = 0; }
            else if (q == 1) { kind = K_SWIGLU; a0 = 0; }
            else if (q == 2) { kind = K_RESID; a0 = 0; }
            else if (q == 3) { kind = K_NORM; a0 = 1; }
            else if (q == 4) kind = K_F32;
            else if (l == 0) { if (q == 5) kind = K_S5GLA; else if (q == 6) kind = K_EVPOST; else if (q == 7) kind = K_GLU; else if (q == 8) { kind = K_RESID; a0 = 2; } else if (q == 9) { kind = K_NORM; a0 = 2; } else if (q == 10) { kind = K_SWIGLU; a0 = 1; } else { kind = K_RESID; a0 = 1; } }
            else { if (q == 5) kind = K_CONV; else if (q == 6) kind = K_LRUG; else if (q == 7) kind = K_LRUSCAN; else if (q == 8) kind = K_LRUCOMB; else if (q == 9) { kind = K_RESID; a0 = 2; } else if (q == 10) { kind = K_NORM; a0 = 2; } else if (q == 11) { kind = K_SWIGLU; a0 = 1; } else { kind = K_RESID; a0 = 1; } }
        }
        const bf16_t* HM = (const bf16_t*)(ws + WS_HM);
        if (kind == K_PREP) { if (PHON(0)) phase_prep(pp, lds, rep); }
        else if (kind == K_NORM) { if (PHON(1)) phase_norm(pp, l, a0); }
        else if (kind == K_SWIGLU) { if (PHON(2)) { EpiSwiglu E{(bf16_t*)(ws + WS_H)}; pg8::gemm_phase<EpiSwiglu, false>(lds, HM, D, (const bf16_t*)(ws + WS_WFI) + (size_t)(l * 2 + a0) * 11264 * 2048, D, 24, 44, D, E); if (!rep) bg_convert(pp, lds, ph); } }
        else if (kind == K_RESID) { if (PHON(3)) {
            const bf16_t* A; const bf16_t* B; int K; int gj; float coef;
            if (a0 < 2) { A = (const bf16_t*)(ws + WS_H); B = (const bf16_t*)(ws + WS_WFO) + (size_t)(l * 2 + a0) * 2048 * 5632; K = DFF; gj = a0 == 0 ? 2 : 8; coef = 0.5f; }
            else { A = (const bf16_t*)(ws + WS_CAT); B = (const bf16_t*)(ws + (l == 0 ? WS_WEO : WS_WOO)); K = D; gj = 5; coef = 1.0f; }
            const bool first = (ph == 3);
            const float* xc_ = first ? pp->in[I_XP] : (const float*)(ws + WS_X); const float* xl_ = first ? pp->in[I_XS] - (size_t)TCTX * D : (const float*)(ws + WS_X);
            EpiResid E{(float*)(ws + WS_X), MOD + (size_t)(l * 3) * 18432 + gj * 2048, coef, xc_, xl_}; pg8::gemm_phase<EpiResid, false>(lds, A, K, B, K, 24, 8, K, E); if (!rep) bg_convert(pp, lds, ph); } }
        else if (kind == K_F32) { if (PHON(4)) {
            { const int nN = l == 0 ? 17 : 16; EpiBf16 E{(bf16_t*)(ws + WS_PROJ), nN * 256}; pg8::gemm_phase<EpiBf16, false>(lds, HM, D, (const bf16_t*)(ws + (l == 0 ? WS_WEI : WS_WOI)), D, 24, nN, D, E); }
            if (!rep) bg_convert(pp, lds, ph); } }
        else if (kind == K_S5GLA) { if (PHON(5)) phase_s5gla(pp, lds); }
        else if (kind == K_EVPOST) { if (PHON(6)) phase_evpost(pp); }
        else if (kind == K_GLU) { if (PHON(7)) { EpiGlu E{(bf16_t*)(ws + WS_CAT), (const bf16_t*)(ws + WS_YSB), pp->in[I_GLUB]}; pg8::gemm_phase<EpiGlu, false>(lds, (const bf16_t*)(ws + WS_YSB), 1024, (const bf16_t*)(ws + WS_WGLU), 1024, 24, 4, 1024, E); if (!rep) bg_convert(pp, lds, ph); } }
        else if (kind == K_CONV) { if (PHON(8)) phase_conv(pp); }
        else if (kind == K_LRUG) { if (PHON(9)) { EpiLru E{(unsigned*)(ws + WS_LA), (const bf16_t*)(ws + WS_XCB), pp->in[I_LBA], pp->in[I_LBX], (const float*)(ws + WS_SP)};
            int kk = 256; asm volatile("" : "+s"(kk));
            pg8::gemm_phase<EpiLru, true>(lds, (const bf16_t*)(ws + WS_XCB), D, (const bf16_t*)(ws + WS_WLRU), kk, 24, 32, kk, E); } }
        else if (kind == K_LRUSCAN) { if (PHON(10)) phase_lruscan1(pp); }
        else { if (PHON(11)) phase_lruscan2(pp); }
#if DUPMASK
        if (rep == 0 && ((DUPMASK >> kind) & 1u)) { xcd_barrier(xbar); rep = 1; --ph; continue; }
        rep = 0;
#endif
        if (ph + 1 < ph_hi) { if (ph == 0) grid.sync(); else xcd_barrier(xbar); }
    }
}

extern "C" void kernel_launch(void* const* d_in, const int* in_sizes, int n_in, void* d_out, int out_size, void* d_ws, size_t ws_size, hipStream_t stream) {
    static int grid = 0;
    if (grid == 0) {
        if (n_in != 38 || ws_size < WS_END) { fprintf(stderr, "kernel_launch: expected 38 inputs and >= %zu bytes of workspace (got %d, %zu)\n", (size_t)WS_END, n_in, ws_size); grid = -1; return; }
        int dev = 0, cus = 0, per_cu = 0;
        hipGetDevice(&dev); hipDeviceGetAttribute(&cus, hipDeviceAttributeMultiprocessorCount, dev);
        hipFuncSetAttribute((const void*)mega, hipFuncAttributeMaxDynamicSharedMemorySize, LDS_BYTES);
        hipOccupancyMaxActiveBlocksPerMultiprocessor(&per_cu, (const void*)mega, 512, LDS_BYTES);
        if (per_cu < 1) { fprintf(stderr, "kernel_launch: occupancy query says %d blocks per CU\n", per_cu); grid = -1; return; }
        grid = cus;
    }
    if (grid < 0) return;
    (void)hipMemsetAsync((char*)d_ws + WS_MOD, 0, ZERO_BYTES, stream);
    Params p{};
    for (int i = 0; i < 38; ++i) p.in[i] = (const float*)d_in[i];
    p.out = (float*)d_out; p.ws = (unsigned char*)d_ws;
#if MEGA
    p.ph_lo = 0; p.ph_hi = NPH;
    void* args[] = {&p};
    hipError_t e = hipLaunchCooperativeKernel((const void*)mega, dim3(grid), dim3(512), args, LDS_BYTES, stream);
    if (e != hipSuccess) fprintf(stderr, "cooperative launch failed: %s (grid %d)\n", hipGetErrorString(e), grid);
#else
    for (int ph = 0; ph < NPH; ++ph) { p.ph_lo = ph; p.ph_hi = ph + 1; hipLaunchKernelGGL(mega, dim3(grid), dim3(512), LDS_BYTES, stream, p); }
#endif
}
```

```cpp
#include <hip/hip_runtime.h>
#include <hip/hip_cooperative_groups.h>
#include <cstdio>
namespace cg = cooperative_groups;

#ifndef MEGA
#define MEGA 1
#endif

#define LAS __attribute__((address_space(3)))
typedef unsigned short bf16_t;
typedef short bf16x8 __attribute__((ext_vector_type(8)));
typedef float f32x4 __attribute__((ext_vector_type(4)));
typedef float f32x2 __attribute__((ext_vector_type(2)));

constexpr int D = 2048, DFF = 5632, MTOK = 6144, TCTX = 4096;
constexpr int EVINP = 4352;
constexpr int NPH = 27;
constexpr int LDS_MAIN = 131072;
constexpr int LDS_BYTES = LDS_MAIN + 64;
constexpr float EPS = 1e-6f;

constexpr size_t al256(size_t x) { return (x + 255) & ~(size_t)255; }
constexpr size_t WS_MOD = 0;
constexpr size_t MOD_BYTES = (size_t)2 * 3 * 9 * 2048 * 4;
constexpr size_t WS_BAR = al256(WS_MOD + MOD_BYTES);
constexpr size_t BAR_BYTES = 3456 * 4;
constexpr size_t ZERO_BYTES = WS_BAR + BAR_BYTES;
constexpr size_t WS_X = al256(WS_BAR + BAR_BYTES);
constexpr size_t WS_HM = WS_X + (size_t)MTOK * D * 4;
constexpr size_t WS_H = WS_HM + (size_t)MTOK * D * 2;
constexpr size_t WS_PROJ = WS_H + (size_t)MTOK * DFF * 2;
constexpr size_t WS_WFI = WS_PROJ + (size_t)MTOK * EVINP * 4;
constexpr size_t WS_WFO = WS_WFI + (size_t)4 * 11264 * 2048 * 2;
constexpr size_t WS_WEI = WS_WFO + (size_t)4 * 2048 * 5632 * 2;
constexpr size_t WS_WEO = WS_WEI + (size_t)EVINP * 2048 * 2;
constexpr size_t WS_WGLU = WS_WEO + (size_t)2048 * 2048 * 2;
constexpr size_t WS_WOI = WS_WGLU + (size_t)1024 * 1024 * 2;
constexpr size_t WS_WOO = WS_WOI + (size_t)4096 * 2048 * 2;
constexpr size_t WS_WLRU = WS_WOO + (size_t)2048 * 2048 * 2;
constexpr size_t WS_YS5 = WS_WLRU + (size_t)2 * 8 * 2 * 256 * 256 * 2;
constexpr size_t WS_OGLA = WS_YS5 + (size_t)2 * MTOK * 1024 * 4;
constexpr size_t WS_YS32 = WS_OGLA + (size_t)2 * MTOK * 1024 * 4;
constexpr size_t WS_YSB = WS_YS32 + (size_t)MTOK * 1024 * 4;
constexpr size_t WS_CAT = WS_YSB + (size_t)MTOK * 1024 * 2;
constexpr size_t WS_XC32 = WS_CAT + (size_t)MTOK * D * 2;
constexpr size_t WS_XCB = WS_XC32 + (size_t)MTOK * D * 4;
constexpr size_t WS_LA = WS_XCB + (size_t)MTOK * D * 2;
constexpr size_t WS_LB = WS_LA + (size_t)2 * MTOK * D * 4;
constexpr size_t WS_SP = WS_LB + (size_t)2 * MTOK * D * 4;
constexpr size_t WS_LSUM = WS_SP + (size_t)2 * D * 4;
constexpr size_t WS_END = WS_LSUM + (size_t)2 * 2 * 384 * D * 4;

constexpr size_t OUT_Y = 0;
constexpr size_t OUT_S5RE = (size_t)MTOK * D;
constexpr size_t OUT_S5IM = OUT_S5RE + 16 * 2 * 64 * 64;
constexpr size_t OUT_GLA = OUT_S5IM + 16 * 2 * 64 * 64;
constexpr size_t OUT_LRU = OUT_GLA + (size_t)16 * 2 * 4 * 128 * 256;

struct Params { const float* in[38]; float* out; unsigned char* ws; int ph_lo, ph_hi; };
typedef const __attribute__((address_space(4))) Params* PP;
__device__ __forceinline__ int tidx() { int t = threadIdx.x; asm volatile("" : "+v"(t)); return t; }
__device__ __forceinline__ int bidx() { int b = blockIdx.x; asm volatile("" : "+s"(b)); return b; }
__device__ __forceinline__ int gdim() { int g = gridDim.x; asm volatile("" : "+s"(g)); return g; }
__device__ __forceinline__ PP get_pp() { PP kp = (PP)__builtin_amdgcn_kernarg_segment_ptr(); asm volatile("" : "+s"(kp)); return kp; }
enum { I_XP = 0, I_XS, I_S5RE, I_S5IM, I_SGLA, I_SLRU, I_C, I_CCTX, I_NORMG, I_ADAW, I_ADAB, I_FWI, I_FWO, I_FNG, I_EVWI, I_EVWO,
       I_LAMRE, I_LAMIM, I_LOGSTEP, I_BRE, I_BIM, I_CRE, I_CIM, I_S5D, I_GLUW, I_GLUB, I_GW2, I_GB, I_GNG, I_ODWI, I_ODWO,
       I_CONVW, I_CONVB, I_LWA, I_LBA, I_LWX, I_LBX, I_LLAM };

__device__ __forceinline__ unsigned cvt_pk_bf16(float lo, float hi) { unsigned r; asm("v_cvt_pk_bf16_f32 %0, %1, %2" : "=v"(r) : "v"(lo), "v"(hi)); return r; }
__device__ __forceinline__ bf16_t f2bf(float x) { return (bf16_t)(cvt_pk_bf16(x, 0.f) & 0xffffu); }
__device__ __forceinline__ float bf2f_(bf16_t v) { return __builtin_bit_cast(float, (unsigned)v << 16); }
__device__ __forceinline__ float lo_bf(unsigned w) { return __builtin_bit_cast(float, w << 16); }
__device__ __forceinline__ float hi_bf(unsigned w) { return __builtin_bit_cast(float, w & 0xffff0000u); }
__device__ __forceinline__ f32x4 unpack4(uint2 w) { return (f32x4){lo_bf(w.x), hi_bf(w.x), lo_bf(w.y), hi_bf(w.y)}; }
__device__ __forceinline__ float sigmoidf_(float x) { return __builtin_amdgcn_rcpf(1.f + __expf(-x)); }
__device__ __forceinline__ float siluf_(float x) { return x * __builtin_amdgcn_rcpf(1.f + __expf(-x)); }
__device__ __forceinline__ float geluf_(float x) { return x * sigmoidf_(1.5957691216f * (x + 0.044715f * x * x * x)); }
__device__ __forceinline__ float softplusf_(float x) { return fmaxf(x, 0.f) + log1pf(__expf(-fabsf(x))); }
__device__ __forceinline__ float neg_expm1_(float x) {
    const float pl = -x * (1.f + x * (0.5f + x * (0.16666667f + x * (0.041666668f + x * (0.0083333338f + x * 0.0013888889f))))); return x > -0.25f ? pl : 1.f - __expf(x); }
__device__ __forceinline__ int cond_of_pm(int pm) { return pm < 16 ? 0 : 1 + ((pm - 16) >> 2); }
__device__ __forceinline__ int cond_of_row(int r) { return r < TCTX ? 0 : 1 + ((r - TCTX) >> 10); }
__device__ __forceinline__ bf16x8 pack8(f32x4 a, f32x4 b) {
    typedef unsigned u32x4 __attribute__((ext_vector_type(4)));
    u32x4 u; u[0] = cvt_pk_bf16(a[0], a[1]); u[1] = cvt_pk_bf16(a[2], a[3]); u[2] = cvt_pk_bf16(b[0], b[1]); u[3] = cvt_pk_bf16(b[2], b[3]);
    return __builtin_bit_cast(bf16x8, u);
}

#define XB_TMO      128
#define XB_XCNT(j)  (256  + 64 * (j))
#define XB_XSUB(j)  (1280 + 64 * (j))
#define XB_XGEN(j)  (2304 + 64 * (j))
#define XB_TOP      3328
#define XB_TOPGEN   3392
#define XCD_BAR_WORDS 3456
#define XB_SPIN_CAP (1u << 18)

__device__ __forceinline__ unsigned xb_ld(unsigned* p)              { return __hip_atomic_load(p, __ATOMIC_RELAXED, __HIP_MEMORY_SCOPE_AGENT); }
__device__ __forceinline__ unsigned xb_add(unsigned* p, unsigned v) { return __hip_atomic_fetch_add(p, v, __ATOMIC_RELAXED, __HIP_MEMORY_SCOPE_AGENT); }
__device__ __forceinline__ unsigned xb_xcc_id() { return (unsigned)__builtin_amdgcn_s_getreg((3 << 11) | 20) & 0xFu; }
#define XB_SPIN(cond, bar) do { unsigned _sp = 0; while (cond) { __builtin_amdgcn_s_sleep(1); \
    if ((++_sp & 255u) == 0u) { if (xb_ld(&(bar)[XB_TMO])) break; if (_sp > XB_SPIN_CAP) { atomicAdd(&(bar)[XB_TMO], 1u); break; } } } } while (0)

struct XcdBarrier {
    unsigned* bar; unsigned x;
    volatile LAS unsigned* st;
};

__device__ __forceinline__ XcdBarrier xcd_barrier_post(unsigned* bar, volatile LAS unsigned* st) {
    XcdBarrier b; b.bar = bar; b.x = xb_xcc_id(); b.st = st;
    if (threadIdx.x == 0) (void)xb_add(&bar[XB_XCNT(b.x)], 1u);
    return b;
}
__device__ __forceinline__ void xcd_barrier_complete(unsigned* bar, unsigned x, unsigned& nloc, unsigned& nx) {
    const unsigned G = gridDim.x * gridDim.y * gridDim.z;
    unsigned sum, cnt, mine, sp = 0u;
    for (;;) {
        sum = 0u; cnt = 0u; mine = 0u;
#pragma unroll
        for (unsigned j = 0; j < 16; ++j) { const unsigned c = xb_ld(&bar[XB_XCNT(j)]); sum += c; cnt += (c > 0u) ? 1u : 0u; mine = (j == x) ? c : mine; }
        if (sum == G) break;
        __builtin_amdgcn_s_sleep(1);
        if ((++sp & 255u) == 0u) { if (xb_ld(&bar[XB_TMO])) break; if (sp > XB_SPIN_CAP) { atomicAdd(&bar[XB_TMO], 1u); break; } }
    }
    nloc = mine > 0u ? mine : 1u; nx = cnt > 0u ? cnt : 1u;
}

__device__ __forceinline__ void xcd_barrier(const XcdBarrier& b) {
    asm volatile("s_waitcnt vmcnt(0)" ::: "memory");
    __syncthreads();
    if (threadIdx.x == 0) {
        unsigned* bar = b.bar;
        __builtin_amdgcn_s_waitcnt(0);
        unsigned nloc = b.st[0], nx = b.st[1];
        if (nloc == 0u) { xcd_barrier_complete(bar, b.x, nloc, nx); b.st[0] = nloc; b.st[1] = nx; }
        const unsigned old = xb_add(&bar[XB_XSUB(b.x)], 1u);
        const unsigned gen = old / nloc;
        if (old + 1u == (gen + 1u) * nloc) {
            __builtin_amdgcn_fence(__ATOMIC_RELEASE, "agent");
            asm volatile("s_waitcnt vmcnt(0)" ::: "memory");
            const unsigned og = xb_add(&bar[XB_TOP], 1u);
            const unsigned tg = og / nx;
            if (og + 1u == (tg + 1u) * nx) xb_add(&bar[XB_TOPGEN], 1u);
            else XB_SPIN(xb_ld(&bar[XB_TOPGEN]) == tg, bar);
            __builtin_amdgcn_fence(__ATOMIC_ACQUIRE, "agent");
            xb_add(&bar[XB_XGEN(b.x)], 1u);
            asm volatile("s_waitcnt vmcnt(0)" ::: "memory");
        } else {
            XB_SPIN(xb_ld(&bar[XB_XGEN(b.x)]) == gen, bar);
            __builtin_amdgcn_fence(__ATOMIC_ACQUIRE, "agent");
            asm volatile("s_waitcnt vmcnt(0)" ::: "memory");
        }
    }
    __syncthreads();
}


namespace pg8 {
constexpr int BM = 256, BK = 64, HALF = 128, HTB = HALF * BK * 2, NXCD = 8, WGM = 8;
__device__ __forceinline__ int lds_byte(int r, int c) { const int st = (r >> 4) * 2 + (c >> 5), rr = r & 15, cc = c & 31, ob = rr * 64 + cc * 2; return st * 1024 + (ob ^ (((ob >> 9) & 1) << 5)); }
__device__ __forceinline__ void stage_rc(int b, int& R, int& C) { const int st = b / 1024, sb = b % 1024, swz = sb ^ (((sb >> 9) & 1) << 5); R = (st >> 1) * 16 + swz / 64; C = (st & 1) * 32 + (swz % 64) / 2; }
struct Unit { int pm, pn; };
struct Order {
    int nM, nN, nwg, G, c;
    __device__ __forceinline__ bool next(int i, Unit& u) const {
        const long L = (long)i * G + c; if (L >= nwg) return false;
        int wgid = (int)L; { const int q = nwg / NXCD, r = nwg % NXCD, xcd = wgid % NXCD, off = wgid / NXCD; wgid = (xcd < r ? xcd * (q + 1) : r * (q + 1) + (xcd - r) * q) + off; }
        const int nig = WGM * nN, gid = wgid / nig, fm = gid * WGM, gsz = (nM - fm) < WGM ? (nM - fm) : WGM;
        u.pm = fm + ((wgid % nig) % gsz); u.pn = (wgid % nig) / gsz; return true;
    }
};

template <class Epi, bool LRU, bool BLK = false>
__device__ __forceinline__ void gemm_phase(LAS unsigned char* lds, const bf16_t* A, int lda, const bf16_t* Bt, int ldb, int nM, int nN, int K, const Epi& E) {
    const int tid = tidx(), wid = __builtin_amdgcn_readfirstlane(tid >> 6), lane = tid & 63, wr = wid >> 2, wc = wid & 3, fr = lane & 15, fq = lane >> 4;
    const int nt = K / BK;
    Order S; S.nM = nM; S.nN = nN; S.nwg = nM * nN; S.G = gdim(); S.c = bidx();
    unsigned voffA[2], voffB[2];
#pragma unroll
    for (int i = 0; i < 2; ++i) { int R, C; stage_rc(tid * 16 + i * 8192, R, C); voffA[i] = (unsigned)(R * (BLK ? 64 : lda) + C) * 2u; voffB[i] = (unsigned)(R * (BLK ? 64 : ldb) + C) * 2u; }
    const size_t kstep = BLK ? (size_t)32768 : (size_t)(BK * 2);
    const size_t hstepA = BLK ? (size_t)16384 : (size_t)HALF * lda * 2, hstepB = BLK ? (size_t)16384 : (size_t)HALF * ldb * 2;
    const size_t tstepA = BLK ? (size_t)nt * 32768 : 2 * hstepA, tstepB = BLK ? (size_t)nt * 32768 : 2 * hstepB;
    const unsigned ldsw = (unsigned)wid * 1024u;
    const int aoff = lds_byte(wr * 64 + fr, fq * 8), boff = lds_byte(wc * 32 + fr, fq * 8);
#define PG8_SA(b, h) (((b) * 2 + (h)) * HTB)
#define PG8_SB(b, h) ((4 + (b) * 2 + (h)) * HTB)
#define PG8_STAGE(bufoff, gbase, voff) do { _Pragma("unroll") for (int _i = 0; _i < 2; ++_i) \
        __builtin_amdgcn_global_load_lds((const unsigned*)((const char*)(gbase) + (voff)[_i]), (LAS unsigned*)(lds + (bufoff) + ldsw + _i * 8192), 16, 0, 0); } while (0)
#define PG8_LDA(dst, b, h) do { _Pragma("unroll") for (int m = 0; m < 4; ++m) _Pragma("unroll") for (int k = 0; k < 2; ++k) dst[m][k] = *(const LAS bf16x8*)(lds + PG8_SA(b, h) + aoff + m * 2048 + k * 1024); } while (0)
#define PG8_LDB(dst, b, h) do { _Pragma("unroll") for (int n = 0; n < 2; ++n) _Pragma("unroll") for (int k = 0; k < 2; ++k) dst[n][k] = *(const LAS bf16x8*)(lds + PG8_SB(b, h) + boff + n * 2048 + k * 1024); } while (0)
#define PG8_MMA(ai, bj, At, Bt_) do { __builtin_amdgcn_s_setprio(1); _Pragma("unroll") for (int m = 0; m < 4; ++m) _Pragma("unroll") for (int n = 0; n < 2; ++n) _Pragma("unroll") for (int k = 0; k < 2; ++k) \
        acc[ai][bj][m][n] = __builtin_amdgcn_mfma_f32_16x16x32_bf16(Bt_[n][k], At[m][k], acc[ai][bj][m][n], 0, 0, 0); __builtin_amdgcn_s_setprio(0); } while (0)
#define PG8_WAIT_V(n) asm volatile("s_waitcnt vmcnt(" #n ")" ::: "memory")
#define PG8_WAIT_L(n) asm volatile("s_waitcnt lgkmcnt(" #n ")" ::: "memory")
#define PG8_BAR __builtin_amdgcn_s_barrier()
#define PG8_SCHED __builtin_amdgcn_sched_barrier(0)
#define PG8_APTR(u) ((const char*)A + (size_t)(u).pm * tstepA + (LRU ? (size_t)((((u).pn >> 1) & 7) * 512) : (size_t)0))
#define PG8_BPTR(u) ((const char*)Bt + (size_t)(u).pn * tstepB)
    Unit cur, nxt; int ui = 0;
    if (!S.next(0, cur)) return;
    f32x4 acc[2][2][4][2];
#pragma unroll
    for (int a = 0; a < 2; ++a)
#pragma unroll
        for (int b = 0; b < 2; ++b)
#pragma unroll
            for (int m = 0; m < 4; ++m)
#pragma unroll
                for (int n = 0; n < 2; ++n) acc[a][b][m][n] = (f32x4){0.f, 0.f, 0.f, 0.f};
    bf16x8 At[4][2], B0[2][2], B1[2][2];
    const char* cA = PG8_APTR(cur); const char* cB = PG8_BPTR(cur);
    PG8_STAGE(PG8_SB(0, 0), cB, voffB); PG8_STAGE(PG8_SA(0, 0), cA, voffA); PG8_STAGE(PG8_SB(0, 1), cB + hstepB, voffB); PG8_STAGE(PG8_SA(0, 1), cA + hstepA, voffA);
    if (wr == 1) PG8_BAR;
    PG8_WAIT_V(4); PG8_BAR;
    PG8_STAGE(PG8_SB(1, 0), cB + kstep, voffB); PG8_STAGE(PG8_SA(1, 0), cA + kstep, voffA); PG8_STAGE(PG8_SB(1, 1), cB + hstepB + kstep, voffB);
    PG8_WAIT_V(6); PG8_BAR;
    for (;;) {
        const bool has_next = S.next(ui + 1, nxt);
        const char* nA = has_next ? PG8_APTR(nxt) : cA; const char* nB = has_next ? PG8_BPTR(nxt) : cB;
        for (int t = 0; t < nt; t += 2) {
            const bool last = (t == nt - 2);
            const char* a1 = cA + (size_t)(t + 1) * kstep;
            const char* a2 = last ? nA : cA + (size_t)(t + 2) * kstep; const char* b2 = last ? nB : cB + (size_t)(t + 2) * kstep;
            const char* a3 = a2 + kstep; const char* b3 = b2 + kstep;
            PG8_LDB(B0, 0, 0); PG8_SCHED; PG8_LDA(At, 0, 0); PG8_STAGE(PG8_SA(1, 1), a1 + hstepA, voffA);
            PG8_WAIT_L(8); PG8_BAR; PG8_WAIT_L(0); PG8_MMA(0, 0, At, B0); PG8_BAR; PG8_SCHED;
            PG8_LDB(B1, 0, 1); PG8_STAGE(PG8_SB(0, 0), b2, voffB);
            PG8_BAR; PG8_WAIT_L(0); PG8_MMA(0, 1, At, B1); PG8_BAR;
            PG8_LDA(At, 0, 1); PG8_STAGE(PG8_SA(0, 0), a2, voffA);
            PG8_BAR; PG8_WAIT_L(0); PG8_MMA(1, 0, At, B0); PG8_BAR; PG8_SCHED;
            PG8_STAGE(PG8_SB(0, 1), b2 + hstepB, voffB);
            PG8_WAIT_V(6); PG8_BAR; PG8_MMA(1, 1, At, B1); PG8_BAR;
            PG8_LDB(B0, 1, 0); PG8_SCHED; PG8_LDA(At, 1, 0); PG8_STAGE(PG8_SA(0, 1), a2 + hstepA, voffA);
            PG8_WAIT_L(8); PG8_BAR; PG8_WAIT_L(0); PG8_MMA(0, 0, At, B0); PG8_BAR; PG8_SCHED;
            PG8_LDB(B1, 1, 1); PG8_STAGE(PG8_SB(1, 0), b3, voffB);
            PG8_BAR; PG8_WAIT_L(0); PG8_MMA(0, 1, At, B1); PG8_BAR;
            PG8_LDA(At, 1, 1); PG8_STAGE(PG8_SA(1, 0), a3, voffA);
            PG8_BAR; PG8_WAIT_L(0); PG8_MMA(1, 0, At, B0); PG8_BAR; PG8_SCHED;
            PG8_STAGE(PG8_SB(1, 1), b3 + hstepB, voffB);
            PG8_WAIT_V(6); PG8_BAR; PG8_MMA(1, 1, At, B1); PG8_BAR;
        }
        E(acc, cur, wr, wc, fr, fq);
        if (!has_next) break;
#pragma unroll
        for (int a = 0; a < 2; ++a)
#pragma unroll
            for (int b = 0; b < 2; ++b)
#pragma unroll
                for (int m = 0; m < 4; ++m)
#pragma unroll
                    for (int n = 0; n < 2; ++n) acc[a][b][m][n] = (f32x4){0.f, 0.f, 0.f, 0.f};
        cur = nxt; cA = nA; cB = nB; ++ui;
    }
    PG8_WAIT_V(0);
    if (wr == 0) PG8_BAR;
    PG8_BAR;
#undef PG8_SA
#undef PG8_SB
#undef PG8_STAGE
#undef PG8_LDA
#undef PG8_LDB
#undef PG8_MMA
#undef PG8_WAIT_V
#undef PG8_WAIT_L
#undef PG8_BAR
#undef PG8_SCHED
#undef PG8_APTR
#undef PG8_BPTR
}
}
using pg8::Unit;

struct EpiSwiglu {
    bf16_t* H;
    __device__ __forceinline__ void operator()(const f32x4 (&acc)[2][2][4][2], const Unit& u, int wr, int wc, int fr, int fq) const {
        const int loff = (wr * 64 + fr) * 64 + (wc & 1) * 32 + 4 * fq;
        bf16_t* ub = H + ((size_t)(u.pm * 88 + u.pn * 2 + (wc >> 1)) * 256) * 64;
#pragma unroll
        for (int ai = 0; ai < 2; ++ai)
#pragma unroll
            for (int m = 0; m < 4; ++m) { bf16_t* rb = ub + (size_t)(ai * 128 + m * 16) * 64;
#pragma unroll
                for (int n = 0; n < 2; ++n) { const f32x4 a = acc[ai][0][m][n], b = acc[ai][1][m][n];
                    uint2 pk; pk.x = cvt_pk_bf16(siluf_(a[0]) * b[0], siluf_(a[1]) * b[1]); pk.y = cvt_pk_bf16(siluf_(a[2]) * b[2], siluf_(a[3]) * b[3]);
                    *(uint2*)(rb + loff + n * 16) = pk; } }
    }
};
struct EpiResid {
    float* X; const float* G; float coef; const float* XinC; const float* XinL;
    __device__ __forceinline__ void operator()(const f32x4 (&acc)[2][2][4][2], const Unit& u, int wr, int wc, int fr, int fq) const {
        const int lcol = wc * 32 + 4 * fq, loff = (wr * 64 + fr) * D + lcol;
        const float* g = G + (size_t)cond_of_pm(u.pm) * (9 * 2048) + u.pn * 256;
        float* ub = X + (size_t)u.pm * 256 * D + u.pn * 256;
        const float* ib = (u.pm < 16 ? XinC : XinL) + (size_t)u.pm * 256 * D + u.pn * 256;
        f32x4 gv[2][2];
#pragma unroll
        for (int bj = 0; bj < 2; ++bj)
#pragma unroll
            for (int n = 0; n < 2; ++n) gv[bj][n] = *(const f32x4*)(g + lcol + bj * 128 + n * 16) * coef;
#pragma unroll
        for (int ai = 0; ai < 2; ++ai)
#pragma unroll
            for (int m = 0; m < 4; ++m) { float* rb = ub + (size_t)(ai * 128 + m * 16) * D; const float* ir = ib + (size_t)(ai * 128 + m * 16) * D;
#pragma unroll
                for (int bj = 0; bj < 2; ++bj)
#pragma unroll
                    for (int n = 0; n < 2; ++n) { *(f32x4*)(rb + loff + bj * 128 + n * 16) = *(const f32x4*)(ir + loff + bj * 128 + n * 16) + gv[bj][n] * acc[ai][bj][m][n]; }
                __builtin_amdgcn_sched_barrier(0); }
    }
};
struct EpiF32 {
    float* C; int ldc;
    __device__ __forceinline__ void operator()(const f32x4 (&acc)[2][2][4][2], const Unit& u, int wr, int wc, int fr, int fq) const {
        const int loff = (wr * 64 + fr) * ldc + wc * 32 + 4 * fq;
        float* ub = C + (size_t)u.pm * 256 * ldc + u.pn * 256;
#pragma unroll
        for (int ai = 0; ai < 2; ++ai)
#pragma unroll
            for (int m = 0; m < 4; ++m) { float* rb = ub + (size_t)(ai * 128 + m * 16) * ldc;
#pragma unroll
                for (int bj = 0; bj < 2; ++bj)
#pragma unroll
                    for (int n = 0; n < 2; ++n) *(f32x4*)(rb + loff + bj * 128 + n * 16) = acc[ai][bj][m][n]; }
    }
};
struct EpiBf16 {
    bf16_t* C; int ldc;
    __device__ __forceinline__ void operator()(const f32x4 (&acc)[2][2][4][2], const Unit& u, int wr, int wc, int fr, int fq) const {
        const int loff = (wr * 64 + fr) * ldc + wc * 32 + 4 * fq;
        bf16_t* ub = C + (size_t)u.pm * 256 * ldc + u.pn * 256;
#pragma unroll
        for (int ai = 0; ai < 2; ++ai)
#pragma unroll
            for (int m = 0; m < 4; ++m) { bf16_t* rb = ub + (size_t)(ai * 128 + m * 16) * ldc;
#pragma unroll
                for (int bj = 0; bj < 2; ++bj)
#pragma unroll
                    for (int n = 0; n < 2; ++n) { const f32x4 v = acc[ai][bj][m][n]; uint2 pk; pk.x = cvt_pk_bf16(v[0], v[1]); pk.y = cvt_pk_bf16(v[2], v[3]); *(uint2*)(rb + loff + bj * 128 + n * 16) = pk; } }
    }
};
struct EpiGlu {
    bf16_t* CAT; const bf16_t* YS; const float* bias;
    __device__ __forceinline__ void operator()(const f32x4 (&acc)[2][2][4][2], const Unit& u, int wr, int wc, int fr, int fq) const {
        const int lcol = wc * 32 + 4 * fq, loffY = (wr * 64 + fr) * 1024 + lcol, loffC = (wr * 64 + fr) * D + lcol;
        const float* bb = bias + u.pn * 256; const bf16_t* yb = YS + (size_t)u.pm * 256 * 1024 + u.pn * 256; bf16_t* cb = CAT + (size_t)u.pm * 256 * D + u.pn * 256;
        f32x4 bv[2][2];
#pragma unroll
        for (int bj = 0; bj < 2; ++bj)
#pragma unroll
            for (int n = 0; n < 2; ++n) bv[bj][n] = *(const f32x4*)(bb + lcol + bj * 128 + n * 16);
#pragma unroll
        for (int ai = 0; ai < 2; ++ai)
#pragma unroll
            for (int m = 0; m < 4; ++m) { const bf16_t* yr = yb + (size_t)(ai * 128 + m * 16) * 1024; bf16_t* cr = cb + (size_t)(ai * 128 + m * 16) * D;
#pragma unroll
                for (int bj = 0; bj < 2; ++bj)
#pragma unroll
                    for (int n = 0; n < 2; ++n) { const f32x4 ys = unpack4(*(const uint2*)(yr + loffY + bj * 128 + n * 16)); const f32x4 z = acc[ai][bj][m][n] + bv[bj][n];
                        uint2 pk; pk.x = cvt_pk_bf16(ys[0] * sigmoidf_(z[0]), ys[1] * sigmoidf_(z[1])); pk.y = cvt_pk_bf16(ys[2] * sigmoidf_(z[2]), ys[3] * sigmoidf_(z[3]));
                        *(uint2*)(cr + loffC + bj * 128 + n * 16) = pk; }
                __builtin_amdgcn_sched_barrier(0); }
    }
};
struct EpiLru {
    unsigned* LAB; const bf16_t* XC; const float* ba; const float* bx; const float* sp;
    __device__ __forceinline__ void operator()(const f32x4 (&acc)[2][2][4][2], const Unit& u, int wr, int wc, int fr, int fq) const {
        const int d = u.pn >> 4, h = (u.pn >> 1) & 7, half = u.pn & 1;
        const int chu = h * 256 + half * 128;
        const int lcol = wc * 32 + 4 * fq, loff = (wr * 64 + fr) * D + lcol;
        const bf16_t* xb = XC + (size_t)u.pm * 256 * D + chu; unsigned* lab = LAB + ((size_t)d * MTOK + u.pm * 256) * D + chu;
        f32x4 bav[2], bxv[2], spv[2];
#pragma unroll
        for (int n = 0; n < 2; ++n) { bav[n] = *(const f32x4*)(ba + d * D + chu + lcol + n * 16); bxv[n] = *(const f32x4*)(bx + d * D + chu + lcol + n * 16); spv[n] = *(const f32x4*)(sp + d * D + chu + lcol + n * 16); }
#pragma unroll
        for (int ai = 0; ai < 2; ++ai)
#pragma unroll
            for (int m = 0; m < 4; ++m) { const size_t ro = (size_t)(ai * 128 + m * 16) * D;
#pragma unroll
                for (int n = 0; n < 2; ++n) { const f32x4 xc = unpack4(*(const uint2*)(xb + ro + loff + n * 16));
                    const f32x4 rp = acc[ai][0][m][n] + bav[n], ip = acc[ai][1][m][n] + bxv[n]; uint4 w;
                    unsigned wv[4];
#pragma unroll
                    for (int e = 0; e < 4; ++e) { const float la = spv[n][e] * sigmoidf_(rp[e]); const float bb = __builtin_amdgcn_sqrtf(fmaxf(neg_expm1_(2.f * la), 0.f)) * (sigmoidf_(ip[e]) * xc[e]); wv[e] = cvt_pk_bf16(la, bb); }
                    w.x = wv[0]; w.y = wv[1]; w.z = wv[2]; w.w = wv[3];
                    *(uint4*)(lab + ro + loff + n * 16) = w; __builtin_amdgcn_sched_barrier(0); } }
    }
};

struct CvtT { const float* src; bf16_t* dst; int K, ldsrc, Nsrc, n_dst0, n_src0, k0, blk; };
__device__ __forceinline__ void cvt_decode(PP p, unsigned char* ws, int t, int total, CvtT& c) {
    constexpr int T_FI = 176 * 32, T_FO = 32 * 88, T_EI = 68 * 32, T_EO = 32 * 32, T_GLU = 16 * 16, T_OI = 64 * 32, T_OO = 32 * 32, T_LRU = 4 * 4;
    c.blk = 0;
    if (t >= total) { c.src = nullptr; c.dst = nullptr; c.K = c.ldsrc = c.Nsrc = c.n_dst0 = c.n_src0 = c.k0 = 0; return; }
    if (t < 4 * T_FI) { const int w = t / T_FI; t %= T_FI; const int nt_ = t / 32, kt = t % 32; c.K = 2048; c.ldsrc = 11264; c.Nsrc = 11264; c.src = p->in[I_FWI] + (size_t)w * 2048 * 11264; c.dst = (bf16_t*)(ws + WS_WFI) + (size_t)w * 11264 * 2048;
        c.n_dst0 = nt_ * 64; const int j = c.n_dst0 >> 8, rr = c.n_dst0 & 255; c.n_src0 = rr < 128 ? j * 128 + rr : 5632 + j * 128 + (rr - 128); c.k0 = kt * 64; }
    else if ((t -= 4 * T_FI) < 4 * T_FO) { const int w = t / T_FO; t %= T_FO; const int nt_ = t / 88, kt = t % 88; c.K = 5632; c.ldsrc = 2048; c.Nsrc = 2048; c.src = p->in[I_FWO] + (size_t)w * 5632 * 2048; c.dst = (bf16_t*)(ws + WS_WFO) + (size_t)w * 2048 * 5632; c.n_dst0 = c.n_src0 = nt_ * 64; c.k0 = kt * 64; c.blk = 1; }
    else if ((t -= 4 * T_FO) < T_EI) { const int nt_ = t / 32, kt = t % 32; c.K = 2048; c.ldsrc = 4128; c.Nsrc = 4128; c.src = p->in[I_EVWI]; c.dst = (bf16_t*)(ws + WS_WEI); c.n_dst0 = c.n_src0 = nt_ * 64; c.k0 = kt * 64; }
    else if ((t -= T_EI) < T_EO) { const int nt_ = t / 32, kt = t % 32; c.K = 2048; c.ldsrc = 2048; c.Nsrc = 2048; c.src = p->in[I_EVWO]; c.dst = (bf16_t*)(ws + WS_WEO); c.n_dst0 = c.n_src0 = nt_ * 64; c.k0 = kt * 64; }
    else if ((t -= T_EO) < T_GLU) { const int nt_ = t / 16, kt = t % 16; c.K = 1024; c.ldsrc = 1024; c.Nsrc = 1024; c.src = p->in[I_GLUW]; c.dst = (bf16_t*)(ws + WS_WGLU); c.n_dst0 = c.n_src0 = nt_ * 64; c.k0 = kt * 64; }
    else if ((t -= T_GLU) < T_OI) { const int nt_ = t / 32, kt = t % 32; c.K = 2048; c.ldsrc = 4096; c.Nsrc = 4096; c.src = p->in[I_ODWI]; c.dst = (bf16_t*)(ws + WS_WOI); c.n_dst0 = c.n_src0 = nt_ * 64; c.k0 = kt * 64; }
    else if ((t -= T_OI) < T_OO) { const int nt_ = t / 32, kt = t % 32; c.K = 2048; c.ldsrc = 2048; c.Nsrc = 2048; c.src = p->in[I_ODWO]; c.dst = (bf16_t*)(ws + WS_WOO); c.n_dst0 = c.n_src0 = nt_ * 64; c.k0 = kt * 64; }
    else { t -= T_OO; const int mi = t / T_LRU; t %= T_LRU; const int which = mi >> 4, dh = mi & 15;
        const int nt_ = t / 4, kt = t % 4; c.K = 256; c.ldsrc = 256; c.Nsrc = 256; c.src = (which ? p->in[I_LWX] : p->in[I_LWA]) + (size_t)dh * 65536; c.dst = (bf16_t*)(ws + WS_WLRU) + (size_t)dh * 2 * 65536;
        c.n_src0 = nt_ * 64; const int half = c.n_src0 >> 7; c.n_dst0 = half * 256 + which * 128 + (c.n_src0 & 127); c.k0 = kt * 64; }
}
constexpr int CV_FI = 176 * 32, CV_FO = 32 * 88, CV_TOTAL = 4 * CV_FI + 4 * CV_FO + 68 * 32 + 32 * 32 + 16 * 16 + 64 * 32 + 32 * 32 + 32 * 16;
__device__ __forceinline__ void cvt_range(PP p, unsigned char* lds, int t_lo, int t_hi, int rank, int n) {
    const int tid = tidx(); unsigned char* ws = p->ws; float* tile = (float*)lds;
    for (int g0 = t_lo + rank * 4; g0 < t_hi; g0 += n * 4) {
        f32x4 v[4][2];
#pragma unroll
        for (int q = 0; q < 4; ++q) { CvtT c; cvt_decode(p, ws, g0 + q, t_hi, c);
#pragma unroll
            for (int h = 0; h < 2; ++h) { const int kk = (tid >> 4) + h * 32, n4 = (tid & 15) * 4; const int ns = c.n_src0 + n4;
                v[q][h] = (f32x4){0.f, 0.f, 0.f, 0.f}; if (ns < c.Nsrc) v[q][h] = __builtin_nontemporal_load((const f32x4*)(c.src + (size_t)(c.k0 + kk) * c.ldsrc + ns)); } }
        __syncthreads();
#pragma unroll
        for (int q = 0; q < 4; ++q)
#pragma unroll
            for (int h = 0; h < 2; ++h) { const int kk = (tid >> 4) + h * 32, n4 = (tid & 15) * 4; float* tp = tile + q * 4160 + kk * 65 + n4; tp[0] = v[q][h][0]; tp[1] = v[q][h][1]; tp[2] = v[q][h][2]; tp[3] = v[q][h][3]; }
        __syncthreads();
#pragma unroll
        for (int q = 0; q < 4; ++q) { CvtT c; cvt_decode(p, ws, g0 + q, t_hi, c);
            if (c.dst) { const int nn = tid >> 3, k8 = (tid & 7) * 8; f32x4 a, b2; const float* tp = tile + q * 4160;
#pragma unroll
                for (int j = 0; j < 4; ++j) { a[j] = tp[(k8 + j) * 65 + nn]; b2[j] = tp[(k8 + 4 + j) * 65 + nn]; }
                const int n_ = c.n_dst0 + nn; bf16_t* dp = c.blk ? c.dst + ((size_t)((n_ >> 8) * (c.K >> 6) + (c.k0 >> 6)) * 256 + (n_ & 255)) * 64 + k8 : c.dst + (size_t)n_ * c.K + c.k0 + k8;
                *(bf16x8*)dp = pack8(a, b2); } }
    }
}
__device__ __forceinline__ void mod_items(PP p, unsigned char* lds, int it_lo, int it_hi, int rank, int n) {
    const int tid = tidx(); unsigned char* ws = p->ws;
    float* sc = (float*)lds;
    __syncthreads();
    for (int i = tid; i < 3 * 2048; i += 512) { const int ci = i >> 11, k = i & 2047; const float v = ci == 0 ? p->in[I_CCTX][k] : p->in[I_C][(ci - 1) * 2048 + k]; sc[i] = siluf_(v); }
    __syncthreads();
    float* MOD = (float*)(ws + WS_MOD);
    for (int it = it_lo + rank; it < it_hi; it += n) { const int l = it / 288, r = it % 288, chunk = r / 32, ks = r % 32; const int col = chunk * 2048 + tid * 4;
        const float* W = p->in[I_ADAW] + (size_t)l * 2048 * 18432 + (size_t)(ks * 64) * 18432 + col;
        f32x4 a0 = (f32x4){0.f, 0.f, 0.f, 0.f}, a1 = a0, a2 = a0;
#pragma unroll 8
        for (int k = 0; k < 64; ++k) { const f32x4 w = __builtin_nontemporal_load((const f32x4*)(W + (size_t)k * 18432)); const int kk = ks * 64 + k; a0 += w * sc[kk]; a1 += w * sc[2048 + kk]; a2 += w * sc[4096 + kk]; }
        if (ks == 0) { const f32x4 bb = *(const f32x4*)(p->in[I_ADAB] + (size_t)l * 18432 + col); a0 += bb; a1 += bb; a2 += bb; }
        float* m0 = MOD + (size_t)(l * 3) * 18432 + col;
#pragma unroll
        for (int e = 0; e < 4; ++e) { atomicAdd(m0 + e, a0[e]); atomicAdd(m0 + 18432 + e, a1[e]); atomicAdd(m0 + 2 * 18432 + e, a2[e]); } }
    __syncthreads();
}
__device__ void phase_prep(PP p, LAS unsigned char* ldsr, int skip_mod) {
    unsigned char* lds = (unsigned char*)ldsr;
    const int tid = tidx(), bid = bidx(), nb = gdim();
    unsigned char* ws = p->ws;
    if (!skip_mod) mod_items(p, lds, 0, 288, bid, nb);
    cvt_range(p, lds, 0, CV_FI, bid, nb);
}
__device__ void bg_convert(PP p, LAS unsigned char* ldsr, int ph) {
    unsigned char* lds = (unsigned char*)ldsr; const int bid = bidx();
    constexpr int S0 = 4 * CV_FI + 4 * CV_FO, S_EI = S0, S_EO = S_EI + 2176, S_OI = S_EO + 1024 + 256, S_OO = S_OI + 2048;
    __syncthreads();
    if (ph == 2) { if (bid >= 32) { cvt_range(p, lds, 4 * CV_FI, 4 * CV_FI + CV_FO, bid - 32, 224); cvt_range(p, lds, S_EI, S_EO, bid - 32, 224); } }
    else if (ph == 3) { if (bid >= 192) cvt_range(p, lds, CV_FI, 2 * CV_FI, bid - 192, 64); }
    else if (ph == 5) { if (bid >= 152) cvt_range(p, lds, S_EO, S_OO, bid - 152, 104); }
    else if (ph == 8) { if (bid >= 96) cvt_range(p, lds, 4 * CV_FI + CV_FO, 4 * CV_FI + 2 * CV_FO, bid - 96, 160); }
    else if (ph == 9) { if (bid >= 192) cvt_range(p, lds, S_OO, CV_TOTAL, bid - 192, 64); }
    else if (ph == 11) { if (bid >= 32) cvt_range(p, lds, 2 * CV_FI, 3 * CV_FI, bid - 32, 224); }
    else if (ph == 12) { if (bid >= 192) { mod_items(p, lds, 288, 448, bid - 192, 64); cvt_range(p, lds, 4 * CV_FI + 2 * CV_FO, 4 * CV_FI + 3 * CV_FO, bid - 192, 64); } }
    else if (ph == 14) { if (bid >= 32) cvt_range(p, lds, 3 * CV_FI, 4 * CV_FI, bid - 32, 224); }
    else if (ph == 15) { if (bid >= 192) { cvt_range(p, lds, 4 * CV_FI + 3 * CV_FO, 4 * CV_FI + 4 * CV_FO, bid - 192, 64); mod_items(p, lds, 448, 576, bid - 192, 64); } }
}

__device__ void phase_norm(PP p, int l, int j  ) {
    const int tid = tidx(), lane = tid & 63, wid = tid >> 6; const int gw = bidx() * 8 + wid, nw = gdim() * 8;
    const float* X = (const float*)(p->ws + WS_X); bf16_t* HM = (bf16_t*)(p->ws + WS_HM);
    const float* g = j < 0 ? p->in[I_FNG] : p->in[I_NORMG] + (size_t)(l * 3 + j) * D;
    const bool from_in = (l == 0 && j == 0);
    for (int r = gw; r < MTOK; r += nw) {
        const float* xr = from_in ? (r < TCTX ? p->in[I_XP] + (size_t)r * D : p->in[I_XS] + (size_t)(r - TCTX) * D) : X + (size_t)r * D; f32x4 v[8]; float ss = 0.f;
#pragma unroll
        for (int i = 0; i < 8; ++i) { v[i] = *(const f32x4*)(xr + lane * 4 + i * 256); ss += v[i][0] * v[i][0] + v[i][1] * v[i][1] + v[i][2] * v[i][2] + v[i][3] * v[i][3]; }
#pragma unroll
        for (int o = 32; o >= 1; o >>= 1) ss += __shfl_xor(ss, o);
        const float rinv = rsqrtf(ss * (1.f / D) + EPS);
        if (j < 0) { float* o = p->out + OUT_Y + (size_t)r * D;
#pragma unroll
            for (int i = 0; i < 8; ++i) { const int c = lane * 4 + i * 256; const f32x4 gg = *(const f32x4*)(g + c); *(f32x4*)(o + c) = v[i] * rinv * gg; } }
        else { const float* mod = (const float*)(p->ws + WS_MOD) + (size_t)(l * 3 + cond_of_row(r)) * 18432; const float* sh = mod + (3 * j) * 2048; const float* scl = mod + (3 * j + 1) * 2048;
#pragma unroll
            for (int i = 0; i < 8; ++i) { const int c = lane * 4 + i * 256; const f32x4 gg = *(const f32x4*)(g + c), s1 = *(const f32x4*)(scl + c), s0 = *(const f32x4*)(sh + c);
                const f32x4 y = (v[i] * rinv * gg) * (s1 + 1.f) + s0; uint2 pk; pk.x = cvt_pk_bf16(y[0], y[1]); pk.y = cvt_pk_bf16(y[2], y[3]); *(uint2*)(HM + (size_t)r * D + c) = pk; } }
    }
}

__device__ __forceinline__ void seq_info(int s, int& L, int& row0) { if (s < 16) { L = 256; row0 = s * 256; } else { L = 1024; row0 = TCTX + (s - 16) * 1024; } }

#define WAVE_LDS_SYNC() asm volatile("s_waitcnt lgkmcnt(0)" ::: "memory")
__device__ __forceinline__ void s5_item(PP p, unsigned char* lds, int s, int d, int gg) {
    const int tid = tidx(), lane = tid & 63, wid = tid >> 6, fr = lane & 15, fq = lane >> 4; const int g = gg * 8 + wid;
    int L, row0; seq_info(s, L, row0);
    float* HS = (float*)(lds + wid * 8448);
    const bf16_t* PROJ = (const bf16_t*)(p->ws + WS_PROJ); float* Y = (float*)(p->ws + WS_YS5) + (size_t)d * MTOK * 1024;
    const int pg0 = (d * 64 + g) * 64, pg = pg0 + lane;
    const float lre = p->in[I_LAMRE][pg], lim = p->in[I_LAMIM][pg], dt = expf(p->in[I_LOGSTEP][d * 64 + g]);
    const float mag = expf(lre * dt); float sn, cs; sincosf(lim * dt, &sn, &cs);
    const float abr = mag * cs, abi = mag * sn, den = lre * lre + lim * lim, nre = abr - 1.f;
    const float fre = (nre * lre + abi * lim) / den, fim = (abi * lre - nre * lim) / den;
    bf16x8 af[8];
#pragma unroll
    for (int tq = 0; tq < 4; ++tq) { const int src = tq * 16 + fr; const float f_r = __shfl(fre, src), f_i = __shfl(fim, src);
        f32x4 r0 = (f32x4){0.f, 0.f, 0.f, 0.f}, r1 = r0, i0 = r0, i1 = r0;
        if (fq < 2) { const float* br = p->in[I_BRE] + (size_t)(pg0 + src) * 16 + fq * 8; const float* bi = p->in[I_BIM] + (size_t)(pg0 + src) * 16 + fq * 8;
            r0 = *(const f32x4*)br; r1 = *(const f32x4*)(br + 4); i0 = *(const f32x4*)bi; i1 = *(const f32x4*)(bi + 4); }
        af[tq] = pack8(r0 * f_r - i0 * f_i, r1 * f_r - i1 * f_i); af[tq + 4] = pack8(i0 * f_r + r0 * f_i, i1 * f_r + r1 * f_i); }
    bf16x8 cf[4];
#pragma unroll
    for (int kk = 0; kk < 4; ++kk) { const float* cp = (kk < 2 ? p->in[I_CRE] : p->in[I_CIM]) + ((size_t)(d * 64 + g) * 16 + fr) * 64 + (kk & 1) * 32 + fq * 8;
        f32x4 a = *(const f32x4*)cp, b = *(const f32x4*)(cp + 4); if (kk >= 2) { a = -a; b = -b; } cf[kk] = pack8(a, b); }
    float hr = 0.f, hi = 0.f;
    if (s >= 16) { const size_t o = ((size_t)((s - 16) * 2 + d) * 64 + g) * 64 + lane; hr = p->in[I_S5RE][o]; hi = p->in[I_S5IM][o]; }
    const f32x4 z4 = (f32x4){0.f, 0.f, 0.f, 0.f};
    bf16x8 un = (bf16x8){0, 0, 0, 0, 0, 0, 0, 0};
#define S5_LOADU(c0_) do { if (fq < 2) { const int row_ = row0 + (d ? L - 1 - ((c0_) + fr) : (c0_) + fr); un = *(const bf16x8*)(PROJ + (size_t)row_ * EVINP + g * 16 + fq * 8); } } while (0)
    S5_LOADU(0);
    __syncthreads();
    for (int c0 = 0; c0 < L; c0 += 16) {
        const bf16x8 ub = un;
        if (c0 + 16 < L) S5_LOADU(c0 + 16);
#pragma unroll
        for (int t8 = 0; t8 < 8; ++t8) { const f32x4 bu = __builtin_amdgcn_mfma_f32_16x16x32_bf16(af[t8], ub, z4, 0, 0, 0); *(f32x4*)(HS + fr * 132 + t8 * 16 + fq * 4) = bu; }
        WAVE_LDS_SYNC();
#pragma unroll
        for (int i = 0; i < 16; ++i) { const float bur = HS[i * 132 + lane], bui = HS[i * 132 + 64 + lane];
            const float nr = abr * hr - abi * hi + bur, ni = abr * hi + abi * hr + bui; hr = nr; hi = ni;
            HS[i * 132 + lane] = hr; HS[i * 132 + 64 + lane] = hi; }
        WAVE_LDS_SYNC();
        { f32x4 acc = z4;
#pragma unroll
          for (int kk = 0; kk < 4; ++kk) { const float* hp = HS + fr * 132 + kk * 32 + fq * 8; const bf16x8 hb = pack8(*(const f32x4*)hp, *(const f32x4*)(hp + 4));
              acc = __builtin_amdgcn_mfma_f32_16x16x32_bf16(cf[kk], hb, acc, 0, 0, 0); }
          const int row = row0 + (d ? L - 1 - (c0 + fr) : c0 + fr);
          *(f32x4*)(Y + (size_t)row * 1024 + g * 16 + fq * 4) = acc; }
        WAVE_LDS_SYNC();
    }
#undef S5_LOADU
    if (s < 16) { const size_t o = ((size_t)(s * 2 + d) * 64 + g) * 64 + lane; p->out[OUT_S5RE + o] = hr; p->out[OUT_S5IM + o] = hi; }
}

template <int NK32> __device__ __forceinline__ f32x4 mma_lds(f32x4 acc, const bf16_t* X, int ldx, const bf16_t* Y, int ldy, int lane) {
    const bf16_t* xp = X + (lane & 15) * ldx + (lane >> 4) * 8; const bf16_t* yp = Y + (lane & 15) * ldy + (lane >> 4) * 8;
#pragma unroll
    for (int kk = 0; kk < NK32; ++kk) acc = __builtin_amdgcn_mfma_f32_16x16x32_bf16(*(const bf16x8*)(xp + kk * 32), *(const bf16x8*)(yp + kk * 32), acc, 0, 0, 0);
    return acc;
}

__device__ __forceinline__ void gla_item(PP p, unsigned char* lds, int s, int h, int d, int vh) {
    const int tid = tidx(), lane = tid & 63, wid = tid >> 6, fr = lane & 15, fq = lane >> 4;
    int L, row0; seq_info(s, L, row0);
    bf16_t* QT = (bf16_t*)(lds);
    bf16_t* KT = (bf16_t*)(lds + 17408);
    bf16_t* KE = (bf16_t*)(lds + 34816);
    bf16_t* VT = (bf16_t*)(lds + 53248);
    bf16_t* ATT = (bf16_t*)(lds + 71680);
    bf16_t* ST = (bf16_t*)(lds + 80896);
    float* LOGA = (float*)(lds + 80896);
    float* SEG = (float*)(lds + 115712);
    float* GLR = (float*)(lds + 117760);
    float* W2S = (float*)(lds + 121856);
    float* GBS = (float*)(lds + 130048);
    float* DEC = (float*)(lds + 130560);
    const bf16_t* PROJ = (const bf16_t*)(p->ws + WS_PROJ); float* O = (float*)(p->ws + WS_OGLA) + (size_t)d * MTOK * 1024;
    __syncthreads();
    for (int i = tid; i < 16 * 128; i += 512) W2S[i] = p->in[I_GW2][(size_t)(d * 16 + (i >> 7)) * 512 + h * 128 + (i & 127)];
    if (tid < 128) GBS[tid] = p->in[I_GB][d * 512 + h * 128 + tid];
    f32x4 sacc[8];
#pragma unroll
    for (int tn = 0; tn < 8; ++tn) { sacc[tn] = (f32x4){0.f, 0.f, 0.f, 0.f};
        if (s >= 16) { const float* sp = p->in[I_SGLA] + ((size_t)(((s - 16) * 2 + d) * 4 + h) * 128 + wid * 16 + fq * 4) * 256 + vh * 128 + tn * 16 + fr;
#pragma unroll
            for (int e = 0; e < 4; ++e) sacc[tn][e] = sp[(size_t)e * 256]; } }
    const float qscale = 0.08838834764831845f;
    const int nch = L >> 6;
    const int c = tid & 127, ig = tid >> 7;
#define GROW(n_, i) (row0 + (d ? L - 1 - ((n_) * 64 + (i)) : (n_) * 64 + (i)))
    f32x4 glr4 = (f32x4){0.f, 0.f, 0.f, 0.f}; float qv[16], kv[16], vv[16];
#define GLA_PREFETCH(n_) do { \
        if (tid < 256) glr4 = unpack4(*(const uint2*)(PROJ + (size_t)GROW(n_, tid >> 2) * EVINP + 4096 + d * 16 + (tid & 3) * 4)); \
        _Pragma("unroll") for (int ii = 0; ii < 16; ++ii) { const size_t ro = (size_t)GROW(n_, ig * 16 + ii) * EVINP; \
            qv[ii] = bf2f_(PROJ[ro + 1024 + h * 128 + c]); kv[ii] = bf2f_(PROJ[ro + 1536 + h * 128 + c]); vv[ii] = bf2f_(PROJ[ro + 2048 + h * 256 + vh * 128 + c]); } } while (0)
    GLA_PREFETCH(0);
    for (int n = 0; n < nch; ++n) {
        __syncthreads();
        if (tid < 256) *(f32x4*)(GLR + (tid >> 2) * 16 + (tid & 3) * 4) = glr4;
        __syncthreads();
        { float run = 0.f; const float gb = GBS[c];
          float w2[16];
#pragma unroll
          for (int r = 0; r < 16; ++r) w2[r] = W2S[r * 128 + c];
          for (int ii = 0; ii < 16; ++ii) { const int i = ig * 16 + ii; float z = gb;
#pragma unroll
              for (int q = 0; q < 4; ++q) { const f32x4 g4 = *(const f32x4*)(GLR + i * 16 + q * 4);
#pragma unroll
                  for (int e = 0; e < 4; ++e) z += g4[e] * w2[q * 4 + e]; }
              run -= (fmaxf(-z, 0.f) + __logf(1.f + __expf(-fabsf(z)))) * (1.f / 16.f); LOGA[i * 128 + c] = run; }
          SEG[ig * 128 + c] = run; }
        __syncthreads();
        { float pre = 0.f, tot = 0.f;
#pragma unroll
          for (int q = 0; q < 4; ++q) { const float sg = SEG[q * 128 + c]; tot += sg; if (q < ig) pre += sg; }
          if (ig == 0) DEC[c] = __expf(tot);
#pragma unroll
          for (int ii = 0; ii < 16; ++ii) { const int i = ig * 16 + ii; const float bc = LOGA[i * 128 + c] + pre;
              QT[i * 136 + c] = f2bf(qv[ii] * qscale * __expf(bc)); KT[i * 136 + c] = f2bf(kv[ii] * __expf(-bc)); KE[c * 72 + i] = f2bf(kv[ii] * __expf(tot - bc)); VT[c * 72 + i] = f2bf(vv[ii]); } }
        __syncthreads();
        if (n + 1 < nch) GLA_PREFETCH(n + 1);
#pragma unroll
        for (int q = 0; q < 2; ++q) { const int tile = wid * 2 + q, ti = tile >> 2, tj = tile & 3; f32x4 a = (f32x4){0.f, 0.f, 0.f, 0.f};
            if (tj <= ti) a = mma_lds<4>(a, QT + ti * 16 * 136, 136, KT + tj * 16 * 136, 136, lane);
#pragma unroll
            for (int e = 0; e < 4; ++e) { const int i = ti * 16 + fq * 4 + e, jx = tj * 16 + fr; ATT[i * 72 + jx] = f2bf(jx <= i ? a[e] : 0.f); } }
#pragma unroll
        for (int tn = 0; tn < 8; ++tn) { uint2 pk; pk.x = cvt_pk_bf16(sacc[tn][0], sacc[tn][1]); pk.y = cvt_pk_bf16(sacc[tn][2], sacc[tn][3]); *(uint2*)(ST + (tn * 16 + fr) * 136 + wid * 16 + fq * 4) = pk; }
        __syncthreads();
#pragma unroll
        for (int ti = 0; ti < 4; ++ti) { f32x4 o = (f32x4){0.f, 0.f, 0.f, 0.f};
            o = mma_lds<2>(o, ATT + ti * 16 * 72, 72, VT + wid * 16 * 72, 72, lane);
            o = mma_lds<4>(o, QT + ti * 16 * 136, 136, ST + wid * 16 * 136, 136, lane);
#pragma unroll
            for (int e = 0; e < 4; ++e) { const int i = ti * 16 + fq * 4 + e; O[(size_t)GROW(n, i) * 1024 + h * 256 + vh * 128 + wid * 16 + fr] = o[e]; } }
        { f32x4 dc;
#pragma unroll
          for (int e = 0; e < 4; ++e) dc[e] = DEC[wid * 16 + fq * 4 + e];
#pragma unroll
          for (int tn = 0; tn < 8; ++tn) { sacc[tn] = sacc[tn] * dc; sacc[tn] = mma_lds<2>(sacc[tn], KE + wid * 16 * 72, 72, VT + tn * 16 * 72, 72, lane); } }
    }
#undef GROW
#undef GLA_PREFETCH
    if (s < 16) {
#pragma unroll
        for (int tn = 0; tn < 8; ++tn) { float* sp = p->out + OUT_GLA + ((size_t)((s * 2 + d) * 4 + h) * 128 + wid * 16 + fq * 4) * 256 + vh * 128 + tn * 16 + fr;
#pragma unroll
            for (int e = 0; e < 4; ++e) sp[(size_t)e * 256] = sacc[tn][e]; } }
}

__device__ void phase_s5gla(PP p, LAS unsigned char* ldsr) {
    unsigned char* lds = (unsigned char*)ldsr; const int bid = bidx(), nb = gdim();
    if (nb >= 64) {
        if (bid < 32) { gla_item(p, lds, 16 + (bid >> 4), (bid >> 2) & 3, (bid >> 1) & 1, bid & 1); return; }
        for (int it = bid - 32; it < 544; it += nb - 32) {
            if (it < 32) s5_item(p, lds, 16 + (it >> 4), (it >> 3) & 1, it & 7);
            else if (it < 288) { const int q = it - 32; s5_item(p, lds, q >> 4, (q >> 3) & 1, q & 7); }
            else { const int q = it - 288; gla_item(p, lds, q >> 4, (q >> 2) & 3, (q >> 1) & 1, q & 1); }
        }
    } else {
        for (int it = bid; it < 576; it += nb) {
            if (it < 32) { gla_item(p, lds, 16 + (it >> 4), (it >> 2) & 3, (it >> 1) & 1, it & 1); }
            else if (it < 64) { const int q = it - 32; s5_item(p, lds, 16 + (q >> 4), (q >> 3) & 1, q & 7); }
            else if (it < 320) { const int q = it - 64; s5_item(p, lds, q >> 4, (q >> 3) & 1, q & 7); }
            else { const int q = it - 320; gla_item(p, lds, q >> 4, (q >> 2) & 3, (q >> 1) & 1, q & 1); }
        }
    }
}

__device__ void phase_evpost(PP p) {
    const int tid = tidx(), lane = tid & 63, wid = tid >> 6; const int gw = bidx() * 8 + wid, nw = gdim() * 8;
    const bf16_t* PROJ = (const bf16_t*)(p->ws + WS_PROJ); const float* Y0 = (const float*)(p->ws + WS_YS5); const float* Y1 = Y0 + (size_t)MTOK * 1024;
    const float* O0 = (const float*)(p->ws + WS_OGLA); const float* O1 = O0 + (size_t)MTOK * 1024;
    bf16_t* YSB = (bf16_t*)(p->ws + WS_YSB); bf16_t* CAT = (bf16_t*)(p->ws + WS_CAT);
    for (int r = gw; r < MTOK; r += nw) {
#pragma unroll
        for (int i = 0; i < 4; ++i) { const int c = lane * 4 + i * 256; const f32x4 y0 = *(const f32x4*)(Y0 + (size_t)r * 1024 + c), y1 = *(const f32x4*)(Y1 + (size_t)r * 1024 + c);
            const f32x4 u = unpack4(*(const uint2*)(PROJ + (size_t)r * EVINP + c)), dd = *(const f32x4*)(p->in[I_S5D] + c); f32x4 v = y0 + y1 + dd * u;
#pragma unroll
            for (int e = 0; e < 4; ++e) v[e] = geluf_(v[e]);
            uint2 pk; pk.x = cvt_pk_bf16(v[0], v[1]); pk.y = cvt_pk_bf16(v[2], v[3]); *(uint2*)(YSB + (size_t)r * 1024 + c) = pk; }
        { const int c0 = lane * 16; f32x4 o[4]; float ss = 0.f;
#pragma unroll
          for (int i = 0; i < 4; ++i) { o[i] = *(const f32x4*)(O0 + (size_t)r * 1024 + c0 + i * 4) + *(const f32x4*)(O1 + (size_t)r * 1024 + c0 + i * 4); ss += o[i][0] * o[i][0] + o[i][1] * o[i][1] + o[i][2] * o[i][2] + o[i][3] * o[i][3]; }
#pragma unroll
          for (int m = 8; m >= 1; m >>= 1) ss += __shfl_xor(ss, m);
          const float rinv = rsqrtf(ss * (1.f / 256.f) + EPS);
#pragma unroll
          for (int i = 0; i < 4; ++i) { const int c = c0 + i * 4; const f32x4 ng = *(const f32x4*)(p->in[I_GNG] + (c & 255)), gt = unpack4(*(const uint2*)(PROJ + (size_t)r * EVINP + 3072 + c)); f32x4 v;
#pragma unroll
              for (int e = 0; e < 4; ++e) v[e] = o[i][e] * rinv * ng[e] * siluf_(gt[e]);
              uint2 pk; pk.x = cvt_pk_bf16(v[0], v[1]); pk.y = cvt_pk_bf16(v[2], v[3]); *(uint2*)(CAT + (size_t)r * D + 1024 + c) = pk; } }
    }
}

__device__ void phase_conv(PP p) {
    const bf16_t* PROJ = (const bf16_t*)(p->ws + WS_PROJ); bf16_t* XCB = (bf16_t*)(p->ws + WS_XCB);
    const float* cw = p->in[I_CONVW]; const float* cb = p->in[I_CONVB];
    const size_t total = (size_t)MTOK * 512;
    { const int gi = bidx() * 512 + tidx(); if (gi < 2 * D) ((float*)(p->ws + WS_SP))[gi] = -8.f * softplusf_(-p->in[I_LLAM][gi]); }
    for (size_t i = (size_t)bidx() * 512 + tidx(); i < total; i += (size_t)gdim() * 512) {
        const int r = (int)(i >> 9), c = (int)(i & 511) * 4; const int seg = r < TCTX ? 256 : 64; const int pos = r & (seg - 1);
        f32x4 acc = *(const f32x4*)(cb + c);
#pragma unroll
        for (int j = 0; j < 4; ++j) { const int pp = pos + j - 2; if (pp >= 0 && pp < seg) acc += *(const f32x4*)(cw + j * D + c) * unpack4(*(const uint2*)(PROJ + (size_t)(r + j - 2) * 4096 + 2048 + c)); }
        uint2 pk; pk.x = cvt_pk_bf16(acc[0], acc[1]); pk.y = cvt_pk_bf16(acc[2], acc[3]); *(uint2*)(XCB + (size_t)r * D + c) = pk;
    }
}
__device__ void phase_lruscan1(PP p) {
    const int tid = tidx(), lane = tid & 63, wid = tid >> 6; const int nb = gdim();
    float* SUM = (float*)(p->ws + WS_LSUM);
    for (int it = bidx() * 8 + wid; it < 384 * 64; it += 8 * nb) {
        const int q = it >> 6, d = (it >> 5) & 1, c = (it & 31) * 64 + lane; const int row0 = q * 16;
        const unsigned* LAB = (const unsigned*)(p->ws + WS_LA) + ((size_t)d * MTOK + row0) * D + c;
        unsigned wv[16];
#pragma unroll
        for (int j = 0; j < 16; ++j) wv[j] = LAB[(size_t)j * D];
        float S = 0.f, h = 0.f;
        if (d == 0) {
#pragma unroll
            for (int j = 0; j < 16; ++j) { const float la = lo_bf(wv[j]); h = __expf(la) * h + hi_bf(wv[j]); S += la; } }
        else {
#pragma unroll
            for (int j = 15; j >= 0; --j) { const float la = lo_bf(wv[j]); h = __expf(la) * h + hi_bf(wv[j]); S += la; } }
        SUM[((size_t)d * 384 + q) * D + c] = __expf(S); SUM[((size_t)(2 + d) * 384 + q) * D + c] = h;
    }
}
__device__ void phase_lruscan2(PP p) {
    const int tid = tidx(), lane = tid & 63, wid = tid >> 6; const int nb = gdim();
    const float* SUM = (const float*)(p->ws + WS_LSUM); const bf16_t* PROJ = (const bf16_t*)(p->ws + WS_PROJ); bf16_t* CAT = (bf16_t*)(p->ws + WS_CAT);
    for (int it0 = bidx() * 8 + wid; it0 < 384 * 32; it0 += 8 * nb) {
        const int it = it0 < 128 * 32 ? it0 + 256 * 32 : it0 - 128 * 32;
        const int q = it >> 5, c = (it & 31) * 64 + lane; const int row0 = q * 16;
        int qs, ql, s; if (q < 256) { s = q >> 4; qs = s * 16; ql = qs + 15; } else { s = 16 + ((q - 256) >> 6); qs = 256 + (s - 16) * 64; ql = qs + 63; }
        float h0 = 0.f, h1 = 0.f;
        if (s >= 16) { h0 = p->in[I_SLRU][(size_t)((s - 16) * 2 + 0) * D + c]; h1 = p->in[I_SLRU][(size_t)((s - 16) * 2 + 1) * D + c]; }
        const float* P0 = SUM + c; const float* H0 = SUM + (size_t)2 * 384 * D + c; const float* P1 = SUM + (size_t)384 * D + c; const float* H1 = SUM + (size_t)3 * 384 * D + c;
        { int j = qs;
          for (; j + 8 <= q; j += 8) { float pv[8], hv[8];
#pragma unroll
              for (int e = 0; e < 8; ++e) { pv[e] = P0[(size_t)(j + e) * D]; hv[e] = H0[(size_t)(j + e) * D]; }
#pragma unroll
              for (int e = 0; e < 8; ++e) h0 = pv[e] * h0 + hv[e]; }
          for (; j < q; ++j) h0 = P0[(size_t)j * D] * h0 + H0[(size_t)j * D]; }
        { int j = ql;
          for (; j - 8 >= q; j -= 8) { float pv[8], hv[8];
#pragma unroll
              for (int e = 0; e < 8; ++e) { pv[e] = P1[(size_t)(j - e) * D]; hv[e] = H1[(size_t)(j - e) * D]; }
#pragma unroll
              for (int e = 0; e < 8; ++e) h1 = pv[e] * h1 + hv[e]; }
          for (; j > q; --j) h1 = P1[(size_t)j * D] * h1 + H1[(size_t)j * D]; }
        const unsigned* W0 = (const unsigned*)(p->ws + WS_LA) + (size_t)row0 * D + c; const unsigned* W1 = W0 + (size_t)MTOK * D; const bf16_t* GT = PROJ + (size_t)row0 * 4096 + c;
        unsigned w0[16], w1[16]; float b0[16], gt[16];
#pragma unroll
        for (int j = 0; j < 16; ++j) { w0[j] = W0[(size_t)j * D]; w1[j] = W1[(size_t)j * D]; gt[j] = bf2f_(GT[(size_t)j * 4096]); }
#pragma unroll
        for (int j = 0; j < 16; ++j) { h0 = __expf(lo_bf(w0[j])) * h0 + hi_bf(w0[j]); b0[j] = h0; }
#pragma unroll
        for (int j = 15; j >= 0; --j) { h1 = __expf(lo_bf(w1[j])) * h1 + hi_bf(w1[j]); CAT[(size_t)(row0 + j) * D + c] = f2bf((b0[j] + h1) * geluf_(gt[j])); }
        if (s < 16) { if (q == ql) p->out[OUT_LRU + (size_t)(s * 2 + 0) * D + c] = h0; if (q == qs) p->out[OUT_LRU + (size_t)(s * 2 + 1) * D + c] = h1; }
    }
}

#ifndef PHMASK
#define PHMASK 0xFFFFFFFFu
#endif
#define PHON(k) ((PHMASK >> (k)) & 1u)
#ifndef DUPMASK
#define DUPMASK 0u
#endif
enum { K_PREP = 0, K_NORM, K_SWIGLU, K_RESID, K_F32, K_S5GLA, K_EVPOST, K_GLU, K_CONV, K_LRUG, K_LRUSCAN, K_LRUCOMB };
__global__ void __launch_bounds__(512, 2) mega(Params p) {
    extern __shared__ __attribute__((aligned(16))) unsigned char shm[];
    LAS unsigned char* lds = (LAS unsigned char*)shm;
    cg::grid_group grid = cg::this_grid();
    const int ph_lo = p.ph_lo, ph_hi = p.ph_hi;
    int rep = 0;
    volatile LAS unsigned* bst = (volatile LAS unsigned*)(lds + LDS_MAIN);
    if (threadIdx.x < 16) bst[threadIdx.x] = 0u;
    __syncthreads();
    XcdBarrier xbar = xcd_barrier_post((unsigned*)(p.ws + WS_BAR), bst);
    for (int ph = ph_lo; ph < ph_hi; ++ph) {
        PP pp = get_pp();
        unsigned char* ws = pp->ws;
        const float* MOD = (const float*)(ws + WS_MOD);
        int kind, l = 0, a0 = 0;
        if (ph == 0) kind = K_PREP;
        else if (ph == 26) { kind = K_NORM; a0 = -1; }
        else { l = ph > 12 ? 1 : 0; const int q = ph - 1 - 12 * l;
            if (q == 0) { kind = K_NORM; a0 = 0; }
            else if (q == 1) { kind = K_SWIGLU; a0 = 0; }
            else if (q == 2) { kind = K_RESID; a0 = 0; }
            else if (q == 3) { kind = K_NORM; a0 = 1; }
            else if (q == 4) kind = K_F32;
            else if (l == 0) { if (q == 5) kind = K_S5GLA; else if (q == 6) kind = K_EVPOST; else if (q == 7) kind = K_GLU; else if (q == 8) { kind = K_RESID; a0 = 2; } else if (q == 9) { kind = K_NORM; a0 = 2; } else if (q == 10) { kind = K_SWIGLU; a0 = 1; } else { kind = K_RESID; a0 = 1; } }
            else { if (q == 5) kind = K_CONV; else if (q == 6) kind = K_LRUG; else if (q == 7) kind = K_LRUSCAN; else if (q == 8) kind = K_LRUCOMB; else if (q == 9) { kind = K_RESID; a0 = 2; } else if (q == 10) { kind = K_NORM; a0 = 2; } else if (q == 11) { kind = K_SWIGLU; a0 = 1; } else { kind = K_RESID; a0 = 1; } }
        }
        const bf16_t* HM = (const bf16_t*)(ws + WS_HM);
        if (kind == K_PREP) { if (PHON(0)) phase_prep(pp, lds, rep); }
        else if (kind == K_NORM) { if (PHON(1)) phase_norm(pp, l, a0); }
        else if (kind == K_SWIGLU) { if (PHON(2)) { EpiSwiglu E{(bf16_t*)(ws + WS_H)}; pg8::gemm_phase<EpiSwiglu, false>(lds, HM, D, (const bf16_t*)(ws + WS_WFI) + (size_t)(l * 2 + a0) * 11264 * 2048, D, 24, 44, D, E); if (!rep) bg_convert(pp, lds, ph); } }
        else if (kind == K_RESID) { if (PHON(3)) {
            const bf16_t* A; const bf16_t* B; int K; int gj; float coef;
            if (a0 < 2) { A = (const bf16_t*)(ws + WS_H); B = (const bf16_t*)(ws + WS_WFO) + (size_t)(l * 2 + a0) * 2048 * 5632; K = DFF; gj = a0 == 0 ? 2 : 8; coef = 0.5f; }
            else { A = (const bf16_t*)(ws + WS_CAT); B = (const bf16_t*)(ws + (l == 0 ? WS_WEO : WS_WOO)); K = D; gj = 5; coef = 1.0f; }
            const bool first = (ph == 3);
            const float* xc_ = first ? pp->in[I_XP] : (const float*)(ws + WS_X); const float* xl_ = first ? pp->in[I_XS] - (size_t)TCTX * D : (const float*)(ws + WS_X);
            EpiResid E{(float*)(ws + WS_X), MOD + (size_t)(l * 3) * 18432 + gj * 2048, coef, xc_, xl_};
            if (a0 < 2) pg8::gemm_phase<EpiResid, false, true>(lds, A, K, B, K, 24, 8, K, E); else pg8::gemm_phase<EpiResid, false, false>(lds, A, K, B, K, 24, 8, K, E); if (!rep) bg_convert(pp, lds, ph); } }
        else if (kind == K_F32) { if (PHON(4)) {
            { const int nN = l == 0 ? 17 : 16; EpiBf16 E{(bf16_t*)(ws + WS_PROJ), nN * 256}; pg8::gemm_phase<EpiBf16, false>(lds, HM, D, (const bf16_t*)(ws + (l == 0 ? WS_WEI : WS_WOI)), D, 24, nN, D, E); }
            if (!rep) bg_convert(pp, lds, ph); } }
        else if (kind == K_S5GLA) { if (PHON(5)) phase_s5gla(pp, lds); }
        else if (kind == K_EVPOST) { if (PHON(6)) phase_evpost(pp); }
        else if (kind == K_GLU) { if (PHON(7)) { EpiGlu E{(bf16_t*)(ws + WS_CAT), (const bf16_t*)(ws + WS_YSB), pp->in[I_GLUB]}; pg8::gemm_phase<EpiGlu, false>(lds, (const bf16_t*)(ws + WS_YSB), 1024, (const bf16_t*)(ws + WS_WGLU), 1024, 24, 4, 1024, E); if (!rep) bg_convert(pp, lds, ph); } }
        else if (kind == K_CONV) { if (PHON(8)) phase_conv(pp); }
        else if (kind == K_LRUG) { if (PHON(9)) { EpiLru E{(unsigned*)(ws + WS_LA), (const bf16_t*)(ws + WS_XCB), pp->in[I_LBA], pp->in[I_LBX], (const float*)(ws + WS_SP)};
            int kk = 256; asm volatile("" : "+s"(kk));
            pg8::gemm_phase<EpiLru, true>(lds, (const bf16_t*)(ws + WS_XCB), D, (const bf16_t*)(ws + WS_WLRU), kk, 24, 32, kk, E); } }
        else if (kind == K_LRUSCAN) { if (PHON(10)) phase_lruscan1(pp); }
        else { if (PHON(11)) phase_lruscan2(pp); }
#if DUPMASK
        if (rep == 0 && ((DUPMASK >> kind) & 1u)) { xcd_barrier(xbar); rep = 1; --ph; continue; }
        rep = 0;
#endif
        if (ph + 1 < ph_hi) { if (ph == 0) grid.sync(); else xcd_barrier(xbar); }
    }
}

extern "C" void kernel_launch(void* const* d_in, const int* in_sizes, int n_in, void* d_out, int out_size, void* d_ws, size_t ws_size, hipStream_t stream) {
    static int grid = 0;
    if (grid == 0) {
        if (n_in != 38 || ws_size < WS_END) { fprintf(stderr, "kernel_launch: expected 38 inputs and >= %zu bytes of workspace (got %d, %zu)\n", (size_t)WS_END, n_in, ws_size); grid = -1; return; }
        int dev = 0, cus = 0, per_cu = 0;
        hipGetDevice(&dev); hipDeviceGetAttribute(&cus, hipDeviceAttributeMultiprocessorCount, dev);
        hipFuncSetAttribute((const void*)mega, hipFuncAttributeMaxDynamicSharedMemorySize, LDS_BYTES);
        hipOccupancyMaxActiveBlocksPerMultiprocessor(&per_cu, (const void*)mega, 512, LDS_BYTES);
        if (per_cu < 1) { fprintf(stderr, "kernel_launch: occupancy query says %d blocks per CU\n", per_cu); grid = -1; return; }
        grid = cus;
    }
    if (grid < 0) return;
    (void)hipMemsetAsync((char*)d_ws + WS_MOD, 0, ZERO_BYTES, stream);
    Params p{};
    for (int i = 0; i < 38; ++i) p.in[i] = (const float*)d_in[i];
    p.out = (float*)d_out; p.ws = (unsigned char*)d_ws;
#if MEGA
    p.ph_lo = 0; p.ph_hi = NPH;
    void* args[] = {&p};
    hipError_t e = hipLaunchCooperativeKernel((const void*)mega, dim3(grid), dim3(512), args, LDS_BYTES, stream);
    if (e != hipSuccess) fprintf(stderr, "cooperative launch failed: %s (grid %d)\n", hipGetErrorString(e), grid);
#else
    for (int ph = 0; ph < NPH; ++ph) { p.ph_lo = ph; p.ph_hi = ph + 1; hipLaunchKernelGGL(mega, dim3(grid), dim3(512), LDS_BYTES, stream, p); }
#endif
}
```

```cpp
#include <hip/hip_runtime.h>
#include <hip/hip_cooperative_groups.h>
#include <cstdio>
namespace cg = cooperative_groups;

#ifndef MEGA
#define MEGA 1
#endif

#define LAS __attribute__((address_space(3)))
typedef unsigned short bf16_t;
typedef short bf16x8 __attribute__((ext_vector_type(8)));
typedef float f32x4 __attribute__((ext_vector_type(4)));
typedef float f32x2 __attribute__((ext_vector_type(2)));

constexpr int D = 2048, DFF = 5632, MTOK = 6144, TCTX = 4096;
constexpr int EVINP = 4352;
constexpr int NPH = 25;
constexpr int LDS_MAIN = 131072;
constexpr int LDS_BYTES = LDS_MAIN + 64;
constexpr float EPS = 1e-6f;

constexpr size_t al256(size_t x) { return (x + 255) & ~(size_t)255; }
constexpr size_t WS_MOD = 0;
constexpr size_t MOD_BYTES = (size_t)2 * 3 * 9 * 2048 * 4;
constexpr size_t WS_BAR = al256(WS_MOD + MOD_BYTES);
constexpr size_t BAR_BYTES = 3456 * 4;
constexpr size_t ZERO_BYTES = WS_BAR + BAR_BYTES;
constexpr size_t WS_X = al256(WS_BAR + BAR_BYTES);
constexpr size_t WS_HM = WS_X + (size_t)MTOK * D * 4;
constexpr size_t WS_H = WS_HM + (size_t)MTOK * D * 2;
constexpr size_t WS_PROJ = WS_H + (size_t)MTOK * DFF * 2;
constexpr size_t WS_WFI = WS_PROJ + (size_t)MTOK * EVINP * 4;
constexpr size_t WS_WFO = WS_WFI + (size_t)4 * 11264 * 2048 * 2;
constexpr size_t WS_WEI = WS_WFO + (size_t)4 * 2048 * 5632 * 2;
constexpr size_t WS_WEO = WS_WEI + (size_t)EVINP * 2048 * 2;
constexpr size_t WS_WGLU = WS_WEO + (size_t)2048 * 2048 * 2;
constexpr size_t WS_WOI = WS_WGLU + (size_t)1024 * 1024 * 2;
constexpr size_t WS_WOO = WS_WOI + (size_t)4096 * 2048 * 2;
constexpr size_t WS_WLRU = WS_WOO + (size_t)2048 * 2048 * 2;
constexpr size_t WS_YS5 = WS_WLRU + (size_t)2 * 8 * 2 * 256 * 256 * 2;
constexpr size_t WS_OGLA = WS_YS5 + (size_t)2 * MTOK * 1024 * 4;
constexpr size_t WS_YS32 = WS_OGLA + (size_t)2 * MTOK * 1024 * 4;
constexpr size_t WS_YSB = WS_YS32 + (size_t)MTOK * 1024 * 4;
constexpr size_t WS_CAT = WS_YSB + (size_t)MTOK * 1024 * 2;
constexpr size_t WS_XC32 = WS_CAT + (size_t)MTOK * D * 2;
constexpr size_t WS_XCB = WS_XC32 + (size_t)MTOK * D * 4;
constexpr size_t WS_LA = WS_XCB + (size_t)MTOK * D * 2;
constexpr size_t WS_LB = WS_LA + (size_t)2 * MTOK * D * 4;
constexpr size_t WS_SP = WS_LB + (size_t)2 * MTOK * D * 4;
constexpr size_t WS_LSUM = WS_SP + (size_t)2 * D * 4;
constexpr size_t WS_END = WS_LSUM + (size_t)2 * 2 * 384 * D * 4;

constexpr size_t OUT_Y = 0;
constexpr size_t OUT_S5RE = (size_t)MTOK * D;
constexpr size_t OUT_S5IM = OUT_S5RE + 16 * 2 * 64 * 64;
constexpr size_t OUT_GLA = OUT_S5IM + 16 * 2 * 64 * 64;
constexpr size_t OUT_LRU = OUT_GLA + (size_t)16 * 2 * 4 * 128 * 256;

struct Params { const float* in[38]; float* out; unsigned char* ws; int ph_lo, ph_hi; };
typedef const __attribute__((address_space(4))) Params* PP;
__device__ __forceinline__ int tidx() { int t = threadIdx.x; asm volatile("" : "+v"(t)); return t; }
__device__ __forceinline__ int bidx() { int b = blockIdx.x; asm volatile("" : "+s"(b)); return b; }
__device__ __forceinline__ int gdim() { int g = gridDim.x; asm volatile("" : "+s"(g)); return g; }
__device__ __forceinline__ PP get_pp() { PP kp = (PP)__builtin_amdgcn_kernarg_segment_ptr(); asm volatile("" : "+s"(kp)); return kp; }
enum { I_XP = 0, I_XS, I_S5RE, I_S5IM, I_SGLA, I_SLRU, I_C, I_CCTX, I_NORMG, I_ADAW, I_ADAB, I_FWI, I_FWO, I_FNG, I_EVWI, I_EVWO,
       I_LAMRE, I_LAMIM, I_LOGSTEP, I_BRE, I_BIM, I_CRE, I_CIM, I_S5D, I_GLUW, I_GLUB, I_GW2, I_GB, I_GNG, I_ODWI, I_ODWO,
       I_CONVW, I_CONVB, I_LWA, I_LBA, I_LWX, I_LBX, I_LLAM };

__device__ __forceinline__ unsigned cvt_pk_bf16(float lo, float hi) { unsigned r; asm("v_cvt_pk_bf16_f32 %0, %1, %2" : "=v"(r) : "v"(lo), "v"(hi)); return r; }
__device__ __forceinline__ bf16_t f2bf(float x) { return (bf16_t)(cvt_pk_bf16(x, 0.f) & 0xffffu); }
__device__ __forceinline__ float bf2f_(bf16_t v) { return __builtin_bit_cast(float, (unsigned)v << 16); }
__device__ __forceinline__ float lo_bf(unsigned w) { return __builtin_bit_cast(float, w << 16); }
__device__ __forceinline__ float hi_bf(unsigned w) { return __builtin_bit_cast(float, w & 0xffff0000u); }
__device__ __forceinline__ f32x4 unpack4(uint2 w) { return (f32x4){lo_bf(w.x), hi_bf(w.x), lo_bf(w.y), hi_bf(w.y)}; }
__device__ __forceinline__ float sigmoidf_(float x) { return __builtin_amdgcn_rcpf(1.f + __expf(-x)); }
__device__ __forceinline__ float siluf_(float x) { return x * __builtin_amdgcn_rcpf(1.f + __expf(-x)); }
__device__ __forceinline__ float geluf_(float x) { return x * sigmoidf_(1.5957691216f * (x + 0.044715f * x * x * x)); }
__device__ __forceinline__ float softplusf_(float x) { return fmaxf(x, 0.f) + log1pf(__expf(-fabsf(x))); }
__device__ __forceinline__ float neg_expm1_(float x) {
    const float pl = -x * (1.f + x * (0.5f + x * (0.16666667f + x * (0.041666668f + x * (0.0083333338f + x * 0.0013888889f))))); return x > -0.25f ? pl : 1.f - __expf(x); }
__device__ __forceinline__ int cond_of_pm(int pm) { return pm < 16 ? 0 : 1 + ((pm - 16) >> 2); }
__device__ __forceinline__ int cond_of_row(int r) { return r < TCTX ? 0 : 1 + ((r - TCTX) >> 10); }
__device__ __forceinline__ bf16x8 pack8(f32x4 a, f32x4 b) {
    typedef unsigned u32x4 __attribute__((ext_vector_type(4)));
    u32x4 u; u[0] = cvt_pk_bf16(a[0], a[1]); u[1] = cvt_pk_bf16(a[2], a[3]); u[2] = cvt_pk_bf16(b[0], b[1]); u[3] = cvt_pk_bf16(b[2], b[3]);
    return __builtin_bit_cast(bf16x8, u);
}

#define XB_TMO      128
#define XB_XCNT(j)  (256  + 64 * (j))
#define XB_XSUB(j)  (1280 + 64 * (j))
#define XB_XGEN(j)  (2304 + 64 * (j))
#define XB_TOP      3328
#define XB_TOPGEN   3392
#define XCD_BAR_WORDS 3456
#define XB_SPIN_CAP (1u << 18)

__device__ __forceinline__ unsigned xb_ld(unsigned* p)              { return __hip_atomic_load(p, __ATOMIC_RELAXED, __HIP_MEMORY_SCOPE_AGENT); }
__device__ __forceinline__ unsigned xb_add(unsigned* p, unsigned v) { return __hip_atomic_fetch_add(p, v, __ATOMIC_RELAXED, __HIP_MEMORY_SCOPE_AGENT); }
__device__ __forceinline__ unsigned xb_xcc_id() { return (unsigned)__builtin_amdgcn_s_getreg((3 << 11) | 20) & 0xFu; }
#define XB_SPIN(cond, bar) do { unsigned _sp = 0; while (cond) { __builtin_amdgcn_s_sleep(1); \
    if ((++_sp & 255u) == 0u) { if (xb_ld(&(bar)[XB_TMO])) break; if (_sp > XB_SPIN_CAP) { atomicAdd(&(bar)[XB_TMO], 1u); break; } } } } while (0)

struct XcdBarrier {
    unsigned* bar; unsigned x;
    volatile LAS unsigned* st;
};

__device__ __forceinline__ XcdBarrier xcd_barrier_post(unsigned* bar, volatile LAS unsigned* st) {
    XcdBarrier b; b.bar = bar; b.x = xb_xcc_id(); b.st = st;
    if (threadIdx.x == 0) (void)xb_add(&bar[XB_XCNT(b.x)], 1u);
    return b;
}
__device__ __forceinline__ void xcd_barrier_complete(unsigned* bar, unsigned x, unsigned& nloc, unsigned& nx) {
    const unsigned G = gridDim.x * gridDim.y * gridDim.z;
    unsigned sum, cnt, mine, sp = 0u;
    for (;;) {
        sum = 0u; cnt = 0u; mine = 0u;
#pragma unroll
        for (unsigned j = 0; j < 16; ++j) { const unsigned c = xb_ld(&bar[XB_XCNT(j)]); sum += c; cnt += (c > 0u) ? 1u : 0u; mine = (j == x) ? c : mine; }
        if (sum == G) break;
        __builtin_amdgcn_s_sleep(1);
        if ((++sp & 255u) == 0u) { if (xb_ld(&bar[XB_TMO])) break; if (sp > XB_SPIN_CAP) { atomicAdd(&bar[XB_TMO], 1u); break; } }
    }
    nloc = mine > 0u ? mine : 1u; nx = cnt > 0u ? cnt : 1u;
}

__device__ __forceinline__ void xcd_barrier(const XcdBarrier& b) {
    asm volatile("s_waitcnt vmcnt(0)" ::: "memory");
    __syncthreads();
    if (threadIdx.x == 0) {
        unsigned* bar = b.bar;
        __builtin_amdgcn_s_waitcnt(0);
        unsigned nloc = b.st[0], nx = b.st[1];
        if (nloc == 0u) { xcd_barrier_complete(bar, b.x, nloc, nx); b.st[0] = nloc; b.st[1] = nx; }
        const unsigned old = xb_add(&bar[XB_XSUB(b.x)], 1u);
        const unsigned gen = old / nloc;
        if (old + 1u == (gen + 1u) * nloc) {
            __builtin_amdgcn_fence(__ATOMIC_RELEASE, "agent");
            asm volatile("s_waitcnt vmcnt(0)" ::: "memory");
            const unsigned og = xb_add(&bar[XB_TOP], 1u);
            const unsigned tg = og / nx;
            if (og + 1u == (tg + 1u) * nx) xb_add(&bar[XB_TOPGEN], 1u);
            else XB_SPIN(xb_ld(&bar[XB_TOPGEN]) == tg, bar);
            __builtin_amdgcn_fence(__ATOMIC_ACQUIRE, "agent");
            xb_add(&bar[XB_XGEN(b.x)], 1u);
            asm volatile("s_waitcnt vmcnt(0)" ::: "memory");
        } else {
            XB_SPIN(xb_ld(&bar[XB_XGEN(b.x)]) == gen, bar);
            __builtin_amdgcn_fence(__ATOMIC_ACQUIRE, "agent");
            asm volatile("s_waitcnt vmcnt(0)" ::: "memory");
        }
    }
    __syncthreads();
}


namespace pg8 {
constexpr int BM = 256, BK = 64, HALF = 128, HTB = HALF * BK * 2, NXCD = 8, WGM = 8;
__device__ __forceinline__ int lds_byte(int r, int c) { const int st = (r >> 4) * 2 + (c >> 5), rr = r & 15, cc = c & 31, ob = rr * 64 + cc * 2; return st * 1024 + (ob ^ (((ob >> 9) & 1) << 5)); }
__device__ __forceinline__ void stage_rc(int b, int& R, int& C) { const int st = b / 1024, sb = b % 1024, swz = sb ^ (((sb >> 9) & 1) << 5); R = (st >> 1) * 16 + swz / 64; C = (st & 1) * 32 + (swz % 64) / 2; }
struct Unit { int pm, pn; };
struct Order {
    int nM, nN, nwg, G, c;
    __device__ __forceinline__ bool next(int i, Unit& u) const {
        const long L = (long)i * G + c; if (L >= nwg) return false;
        int wgid = (int)L; { const int q = nwg / NXCD, r = nwg % NXCD, xcd = wgid % NXCD, off = wgid / NXCD; wgid = (xcd < r ? xcd * (q + 1) : r * (q + 1) + (xcd - r) * q) + off; }
        const int nig = WGM * nN, gid = wgid / nig, fm = gid * WGM, gsz = (nM - fm) < WGM ? (nM - fm) : WGM;
        u.pm = fm + ((wgid % nig) % gsz); u.pn = (wgid % nig) / gsz; return true;
    }
};

template <class Epi, bool LRU, bool BLK = false>
__device__ __forceinline__ void gemm_phase(LAS unsigned char* lds, const bf16_t* A, int lda, const bf16_t* Bt, int ldb, int nM, int nN, int K, const Epi& E) {
    const int tid = tidx(), wid = __builtin_amdgcn_readfirstlane(tid >> 6), lane = tid & 63, wr = wid >> 2, wc = wid & 3, fr = lane & 15, fq = lane >> 4;
    const int nt = K / BK;
    Order S; S.nM = nM; S.nN = nN; S.nwg = nM * nN; S.G = gdim(); S.c = bidx();
    unsigned voffA[2], voffB[2];
#pragma unroll
    for (int i = 0; i < 2; ++i) { int R, C; stage_rc(tid * 16 + i * 8192, R, C); voffA[i] = (unsigned)(R * (BLK ? 64 : lda) + C) * 2u; voffB[i] = (unsigned)(R * (BLK ? 64 : ldb) + C) * 2u; }
    const size_t kstep = BLK ? (size_t)32768 : (size_t)(BK * 2);
    const size_t hstepA = BLK ? (size_t)16384 : (size_t)HALF * lda * 2, hstepB = BLK ? (size_t)16384 : (size_t)HALF * ldb * 2;
    const size_t tstepA = BLK ? (size_t)nt * 32768 : 2 * hstepA, tstepB = BLK ? (size_t)nt * 32768 : 2 * hstepB;
    const unsigned ldsw = (unsigned)wid * 1024u;
    const int aoff = lds_byte(wr * 64 + fr, fq * 8), boff = lds_byte(wc * 32 + fr, fq * 8);
#define PG8_SA(b, h) (((b) * 2 + (h)) * HTB)
#define PG8_SB(b, h) ((4 + (b) * 2 + (h)) * HTB)
#define PG8_STAGE(bufoff, gbase, voff) do { _Pragma("unroll") for (int _i = 0; _i < 2; ++_i) \
        __builtin_amdgcn_global_load_lds((const unsigned*)((const char*)(gbase) + (voff)[_i]), (LAS unsigned*)(lds + (bufoff) + ldsw + _i * 8192), 16, 0, 0); } while (0)
#define PG8_LDA(dst, b, h) do { _Pragma("unroll") for (int m = 0; m < 4; ++m) _Pragma("unroll") for (int k = 0; k < 2; ++k) dst[m][k] = *(const LAS bf16x8*)(lds + PG8_SA(b, h) + aoff + m * 2048 + k * 1024); } while (0)
#define PG8_LDB(dst, b, h) do { _Pragma("unroll") for (int n = 0; n < 2; ++n) _Pragma("unroll") for (int k = 0; k < 2; ++k) dst[n][k] = *(const LAS bf16x8*)(lds + PG8_SB(b, h) + boff + n * 2048 + k * 1024); } while (0)
#define PG8_MMA(ai, bj, At, Bt_) do { __builtin_amdgcn_s_setprio(1); _Pragma("unroll") for (int m = 0; m < 4; ++m) _Pragma("unroll") for (int n = 0; n < 2; ++n) _Pragma("unroll") for (int k = 0; k < 2; ++k) \
        acc[ai][bj][m][n] = __builtin_amdgcn_mfma_f32_16x16x32_bf16(Bt_[n][k], At[m][k], acc[ai][bj][m][n], 0, 0, 0); __builtin_amdgcn_s_setprio(0); } while (0)
#define PG8_WAIT_V(n) asm volatile("s_waitcnt vmcnt(" #n ")" ::: "memory")
#define PG8_WAIT_L(n) asm volatile("s_waitcnt lgkmcnt(" #n ")" ::: "memory")
#define PG8_BAR __builtin_amdgcn_s_barrier()
#define PG8_SCHED __builtin_amdgcn_sched_barrier(0)
#define PG8_APTR(u) ((const char*)A + (size_t)(u).pm * tstepA + (LRU ? (size_t)((((u).pn >> 1) & 7) * 512) : (size_t)0))
#define PG8_BPTR(u) ((const char*)Bt + (size_t)(u).pn * tstepB)
    Unit cur, nxt; int ui = 0;
    if (!S.next(0, cur)) return;
    f32x4 acc[2][2][4][2];
#pragma unroll
    for (int a = 0; a < 2; ++a)
#pragma unroll
        for (int b = 0; b < 2; ++b)
#pragma unroll
            for (int m = 0; m < 4; ++m)
#pragma unroll
                for (int n = 0; n < 2; ++n) acc[a][b][m][n] = (f32x4){0.f, 0.f, 0.f, 0.f};
    bf16x8 At[4][2], B0[2][2], B1[2][2];
    const char* cA = PG8_APTR(cur); const char* cB = PG8_BPTR(cur);
    PG8_STAGE(PG8_SB(0, 0), cB, voffB); PG8_STAGE(PG8_SA(0, 0), cA, voffA); PG8_STAGE(PG8_SB(0, 1), cB + hstepB, voffB); PG8_STAGE(PG8_SA(0, 1), cA + hstepA, voffA);
    if (wr == 1) PG8_BAR;
    PG8_WAIT_V(4); PG8_BAR;
    PG8_STAGE(PG8_SB(1, 0), cB + kstep, voffB); PG8_STAGE(PG8_SA(1, 0), cA + kstep, voffA); PG8_STAGE(PG8_SB(1, 1), cB + hstepB + kstep, voffB);
    PG8_WAIT_V(6); PG8_BAR;
    for (;;) {
        const bool has_next = S.next(ui + 1, nxt);
        const char* nA = has_next ? PG8_APTR(nxt) : cA; const char* nB = has_next ? PG8_BPTR(nxt) : cB;
        for (int t = 0; t < nt; t += 2) {
            const bool last = (t == nt - 2);
            const char* a1 = cA + (size_t)(t + 1) * kstep;
            const char* a2 = last ? nA : cA + (size_t)(t + 2) * kstep; const char* b2 = last ? nB : cB + (size_t)(t + 2) * kstep;
            const char* a3 = a2 + kstep; const char* b3 = b2 + kstep;
            PG8_LDB(B0, 0, 0); PG8_SCHED; PG8_LDA(At, 0, 0); PG8_STAGE(PG8_SA(1, 1), a1 + hstepA, voffA);
            PG8_WAIT_L(8); PG8_BAR; PG8_WAIT_L(0); PG8_MMA(0, 0, At, B0); PG8_BAR; PG8_SCHED;
            PG8_LDB(B1, 0, 1); PG8_STAGE(PG8_SB(0, 0), b2, voffB);
            PG8_BAR; PG8_WAIT_L(0); PG8_MMA(0, 1, At, B1); PG8_BAR;
            PG8_LDA(At, 0, 1); PG8_STAGE(PG8_SA(0, 0), a2, voffA);
            PG8_BAR; PG8_WAIT_L(0); PG8_MMA(1, 0, At, B0); PG8_BAR; PG8_SCHED;
            PG8_STAGE(PG8_SB(0, 1), b2 + hstepB, voffB);
            PG8_WAIT_V(6); PG8_BAR; PG8_MMA(1, 1, At, B1); PG8_BAR;
            PG8_LDB(B0, 1, 0); PG8_SCHED; PG8_LDA(At, 1, 0); PG8_STAGE(PG8_SA(0, 1), a2 + hstepA, voffA);
            PG8_WAIT_L(8); PG8_BAR; PG8_WAIT_L(0); PG8_MMA(0, 0, At, B0); PG8_BAR; PG8_SCHED;
            PG8_LDB(B1, 1, 1); PG8_STAGE(PG8_SB(1, 0), b3, voffB);
            PG8_BAR; PG8_WAIT_L(0); PG8_MMA(0, 1, At, B1); PG8_BAR;
            PG8_LDA(At, 1, 1); PG8_STAGE(PG8_SA(1, 0), a3, voffA);
            PG8_BAR; PG8_WAIT_L(0); PG8_MMA(1, 0, At, B0); PG8_BAR; PG8_SCHED;
            PG8_STAGE(PG8_SB(1, 1), b3 + hstepB, voffB);
            PG8_WAIT_V(6); PG8_BAR; PG8_MMA(1, 1, At, B1); PG8_BAR;
        }
        E(acc, cur, wr, wc, fr, fq);
        if (!has_next) break;
#pragma unroll
        for (int a = 0; a < 2; ++a)
#pragma unroll
            for (int b = 0; b < 2; ++b)
#pragma unroll
                for (int m = 0; m < 4; ++m)
#pragma unroll
                    for (int n = 0; n < 2; ++n) acc[a][b][m][n] = (f32x4){0.f, 0.f, 0.f, 0.f};
        cur = nxt; cA = nA; cB = nB; ++ui;
    }
    PG8_WAIT_V(0);
    if (wr == 0) PG8_BAR;
    PG8_BAR;
#undef PG8_SA
#undef PG8_SB
#undef PG8_STAGE
#undef PG8_LDA
#undef PG8_LDB
#undef PG8_MMA
#undef PG8_WAIT_V
#undef PG8_WAIT_L
#undef PG8_BAR
#undef PG8_SCHED
#undef PG8_APTR
#undef PG8_BPTR
}
}
using pg8::Unit;

struct EpiSwiglu {
    bf16_t* H;
    __device__ __forceinline__ void operator()(const f32x4 (&acc)[2][2][4][2], const Unit& u, int wr, int wc, int fr, int fq) const {
        const int loff = (wr * 64 + fr) * 64 + (wc & 1) * 32 + 4 * fq;
        bf16_t* ub = H + ((size_t)(u.pm * 88 + u.pn * 2 + (wc >> 1)) * 256) * 64;
#pragma unroll
        for (int ai = 0; ai < 2; ++ai)
#pragma unroll
            for (int m = 0; m < 4; ++m) { bf16_t* rb = ub + (size_t)(ai * 128 + m * 16) * 64;
#pragma unroll
                for (int n = 0; n < 2; ++n) { const f32x4 a = acc[ai][0][m][n], b = acc[ai][1][m][n];
                    uint2 pk; pk.x = cvt_pk_bf16(siluf_(a[0]) * b[0], siluf_(a[1]) * b[1]); pk.y = cvt_pk_bf16(siluf_(a[2]) * b[2], siluf_(a[3]) * b[3]);
                    *(uint2*)(rb + loff + n * 16) = pk; } }
    }
};
struct EpiResid {
    float* X; const float* G; float coef; const float* XinC; const float* XinL;
    __device__ __forceinline__ void operator()(const f32x4 (&acc)[2][2][4][2], const Unit& u, int wr, int wc, int fr, int fq) const {
        const int lcol = wc * 32 + 4 * fq, loff = (wr * 64 + fr) * D + lcol;
        const float* g = G + (size_t)cond_of_pm(u.pm) * (9 * 2048) + u.pn * 256;
        float* ub = X + (size_t)u.pm * 256 * D + u.pn * 256;
        const float* ib = (u.pm < 16 ? XinC : XinL) + (size_t)u.pm * 256 * D + u.pn * 256;
        f32x4 gv[2][2];
#pragma unroll
        for (int bj = 0; bj < 2; ++bj)
#pragma unroll
            for (int n = 0; n < 2; ++n) gv[bj][n] = *(const f32x4*)(g + lcol + bj * 128 + n * 16) * coef;
#pragma unroll
        for (int ai = 0; ai < 2; ++ai)
#pragma unroll
            for (int m = 0; m < 4; ++m) { float* rb = ub + (size_t)(ai * 128 + m * 16) * D; const float* ir = ib + (size_t)(ai * 128 + m * 16) * D;
#pragma unroll
                for (int bj = 0; bj < 2; ++bj)
#pragma unroll
                    for (int n = 0; n < 2; ++n) { *(f32x4*)(rb + loff + bj * 128 + n * 16) = *(const f32x4*)(ir + loff + bj * 128 + n * 16) + gv[bj][n] * acc[ai][bj][m][n]; }
                __builtin_amdgcn_sched_barrier(0); }
    }
};
struct EpiF32 {
    float* C; int ldc;
    __device__ __forceinline__ void operator()(const f32x4 (&acc)[2][2][4][2], const Unit& u, int wr, int wc, int fr, int fq) const {
        const int loff = (wr * 64 + fr) * ldc + wc * 32 + 4 * fq;
        float* ub = C + (size_t)u.pm * 256 * ldc + u.pn * 256;
#pragma unroll
        for (int ai = 0; ai < 2; ++ai)
#pragma unroll
            for (int m = 0; m < 4; ++m) { float* rb = ub + (size_t)(ai * 128 + m * 16) * ldc;
#pragma unroll
                for (int bj = 0; bj < 2; ++bj)
#pragma unroll
                    for (int n = 0; n < 2; ++n) *(f32x4*)(rb + loff + bj * 128 + n * 16) = acc[ai][bj][m][n]; }
    }
};
struct EpiBf16 {
    bf16_t* C; int ldc;
    __device__ __forceinline__ void operator()(const f32x4 (&acc)[2][2][4][2], const Unit& u, int wr, int wc, int fr, int fq) const {
        const int loff = (wr * 64 + fr) * ldc + wc * 32 + 4 * fq;
        bf16_t* ub = C + (size_t)u.pm * 256 * ldc + u.pn * 256;
#pragma unroll
        for (int ai = 0; ai < 2; ++ai)
#pragma unroll
            for (int m = 0; m < 4; ++m) { bf16_t* rb = ub + (size_t)(ai * 128 + m * 16) * ldc;
#pragma unroll
                for (int bj = 0; bj < 2; ++bj)
#pragma unroll
                    for (int n = 0; n < 2; ++n) { const f32x4 v = acc[ai][bj][m][n]; uint2 pk; pk.x = cvt_pk_bf16(v[0], v[1]); pk.y = cvt_pk_bf16(v[2], v[3]); *(uint2*)(rb + loff + bj * 128 + n * 16) = pk; } }
    }
};
struct EpiGlu {
    bf16_t* CAT; const bf16_t* YS; const float* bias;
    __device__ __forceinline__ void operator()(const f32x4 (&acc)[2][2][4][2], const Unit& u, int wr, int wc, int fr, int fq) const {
        const int lcol = wc * 32 + 4 * fq, loffY = (wr * 64 + fr) * 1024 + lcol, loffC = (wr * 64 + fr) * D + lcol;
        const float* bb = bias + u.pn * 256; const bf16_t* yb = YS + (size_t)u.pm * 256 * 1024 + u.pn * 256; bf16_t* cb = CAT + (size_t)u.pm * 256 * D + u.pn * 256;
        f32x4 bv[2][2];
#pragma unroll
        for (int bj = 0; bj < 2; ++bj)
#pragma unroll
            for (int n = 0; n < 2; ++n) bv[bj][n] = *(const f32x4*)(bb + lcol + bj * 128 + n * 16);
#pragma unroll
        for (int ai = 0; ai < 2; ++ai)
#pragma unroll
            for (int m = 0; m < 4; ++m) { const bf16_t* yr = yb + (size_t)(ai * 128 + m * 16) * 1024; bf16_t* cr = cb + (size_t)(ai * 128 + m * 16) * D;
#pragma unroll
                for (int bj = 0; bj < 2; ++bj)
#pragma unroll
                    for (int n = 0; n < 2; ++n) { const f32x4 ys = unpack4(*(const uint2*)(yr + loffY + bj * 128 + n * 16)); const f32x4 z = acc[ai][bj][m][n] + bv[bj][n];
                        uint2 pk; pk.x = cvt_pk_bf16(ys[0] * sigmoidf_(z[0]), ys[1] * sigmoidf_(z[1])); pk.y = cvt_pk_bf16(ys[2] * sigmoidf_(z[2]), ys[3] * sigmoidf_(z[3]));
                        *(uint2*)(cr + loffC + bj * 128 + n * 16) = pk; }
                __builtin_amdgcn_sched_barrier(0); }
    }
};
struct EpiLru {
    unsigned* LAB; const bf16_t* XC; const float* ba; const float* bx; const float* sp;
    __device__ __forceinline__ void operator()(const f32x4 (&acc)[2][2][4][2], const Unit& u, int wr, int wc, int fr, int fq) const {
        const int d = u.pn >> 4, h = (u.pn >> 1) & 7, half = u.pn & 1;
        const int chu = h * 256 + half * 128;
        const int lcol = wc * 32 + 4 * fq, loff = (wr * 64 + fr) * D + lcol;
        const bf16_t* xb = XC + (size_t)u.pm * 256 * D + chu; unsigned* lab = LAB + ((size_t)d * MTOK + u.pm * 256) * D + chu;
        f32x4 bav[2], bxv[2], spv[2];
#pragma unroll
        for (int n = 0; n < 2; ++n) { bav[n] = *(const f32x4*)(ba + d * D + chu + lcol + n * 16); bxv[n] = *(const f32x4*)(bx + d * D + chu + lcol + n * 16); spv[n] = *(const f32x4*)(sp + d * D + chu + lcol + n * 16); }
#pragma unroll
        for (int ai = 0; ai < 2; ++ai)
#pragma unroll
            for (int m = 0; m < 4; ++m) { const size_t ro = (size_t)(ai * 128 + m * 16) * D;
#pragma unroll
                for (int n = 0; n < 2; ++n) { const f32x4 xc = unpack4(*(const uint2*)(xb + ro + loff + n * 16));
                    const f32x4 rp = acc[ai][0][m][n] + bav[n], ip = acc[ai][1][m][n] + bxv[n]; uint4 w;
                    unsigned wv[4];
#pragma unroll
                    for (int e = 0; e < 4; ++e) { const float la = spv[n][e] * sigmoidf_(rp[e]); const float bb = __builtin_amdgcn_sqrtf(fmaxf(neg_expm1_(2.f * la), 0.f)) * (sigmoidf_(ip[e]) * xc[e]); wv[e] = cvt_pk_bf16(la, bb); }
                    w.x = wv[0]; w.y = wv[1]; w.z = wv[2]; w.w = wv[3];
                    *(uint4*)(lab + ro + loff + n * 16) = w; __builtin_amdgcn_sched_barrier(0); } }
    }
};

struct CvtT { const float* src; bf16_t* dst; int K, ldsrc, Nsrc, n_dst0, n_src0, k0, blk; };
__device__ __forceinline__ void cvt_decode(PP p, unsigned char* ws, int t, int total, CvtT& c) {
    constexpr int T_FI = 176 * 32, T_FO = 32 * 88, T_EI = 68 * 32, T_EO = 32 * 32, T_GLU = 16 * 16, T_OI = 64 * 32, T_OO = 32 * 32, T_LRU = 4 * 4;
    c.blk = 0;
    if (t >= total) { c.src = nullptr; c.dst = nullptr; c.K = c.ldsrc = c.Nsrc = c.n_dst0 = c.n_src0 = c.k0 = 0; return; }
    if (t < 4 * T_FI) { const int w = t / T_FI; t %= T_FI; const int nt_ = t / 32, kt = t % 32; c.K = 2048; c.ldsrc = 11264; c.Nsrc = 11264; c.src = p->in[I_FWI] + (size_t)w * 2048 * 11264; c.dst = (bf16_t*)(ws + WS_WFI) + (size_t)w * 11264 * 2048;
        c.n_dst0 = nt_ * 64; const int j = c.n_dst0 >> 8, rr = c.n_dst0 & 255; c.n_src0 = rr < 128 ? j * 128 + rr : 5632 + j * 128 + (rr - 128); c.k0 = kt * 64; }
    else if ((t -= 4 * T_FI) < 4 * T_FO) { const int w = t / T_FO; t %= T_FO; const int nt_ = t / 88, kt = t % 88; c.K = 5632; c.ldsrc = 2048; c.Nsrc = 2048; c.src = p->in[I_FWO] + (size_t)w * 5632 * 2048; c.dst = (bf16_t*)(ws + WS_WFO) + (size_t)w * 2048 * 5632; c.n_dst0 = c.n_src0 = nt_ * 64; c.k0 = kt * 64; c.blk = 1; }
    else if ((t -= 4 * T_FO) < T_EI) { const int nt_ = t / 32, kt = t % 32; c.K = 2048; c.ldsrc = 4128; c.Nsrc = 4128; c.src = p->in[I_EVWI]; c.dst = (bf16_t*)(ws + WS_WEI); c.n_dst0 = c.n_src0 = nt_ * 64; c.k0 = kt * 64; }
    else if ((t -= T_EI) < T_EO) { const int nt_ = t / 32, kt = t % 32; c.K = 2048; c.ldsrc = 2048; c.Nsrc = 2048; c.src = p->in[I_EVWO]; c.dst = (bf16_t*)(ws + WS_WEO); c.n_dst0 = c.n_src0 = nt_ * 64; c.k0 = kt * 64; }
    else if ((t -= T_EO) < T_GLU) { const int nt_ = t / 16, kt = t % 16; c.K = 1024; c.ldsrc = 1024; c.Nsrc = 1024; c.src = p->in[I_GLUW]; c.dst = (bf16_t*)(ws + WS_WGLU); c.n_dst0 = c.n_src0 = nt_ * 64; c.k0 = kt * 64; }
    else if ((t -= T_GLU) < T_OI) { const int nt_ = t / 32, kt = t % 32; c.K = 2048; c.ldsrc = 4096; c.Nsrc = 4096; c.src = p->in[I_ODWI]; c.dst = (bf16_t*)(ws + WS_WOI); c.n_dst0 = c.n_src0 = nt_ * 64; c.k0 = kt * 64; }
    else if ((t -= T_OI) < T_OO) { const int nt_ = t / 32, kt = t % 32; c.K = 2048; c.ldsrc = 2048; c.Nsrc = 2048; c.src = p->in[I_ODWO]; c.dst = (bf16_t*)(ws + WS_WOO); c.n_dst0 = c.n_src0 = nt_ * 64; c.k0 = kt * 64; }
    else { t -= T_OO; const int mi = t / T_LRU; t %= T_LRU; const int which = mi >> 4, dh = mi & 15;
        const int nt_ = t / 4, kt = t % 4; c.K = 256; c.ldsrc = 256; c.Nsrc = 256; c.src = (which ? p->in[I_LWX] : p->in[I_LWA]) + (size_t)dh * 65536; c.dst = (bf16_t*)(ws + WS_WLRU) + (size_t)dh * 2 * 65536;
        c.n_src0 = nt_ * 64; const int half = c.n_src0 >> 7; c.n_dst0 = half * 256 + which * 128 + (c.n_src0 & 127); c.k0 = kt * 64; }
}
constexpr int CV_FI = 176 * 32, CV_FO = 32 * 88, CV_TOTAL = 4 * CV_FI + 4 * CV_FO + 68 * 32 + 32 * 32 + 16 * 16 + 64 * 32 + 32 * 32 + 32 * 16;
__device__ __forceinline__ void cvt_range(PP p, unsigned char* lds, int t_lo, int t_hi, int rank, int n) {
    const int tid = tidx(); unsigned char* ws = p->ws; float* tile = (float*)lds;
    for (int g0 = t_lo + rank * 4; g0 < t_hi; g0 += n * 4) {
        f32x4 v[4][2];
#pragma unroll
        for (int q = 0; q < 4; ++q) { CvtT c; cvt_decode(p, ws, g0 + q, t_hi, c);
#pragma unroll
            for (int h = 0; h < 2; ++h) { const int kk = (tid >> 4) + h * 32, n4 = (tid & 15) * 4; const int ns = c.n_src0 + n4;
                v[q][h] = (f32x4){0.f, 0.f, 0.f, 0.f}; if (ns < c.Nsrc) v[q][h] = __builtin_nontemporal_load((const f32x4*)(c.src + (size_t)(c.k0 + kk) * c.ldsrc + ns)); } }
        __syncthreads();
#pragma unroll
        for (int q = 0; q < 4; ++q)
#pragma unroll
            for (int h = 0; h < 2; ++h) { const int kk = (tid >> 4) + h * 32, n4 = (tid & 15) * 4; float* tp = tile + q * 4160 + kk * 65 + n4; tp[0] = v[q][h][0]; tp[1] = v[q][h][1]; tp[2] = v[q][h][2]; tp[3] = v[q][h][3]; }
        __syncthreads();
#pragma unroll
        for (int q = 0; q < 4; ++q) { CvtT c; cvt_decode(p, ws, g0 + q, t_hi, c);
            if (c.dst) { const int nn = tid >> 3, k8 = (tid & 7) * 8; f32x4 a, b2; const float* tp = tile + q * 4160;
#pragma unroll
                for (int j = 0; j < 4; ++j) { a[j] = tp[(k8 + j) * 65 + nn]; b2[j] = tp[(k8 + 4 + j) * 65 + nn]; }
                const int n_ = c.n_dst0 + nn; bf16_t* dp = c.blk ? c.dst + ((size_t)((n_ >> 8) * (c.K >> 6) + (c.k0 >> 6)) * 256 + (n_ & 255)) * 64 + k8 : c.dst + (size_t)n_ * c.K + c.k0 + k8;
                *(bf16x8*)dp = pack8(a, b2); } }
    }
}
__device__ __forceinline__ void mod_items(PP p, unsigned char* lds, int it_lo, int it_hi, int rank, int n) {
    const int tid = tidx(); unsigned char* ws = p->ws;
    float* sc = (float*)lds;
    __syncthreads();
    for (int i = tid; i < 3 * 2048; i += 512) { const int ci = i >> 11, k = i & 2047; const float v = ci == 0 ? p->in[I_CCTX][k] : p->in[I_C][(ci - 1) * 2048 + k]; sc[i] = siluf_(v); }
    __syncthreads();
    float* MOD = (float*)(ws + WS_MOD);
    for (int it = it_lo + rank; it < it_hi; it += n) { const int l = it / 288, r = it % 288, chunk = r / 32, ks = r % 32; const int col = chunk * 2048 + tid * 4;
        const float* W = p->in[I_ADAW] + (size_t)l * 2048 * 18432 + (size_t)(ks * 64) * 18432 + col;
        f32x4 a0 = (f32x4){0.f, 0.f, 0.f, 0.f}, a1 = a0, a2 = a0;
#pragma unroll 8
        for (int k = 0; k < 64; ++k) { const f32x4 w = __builtin_nontemporal_load((const f32x4*)(W + (size_t)k * 18432)); const int kk = ks * 64 + k; a0 += w * sc[kk]; a1 += w * sc[2048 + kk]; a2 += w * sc[4096 + kk]; }
        if (ks == 0) { const f32x4 bb = *(const f32x4*)(p->in[I_ADAB] + (size_t)l * 18432 + col); a0 += bb; a1 += bb; a2 += bb; }
        float* m0 = MOD + (size_t)(l * 3) * 18432 + col;
#pragma unroll
        for (int e = 0; e < 4; ++e) { atomicAdd(m0 + e, a0[e]); atomicAdd(m0 + 18432 + e, a1[e]); atomicAdd(m0 + 2 * 18432 + e, a2[e]); } }
    __syncthreads();
}
__device__ void phase_prep(PP p, LAS unsigned char* ldsr, int skip_mod) {
    unsigned char* lds = (unsigned char*)ldsr;
    const int tid = tidx(), bid = bidx(), nb = gdim();
    unsigned char* ws = p->ws;
    if (!skip_mod) mod_items(p, lds, 0, 288, bid, nb);
    cvt_range(p, lds, 0, CV_FI, bid, nb);
}
__device__ void bg_convert(PP p, LAS unsigned char* ldsr, int ph) {
    unsigned char* lds = (unsigned char*)ldsr; const int bid = bidx();
    constexpr int S0 = 4 * CV_FI + 4 * CV_FO, S_EI = S0, S_EO = S_EI + 2176, S_OI = S_EO + 1024 + 256, S_OO = S_OI + 2048;
    __syncthreads();
    if (ph == 2) { if (bid >= 32) { cvt_range(p, lds, 4 * CV_FI, 4 * CV_FI + CV_FO, bid - 32, 224); cvt_range(p, lds, S_EI, S_EO, bid - 32, 224); } }
    else if (ph == 3) { if (bid >= 192) cvt_range(p, lds, CV_FI, 2 * CV_FI, bid - 192, 64); }
    else if (ph == 5) { if (bid >= 152) cvt_range(p, lds, S_EO, S_OO, bid - 152, 104); }
    else if (ph == 8) { if (bid >= 96) cvt_range(p, lds, 4 * CV_FI + CV_FO, 4 * CV_FI + 2 * CV_FO, bid - 96, 160); }
    else if (ph == 9) { if (bid >= 192) cvt_range(p, lds, S_OO, CV_TOTAL, bid - 192, 64); }
    else if (ph == 11) { if (bid >= 32) cvt_range(p, lds, 2 * CV_FI, 3 * CV_FI, bid - 32, 224); }
    else if (ph == 12) { if (bid >= 192) { mod_items(p, lds, 288, 448, bid - 192, 64); cvt_range(p, lds, 4 * CV_FI + 2 * CV_FO, 4 * CV_FI + 3 * CV_FO, bid - 192, 64); } }
    else if (ph == 14) { if (bid >= 32) cvt_range(p, lds, 3 * CV_FI, 4 * CV_FI, bid - 32, 224); }
    else if (ph == 15) { if (bid >= 192) { cvt_range(p, lds, 4 * CV_FI + 3 * CV_FO, 4 * CV_FI + 4 * CV_FO, bid - 192, 64); mod_items(p, lds, 448, 576, bid - 192, 64); } }
}

__device__ void phase_norm(PP p, int l, int j  ) {
    const int tid = tidx(), lane = tid & 63, wid = tid >> 6; const int gw = bidx() * 8 + wid, nw = gdim() * 8;
    const float* X = (const float*)(p->ws + WS_X); bf16_t* HM = (bf16_t*)(p->ws + WS_HM);
    const float* g = j < 0 ? p->in[I_FNG] : p->in[I_NORMG] + (size_t)(l * 3 + j) * D;
    const bool from_in = (l == 0 && j == 0);
    for (int r = gw; r < MTOK; r += nw) {
        const float* xr = from_in ? (r < TCTX ? p->in[I_XP] + (size_t)r * D : p->in[I_XS] + (size_t)(r - TCTX) * D) : X + (size_t)r * D; f32x4 v[8]; float ss = 0.f;
#pragma unroll
        for (int i = 0; i < 8; ++i) { v[i] = *(const f32x4*)(xr + lane * 4 + i * 256); ss += v[i][0] * v[i][0] + v[i][1] * v[i][1] + v[i][2] * v[i][2] + v[i][3] * v[i][3]; }
#pragma unroll
        for (int o = 32; o >= 1; o >>= 1) ss += __shfl_xor(ss, o);
        const float rinv = rsqrtf(ss * (1.f / D) + EPS);
        if (j < 0) { float* o = p->out + OUT_Y + (size_t)r * D;
#pragma unroll
            for (int i = 0; i < 8; ++i) { const int c = lane * 4 + i * 256; const f32x4 gg = *(const f32x4*)(g + c); *(f32x4*)(o + c) = v[i] * rinv * gg; } }
        else { const float* mod = (const float*)(p->ws + WS_MOD) + (size_t)(l * 3 + cond_of_row(r)) * 18432; const float* sh = mod + (3 * j) * 2048; const float* scl = mod + (3 * j + 1) * 2048;
#pragma unroll
            for (int i = 0; i < 8; ++i) { const int c = lane * 4 + i * 256; const f32x4 gg = *(const f32x4*)(g + c), s1 = *(const f32x4*)(scl + c), s0 = *(const f32x4*)(sh + c);
                const f32x4 y = (v[i] * rinv * gg) * (s1 + 1.f) + s0; uint2 pk; pk.x = cvt_pk_bf16(y[0], y[1]); pk.y = cvt_pk_bf16(y[2], y[3]); *(uint2*)(HM + (size_t)r * D + c) = pk; } }
    }
}

__device__ __forceinline__ void seq_info(int s, int& L, int& row0) { if (s < 16) { L = 256; row0 = s * 256; } else { L = 1024; row0 = TCTX + (s - 16) * 1024; } }

#define WAVE_LDS_SYNC() asm volatile("s_waitcnt lgkmcnt(0)" ::: "memory")
__device__ __forceinline__ void s5_item(PP p, unsigned char* lds, int s, int d, int gg) {
    const int tid = tidx(), lane = tid & 63, wid = tid >> 6, fr = lane & 15, fq = lane >> 4; const int g = gg * 8 + wid;
    int L, row0; seq_info(s, L, row0);
    float* HS = (float*)(lds + wid * 8448);
    const bf16_t* PROJ = (const bf16_t*)(p->ws + WS_PROJ); float* Y = (float*)(p->ws + WS_YS5) + (size_t)d * MTOK * 1024;
    const int pg0 = (d * 64 + g) * 64, pg = pg0 + lane;
    const float lre = p->in[I_LAMRE][pg], lim = p->in[I_LAMIM][pg], dt = expf(p->in[I_LOGSTEP][d * 64 + g]);
    const float mag = expf(lre * dt); float sn, cs; sincosf(lim * dt, &sn, &cs);
    const float abr = mag * cs, abi = mag * sn, den = lre * lre + lim * lim, nre = abr - 1.f;
    const float fre = (nre * lre + abi * lim) / den, fim = (abi * lre - nre * lim) / den;
    bf16x8 af[8];
#pragma unroll
    for (int tq = 0; tq < 4; ++tq) { const int src = tq * 16 + fr; const float f_r = __shfl(fre, src), f_i = __shfl(fim, src);
        f32x4 r0 = (f32x4){0.f, 0.f, 0.f, 0.f}, r1 = r0, i0 = r0, i1 = r0;
        if (fq < 2) { const float* br = p->in[I_BRE] + (size_t)(pg0 + src) * 16 + fq * 8; const float* bi = p->in[I_BIM] + (size_t)(pg0 + src) * 16 + fq * 8;
            r0 = *(const f32x4*)br; r1 = *(const f32x4*)(br + 4); i0 = *(const f32x4*)bi; i1 = *(const f32x4*)(bi + 4); }
        af[tq] = pack8(r0 * f_r - i0 * f_i, r1 * f_r - i1 * f_i); af[tq + 4] = pack8(i0 * f_r + r0 * f_i, i1 * f_r + r1 * f_i); }
    bf16x8 cf[4];
#pragma unroll
    for (int kk = 0; kk < 4; ++kk) { const float* cp = (kk < 2 ? p->in[I_CRE] : p->in[I_CIM]) + ((size_t)(d * 64 + g) * 16 + fr) * 64 + (kk & 1) * 32 + fq * 8;
        f32x4 a = *(const f32x4*)cp, b = *(const f32x4*)(cp + 4); if (kk >= 2) { a = -a; b = -b; } cf[kk] = pack8(a, b); }
    float hr = 0.f, hi = 0.f;
    if (s >= 16) { const size_t o = ((size_t)((s - 16) * 2 + d) * 64 + g) * 64 + lane; hr = p->in[I_S5RE][o]; hi = p->in[I_S5IM][o]; }
    const f32x4 z4 = (f32x4){0.f, 0.f, 0.f, 0.f};
    bf16x8 un = (bf16x8){0, 0, 0, 0, 0, 0, 0, 0};
#define S5_LOADU(c0_) do { if (fq < 2) { const int row_ = row0 + (d ? L - 1 - ((c0_) + fr) : (c0_) + fr); un = *(const bf16x8*)(PROJ + (size_t)row_ * EVINP + g * 16 + fq * 8); } } while (0)
    S5_LOADU(0);
    __syncthreads();
    for (int c0 = 0; c0 < L; c0 += 16) {
        const bf16x8 ub = un;
        if (c0 + 16 < L) S5_LOADU(c0 + 16);
#pragma unroll
        for (int t8 = 0; t8 < 8; ++t8) { const f32x4 bu = __builtin_amdgcn_mfma_f32_16x16x32_bf16(af[t8], ub, z4, 0, 0, 0); *(f32x4*)(HS + fr * 132 + t8 * 16 + fq * 4) = bu; }
        WAVE_LDS_SYNC();
#pragma unroll
        for (int i = 0; i < 16; ++i) { const float bur = HS[i * 132 + lane], bui = HS[i * 132 + 64 + lane];
            const float nr = abr * hr - abi * hi + bur, ni = abr * hi + abi * hr + bui; hr = nr; hi = ni;
            HS[i * 132 + lane] = hr; HS[i * 132 + 64 + lane] = hi; }
        WAVE_LDS_SYNC();
        { f32x4 acc = z4;
#pragma unroll
          for (int kk = 0; kk < 4; ++kk) { const float* hp = HS + fr * 132 + kk * 32 + fq * 8; const bf16x8 hb = pack8(*(const f32x4*)hp, *(const f32x4*)(hp + 4));
              acc = __builtin_amdgcn_mfma_f32_16x16x32_bf16(cf[kk], hb, acc, 0, 0, 0); }
          const int row = row0 + (d ? L - 1 - (c0 + fr) : c0 + fr);
          *(f32x4*)(Y + (size_t)row * 1024 + g * 16 + fq * 4) = acc; }
        WAVE_LDS_SYNC();
    }
#undef S5_LOADU
    if (s < 16) { const size_t o = ((size_t)(s * 2 + d) * 64 + g) * 64 + lane; p->out[OUT_S5RE + o] = hr; p->out[OUT_S5IM + o] = hi; }
}

template <int NK32> __device__ __forceinline__ f32x4 mma_lds(f32x4 acc, const bf16_t* X, int ldx, const bf16_t* Y, int ldy, int lane) {
    const bf16_t* xp = X + (lane & 15) * ldx + (lane >> 4) * 8; const bf16_t* yp = Y + (lane & 15) * ldy + (lane >> 4) * 8;
#pragma unroll
    for (int kk = 0; kk < NK32; ++kk) acc = __builtin_amdgcn_mfma_f32_16x16x32_bf16(*(const bf16x8*)(xp + kk * 32), *(const bf16x8*)(yp + kk * 32), acc, 0, 0, 0);
    return acc;
}

__device__ __forceinline__ void gla_item(PP p, unsigned char* lds, int s, int h, int d, int vh) {
    const int tid = tidx(), lane = tid & 63, wid = tid >> 6, fr = lane & 15, fq = lane >> 4;
    int L, row0; seq_info(s, L, row0);
    bf16_t* QT = (bf16_t*)(lds);
    bf16_t* KT = (bf16_t*)(lds + 17408);
    bf16_t* KE = (bf16_t*)(lds + 34816);
    bf16_t* VT = (bf16_t*)(lds + 53248);
    bf16_t* ATT = (bf16_t*)(lds + 71680);
    bf16_t* ST = (bf16_t*)(lds + 80896);
    float* LOGA = (float*)(lds + 80896);
    float* SEG = (float*)(lds + 115712);
    float* GLR = (float*)(lds + 117760);
    float* W2S = (float*)(lds + 121856);
    float* GBS = (float*)(lds + 130048);
    float* DEC = (float*)(lds + 130560);
    const bf16_t* PROJ = (const bf16_t*)(p->ws + WS_PROJ); float* O = (float*)(p->ws + WS_OGLA) + (size_t)d * MTOK * 1024;
    __syncthreads();
    for (int i = tid; i < 16 * 128; i += 512) W2S[i] = p->in[I_GW2][(size_t)(d * 16 + (i >> 7)) * 512 + h * 128 + (i & 127)];
    if (tid < 128) GBS[tid] = p->in[I_GB][d * 512 + h * 128 + tid];
    f32x4 sacc[8];
#pragma unroll
    for (int tn = 0; tn < 8; ++tn) { sacc[tn] = (f32x4){0.f, 0.f, 0.f, 0.f};
        if (s >= 16) { const float* sp = p->in[I_SGLA] + ((size_t)(((s - 16) * 2 + d) * 4 + h) * 128 + wid * 16 + fq * 4) * 256 + vh * 128 + tn * 16 + fr;
#pragma unroll
            for (int e = 0; e < 4; ++e) sacc[tn][e] = sp[(size_t)e * 256]; } }
    const float qscale = 0.08838834764831845f;
    const int nch = L >> 6;
    const int c = tid & 127, ig = tid >> 7;
#define GROW(n_, i) (row0 + (d ? L - 1 - ((n_) * 64 + (i)) : (n_) * 64 + (i)))
    f32x4 glr4 = (f32x4){0.f, 0.f, 0.f, 0.f}; float qv[16], kv[16], vv[16];
#define GLA_PREFETCH(n_) do { \
        if (tid < 256) glr4 = unpack4(*(const uint2*)(PROJ + (size_t)GROW(n_, tid >> 2) * EVINP + 4096 + d * 16 + (tid & 3) * 4)); \
        _Pragma("unroll") for (int ii = 0; ii < 16; ++ii) { const size_t ro = (size_t)GROW(n_, ig * 16 + ii) * EVINP; \
            qv[ii] = bf2f_(PROJ[ro + 1024 + h * 128 + c]); kv[ii] = bf2f_(PROJ[ro + 1536 + h * 128 + c]); vv[ii] = bf2f_(PROJ[ro + 2048 + h * 256 + vh * 128 + c]); } } while (0)
    GLA_PREFETCH(0);
    for (int n = 0; n < nch; ++n) {
        __syncthreads();
        if (tid < 256) *(f32x4*)(GLR + (tid >> 2) * 16 + (tid & 3) * 4) = glr4;
        __syncthreads();
        { float run = 0.f; const float gb = GBS[c];
          float w2[16];
#pragma unroll
          for (int r = 0; r < 16; ++r) w2[r] = W2S[r * 128 + c];
          for (int ii = 0; ii < 16; ++ii) { const int i = ig * 16 + ii; float z = gb;
#pragma unroll
              for (int q = 0; q < 4; ++q) { const f32x4 g4 = *(const f32x4*)(GLR + i * 16 + q * 4);
#pragma unroll
                  for (int e = 0; e < 4; ++e) z += g4[e] * w2[q * 4 + e]; }
              run -= (fmaxf(-z, 0.f) + __logf(1.f + __expf(-fabsf(z)))) * (1.f / 16.f); LOGA[i * 128 + c] = run; }
          SEG[ig * 128 + c] = run; }
        __syncthreads();
        { float pre = 0.f, tot = 0.f;
#pragma unroll
          for (int q = 0; q < 4; ++q) { const float sg = SEG[q * 128 + c]; tot += sg; if (q < ig) pre += sg; }
          if (ig == 0) DEC[c] = __expf(tot);
#pragma unroll
          for (int ii = 0; ii < 16; ++ii) { const int i = ig * 16 + ii; const float bc = LOGA[i * 128 + c] + pre;
              QT[i * 136 + c] = f2bf(qv[ii] * qscale * __expf(bc)); KT[i * 136 + c] = f2bf(kv[ii] * __expf(-bc)); KE[c * 72 + i] = f2bf(kv[ii] * __expf(tot - bc)); VT[c * 72 + i] = f2bf(vv[ii]); } }
        __syncthreads();
        if (n + 1 < nch) GLA_PREFETCH(n + 1);
#pragma unroll
        for (int q = 0; q < 2; ++q) { const int tile = wid * 2 + q, ti = tile >> 2, tj = tile & 3; f32x4 a = (f32x4){0.f, 0.f, 0.f, 0.f};
            if (tj <= ti) a = mma_lds<4>(a, QT + ti * 16 * 136, 136, KT + tj * 16 * 136, 136, lane);
#pragma unroll
            for (int e = 0; e < 4; ++e) { const int i = ti * 16 + fq * 4 + e, jx = tj * 16 + fr; ATT[i * 72 + jx] = f2bf(jx <= i ? a[e] : 0.f); } }
#pragma unroll
        for (int tn = 0; tn < 8; ++tn) { uint2 pk; pk.x = cvt_pk_bf16(sacc[tn][0], sacc[tn][1]); pk.y = cvt_pk_bf16(sacc[tn][2], sacc[tn][3]); *(uint2*)(ST + (tn * 16 + fr) * 136 + wid * 16 + fq * 4) = pk; }
        __syncthreads();
#pragma unroll
        for (int ti = 0; ti < 4; ++ti) { f32x4 o = (f32x4){0.f, 0.f, 0.f, 0.f};
            o = mma_lds<2>(o, ATT + ti * 16 * 72, 72, VT + wid * 16 * 72, 72, lane);
            o = mma_lds<4>(o, QT + ti * 16 * 136, 136, ST + wid * 16 * 136, 136, lane);
#pragma unroll
            for (int e = 0; e < 4; ++e) { const int i = ti * 16 + fq * 4 + e; O[(size_t)GROW(n, i) * 1024 + h * 256 + vh * 128 + wid * 16 + fr] = o[e]; } }
        { f32x4 dc;
#pragma unroll
          for (int e = 0; e < 4; ++e) dc[e] = DEC[wid * 16 + fq * 4 + e];
#pragma unroll
          for (int tn = 0; tn < 8; ++tn) { sacc[tn] = sacc[tn] * dc; sacc[tn] = mma_lds<2>(sacc[tn], KE + wid * 16 * 72, 72, VT + tn * 16 * 72, 72, lane); } }
    }
#undef GROW
#undef GLA_PREFETCH
    if (s < 16) {
#pragma unroll
        for (int tn = 0; tn < 8; ++tn) { float* sp = p->out + OUT_GLA + ((size_t)((s * 2 + d) * 4 + h) * 128 + wid * 16 + fq * 4) * 256 + vh * 128 + tn * 16 + fr;
#pragma unroll
            for (int e = 0; e < 4; ++e) sp[(size_t)e * 256] = sacc[tn][e]; } }
}

__device__ void phase_s5gla(PP p, LAS unsigned char* ldsr) {
    unsigned char* lds = (unsigned char*)ldsr; const int bid = bidx(), nb = gdim();
    if (nb >= 64) {
        if (bid < 32) { gla_item(p, lds, 16 + (bid >> 4), (bid >> 2) & 3, (bid >> 1) & 1, bid & 1); return; }
        for (int it = bid - 32; it < 544; it += nb - 32) {
            if (it < 32) s5_item(p, lds, 16 + (it >> 4), (it >> 3) & 1, it & 7);
            else if (it < 288) { const int q = it - 32; s5_item(p, lds, q >> 4, (q >> 3) & 1, q & 7); }
            else { const int q = it - 288; gla_item(p, lds, q >> 4, (q >> 2) & 3, (q >> 1) & 1, q & 1); }
        }
    } else {
        for (int it = bid; it < 576; it += nb) {
            if (it < 32) { gla_item(p, lds, 16 + (it >> 4), (it >> 2) & 3, (it >> 1) & 1, it & 1); }
            else if (it < 64) { const int q = it - 32; s5_item(p, lds, 16 + (q >> 4), (q >> 3) & 1, q & 7); }
            else if (it < 320) { const int q = it - 64; s5_item(p, lds, q >> 4, (q >> 3) & 1, q & 7); }
            else { const int q = it - 320; gla_item(p, lds, q >> 4, (q >> 2) & 3, (q >> 1) & 1, q & 1); }
        }
    }
}

__device__ void phase_evpost(PP p) {
    const int tid = tidx(), lane = tid & 63, wid = tid >> 6; const int gw = bidx() * 8 + wid, nw = gdim() * 8;
    const bf16_t* PROJ = (const bf16_t*)(p->ws + WS_PROJ); const float* Y0 = (const float*)(p->ws + WS_YS5); const float* Y1 = Y0 + (size_t)MTOK * 1024;
    const float* O0 = (const float*)(p->ws + WS_OGLA); const float* O1 = O0 + (size_t)MTOK * 1024;
    bf16_t* YSB = (bf16_t*)(p->ws + WS_YSB); bf16_t* CAT = (bf16_t*)(p->ws + WS_CAT);
    for (int r = gw; r < MTOK; r += nw) {
#pragma unroll
        for (int i = 0; i < 4; ++i) { const int c = lane * 4 + i * 256; const f32x4 y0 = *(const f32x4*)(Y0 + (size_t)r * 1024 + c), y1 = *(const f32x4*)(Y1 + (size_t)r * 1024 + c);
            const f32x4 u = unpack4(*(const uint2*)(PROJ + (size_t)r * EVINP + c)), dd = *(const f32x4*)(p->in[I_S5D] + c); f32x4 v = y0 + y1 + dd * u;
#pragma unroll
            for (int e = 0; e < 4; ++e) v[e] = geluf_(v[e]);
            uint2 pk; pk.x = cvt_pk_bf16(v[0], v[1]); pk.y = cvt_pk_bf16(v[2], v[3]); *(uint2*)(YSB + (size_t)r * 1024 + c) = pk; }
        { const int c0 = lane * 16; f32x4 o[4]; float ss = 0.f;
#pragma unroll
          for (int i = 0; i < 4; ++i) { o[i] = *(const f32x4*)(O0 + (size_t)r * 1024 + c0 + i * 4) + *(const f32x4*)(O1 + (size_t)r * 1024 + c0 + i * 4); ss += o[i][0] * o[i][0] + o[i][1] * o[i][1] + o[i][2] * o[i][2] + o[i][3] * o[i][3]; }
#pragma unroll
          for (int m = 8; m >= 1; m >>= 1) ss += __shfl_xor(ss, m);
          const float rinv = rsqrtf(ss * (1.f / 256.f) + EPS);
#pragma unroll
          for (int i = 0; i < 4; ++i) { const int c = c0 + i * 4; const f32x4 ng = *(const f32x4*)(p->in[I_GNG] + (c & 255)), gt = unpack4(*(const uint2*)(PROJ + (size_t)r * EVINP + 3072 + c)); f32x4 v;
#pragma unroll
              for (int e = 0; e < 4; ++e) v[e] = o[i][e] * rinv * ng[e] * siluf_(gt[e]);
              uint2 pk; pk.x = cvt_pk_bf16(v[0], v[1]); pk.y = cvt_pk_bf16(v[2], v[3]); *(uint2*)(CAT + (size_t)r * D + 1024 + c) = pk; } }
    }
}

__device__ void phase_conv(PP p) {
    const bf16_t* PROJ = (const bf16_t*)(p->ws + WS_PROJ); bf16_t* XCB = (bf16_t*)(p->ws + WS_XCB);
    const float* cw = p->in[I_CONVW]; const float* cb = p->in[I_CONVB];
    const size_t total = (size_t)MTOK * 512;
    { const int gi = bidx() * 512 + tidx(); if (gi < 2 * D) ((float*)(p->ws + WS_SP))[gi] = -8.f * softplusf_(-p->in[I_LLAM][gi]); }
    for (size_t i = (size_t)bidx() * 512 + tidx(); i < total; i += (size_t)gdim() * 512) {
        const int r = (int)(i >> 9), c = (int)(i & 511) * 4; const int seg = r < TCTX ? 256 : 64; const int pos = r & (seg - 1);
        f32x4 acc = *(const f32x4*)(cb + c);
#pragma unroll
        for (int j = 0; j < 4; ++j) { const int pp = pos + j - 2; if (pp >= 0 && pp < seg) acc += *(const f32x4*)(cw + j * D + c) * unpack4(*(const uint2*)(PROJ + (size_t)(r + j - 2) * 4096 + 2048 + c)); }
        uint2 pk; pk.x = cvt_pk_bf16(acc[0], acc[1]); pk.y = cvt_pk_bf16(acc[2], acc[3]); *(uint2*)(XCB + (size_t)r * D + c) = pk;
    }
}
__device__ void phase_lruscan1(PP p) {
    const int tid = tidx(), lane = tid & 63, wid = tid >> 6; const int nb = gdim();
    float* SUM = (float*)(p->ws + WS_LSUM);
    for (int it = bidx() * 8 + wid; it < 384 * 64; it += 8 * nb) {
        const int q = it >> 6, d = (it >> 5) & 1, c = (it & 31) * 64 + lane; const int row0 = q * 16;
        const unsigned* LAB = (const unsigned*)(p->ws + WS_LA) + ((size_t)d * MTOK + row0) * D + c;
        unsigned wv[16];
#pragma unroll
        for (int j = 0; j < 16; ++j) wv[j] = LAB[(size_t)j * D];
        float S = 0.f, h = 0.f;
        if (d == 0) {
#pragma unroll
            for (int j = 0; j < 16; ++j) { const float la = lo_bf(wv[j]); h = __expf(la) * h + hi_bf(wv[j]); S += la; } }
        else {
#pragma unroll
            for (int j = 15; j >= 0; --j) { const float la = lo_bf(wv[j]); h = __expf(la) * h + hi_bf(wv[j]); S += la; } }
        SUM[((size_t)d * 384 + q) * D + c] = __expf(S); SUM[((size_t)(2 + d) * 384 + q) * D + c] = h;
    }
}
__device__ void conv_tile(PP p, int pm, int pnx) {
    const int tid = tidx();
    const bf16_t* PROJ = (const bf16_t*)(p->ws + WS_PROJ); bf16_t* XCB = (bf16_t*)(p->ws + WS_XCB); const float* cw = p->in[I_CONVW]; const float* cb = p->in[I_CONVB];
    const int c = pnx * 256 + (tid & 63) * 4; const int rl0 = tid >> 6;
    f32x4 w[4]; const f32x4 bias = *(const f32x4*)(cb + c);
#pragma unroll
    for (int j = 0; j < 4; ++j) w[j] = *(const f32x4*)(cw + j * D + c);
    for (int kb = 0; kb < 32; kb += 4) {
        uint2 t[4][4];
#pragma unroll
        for (int u = 0; u < 4; ++u) { const int r = pm * 256 + rl0 + 8 * (kb + u); const int seg = r < TCTX ? 256 : 64; const int pos = r & (seg - 1);
#pragma unroll
            for (int j = 0; j < 4; ++j) { const int pp = pos + j - 2; t[u][j] = (uint2){0u, 0u}; if (pp >= 0 && pp < seg) t[u][j] = *(const uint2*)(PROJ + (size_t)(r + j - 2) * 4096 + 2048 + c); } }
#pragma unroll
        for (int u = 0; u < 4; ++u) { const int r = pm * 256 + rl0 + 8 * (kb + u); f32x4 acc = bias;
#pragma unroll
            for (int j = 0; j < 4; ++j) acc += w[j] * unpack4(t[u][j]);
            uint2 pk; pk.x = cvt_pk_bf16(acc[0], acc[1]); pk.y = cvt_pk_bf16(acc[2], acc[3]); *(uint2*)(XCB + (size_t)r * D + c) = pk; } }
}
__device__ void scan1_tile(PP p, int pm, int pn) {
    const int tid = tidx(); const int d = pn >> 4, chu = ((pn >> 1) & 7) * 256 + (pn & 1) * 128; float* SUM = (float*)(p->ws + WS_LSUM);
    const int c = chu + (tid & 127);
    unsigned wv[4][16];
#pragma unroll
    for (int k = 0; k < 4; ++k) { const int q = pm * 16 + (tid >> 7) + 4 * k; const unsigned* LAB = (const unsigned*)(p->ws + WS_LA) + ((size_t)d * MTOK + q * 16) * D + c;
#pragma unroll
        for (int j = 0; j < 16; ++j) wv[k][j] = LAB[(size_t)j * D]; }
#pragma unroll
    for (int k = 0; k < 4; ++k) { const int q = pm * 16 + (tid >> 7) + 4 * k; float S = 0.f, h = 0.f;
        if (d == 0) {
#pragma unroll
            for (int j = 0; j < 16; ++j) { const float la = lo_bf(wv[k][j]); h = __expf(la) * h + hi_bf(wv[k][j]); S += la; } }
        else {
#pragma unroll
            for (int j = 15; j >= 0; --j) { const float la = lo_bf(wv[k][j]); h = __expf(la) * h + hi_bf(wv[k][j]); S += la; } }
        SUM[((size_t)d * 384 + q) * D + c] = __expf(S); SUM[((size_t)(2 + d) * 384 + q) * D + c] = h; }
}
__device__ void phase_lruscan2(PP p) {
    const int tid = tidx(), lane = tid & 63, wid = tid >> 6; const int nb = gdim();
    const float* SUM = (const float*)(p->ws + WS_LSUM); const bf16_t* PROJ = (const bf16_t*)(p->ws + WS_PROJ); bf16_t* CAT = (bf16_t*)(p->ws + WS_CAT);
    for (int it0 = bidx() * 8 + wid; it0 < 384 * 32; it0 += 8 * nb) {
        const int it = it0 < 128 * 32 ? it0 + 256 * 32 : it0 - 128 * 32;
        const int q = it >> 5, c = (it & 31) * 64 + lane; const int row0 = q * 16;
        int qs, ql, s; if (q < 256) { s = q >> 4; qs = s * 16; ql = qs + 15; } else { s = 16 + ((q - 256) >> 6); qs = 256 + (s - 16) * 64; ql = qs + 63; }
        float h0 = 0.f, h1 = 0.f;
        if (s >= 16) { h0 = p->in[I_SLRU][(size_t)((s - 16) * 2 + 0) * D + c]; h1 = p->in[I_SLRU][(size_t)((s - 16) * 2 + 1) * D + c]; }
        const float* P0 = SUM + c; const float* H0 = SUM + (size_t)2 * 384 * D + c; const float* P1 = SUM + (size_t)384 * D + c; const float* H1 = SUM + (size_t)3 * 384 * D + c;
        { int j = qs;
          for (; j + 8 <= q; j += 8) { float pv[8], hv[8];
#pragma unroll
              for (int e = 0; e < 8; ++e) { pv[e] = P0[(size_t)(j + e) * D]; hv[e] = H0[(size_t)(j + e) * D]; }
#pragma unroll
              for (int e = 0; e < 8; ++e) h0 = pv[e] * h0 + hv[e]; }
          for (; j < q; ++j) h0 = P0[(size_t)j * D] * h0 + H0[(size_t)j * D]; }
        { int j = ql;
          for (; j - 8 >= q; j -= 8) { float pv[8], hv[8];
#pragma unroll
              for (int e = 0; e < 8; ++e) { pv[e] = P1[(size_t)(j - e) * D]; hv[e] = H1[(size_t)(j - e) * D]; }
#pragma unroll
              for (int e = 0; e < 8; ++e) h1 = pv[e] * h1 + hv[e]; }
          for (; j > q; --j) h1 = P1[(size_t)j * D] * h1 + H1[(size_t)j * D]; }
        const unsigned* W0 = (const unsigned*)(p->ws + WS_LA) + (size_t)row0 * D + c; const unsigned* W1 = W0 + (size_t)MTOK * D; const bf16_t* GT = PROJ + (size_t)row0 * 4096 + c;
        unsigned w0[16], w1[16]; float b0[16], gt[16];
#pragma unroll
        for (int j = 0; j < 16; ++j) { w0[j] = W0[(size_t)j * D]; w1[j] = W1[(size_t)j * D]; gt[j] = bf2f_(GT[(size_t)j * 4096]); }
#pragma unroll
        for (int j = 0; j < 16; ++j) { h0 = __expf(lo_bf(w0[j])) * h0 + hi_bf(w0[j]); b0[j] = h0; }
#pragma unroll
        for (int j = 15; j >= 0; --j) { h1 = __expf(lo_bf(w1[j])) * h1 + hi_bf(w1[j]); CAT[(size_t)(row0 + j) * D + c] = f2bf((b0[j] + h1) * geluf_(gt[j])); }
        if (s < 16) { if (q == ql) p->out[OUT_LRU + (size_t)(s * 2 + 0) * D + c] = h0; if (q == qs) p->out[OUT_LRU + (size_t)(s * 2 + 1) * D + c] = h1; }
    }
}

#ifndef PHMASK
#define PHMASK 0xFFFFFFFFu
#endif
#define PHON(k) ((PHMASK >> (k)) & 1u)
#ifndef DUPMASK
#define DUPMASK 0u
#endif
enum { K_PREP = 0, K_NORM, K_SWIGLU, K_RESID, K_F32, K_S5GLA, K_EVPOST, K_GLU, K_CONV, K_LRUG, K_LRUSCAN, K_LRUCOMB };
__global__ void __launch_bounds__(512, 2) mega(Params p) {
    extern __shared__ __attribute__((aligned(16))) unsigned char shm[];
    LAS unsigned char* lds = (LAS unsigned char*)shm;
    cg::grid_group grid = cg::this_grid();
    const int ph_lo = p.ph_lo, ph_hi = p.ph_hi;
    int rep = 0;
    volatile LAS unsigned* bst = (volatile LAS unsigned*)(lds + LDS_MAIN);
    if (threadIdx.x < 16) bst[threadIdx.x] = 0u;
    __syncthreads();
    XcdBarrier xbar = xcd_barrier_post((unsigned*)(p.ws + WS_BAR), bst);
    for (int ph = ph_lo; ph < ph_hi; ++ph) {
        PP pp = get_pp();
        unsigned char* ws = pp->ws;
        const float* MOD = (const float*)(ws + WS_MOD);
        int kind, l = 0, a0 = 0;
        if (ph == 0) kind = K_PREP;
        else if (ph == 24) { kind = K_NORM; a0 = -1; }
        else { l = ph > 12 ? 1 : 0; const int q = ph - 1 - 12 * l;
            if (q == 0) { kind = K_NORM; a0 = 0; }
            else if (q == 1) { kind = K_SWIGLU; a0 = 0; }
            else if (q == 2) { kind = K_RESID; a0 = 0; }
            else if (q == 3) { kind = K_NORM; a0 = 1; }
            else if (q == 4) kind = K_F32;
            else if (l == 0) { if (q == 5) kind = K_S5GLA; else if (q == 6) kind = K_EVPOST; else if (q == 7) kind = K_GLU; else if (q == 8) { kind = K_RESID; a0 = 2; } else if (q == 9) { kind = K_NORM; a0 = 2; } else if (q == 10) { kind = K_SWIGLU; a0 = 1; } else { kind = K_RESID; a0 = 1; } }
            else { if (q == 5) kind = K_LRUG; else if (q == 6) kind = K_LRUCOMB; else if (q == 7) { kind = K_RESID; a0 = 2; } else if (q == 8) { kind = K_NORM; a0 = 2; } else if (q == 9) { kind = K_SWIGLU; a0 = 1; } else { kind = K_RESID; a0 = 1; } }
        }
        const bf16_t* HM = (const bf16_t*)(ws + WS_HM);
        if (kind == K_PREP) { if (PHON(0)) phase_prep(pp, lds, rep); }
        else if (kind == K_NORM) { if (PHON(1)) phase_norm(pp, l, a0); }
        else if (kind == K_SWIGLU) { if (PHON(2)) { EpiSwiglu E{(bf16_t*)(ws + WS_H)}; pg8::gemm_phase<EpiSwiglu, false>(lds, HM, D, (const bf16_t*)(ws + WS_WFI) + (size_t)(l * 2 + a0) * 11264 * 2048, D, 24, 44, D, E); if (!rep) bg_convert(pp, lds, ph); } }
        else if (kind == K_RESID) { if (PHON(3)) {
            const bf16_t* A; const bf16_t* B; int K; int gj; float coef;
            if (a0 < 2) { A = (const bf16_t*)(ws + WS_H); B = (const bf16_t*)(ws + WS_WFO) + (size_t)(l * 2 + a0) * 2048 * 5632; K = DFF; gj = a0 == 0 ? 2 : 8; coef = 0.5f; }
            else { A = (const bf16_t*)(ws + WS_CAT); B = (const bf16_t*)(ws + (l == 0 ? WS_WEO : WS_WOO)); K = D; gj = 5; coef = 1.0f; }
            const bool first = (ph == 3);
            const float* xc_ = first ? pp->in[I_XP] : (const float*)(ws + WS_X); const float* xl_ = first ? pp->in[I_XS] - (size_t)TCTX * D : (const float*)(ws + WS_X);
            EpiResid E{(float*)(ws + WS_X), MOD + (size_t)(l * 3) * 18432 + gj * 2048, coef, xc_, xl_};
            if (a0 < 2) pg8::gemm_phase<EpiResid, false, true>(lds, A, K, B, K, 24, 8, K, E); else pg8::gemm_phase<EpiResid, false, false>(lds, A, K, B, K, 24, 8, K, E); if (!rep) bg_convert(pp, lds, ph); } }
        else if (kind == K_F32) { if (PHON(4)) {
            { const int nN = l == 0 ? 17 : 16; EpiBf16 E{(bf16_t*)(ws + WS_PROJ), nN * 256}; pg8::gemm_phase<EpiBf16, false>(lds, HM, D, (const bf16_t*)(ws + (l == 0 ? WS_WEI : WS_WOI)), D, 24, nN, D, E); }
            if (l == 1) {
                { const int gi = bidx() * 512 + tidx(); if (gi < 2 * D) ((float*)(ws + WS_SP))[gi] = -8.f * softplusf_(-pp->in[I_LLAM][gi]); }
                pg8::Order S; S.nM = 24; S.nN = 16; S.nwg = 384; S.G = gdim(); S.c = bidx(); Unit u;
                for (int i = 0; S.next(i, u); ++i) if (u.pn >= 8) conv_tile(pp, u.pm, u.pn - 8); }
            if (!rep) bg_convert(pp, lds, ph); } }
        else if (kind == K_S5GLA) { if (PHON(5)) phase_s5gla(pp, lds); }
        else if (kind == K_EVPOST) { if (PHON(6)) phase_evpost(pp); }
        else if (kind == K_GLU) { if (PHON(7)) { EpiGlu E{(bf16_t*)(ws + WS_CAT), (const bf16_t*)(ws + WS_YSB), pp->in[I_GLUB]}; pg8::gemm_phase<EpiGlu, false>(lds, (const bf16_t*)(ws + WS_YSB), 1024, (const bf16_t*)(ws + WS_WGLU), 1024, 24, 4, 1024, E); if (!rep) bg_convert(pp, lds, ph); } }
        else if (kind == K_CONV) { if (PHON(8)) phase_conv(pp); }
        else if (kind == K_LRUG) { if (PHON(9)) { EpiLru E{(unsigned*)(ws + WS_LA), (const bf16_t*)(ws + WS_XCB), pp->in[I_LBA], pp->in[I_LBX], (const float*)(ws + WS_SP)};
            int kk = 256; asm volatile("" : "+s"(kk));
            pg8::gemm_phase<EpiLru, true>(lds, (const bf16_t*)(ws + WS_XCB), D, (const bf16_t*)(ws + WS_WLRU), kk, 24, 32, kk, E);
            { pg8::Order S; S.nM = 24; S.nN = 32; S.nwg = 768; S.G = gdim(); S.c = bidx(); Unit u; for (int i = 0; S.next(i, u); ++i) scan1_tile(pp, u.pm, u.pn); } } }
        else if (kind == K_LRUSCAN) { if (PHON(10)) phase_lruscan1(pp); }
        else { if (PHON(11)) phase_lruscan2(pp); }
#if DUPMASK
        if (rep == 0 && ((DUPMASK >> kind) & 1u)) { xcd_barrier(xbar); rep = 1; --ph; continue; }
        rep = 0;
#endif
        if (ph + 1 < ph_hi) { if (ph == 0) grid.sync(); else xcd_barrier(xbar); }
    }
}

extern "C" void kernel_launch(void* const* d_in, const int* in_sizes, int n_in, void* d_out, int out_size, void* d_ws, size_t ws_size, hipStream_t stream) {
    static int grid = 0;
    if (grid == 0) {
        if (n_in != 38 || ws_size < WS_END) { fprintf(stderr, "kernel_launch: expected 38 inputs and >= %zu bytes of workspace (got %d, %zu)\n", (size_t)WS_END, n_in, ws_size); grid = -1; return; }
        int dev = 0, cus = 0, per_cu = 0;
        hipGetDevice(&dev); hipDeviceGetAttribute(&cus, hipDeviceAttributeMultiprocessorCount, dev);
        hipFuncSetAttribute((const void*)mega, hipFuncAttributeMaxDynamicSharedMemorySize, LDS_BYTES);
        hipOccupancyMaxActiveBlocksPerMultiprocessor(&per_cu, (const void*)mega, 512, LDS_BYTES);
        if (per_cu < 1) { fprintf(stderr, "kernel_launch: occupancy query says %d blocks per CU\n", per_cu); grid = -1; return; }
        grid = cus;
    }
    if (grid < 0) return;
    (void)hipMemsetAsync((char*)d_ws + WS_MOD, 0, ZERO_BYTES, stream);
    Params p{};
    for (int i = 0; i < 38; ++i) p.in[i] = (const float*)d_in[i];
    p.out = (float*)d_out; p.ws = (unsigned char*)d_ws;
#if MEGA
    p.ph_lo = 0; p.ph_hi = NPH;
    void* args[] = {&p};
    hipError_t e = hipLaunchCooperativeKernel((const void*)mega, dim3(grid), dim3(512), args, LDS_BYTES, stream);
    if (e != hipSuccess) fprintf(stderr, "cooperative launch failed: %s (grid %d)\n", hipGetErrorString(e), grid);
#else
    for (int ph = 0; ph < NPH; ++ph) { p.ph_lo = ph; p.ph_hi = ph + 1; hipLaunchKernelGGL(mega, dim3(grid), dim3(512), LDS_BYTES, stream, p); }
#endif
}
```

```cpp
#include <hip/hip_runtime.h>
#include <hip/hip_cooperative_groups.h>
#include <cstdio>
namespace cg = cooperative_groups;

#ifndef MEGA
#define MEGA 1
#endif

#define LAS __attribute__((address_space(3)))
typedef unsigned short bf16_t;
typedef short bf16x8 __attribute__((ext_vector_type(8)));
typedef float f32x4 __attribute__((ext_vector_type(4)));
typedef float f32x2 __attribute__((ext_vector_type(2)));

constexpr int D = 2048, DFF = 5632, MTOK = 6144, TCTX = 4096;
constexpr int EVINP = 4352;
constexpr int NPH = 25;
constexpr int LDS_MAIN = 131072;
constexpr int LDS_BYTES = LDS_MAIN + 64;
constexpr float EPS = 1e-6f;

constexpr size_t al256(size_t x) { return (x + 255) & ~(size_t)255; }
constexpr size_t WS_MOD = 0;
constexpr size_t MOD_BYTES = (size_t)2 * 3 * 9 * 2048 * 4;
constexpr size_t WS_BAR = al256(WS_MOD + MOD_BYTES);
constexpr size_t BAR_BYTES = 3456 * 4;
constexpr size_t ZERO_BYTES = WS_BAR + BAR_BYTES;
constexpr size_t WS_X = al256(WS_BAR + BAR_BYTES);
constexpr size_t WS_HM = WS_X + (size_t)MTOK * D * 4;
constexpr size_t WS_H = WS_HM + (size_t)MTOK * D * 2;
constexpr size_t WS_PROJ = WS_H + (size_t)MTOK * DFF * 2;
constexpr size_t WS_WFI = WS_PROJ + (size_t)MTOK * EVINP * 4;
constexpr size_t WS_WFO = WS_WFI + (size_t)4 * 11264 * 2048 * 2;
constexpr size_t WS_WEI = WS_WFO + (size_t)4 * 2048 * 5632 * 2;
constexpr size_t WS_WEO = WS_WEI + (size_t)EVINP * 2048 * 2;
constexpr size_t WS_WGLU = WS_WEO + (size_t)2048 * 2048 * 2;
constexpr size_t WS_WOI = WS_WGLU + (size_t)1024 * 1024 * 2;
constexpr size_t WS_WOO = WS_WOI + (size_t)4096 * 2048 * 2;
constexpr size_t WS_WLRU = WS_WOO + (size_t)2048 * 2048 * 2;
constexpr size_t WS_YS5 = WS_WLRU + (size_t)2 * 8 * 2 * 256 * 256 * 2;
constexpr size_t WS_OGLA = WS_YS5 + (size_t)2 * MTOK * 1024 * 4;
constexpr size_t WS_YS32 = WS_OGLA + (size_t)2 * MTOK * 1024 * 4;
constexpr size_t WS_YSB = WS_YS32 + (size_t)MTOK * 1024 * 4;
constexpr size_t WS_CAT = WS_YSB + (size_t)MTOK * 1024 * 2;
constexpr size_t WS_XC32 = WS_CAT + (size_t)MTOK * D * 2;
constexpr size_t WS_XCB = WS_XC32 + (size_t)MTOK * D * 4;
constexpr size_t WS_LA = WS_XCB + (size_t)MTOK * D * 2;
constexpr size_t WS_LB = WS_LA + (size_t)2 * MTOK * D * 4;
constexpr size_t WS_SP = WS_LB + (size_t)2 * MTOK * D * 4;
constexpr size_t WS_LSUM = WS_SP + (size_t)2 * D * 4;
constexpr size_t WS_END = WS_LSUM + (size_t)2 * 2 * 384 * D * 4;

constexpr size_t OUT_Y = 0;
constexpr size_t OUT_S5RE = (size_t)MTOK * D;
constexpr size_t OUT_S5IM = OUT_S5RE + 16 * 2 * 64 * 64;
constexpr size_t OUT_GLA = OUT_S5IM + 16 * 2 * 64 * 64;
constexpr size_t OUT_LRU = OUT_GLA + (size_t)16 * 2 * 4 * 128 * 256;

struct Params { const float* in[38]; float* out; unsigned char* ws; int ph_lo, ph_hi; };
typedef const __attribute__((address_space(4))) Params* PP;
__device__ __forceinline__ int tidx() { int t = threadIdx.x; asm volatile("" : "+v"(t)); return t; }
__device__ __forceinline__ int bidx() { int b = blockIdx.x; asm volatile("" : "+s"(b)); return b; }
__device__ __forceinline__ int gdim() { int g = gridDim.x; asm volatile("" : "+s"(g)); return g; }
__device__ __forceinline__ PP get_pp() { PP kp = (PP)__builtin_amdgcn_kernarg_segment_ptr(); asm volatile("" : "+s"(kp)); return kp; }
enum { I_XP = 0, I_XS, I_S5RE, I_S5IM, I_SGLA, I_SLRU, I_C, I_CCTX, I_NORMG, I_ADAW, I_ADAB, I_FWI, I_FWO, I_FNG, I_EVWI, I_EVWO,
       I_LAMRE, I_LAMIM, I_LOGSTEP, I_BRE, I_BIM, I_CRE, I_CIM, I_S5D, I_GLUW, I_GLUB, I_GW2, I_GB, I_GNG, I_ODWI, I_ODWO,
       I_CONVW, I_CONVB, I_LWA, I_LBA, I_LWX, I_LBX, I_LLAM };

__device__ __forceinline__ unsigned cvt_pk_bf16(float lo, float hi) { unsigned r; asm("v_cvt_pk_bf16_f32 %0, %1, %2" : "=v"(r) : "v"(lo), "v"(hi)); return r; }
__device__ __forceinline__ bf16_t f2bf(float x) { return (bf16_t)(cvt_pk_bf16(x, 0.f) & 0xffffu); }
__device__ __forceinline__ float bf2f_(bf16_t v) { return __builtin_bit_cast(float, (unsigned)v << 16); }
__device__ __forceinline__ float lo_bf(unsigned w) { return __builtin_bit_cast(float, w << 16); }
__device__ __forceinline__ float hi_bf(unsigned w) { return __builtin_bit_cast(float, w & 0xffff0000u); }
__device__ __forceinline__ f32x4 unpack4(uint2 w) { return (f32x4){lo_bf(w.x), hi_bf(w.x), lo_bf(w.y), hi_bf(w.y)}; }
__device__ __forceinline__ float sigmoidf_(float x) { return __builtin_amdgcn_rcpf(1.f + __expf(-x)); }
__device__ __forceinline__ float siluf_(float x) { return x * __builtin_amdgcn_rcpf(1.f + __expf(-x)); }
__device__ __forceinline__ float geluf_(float x) { return x * sigmoidf_(1.5957691216f * (x + 0.044715f * x * x * x)); }
__device__ __forceinline__ float softplusf_(float x) { return fmaxf(x, 0.f) + log1pf(__expf(-fabsf(x))); }
__device__ __forceinline__ float neg_expm1_(float x) {
    const float pl = -x * (1.f + x * (0.5f + x * (0.16666667f + x * (0.041666668f + x * (0.0083333338f + x * 0.0013888889f))))); return x > -0.25f ? pl : 1.f - __expf(x); }
__device__ __forceinline__ int cond_of_pm(int pm) { return pm < 16 ? 0 : 1 + ((pm - 16) >> 2); }
__device__ __forceinline__ int cond_of_row(int r) { return r < TCTX ? 0 : 1 + ((r - TCTX) >> 10); }
__device__ __forceinline__ bf16x8 pack8(f32x4 a, f32x4 b) {
    typedef unsigned u32x4 __attribute__((ext_vector_type(4)));
    u32x4 u; u[0] = cvt_pk_bf16(a[0], a[1]); u[1] = cvt_pk_bf16(a[2], a[3]); u[2] = cvt_pk_bf16(b[0], b[1]); u[3] = cvt_pk_bf16(b[2], b[3]);
    return __builtin_bit_cast(bf16x8, u);
}

#define XB_TMO      128
#define XB_XCNT(j)  (256  + 64 * (j))
#define XB_XSUB(j)  (1280 + 64 * (j))
#define XB_XGEN(j)  (2304 + 64 * (j))
#define XB_TOP      3328
#define XB_TOPGEN   3392
#define XCD_BAR_WORDS 3456
#define XB_SPIN_CAP (1u << 18)

__device__ __forceinline__ unsigned xb_ld(unsigned* p)              { return __hip_atomic_load(p, __ATOMIC_RELAXED, __HIP_MEMORY_SCOPE_AGENT); }
__device__ __forceinline__ unsigned xb_add(unsigned* p, unsigned v) { return __hip_atomic_fetch_add(p, v, __ATOMIC_RELAXED, __HIP_MEMORY_SCOPE_AGENT); }
__device__ __forceinline__ unsigned xb_xcc_id() { return (unsigned)__builtin_amdgcn_s_getreg((3 << 11) | 20) & 0xFu; }
#define XB_SPIN(cond, bar) do { unsigned _sp = 0; while (cond) { __builtin_amdgcn_s_sleep(1); \
    if ((++_sp & 255u) == 0u) { if (xb_ld(&(bar)[XB_TMO])) break; if (_sp > XB_SPIN_CAP) { atomicAdd(&(bar)[XB_TMO], 1u); break; } } } } while (0)

struct XcdBarrier {
    unsigned* bar; unsigned x;
    volatile LAS unsigned* st;
};

__device__ __forceinline__ XcdBarrier xcd_barrier_post(unsigned* bar, volatile LAS unsigned* st) {
    XcdBarrier b; b.bar = bar; b.x = xb_xcc_id(); b.st = st;
    if (threadIdx.x == 0) (void)xb_add(&bar[XB_XCNT(b.x)], 1u);
    return b;
}
__device__ __forceinline__ void xcd_barrier_complete(unsigned* bar, unsigned x, unsigned& nloc, unsigned& nx) {
    const unsigned G = gridDim.x * gridDim.y * gridDim.z;
    unsigned sum, cnt, mine, sp = 0u;
    for (;;) {
        sum = 0u; cnt = 0u; mine = 0u;
#pragma unroll
        for (unsigned j = 0; j < 16; ++j) { const unsigned c = xb_ld(&bar[XB_XCNT(j)]); sum += c; cnt += (c > 0u) ? 1u : 0u; mine = (j == x) ? c : mine; }
        if (sum == G) break;
        __builtin_amdgcn_s_sleep(1);
        if ((++sp & 255u) == 0u) { if (xb_ld(&bar[XB_TMO])) break; if (sp > XB_SPIN_CAP) { atomicAdd(&bar[XB_TMO], 1u); break; } }
    }
    nloc = mine > 0u ? mine : 1u; nx = cnt > 0u ? cnt : 1u;
}

__device__ __forceinline__ void xcd_barrier(const XcdBarrier& b) {
    asm volatile("s_waitcnt vmcnt(0)" ::: "memory");
    __syncthreads();
    if (threadIdx.x == 0) {
        unsigned* bar = b.bar;
        __builtin_amdgcn_s_waitcnt(0);
        unsigned nloc = b.st[0], nx = b.st[1];
        if (nloc == 0u) { xcd_barrier_complete(bar, b.x, nloc, nx); b.st[0] = nloc; b.st[1] = nx; }
        const unsigned old = xb_add(&bar[XB_XSUB(b.x)], 1u);
        const unsigned gen = old / nloc;
        if (old + 1u == (gen + 1u) * nloc) {
            __builtin_amdgcn_fence(__ATOMIC_RELEASE, "agent");
            asm volatile("s_waitcnt vmcnt(0)" ::: "memory");
            const unsigned og = xb_add(&bar[XB_TOP], 1u);
            const unsigned tg = og / nx;
            if (og + 1u == (tg + 1u) * nx) xb_add(&bar[XB_TOPGEN], 1u);
            else XB_SPIN(xb_ld(&bar[XB_TOPGEN]) == tg, bar);
            __builtin_amdgcn_fence(__ATOMIC_ACQUIRE, "agent");
            xb_add(&bar[XB_XGEN(b.x)], 1u);
            asm volatile("s_waitcnt vmcnt(0)" ::: "memory");
        } else {
            XB_SPIN(xb_ld(&bar[XB_XGEN(b.x)]) == gen, bar);
            __builtin_amdgcn_fence(__ATOMIC_ACQUIRE, "agent");
            asm volatile("s_waitcnt vmcnt(0)" ::: "memory");
        }
    }
    __syncthreads();
}


namespace pg8 {
constexpr int BM = 256, BK = 64, HALF = 128, HTB = HALF * BK * 2, NXCD = 8, WGM = 8;
__device__ __forceinline__ int lds_byte(int r, int c) { const int st = (r >> 4) * 2 + (c >> 5), rr = r & 15, cc = c & 31, ob = rr * 64 + cc * 2; return st * 1024 + (ob ^ (((ob >> 9) & 1) << 5)); }
__device__ __forceinline__ void stage_rc(int b, int& R, int& C) { const int st = b / 1024, sb = b % 1024, swz = sb ^ (((sb >> 9) & 1) << 5); R = (st >> 1) * 16 + swz / 64; C = (st & 1) * 32 + (swz % 64) / 2; }
struct Unit { int pm, pn; };
struct Order {
    int nM, nN, nwg, G, c;
    __device__ __forceinline__ bool next(int i, Unit& u) const {
        const long L = (long)i * G + c; if (L >= nwg) return false;
        int wgid = (int)L; { const int q = nwg / NXCD, r = nwg % NXCD, xcd = wgid % NXCD, off = wgid / NXCD; wgid = (xcd < r ? xcd * (q + 1) : r * (q + 1) + (xcd - r) * q) + off; }
        const int nig = WGM * nN, gid = wgid / nig, fm = gid * WGM, gsz = (nM - fm) < WGM ? (nM - fm) : WGM;
        u.pm = fm + ((wgid % nig) % gsz); u.pn = (wgid % nig) / gsz; return true;
    }
};

template <class Epi, bool LRU, bool BLK = false>
__device__ __forceinline__ void gemm_phase(LAS unsigned char* lds, const bf16_t* A, int lda, const bf16_t* Bt, int ldb, int nM, int nN, int K, const Epi& E) {
    const int tid = tidx(), wid = __builtin_amdgcn_readfirstlane(tid >> 6), lane = tid & 63, wr = wid >> 2, wc = wid & 3, fr = lane & 15, fq = lane >> 4;
    const int nt = K / BK;
    Order S; S.nM = nM; S.nN = nN; S.nwg = nM * nN; S.G = gdim(); S.c = bidx();
    unsigned voffA[2], voffB[2];
#pragma unroll
    for (int i = 0; i < 2; ++i) { int R, C; stage_rc(tid * 16 + i * 8192, R, C); voffA[i] = (unsigned)(R * (BLK ? 64 : lda) + C) * 2u; voffB[i] = (unsigned)(R * (BLK ? 64 : ldb) + C) * 2u; }
    const size_t kstep = BLK ? (size_t)32768 : (size_t)(BK * 2);
    const size_t hstepA = BLK ? (size_t)16384 : (size_t)HALF * lda * 2, hstepB = BLK ? (size_t)16384 : (size_t)HALF * ldb * 2;
    const size_t tstepA = BLK ? (size_t)nt * 32768 : 2 * hstepA, tstepB = BLK ? (size_t)nt * 32768 : 2 * hstepB;
    const unsigned ldsw = (unsigned)wid * 1024u;
    const int aoff = lds_byte(wr * 64 + fr, fq * 8), boff = lds_byte(wc * 32 + fr, fq * 8);
#define PG8_SA(b, h) (((b) * 2 + (h)) * HTB)
#define PG8_SB(b, h) ((4 + (b) * 2 + (h)) * HTB)
#define PG8_STAGE(bufoff, gbase, voff) do { _Pragma("unroll") for (int _i = 0; _i < 2; ++_i) \
        __builtin_amdgcn_global_load_lds((const unsigned*)((const char*)(gbase) + (voff)[_i]), (LAS unsigned*)(lds + (bufoff) + ldsw + _i * 8192), 16, 0, 0); } while (0)
#define PG8_LDA(dst, b, h) do { _Pragma("unroll") for (int m = 0; m < 4; ++m) _Pragma("unroll") for (int k = 0; k < 2; ++k) dst[m][k] = *(const LAS bf16x8*)(lds + PG8_SA(b, h) + aoff + m * 2048 + k * 1024); } while (0)
#define PG8_LDB(dst, b, h) do { _Pragma("unroll") for (int n = 0; n < 2; ++n) _Pragma("unroll") for (int k = 0; k < 2; ++k) dst[n][k] = *(const LAS bf16x8*)(lds + PG8_SB(b, h) + boff + n * 2048 + k * 1024); } while (0)
#define PG8_MMA(ai, bj, At, Bt_) do { __builtin_amdgcn_s_setprio(1); _Pragma("unroll") for (int m = 0; m < 4; ++m) _Pragma("unroll") for (int n = 0; n < 2; ++n) _Pragma("unroll") for (int k = 0; k < 2; ++k) \
        acc[ai][bj][m][n] = __builtin_amdgcn_mfma_f32_16x16x32_bf16(Bt_[n][k], At[m][k], acc[ai][bj][m][n], 0, 0, 0); __builtin_amdgcn_s_setprio(0); } while (0)
#define PG8_WAIT_V(n) asm volatile("s_waitcnt vmcnt(" #n ")" ::: "memory")
#define PG8_WAIT_L(n) asm volatile("s_waitcnt lgkmcnt(" #n ")" ::: "memory")
#define PG8_BAR __builtin_amdgcn_s_barrier()
#define PG8_SCHED __builtin_amdgcn_sched_barrier(0)
#define PG8_APTR(u) ((const char*)A + (size_t)(u).pm * tstepA + (LRU ? (size_t)((((u).pn >> 1) & 7) * 512) : (size_t)0))
#define PG8_BPTR(u) ((const char*)Bt + (size_t)(u).pn * tstepB)
    Unit cur, nxt; int ui = 0;
    if (!S.next(0, cur)) return;
    f32x4 acc[2][2][4][2];
#pragma unroll
    for (int a = 0; a < 2; ++a)
#pragma unroll
        for (int b = 0; b < 2; ++b)
#pragma unroll
            for (int m = 0; m < 4; ++m)
#pragma unroll
                for (int n = 0; n < 2; ++n) acc[a][b][m][n] = (f32x4){0.f, 0.f, 0.f, 0.f};
    bf16x8 At[4][2], B0[2][2], B1[2][2];
    const char* cA = PG8_APTR(cur); const char* cB = PG8_BPTR(cur);
    PG8_STAGE(PG8_SB(0, 0), cB, voffB); PG8_STAGE(PG8_SA(0, 0), cA, voffA); PG8_STAGE(PG8_SB(0, 1), cB + hstepB, voffB); PG8_STAGE(PG8_SA(0, 1), cA + hstepA, voffA);
    if (wr == 1) PG8_BAR;
    PG8_WAIT_V(4); PG8_BAR;
    PG8_STAGE(PG8_SB(1, 0), cB + kstep, voffB); PG8_STAGE(PG8_SA(1, 0), cA + kstep, voffA); PG8_STAGE(PG8_SB(1, 1), cB + hstepB + kstep, voffB);
    PG8_WAIT_V(6); PG8_BAR;
    for (;;) {
        const bool has_next = S.next(ui + 1, nxt);
        const char* nA = has_next ? PG8_APTR(nxt) : cA; const char* nB = has_next ? PG8_BPTR(nxt) : cB;
        for (int t = 0; t < nt; t += 2) {
            const bool last = (t == nt - 2);
            const char* a1 = cA + (size_t)(t + 1) * kstep;
            const char* a2 = last ? nA : cA + (size_t)(t + 2) * kstep; const char* b2 = last ? nB : cB + (size_t)(t + 2) * kstep;
            const char* a3 = a2 + kstep; const char* b3 = b2 + kstep;
            PG8_LDB(B0, 0, 0); PG8_SCHED; PG8_LDA(At, 0, 0); PG8_STAGE(PG8_SA(1, 1), a1 + hstepA, voffA);
            PG8_WAIT_L(8); PG8_BAR; PG8_WAIT_L(0); PG8_MMA(0, 0, At, B0); PG8_BAR; PG8_SCHED;
            PG8_LDB(B1, 0, 1); PG8_STAGE(PG8_SB(0, 0), b2, voffB);
            PG8_BAR; PG8_WAIT_L(0); PG8_MMA(0, 1, At, B1); PG8_BAR;
            PG8_LDA(At, 0, 1); PG8_STAGE(PG8_SA(0, 0), a2, voffA);
            PG8_BAR; PG8_WAIT_L(0); PG8_MMA(1, 0, At, B0); PG8_BAR; PG8_SCHED;
            PG8_STAGE(PG8_SB(0, 1), b2 + hstepB, voffB);
            PG8_WAIT_V(6); PG8_BAR; PG8_MMA(1, 1, At, B1); PG8_BAR;
            PG8_LDB(B0, 1, 0); PG8_SCHED; PG8_LDA(At, 1, 0); PG8_STAGE(PG8_SA(0, 1), a2 + hstepA, voffA);
            PG8_WAIT_L(8); PG8_BAR; PG8_WAIT_L(0); PG8_MMA(0, 0, At, B0); PG8_BAR; PG8_SCHED;
            PG8_LDB(B1, 1, 1); PG8_STAGE(PG8_SB(1, 0), b3, voffB);
            PG8_BAR; PG8_WAIT_L(0); PG8_MMA(0, 1, At, B1); PG8_BAR;
            PG8_LDA(At, 1, 1); PG8_STAGE(PG8_SA(1, 0), a3, voffA);
            PG8_BAR; PG8_WAIT_L(0); PG8_MMA(1, 0, At, B0); PG8_BAR; PG8_SCHED;
            PG8_STAGE(PG8_SB(1, 1), b3 + hstepB, voffB);
            PG8_WAIT_V(6); PG8_BAR; PG8_MMA(1, 1, At, B1); PG8_BAR;
        }
        E(acc, cur, wr, wc, fr, fq);
        if (!has_next) break;
#pragma unroll
        for (int a = 0; a < 2; ++a)
#pragma unroll
            for (int b = 0; b < 2; ++b)
#pragma unroll
                for (int m = 0; m < 4; ++m)
#pragma unroll
                    for (int n = 0; n < 2; ++n) acc[a][b][m][n] = (f32x4){0.f, 0.f, 0.f, 0.f};
        cur = nxt; cA = nA; cB = nB; ++ui;
    }
    PG8_WAIT_V(0);
    if (wr == 0) PG8_BAR;
    PG8_BAR;
#undef PG8_SA
#undef PG8_SB
#undef PG8_STAGE
#undef PG8_LDA
#undef PG8_LDB
#undef PG8_MMA
#undef PG8_WAIT_V
#undef PG8_WAIT_L
#undef PG8_BAR
#undef PG8_SCHED
#undef PG8_APTR
#undef PG8_BPTR
}
}
using pg8::Unit;

struct EpiSwiglu {
    bf16_t* H;
    __device__ __forceinline__ void operator()(const f32x4 (&acc)[2][2][4][2], const Unit& u, int wr, int wc, int fr, int fq) const {
        const int loff = (wr * 64 + fr) * 64 + (wc & 1) * 32 + 4 * fq;
        bf16_t* ub = H + ((size_t)(u.pm * 88 + u.pn * 2 + (wc >> 1)) * 256) * 64;
#pragma unroll
        for (int ai = 0; ai < 2; ++ai)
#pragma unroll
            for (int m = 0; m < 4; ++m) { bf16_t* rb = ub + (size_t)(ai * 128 + m * 16) * 64;
#pragma unroll
                for (int n = 0; n < 2; ++n) { const f32x4 a = acc[ai][0][m][n], b = acc[ai][1][m][n];
                    uint2 pk; pk.x = cvt_pk_bf16(siluf_(a[0]) * b[0], siluf_(a[1]) * b[1]); pk.y = cvt_pk_bf16(siluf_(a[2]) * b[2], siluf_(a[3]) * b[3]);
                    *(uint2*)(rb + loff + n * 16) = pk; } }
    }
};
struct EpiResid {
    float* X; const float* G; float coef; const float* XinC; const float* XinL;
    __device__ __forceinline__ void operator()(const f32x4 (&acc)[2][2][4][2], const Unit& u, int wr, int wc, int fr, int fq) const {
        const int lcol = wc * 32 + 4 * fq, loff = (wr * 64 + fr) * D + lcol;
        const float* g = G + (size_t)cond_of_pm(u.pm) * (9 * 2048) + u.pn * 256;
        float* ub = X + (size_t)u.pm * 256 * D + u.pn * 256;
        const float* ib = (u.pm < 16 ? XinC : XinL) + (size_t)u.pm * 256 * D + u.pn * 256;
        f32x4 gv[2][2];
#pragma unroll
        for (int bj = 0; bj < 2; ++bj)
#pragma unroll
            for (int n = 0; n < 2; ++n) gv[bj][n] = *(const f32x4*)(g + lcol + bj * 128 + n * 16) * coef;
#pragma unroll
        for (int ai = 0; ai < 2; ++ai)
#pragma unroll
            for (int mp = 0; mp < 4; mp += 2) { f32x4 xin[2][2][2];
#pragma unroll
                for (int m2 = 0; m2 < 2; ++m2) { const float* ir = ib + (size_t)(ai * 128 + (mp + m2) * 16) * D;
#pragma unroll
                    for (int bj = 0; bj < 2; ++bj)
#pragma unroll
                        for (int n = 0; n < 2; ++n) xin[m2][bj][n] = *(const f32x4*)(ir + loff + bj * 128 + n * 16); }
                __builtin_amdgcn_sched_barrier(0);
#pragma unroll
                for (int m2 = 0; m2 < 2; ++m2) { float* rb = ub + (size_t)(ai * 128 + (mp + m2) * 16) * D;
#pragma unroll
                    for (int bj = 0; bj < 2; ++bj)
#pragma unroll
                        for (int n = 0; n < 2; ++n) { *(f32x4*)(rb + loff + bj * 128 + n * 16) = xin[m2][bj][n] + gv[bj][n] * acc[ai][bj][mp + m2][n]; } }
                __builtin_amdgcn_sched_barrier(0); }
    }
};
struct EpiF32 {
    float* C; int ldc;
    __device__ __forceinline__ void operator()(const f32x4 (&acc)[2][2][4][2], const Unit& u, int wr, int wc, int fr, int fq) const {
        const int loff = (wr * 64 + fr) * ldc + wc * 32 + 4 * fq;
        float* ub = C + (size_t)u.pm * 256 * ldc + u.pn * 256;
#pragma unroll
        for (int ai = 0; ai < 2; ++ai)
#pragma unroll
            for (int m = 0; m < 4; ++m) { float* rb = ub + (size_t)(ai * 128 + m * 16) * ldc;
#pragma unroll
                for (int bj = 0; bj < 2; ++bj)
#pragma unroll
                    for (int n = 0; n < 2; ++n) *(f32x4*)(rb + loff + bj * 128 + n * 16) = acc[ai][bj][m][n]; }
    }
};
struct EpiBf16 {
    bf16_t* C; int ldc;
    __device__ __forceinline__ void operator()(const f32x4 (&acc)[2][2][4][2], const Unit& u, int wr, int wc, int fr, int fq) const {
        const int loff = (wr * 64 + fr) * ldc + wc * 32 + 4 * fq;
        bf16_t* ub = C + (size_t)u.pm * 256 * ldc + u.pn * 256;
#pragma unroll
        for (int ai = 0; ai < 2; ++ai)
#pragma unroll
            for (int m = 0; m < 4; ++m) { bf16_t* rb = ub + (size_t)(ai * 128 + m * 16) * ldc;
#pragma unroll
                for (int bj = 0; bj < 2; ++bj)
#pragma unroll
                    for (int n = 0; n < 2; ++n) { const f32x4 v = acc[ai][bj][m][n]; uint2 pk; pk.x = cvt_pk_bf16(v[0], v[1]); pk.y = cvt_pk_bf16(v[2], v[3]); *(uint2*)(rb + loff + bj * 128 + n * 16) = pk; } }
    }
};
struct EpiGlu {
    bf16_t* CAT; const bf16_t* YS; const float* bias;
    __device__ __forceinline__ void operator()(const f32x4 (&acc)[2][2][4][2], const Unit& u, int wr, int wc, int fr, int fq) const {
        const int lcol = wc * 32 + 4 * fq, loffY = (wr * 64 + fr) * 1024 + lcol, loffC = (wr * 64 + fr) * D + lcol;
        const float* bb = bias + u.pn * 256; const bf16_t* yb = YS + (size_t)u.pm * 256 * 1024 + u.pn * 256; bf16_t* cb = CAT + (size_t)u.pm * 256 * D + u.pn * 256;
        f32x4 bv[2][2];
#pragma unroll
        for (int bj = 0; bj < 2; ++bj)
#pragma unroll
            for (int n = 0; n < 2; ++n) bv[bj][n] = *(const f32x4*)(bb + lcol + bj * 128 + n * 16);
#pragma unroll
        for (int ai = 0; ai < 2; ++ai)
#pragma unroll
            for (int m = 0; m < 4; ++m) { const bf16_t* yr = yb + (size_t)(ai * 128 + m * 16) * 1024; bf16_t* cr = cb + (size_t)(ai * 128 + m * 16) * D;
#pragma unroll
                for (int bj = 0; bj < 2; ++bj)
#pragma unroll
                    for (int n = 0; n < 2; ++n) { const f32x4 ys = unpack4(*(const uint2*)(yr + loffY + bj * 128 + n * 16)); const f32x4 z = acc[ai][bj][m][n] + bv[bj][n];
                        uint2 pk; pk.x = cvt_pk_bf16(ys[0] * sigmoidf_(z[0]), ys[1] * sigmoidf_(z[1])); pk.y = cvt_pk_bf16(ys[2] * sigmoidf_(z[2]), ys[3] * sigmoidf_(z[3]));
                        *(uint2*)(cr + loffC + bj * 128 + n * 16) = pk; }
                __builtin_amdgcn_sched_barrier(0); }
    }
};
struct EpiLru {
    unsigned* LAB; const bf16_t* XC; const float* ba; const float* bx; const float* sp;
    __device__ __forceinline__ void operator()(const f32x4 (&acc)[2][2][4][2], const Unit& u, int wr, int wc, int fr, int fq) const {
        const int d = u.pn >> 4, h = (u.pn >> 1) & 7, half = u.pn & 1;
        const int chu = h * 256 + half * 128;
        const int lcol = wc * 32 + 4 * fq, loff = (wr * 64 + fr) * D + lcol;
        const bf16_t* xb = XC + (size_t)u.pm * 256 * D + chu; unsigned* lab = LAB + ((size_t)d * MTOK + u.pm * 256) * D + chu;
        f32x4 bav[2], bxv[2], spv[2];
#pragma unroll
        for (int n = 0; n < 2; ++n) { bav[n] = *(const f32x4*)(ba + d * D + chu + lcol + n * 16); bxv[n] = *(const f32x4*)(bx + d * D + chu + lcol + n * 16); spv[n] = *(const f32x4*)(sp + d * D + chu + lcol + n * 16); }
#pragma unroll
        for (int ai = 0; ai < 2; ++ai) { uint2 xw[4][2];
#pragma unroll
            for (int m = 0; m < 4; ++m)
#pragma unroll
                for (int n = 0; n < 2; ++n) xw[m][n] = *(const uint2*)(xb + (size_t)(ai * 128 + m * 16) * D + loff + n * 16);
            __builtin_amdgcn_sched_barrier(0);
#pragma unroll
            for (int m = 0; m < 4; ++m) { const size_t ro = (size_t)(ai * 128 + m * 16) * D;
#pragma unroll
                for (int n = 0; n < 2; ++n) { const f32x4 xc = unpack4(xw[m][n]);
                    const f32x4 rp = acc[ai][0][m][n] + bav[n], ip = acc[ai][1][m][n] + bxv[n]; uint4 w;
                    unsigned wv[4];
#pragma unroll
                    for (int e = 0; e < 4; ++e) { const float la = spv[n][e] * sigmoidf_(rp[e]); const float bb = __builtin_amdgcn_sqrtf(fmaxf(neg_expm1_(2.f * la), 0.f)) * (sigmoidf_(ip[e]) * xc[e]); wv[e] = cvt_pk_bf16(la, bb); }
                    w.x = wv[0]; w.y = wv[1]; w.z = wv[2]; w.w = wv[3];
                    *(uint4*)(lab + ro + loff + n * 16) = w; __builtin_amdgcn_sched_barrier(0); } } }
    }
};

struct CvtT { const float* src; bf16_t* dst; int K, ldsrc, Nsrc, n_dst0, n_src0, k0, blk; };
__device__ __forceinline__ void cvt_decode(PP p, unsigned char* ws, int t, int total, CvtT& c) {
    constexpr int T_FI = 176 * 32, T_FO = 32 * 88, T_EI = 68 * 32, T_EO = 32 * 32, T_GLU = 16 * 16, T_OI = 64 * 32, T_OO = 32 * 32, T_LRU = 4 * 4;
    c.blk = 0;
    if (t >= total) { c.src = nullptr; c.dst = nullptr; c.K = c.ldsrc = c.Nsrc = c.n_dst0 = c.n_src0 = c.k0 = 0; return; }
    if (t < 4 * T_FI) { const int w = t / T_FI; t %= T_FI; const int nt_ = t / 32, kt = t % 32; c.K = 2048; c.ldsrc = 11264; c.Nsrc = 11264; c.src = p->in[I_FWI] + (size_t)w * 2048 * 11264; c.dst = (bf16_t*)(ws + WS_WFI) + (size_t)w * 11264 * 2048;
        c.n_dst0 = nt_ * 64; const int j = c.n_dst0 >> 8, rr = c.n_dst0 & 255; c.n_src0 = rr < 128 ? j * 128 + rr : 5632 + j * 128 + (rr - 128); c.k0 = kt * 64; }
    else if ((t -= 4 * T_FI) < 4 * T_FO) { const int w = t / T_FO; t %= T_FO; const int nt_ = t / 88, kt = t % 88; c.K = 5632; c.ldsrc = 2048; c.Nsrc = 2048; c.src = p->in[I_FWO] + (size_t)w * 5632 * 2048; c.dst = (bf16_t*)(ws + WS_WFO) + (size_t)w * 2048 * 5632; c.n_dst0 = c.n_src0 = nt_ * 64; c.k0 = kt * 64; c.blk = 1; }
    else if ((t -= 4 * T_FO) < T_EI) { const int nt_ = t / 32, kt = t % 32; c.K = 2048; c.ldsrc = 4128; c.Nsrc = 4128; c.src = p->in[I_EVWI]; c.dst = (bf16_t*)(ws + WS_WEI); c.n_dst0 = c.n_src0 = nt_ * 64; c.k0 = kt * 64; }
    else if ((t -= T_EI) < T_EO) { const int nt_ = t / 32, kt = t % 32; c.K = 2048; c.ldsrc = 2048; c.Nsrc = 2048; c.src = p->in[I_EVWO]; c.dst = (bf16_t*)(ws + WS_WEO); c.n_dst0 = c.n_src0 = nt_ * 64; c.k0 = kt * 64; }
    else if ((t -= T_EO) < T_GLU) { const int nt_ = t / 16, kt = t % 16; c.K = 1024; c.ldsrc = 1024; c.Nsrc = 1024; c.src = p->in[I_GLUW]; c.dst = (bf16_t*)(ws + WS_WGLU); c.n_dst0 = c.n_src0 = nt_ * 64; c.k0 = kt * 64; }
    else if ((t -= T_GLU) < T_OI) { const int nt_ = t / 32, kt = t % 32; c.K = 2048; c.ldsrc = 4096; c.Nsrc = 4096; c.src = p->in[I_ODWI]; c.dst = (bf16_t*)(ws + WS_WOI); c.n_dst0 = c.n_src0 = nt_ * 64; c.k0 = kt * 64; }
    else if ((t -= T_OI) < T_OO) { const int nt_ = t / 32, kt = t % 32; c.K = 2048; c.ldsrc = 2048; c.Nsrc = 2048; c.src = p->in[I_ODWO]; c.dst = (bf16_t*)(ws + WS_WOO); c.n_dst0 = c.n_src0 = nt_ * 64; c.k0 = kt * 64; }
    else { t -= T_OO; const int mi = t / T_LRU; t %= T_LRU; const int which = mi >> 4, dh = mi & 15;
        const int nt_ = t / 4, kt = t % 4; c.K = 256; c.ldsrc = 256; c.Nsrc = 256; c.src = (which ? p->in[I_LWX] : p->in[I_LWA]) + (size_t)dh * 65536; c.dst = (bf16_t*)(ws + WS_WLRU) + (size_t)dh * 2 * 65536;
        c.n_src0 = nt_ * 64; const int half = c.n_src0 >> 7; c.n_dst0 = half * 256 + which * 128 + (c.n_src0 & 127); c.k0 = kt * 64; }
}
constexpr int CV_FI = 176 * 32, CV_FO = 32 * 88, CV_TOTAL = 4 * CV_FI + 4 * CV_FO + 68 * 32 + 32 * 32 + 16 * 16 + 64 * 32 + 32 * 32 + 32 * 16;
__device__ __forceinline__ void cvt_range(PP p, unsigned char* lds, int t_lo, int t_hi, int rank, int n) {
    const int tid = tidx(); unsigned char* ws = p->ws; float* tile = (float*)lds;
    for (int g0 = t_lo + rank * 4; g0 < t_hi; g0 += n * 4) {
        f32x4 v[4][2];
#pragma unroll
        for (int q = 0; q < 4; ++q) { CvtT c; cvt_decode(p, ws, g0 + q, t_hi, c);
#pragma unroll
            for (int h = 0; h < 2; ++h) { const int kk = (tid >> 4) + h * 32, n4 = (tid & 15) * 4; const int ns = c.n_src0 + n4;
                v[q][h] = (f32x4){0.f, 0.f, 0.f, 0.f}; if (ns < c.Nsrc) v[q][h] = __builtin_nontemporal_load((const f32x4*)(c.src + (size_t)(c.k0 + kk) * c.ldsrc + ns)); } }
        __syncthreads();
#pragma unroll
        for (int q = 0; q < 4; ++q)
#pragma unroll
            for (int h = 0; h < 2; ++h) { const int kk = (tid >> 4) + h * 32, n4 = (tid & 15) * 4; float* tp = tile + q * 4160 + kk * 65 + n4; tp[0] = v[q][h][0]; tp[1] = v[q][h][1]; tp[2] = v[q][h][2]; tp[3] = v[q][h][3]; }
        __syncthreads();
#pragma unroll
        for (int q = 0; q < 4; ++q) { CvtT c; cvt_decode(p, ws, g0 + q, t_hi, c);
            if (c.dst) { const int nn = tid >> 3, k8 = (tid & 7) * 8; f32x4 a, b2; const float* tp = tile + q * 4160;
#pragma unroll
                for (int j = 0; j < 4; ++j) { a[j] = tp[(k8 + j) * 65 + nn]; b2[j] = tp[(k8 + 4 + j) * 65 + nn]; }
                const int n_ = c.n_dst0 + nn; bf16_t* dp = c.blk ? c.dst + ((size_t)((n_ >> 8) * (c.K >> 6) + (c.k0 >> 6)) * 256 + (n_ & 255)) * 64 + k8 : c.dst + (size_t)n_ * c.K + c.k0 + k8;
                *(bf16x8*)dp = pack8(a, b2); } }
    }
}
__device__ __forceinline__ void mod_items(PP p, unsigned char* lds, int it_lo, int it_hi, int rank, int n) {
    const int tid = tidx(); unsigned char* ws = p->ws;
    float* sc = (float*)lds;
    __syncthreads();
    for (int i = tid; i < 3 * 2048; i += 512) { const int ci = i >> 11, k = i & 2047; const float v = ci == 0 ? p->in[I_CCTX][k] : p->in[I_C][(ci - 1) * 2048 + k]; sc[i] = siluf_(v); }
    __syncthreads();
    float* MOD = (float*)(ws + WS_MOD);
    for (int it = it_lo + rank; it < it_hi; it += n) { const int l = it / 288, r = it % 288, chunk = r / 32, ks = r % 32; const int col = chunk * 2048 + tid * 4;
        const float* W = p->in[I_ADAW] + (size_t)l * 2048 * 18432 + (size_t)(ks * 64) * 18432 + col;
        f32x4 a0 = (f32x4){0.f, 0.f, 0.f, 0.f}, a1 = a0, a2 = a0;
#pragma unroll 8
        for (int k = 0; k < 64; ++k) { const f32x4 w = __builtin_nontemporal_load((const f32x4*)(W + (size_t)k * 18432)); const int kk = ks * 64 + k; a0 += w * sc[kk]; a1 += w * sc[2048 + kk]; a2 += w * sc[4096 + kk]; }
        if (ks == 0) { const f32x4 bb = *(const f32x4*)(p->in[I_ADAB] + (size_t)l * 18432 + col); a0 += bb; a1 += bb; a2 += bb; }
        float* m0 = MOD + (size_t)(l * 3) * 18432 + col;
#pragma unroll
        for (int e = 0; e < 4; ++e) { atomicAdd(m0 + e, a0[e]); atomicAdd(m0 + 18432 + e, a1[e]); atomicAdd(m0 + 2 * 18432 + e, a2[e]); } }
    __syncthreads();
}
__device__ void phase_prep(PP p, LAS unsigned char* ldsr, int skip_mod) {
    unsigned char* lds = (unsigned char*)ldsr;
    const int tid = tidx(), bid = bidx(), nb = gdim();
    unsigned char* ws = p->ws;
    if (!skip_mod) mod_items(p, lds, 0, 288, bid, nb);
    cvt_range(p, lds, 0, CV_FI, bid, nb);
}
__device__ void bg_convert(PP p, LAS unsigned char* ldsr, int ph) {
    unsigned char* lds = (unsigned char*)ldsr; const int bid = bidx();
    constexpr int S0 = 4 * CV_FI + 4 * CV_FO, S_EI = S0, S_EO = S_EI + 2176, S_OI = S_EO + 1024 + 256, S_OO = S_OI + 2048;
    __syncthreads();
    if (ph == 2) { if (bid >= 32) { cvt_range(p, lds, 4 * CV_FI, 4 * CV_FI + CV_FO, bid - 32, 224); cvt_range(p, lds, S_EI, S_EO, bid - 32, 224); } }
    else if (ph == 3) { if (bid >= 192) cvt_range(p, lds, CV_FI, 2 * CV_FI, bid - 192, 64); }
    else if (ph == 5) { if (bid >= 152) cvt_range(p, lds, S_EO, S_OO, bid - 152, 104); }
    else if (ph == 8) { if (bid >= 96) cvt_range(p, lds, 4 * CV_FI + CV_FO, 4 * CV_FI + 2 * CV_FO, bid - 96, 160); }
    else if (ph == 9) { if (bid >= 192) cvt_range(p, lds, S_OO, CV_TOTAL, bid - 192, 64); }
    else if (ph == 11) { if (bid >= 32) cvt_range(p, lds, 2 * CV_FI, 3 * CV_FI, bid - 32, 224); }
    else if (ph == 12) { if (bid >= 192) { mod_items(p, lds, 288, 448, bid - 192, 64); cvt_range(p, lds, 4 * CV_FI + 2 * CV_FO, 4 * CV_FI + 3 * CV_FO, bid - 192, 64); } }
    else if (ph == 14) { if (bid >= 32) cvt_range(p, lds, 3 * CV_FI, 4 * CV_FI, bid - 32, 224); }
    else if (ph == 15) { if (bid >= 192) { cvt_range(p, lds, 4 * CV_FI + 3 * CV_FO, 4 * CV_FI + 4 * CV_FO, bid - 192, 64); mod_items(p, lds, 448, 576, bid - 192, 64); } }
}

__device__ void phase_norm(PP p, int l, int j  ) {
    const int tid = tidx(), lane = tid & 63, wid = tid >> 6; const int gw = bidx() * 8 + wid, nw = gdim() * 8;
    const float* X = (const float*)(p->ws + WS_X); bf16_t* HM = (bf16_t*)(p->ws + WS_HM);
    const float* g = j < 0 ? p->in[I_FNG] : p->in[I_NORMG] + (size_t)(l * 3 + j) * D;
    const bool from_in = (l == 0 && j == 0);
    for (int r = gw; r < MTOK; r += nw) {
        const float* xr = from_in ? (r < TCTX ? p->in[I_XP] + (size_t)r * D : p->in[I_XS] + (size_t)(r - TCTX) * D) : X + (size_t)r * D; f32x4 v[8]; float ss = 0.f;
#pragma unroll
        for (int i = 0; i < 8; ++i) { v[i] = *(const f32x4*)(xr + lane * 4 + i * 256); ss += v[i][0] * v[i][0] + v[i][1] * v[i][1] + v[i][2] * v[i][2] + v[i][3] * v[i][3]; }
#pragma unroll
        for (int o = 32; o >= 1; o >>= 1) ss += __shfl_xor(ss, o);
        const float rinv = rsqrtf(ss * (1.f / D) + EPS);
        if (j < 0) { float* o = p->out + OUT_Y + (size_t)r * D;
#pragma unroll
            for (int i = 0; i < 8; ++i) { const int c = lane * 4 + i * 256; const f32x4 gg = *(const f32x4*)(g + c); *(f32x4*)(o + c) = v[i] * rinv * gg; } }
        else { const float* mod = (const float*)(p->ws + WS_MOD) + (size_t)(l * 3 + cond_of_row(r)) * 18432; const float* sh = mod + (3 * j) * 2048; const float* scl = mod + (3 * j + 1) * 2048;
#pragma unroll
            for (int i = 0; i < 8; ++i) { const int c = lane * 4 + i * 256; const f32x4 gg = *(const f32x4*)(g + c), s1 = *(const f32x4*)(scl + c), s0 = *(const f32x4*)(sh + c);
                const f32x4 y = (v[i] * rinv * gg) * (s1 + 1.f) + s0; uint2 pk; pk.x = cvt_pk_bf16(y[0], y[1]); pk.y = cvt_pk_bf16(y[2], y[3]); *(uint2*)(HM + (size_t)r * D + c) = pk; } }
    }
}

__device__ __forceinline__ void seq_info(int s, int& L, int& row0) { if (s < 16) { L = 256; row0 = s * 256; } else { L = 1024; row0 = TCTX + (s - 16) * 1024; } }

#define WAVE_LDS_SYNC() asm volatile("s_waitcnt lgkmcnt(0)" ::: "memory")
__device__ __forceinline__ void s5_item(PP p, unsigned char* lds, int s, int d, int gg) {
    const int tid = tidx(), lane = tid & 63, wid = tid >> 6, fr = lane & 15, fq = lane >> 4; const int g = gg * 8 + wid;
    int L, row0; seq_info(s, L, row0);
    float* HS = (float*)(lds + wid * 8448);
    const bf16_t* PROJ = (const bf16_t*)(p->ws + WS_PROJ); float* Y = (float*)(p->ws + WS_YS5) + (size_t)d * MTOK * 1024;
    const int pg0 = (d * 64 + g) * 64, pg = pg0 + lane;
    const float lre = p->in[I_LAMRE][pg], lim = p->in[I_LAMIM][pg], dt = expf(p->in[I_LOGSTEP][d * 64 + g]);
    const float mag = expf(lre * dt); float sn, cs; sincosf(lim * dt, &sn, &cs);
    const float abr = mag * cs, abi = mag * sn, den = lre * lre + lim * lim, nre = abr - 1.f;
    const float fre = (nre * lre + abi * lim) / den, fim = (abi * lre - nre * lim) / den;
    bf16x8 af[8];
#pragma unroll
    for (int tq = 0; tq < 4; ++tq) { const int src = tq * 16 + fr; const float f_r = __shfl(fre, src), f_i = __shfl(fim, src);
        f32x4 r0 = (f32x4){0.f, 0.f, 0.f, 0.f}, r1 = r0, i0 = r0, i1 = r0;
        if (fq < 2) { const float* br = p->in[I_BRE] + (size_t)(pg0 + src) * 16 + fq * 8; const float* bi = p->in[I_BIM] + (size_t)(pg0 + src) * 16 + fq * 8;
            r0 = *(const f32x4*)br; r1 = *(const f32x4*)(br + 4); i0 = *(const f32x4*)bi; i1 = *(const f32x4*)(bi + 4); }
        af[tq] = pack8(r0 * f_r - i0 * f_i, r1 * f_r - i1 * f_i); af[tq + 4] = pack8(i0 * f_r + r0 * f_i, i1 * f_r + r1 * f_i); }
    bf16x8 cf[4];
#pragma unroll
    for (int kk = 0; kk < 4; ++kk) { const float* cp = (kk < 2 ? p->in[I_CRE] : p->in[I_CIM]) + ((size_t)(d * 64 + g) * 16 + fr) * 64 + (kk & 1) * 32 + fq * 8;
        f32x4 a = *(const f32x4*)cp, b = *(const f32x4*)(cp + 4); if (kk >= 2) { a = -a; b = -b; } cf[kk] = pack8(a, b); }
    float hr = 0.f, hi = 0.f;
    if (s >= 16) { const size_t o = ((size_t)((s - 16) * 2 + d) * 64 + g) * 64 + lane; hr = p->in[I_S5RE][o]; hi = p->in[I_S5IM][o]; }
    const f32x4 z4 = (f32x4){0.f, 0.f, 0.f, 0.f};
    bf16x8 un = (bf16x8){0, 0, 0, 0, 0, 0, 0, 0};
#define S5_LOADU(c0_) do { if (fq < 2) { const int row_ = row0 + (d ? L - 1 - ((c0_) + fr) : (c0_) + fr); un = *(const bf16x8*)(PROJ + (size_t)row_ * EVINP + g * 16 + fq * 8); } } while (0)
    S5_LOADU(0);
    __syncthreads();
    for (int c0 = 0; c0 < L; c0 += 16) {
        const bf16x8 ub = un;
        if (c0 + 16 < L) S5_LOADU(c0 + 16);
#pragma unroll
        for (int t8 = 0; t8 < 8; ++t8) { const f32x4 bu = __builtin_amdgcn_mfma_f32_16x16x32_bf16(af[t8], ub, z4, 0, 0, 0); *(f32x4*)(HS + fr * 132 + t8 * 16 + fq * 4) = bu; }
        WAVE_LDS_SYNC();
#pragma unroll
        for (int i = 0; i < 16; ++i) { const float bur = HS[i * 132 + lane], bui = HS[i * 132 + 64 + lane];
            const float nr = abr * hr - abi * hi + bur, ni = abr * hi + abi * hr + bui; hr = nr; hi = ni;
            HS[i * 132 + lane] = hr; HS[i * 132 + 64 + lane] = hi; }
        WAVE_LDS_SYNC();
        { f32x4 acc = z4;
#pragma unroll
          for (int kk = 0; kk < 4; ++kk) { const float* hp = HS + fr * 132 + kk * 32 + fq * 8; const bf16x8 hb = pack8(*(const f32x4*)hp, *(const f32x4*)(hp + 4));
              acc = __builtin_amdgcn_mfma_f32_16x16x32_bf16(cf[kk], hb, acc, 0, 0, 0); }
          const int row = row0 + (d ? L - 1 - (c0 + fr) : c0 + fr);
          *(f32x4*)(Y + (size_t)row * 1024 + g * 16 + fq * 4) = acc; }
        WAVE_LDS_SYNC();
    }
#undef S5_LOADU
    if (s < 16) { const size_t o = ((size_t)(s * 2 + d) * 64 + g) * 64 + lane; p->out[OUT_S5RE + o] = hr; p->out[OUT_S5IM + o] = hi; }
}

template <int NK32> __device__ __forceinline__ f32x4 mma_lds(f32x4 acc, const bf16_t* X, int ldx, const bf16_t* Y, int ldy, int lane) {
    const bf16_t* xp = X + (lane & 15) * ldx + (lane >> 4) * 8; const bf16_t* yp = Y + (lane & 15) * ldy + (lane >> 4) * 8;
#pragma unroll
    for (int kk = 0; kk < NK32; ++kk) acc = __builtin_amdgcn_mfma_f32_16x16x32_bf16(*(const bf16x8*)(xp + kk * 32), *(const bf16x8*)(yp + kk * 32), acc, 0, 0, 0);
    return acc;
}

__device__ __forceinline__ void gla_item(PP p, unsigned char* lds, int s, int h, int d, int vh) {
    const int tid = tidx(), lane = tid & 63, wid = tid >> 6, fr = lane & 15, fq = lane >> 4;
    int L, row0; seq_info(s, L, row0);
    bf16_t* QT = (bf16_t*)(lds);
    bf16_t* KT = (bf16_t*)(lds + 17408);
    bf16_t* KE = (bf16_t*)(lds + 34816);
    bf16_t* VT = (bf16_t*)(lds + 53248);
    bf16_t* ATT = (bf16_t*)(lds + 71680);
    bf16_t* ST = (bf16_t*)(lds + 80896);
    float* LOGA = (float*)(lds + 80896);
    float* SEG = (float*)(lds + 115712);
    float* GLR = (float*)(lds + 117760);
    float* W2S = (float*)(lds + 121856);
    float* GBS = (float*)(lds + 130048);
    float* DEC = (float*)(lds + 130560);
    const bf16_t* PROJ = (const bf16_t*)(p->ws + WS_PROJ); float* O = (float*)(p->ws + WS_OGLA) + (size_t)d * MTOK * 1024;
    __syncthreads();
    for (int i = tid; i < 16 * 128; i += 512) W2S[i] = p->in[I_GW2][(size_t)(d * 16 + (i >> 7)) * 512 + h * 128 + (i & 127)];
    if (tid < 128) GBS[tid] = p->in[I_GB][d * 512 + h * 128 + tid];
    f32x4 sacc[8];
#pragma unroll
    for (int tn = 0; tn < 8; ++tn) { sacc[tn] = (f32x4){0.f, 0.f, 0.f, 0.f};
        if (s >= 16) { const float* sp = p->in[I_SGLA] + ((size_t)(((s - 16) * 2 + d) * 4 + h) * 128 + wid * 16 + fq * 4) * 256 + vh * 128 + tn * 16 + fr;
#pragma unroll
            for (int e = 0; e < 4; ++e) sacc[tn][e] = sp[(size_t)e * 256]; } }
    const float qscale = 0.08838834764831845f;
    const int nch = L >> 6;
    const int c = tid & 127, ig = tid >> 7;
#define GROW(n_, i) (row0 + (d ? L - 1 - ((n_) * 64 + (i)) : (n_) * 64 + (i)))
    f32x4 glr4 = (f32x4){0.f, 0.f, 0.f, 0.f}; float qv[16], kv[16], vv[16];
#define GLA_PREFETCH(n_) do { \
        if (tid < 256) glr4 = unpack4(*(const uint2*)(PROJ + (size_t)GROW(n_, tid >> 2) * EVINP + 4096 + d * 16 + (tid & 3) * 4)); \
        _Pragma("unroll") for (int ii = 0; ii < 16; ++ii) { const size_t ro = (size_t)GROW(n_, ig * 16 + ii) * EVINP; \
            qv[ii] = bf2f_(PROJ[ro + 1024 + h * 128 + c]); kv[ii] = bf2f_(PROJ[ro + 1536 + h * 128 + c]); vv[ii] = bf2f_(PROJ[ro + 2048 + h * 256 + vh * 128 + c]); } } while (0)
    GLA_PREFETCH(0);
    for (int n = 0; n < nch; ++n) {
        __syncthreads();
        if (tid < 256) *(f32x4*)(GLR + (tid >> 2) * 16 + (tid & 3) * 4) = glr4;
        __syncthreads();
        { float run = 0.f; const float gb = GBS[c];
          float w2[16];
#pragma unroll
          for (int r = 0; r < 16; ++r) w2[r] = W2S[r * 128 + c];
          for (int ii = 0; ii < 16; ++ii) { const int i = ig * 16 + ii; float z = gb;
#pragma unroll
              for (int q = 0; q < 4; ++q) { const f32x4 g4 = *(const f32x4*)(GLR + i * 16 + q * 4);
#pragma unroll
                  for (int e = 0; e < 4; ++e) z += g4[e] * w2[q * 4 + e]; }
              run -= (fmaxf(-z, 0.f) + __logf(1.f + __expf(-fabsf(z)))) * (1.f / 16.f); LOGA[i * 128 + c] = run; }
          SEG[ig * 128 + c] = run; }
        __syncthreads();
        { float pre = 0.f, tot = 0.f;
#pragma unroll
          for (int q = 0; q < 4; ++q) { const float sg = SEG[q * 128 + c]; tot += sg; if (q < ig) pre += sg; }
          if (ig == 0) DEC[c] = __expf(tot);
#pragma unroll
          for (int ii = 0; ii < 16; ++ii) { const int i = ig * 16 + ii; const float bc = LOGA[i * 128 + c] + pre;
              QT[i * 136 + c] = f2bf(qv[ii] * qscale * __expf(bc)); KT[i * 136 + c] = f2bf(kv[ii] * __expf(-bc)); KE[c * 72 + i] = f2bf(kv[ii] * __expf(tot - bc)); VT[c * 72 + i] = f2bf(vv[ii]); } }
        __syncthreads();
        if (n + 1 < nch) GLA_PREFETCH(n + 1);
#pragma unroll
        for (int q = 0; q < 2; ++q) { const int tile = wid * 2 + q, ti = tile >> 2, tj = tile & 3; f32x4 a = (f32x4){0.f, 0.f, 0.f, 0.f};
            if (tj <= ti) a = mma_lds<4>(a, QT + ti * 16 * 136, 136, KT + tj * 16 * 136, 136, lane);
#pragma unroll
            for (int e = 0; e < 4; ++e) { const int i = ti * 16 + fq * 4 + e, jx = tj * 16 + fr; ATT[i * 72 + jx] = f2bf(jx <= i ? a[e] : 0.f); } }
#pragma unroll
        for (int tn = 0; tn < 8; ++tn) { uint2 pk; pk.x = cvt_pk_bf16(sacc[tn][0], sacc[tn][1]); pk.y = cvt_pk_bf16(sacc[tn][2], sacc[tn][3]); *(uint2*)(ST + (tn * 16 + fr) * 136 + wid * 16 + fq * 4) = pk; }
        __syncthreads();
#pragma unroll
        for (int ti = 0; ti < 4; ++ti) { f32x4 o = (f32x4){0.f, 0.f, 0.f, 0.f};
            o = mma_lds<2>(o, ATT + ti * 16 * 72, 72, VT + wid * 16 * 72, 72, lane);
            o = mma_lds<4>(o, QT + ti * 16 * 136, 136, ST + wid * 16 * 136, 136, lane);
#pragma unroll
            for (int e = 0; e < 4; ++e) { const int i = ti * 16 + fq * 4 + e; O[(size_t)GROW(n, i) * 1024 + h * 256 + vh * 128 + wid * 16 + fr] = o[e]; } }
        { f32x4 dc;
#pragma unroll
          for (int e = 0; e < 4; ++e) dc[e] = DEC[wid * 16 + fq * 4 + e];
#pragma unroll
          for (int tn = 0; tn < 8; ++tn) { sacc[tn] = sacc[tn] * dc; sacc[tn] = mma_lds<2>(sacc[tn], KE + wid * 16 * 72, 72, VT + tn * 16 * 72, 72, lane); } }
    }
#undef GROW
#undef GLA_PREFETCH
    if (s < 16) {
#pragma unroll
        for (int tn = 0; tn < 8; ++tn) { float* sp = p->out + OUT_GLA + ((size_t)((s * 2 + d) * 4 + h) * 128 + wid * 16 + fq * 4) * 256 + vh * 128 + tn * 16 + fr;
#pragma unroll
            for (int e = 0; e < 4; ++e) sp[(size_t)e * 256] = sacc[tn][e]; } }
}

__device__ void phase_s5gla(PP p, LAS unsigned char* ldsr) {
    unsigned char* lds = (unsigned char*)ldsr; const int bid = bidx(), nb = gdim();
    if (nb >= 64) {
        if (bid < 32) { gla_item(p, lds, 16 + (bid >> 4), (bid >> 2) & 3, (bid >> 1) & 1, bid & 1); return; }
        for (int it = bid - 32; it < 544; it += nb - 32) {
            if (it < 32) s5_item(p, lds, 16 + (it >> 4), (it >> 3) & 1, it & 7);
            else if (it < 288) { const int q = it - 32; s5_item(p, lds, q >> 4, (q >> 3) & 1, q & 7); }
            else { const int q = it - 288; gla_item(p, lds, q >> 4, (q >> 2) & 3, (q >> 1) & 1, q & 1); }
        }
    } else {
        for (int it = bid; it < 576; it += nb) {
            if (it < 32) { gla_item(p, lds, 16 + (it >> 4), (it >> 2) & 3, (it >> 1) & 1, it & 1); }
            else if (it < 64) { const int q = it - 32; s5_item(p, lds, 16 + (q >> 4), (q >> 3) & 1, q & 7); }
            else if (it < 320) { const int q = it - 64; s5_item(p, lds, q >> 4, (q >> 3) & 1, q & 7); }
            else { const int q = it - 320; gla_item(p, lds, q >> 4, (q >> 2) & 3, (q >> 1) & 1, q & 1); }
        }
    }
}

__device__ void phase_evpost(PP p) {
    const int tid = tidx(), lane = tid & 63, wid = tid >> 6; const int gw = bidx() * 8 + wid, nw = gdim() * 8;
    const bf16_t* PROJ = (const bf16_t*)(p->ws + WS_PROJ); const float* Y0 = (const float*)(p->ws + WS_YS5); const float* Y1 = Y0 + (size_t)MTOK * 1024;
    const float* O0 = (const float*)(p->ws + WS_OGLA); const float* O1 = O0 + (size_t)MTOK * 1024;
    bf16_t* YSB = (bf16_t*)(p->ws + WS_YSB); bf16_t* CAT = (bf16_t*)(p->ws + WS_CAT);
    for (int r = gw; r < MTOK; r += nw) {
#pragma unroll
        for (int i = 0; i < 4; ++i) { const int c = lane * 4 + i * 256; const f32x4 y0 = *(const f32x4*)(Y0 + (size_t)r * 1024 + c), y1 = *(const f32x4*)(Y1 + (size_t)r * 1024 + c);
            const f32x4 u = unpack4(*(const uint2*)(PROJ + (size_t)r * EVINP + c)), dd = *(const f32x4*)(p->in[I_S5D] + c); f32x4 v = y0 + y1 + dd * u;
#pragma unroll
            for (int e = 0; e < 4; ++e) v[e] = geluf_(v[e]);
            uint2 pk; pk.x = cvt_pk_bf16(v[0], v[1]); pk.y = cvt_pk_bf16(v[2], v[3]); *(uint2*)(YSB + (size_t)r * 1024 + c) = pk; }
        { const int c0 = lane * 16; f32x4 o[4]; float ss = 0.f;
#pragma unroll
          for (int i = 0; i < 4; ++i) { o[i] = *(const f32x4*)(O0 + (size_t)r * 1024 + c0 + i * 4) + *(const f32x4*)(O1 + (size_t)r * 1024 + c0 + i * 4); ss += o[i][0] * o[i][0] + o[i][1] * o[i][1] + o[i][2] * o[i][2] + o[i][3] * o[i][3]; }
#pragma unroll
          for (int m = 8; m >= 1; m >>= 1) ss += __shfl_xor(ss, m);
          const float rinv = rsqrtf(ss * (1.f / 256.f) + EPS);
#pragma unroll
          for (int i = 0; i < 4; ++i) { const int c = c0 + i * 4; const f32x4 ng = *(const f32x4*)(p->in[I_GNG] + (c & 255)), gt = unpack4(*(const uint2*)(PROJ + (size_t)r * EVINP + 3072 + c)); f32x4 v;
#pragma unroll
              for (int e = 0; e < 4; ++e) v[e] = o[i][e] * rinv * ng[e] * siluf_(gt[e]);
              uint2 pk; pk.x = cvt_pk_bf16(v[0], v[1]); pk.y = cvt_pk_bf16(v[2], v[3]); *(uint2*)(CAT + (size_t)r * D + 1024 + c) = pk; } }
    }
}

__device__ void phase_conv(PP p) {
    const bf16_t* PROJ = (const bf16_t*)(p->ws + WS_PROJ); bf16_t* XCB = (bf16_t*)(p->ws + WS_XCB);
    const float* cw = p->in[I_CONVW]; const float* cb = p->in[I_CONVB];
    const size_t total = (size_t)MTOK * 512;
    { const int gi = bidx() * 512 + tidx(); if (gi < 2 * D) ((float*)(p->ws + WS_SP))[gi] = -8.f * softplusf_(-p->in[I_LLAM][gi]); }
    for (size_t i = (size_t)bidx() * 512 + tidx(); i < total; i += (size_t)gdim() * 512) {
        const int r = (int)(i >> 9), c = (int)(i & 511) * 4; const int seg = r < TCTX ? 256 : 64; const int pos = r & (seg - 1);
        f32x4 acc = *(const f32x4*)(cb + c);
#pragma unroll
        for (int j = 0; j < 4; ++j) { const int pp = pos + j - 2; if (pp >= 0 && pp < seg) acc += *(const f32x4*)(cw + j * D + c) * unpack4(*(const uint2*)(PROJ + (size_t)(r + j - 2) * 4096 + 2048 + c)); }
        uint2 pk; pk.x = cvt_pk_bf16(acc[0], acc[1]); pk.y = cvt_pk_bf16(acc[2], acc[3]); *(uint2*)(XCB + (size_t)r * D + c) = pk;
    }
}
__device__ void phase_lruscan1(PP p) {
    const int tid = tidx(), lane = tid & 63, wid = tid >> 6; const int nb = gdim();
    float* SUM = (float*)(p->ws + WS_LSUM);
    for (int it = bidx() * 8 + wid; it < 384 * 64; it += 8 * nb) {
        const int q = it >> 6, d = (it >> 5) & 1, c = (it & 31) * 64 + lane; const int row0 = q * 16;
        const unsigned* LAB = (const unsigned*)(p->ws + WS_LA) + ((size_t)d * MTOK + row0) * D + c;
        unsigned wv[16];
#pragma unroll
        for (int j = 0; j < 16; ++j) wv[j] = LAB[(size_t)j * D];
        float S = 0.f, h = 0.f;
        if (d == 0) {
#pragma unroll
            for (int j = 0; j < 16; ++j) { const float la = lo_bf(wv[j]); h = __expf(la) * h + hi_bf(wv[j]); S += la; } }
        else {
#pragma unroll
            for (int j = 15; j >= 0; --j) { const float la = lo_bf(wv[j]); h = __expf(la) * h + hi_bf(wv[j]); S += la; } }
        SUM[((size_t)d * 384 + q) * D + c] = __expf(S); SUM[((size_t)(2 + d) * 384 + q) * D + c] = h;
    }
}
__device__ void conv_tile(PP p, int pm, int pnx) {
    const int tid = tidx();
    const bf16_t* PROJ = (const bf16_t*)(p->ws + WS_PROJ); bf16_t* XCB = (bf16_t*)(p->ws + WS_XCB); const float* cw = p->in[I_CONVW]; const float* cb = p->in[I_CONVB];
    const int c = pnx * 256 + (tid & 63) * 4; const int rl0 = tid >> 6;
    f32x4 w[4]; const f32x4 bias = *(const f32x4*)(cb + c);
#pragma unroll
    for (int j = 0; j < 4; ++j) w[j] = *(const f32x4*)(cw + j * D + c);
    for (int kb = 0; kb < 32; kb += 4) {
        uint2 t[4][4];
#pragma unroll
        for (int u = 0; u < 4; ++u) { const int r = pm * 256 + rl0 + 8 * (kb + u); const int seg = r < TCTX ? 256 : 64; const int pos = r & (seg - 1);
#pragma unroll
            for (int j = 0; j < 4; ++j) { const int pp = pos + j - 2; t[u][j] = (uint2){0u, 0u}; if (pp >= 0 && pp < seg) t[u][j] = *(const uint2*)(PROJ + (size_t)(r + j - 2) * 4096 + 2048 + c); } }
#pragma unroll
        for (int u = 0; u < 4; ++u) { const int r = pm * 256 + rl0 + 8 * (kb + u); f32x4 acc = bias;
#pragma unroll
            for (int j = 0; j < 4; ++j) acc += w[j] * unpack4(t[u][j]);
            uint2 pk; pk.x = cvt_pk_bf16(acc[0], acc[1]); pk.y = cvt_pk_bf16(acc[2], acc[3]); *(uint2*)(XCB + (size_t)r * D + c) = pk; } }
}
__device__ void scan1_tile(PP p, int pm, int pn) {
    const int tid = tidx(); const int d = pn >> 4, chu = ((pn >> 1) & 7) * 256 + (pn & 1) * 128; float* SUM = (float*)(p->ws + WS_LSUM);
    const int c = chu + (tid & 127);
    unsigned wv[4][16];
#pragma unroll
    for (int k = 0; k < 4; ++k) { const int q = pm * 16 + (tid >> 7) + 4 * k; const unsigned* LAB = (const unsigned*)(p->ws + WS_LA) + ((size_t)d * MTOK + q * 16) * D + c;
#pragma unroll
        for (int j = 0; j < 16; ++j) wv[k][j] = LAB[(size_t)j * D]; }
#pragma unroll
    for (int k = 0; k < 4; ++k) { const int q = pm * 16 + (tid >> 7) + 4 * k; float S = 0.f, h = 0.f;
        if (d == 0) {
#pragma unroll
            for (int j = 0; j < 16; ++j) { const float la = lo_bf(wv[k][j]); h = __expf(la) * h + hi_bf(wv[k][j]); S += la; } }
        else {
#pragma unroll
            for (int j = 15; j >= 0; --j) { const float la = lo_bf(wv[k][j]); h = __expf(la) * h + hi_bf(wv[k][j]); S += la; } }
        SUM[((size_t)d * 384 + q) * D + c] = __expf(S); SUM[((size_t)(2 + d) * 384 + q) * D + c] = h; }
}
__device__ void phase_lruscan2(PP p) {
    const int tid = tidx(), lane = tid & 63, wid = tid >> 6; const int nb = gdim();
    const float* SUM = (const float*)(p->ws + WS_LSUM); const bf16_t* PROJ = (const bf16_t*)(p->ws + WS_PROJ); bf16_t* CAT = (bf16_t*)(p->ws + WS_CAT);
    for (int it0 = bidx() * 8 + wid; it0 < 384 * 32; it0 += 8 * nb) {
        const int it = it0 < 128 * 32 ? it0 + 256 * 32 : it0 - 128 * 32;
        const int q = it >> 5, c = (it & 31) * 64 + lane; const int row0 = q * 16;
        int qs, ql, s; if (q < 256) { s = q >> 4; qs = s * 16; ql = qs + 15; } else { s = 16 + ((q - 256) >> 6); qs = 256 + (s - 16) * 64; ql = qs + 63; }
        float h0 = 0.f, h1 = 0.f;
        if (s >= 16) { h0 = p->in[I_SLRU][(size_t)((s - 16) * 2 + 0) * D + c]; h1 = p->in[I_SLRU][(size_t)((s - 16) * 2 + 1) * D + c]; }
        const float* P0 = SUM + c; const float* H0 = SUM + (size_t)2 * 384 * D + c; const float* P1 = SUM + (size_t)384 * D + c; const float* H1 = SUM + (size_t)3 * 384 * D + c;
        { int j = qs;
          for (; j + 8 <= q; j += 8) { float pv[8], hv[8];
#pragma unroll
              for (int e = 0; e < 8; ++e) { pv[e] = P0[(size_t)(j + e) * D]; hv[e] = H0[(size_t)(j + e) * D]; }
#pragma unroll
              for (int e = 0; e < 8; ++e) h0 = pv[e] * h0 + hv[e]; }
          for (; j < q; ++j) h0 = P0[(size_t)j * D] * h0 + H0[(size_t)j * D]; }
        { int j = ql;
          for (; j - 8 >= q; j -= 8) { float pv[8], hv[8];
#pragma unroll
              for (int e = 0; e < 8; ++e) { pv[e] = P1[(size_t)(j - e) * D]; hv[e] = H1[(size_t)(j - e) * D]; }
#pragma unroll
              for (int e = 0; e < 8; ++e) h1 = pv[e] * h1 + hv[e]; }
          for (; j > q; --j) h1 = P1[(size_t)j * D] * h1 + H1[(size_t)j * D]; }
        const unsigned* W0 = (const unsigned*)(p->ws + WS_LA) + (size_t)row0 * D + c; const unsigned* W1 = W0 + (size_t)MTOK * D; const bf16_t* GT = PROJ + (size_t)row0 * 4096 + c;
        unsigned w0[16], w1[16]; float b0[16], gt[16];
#pragma unroll
        for (int j = 0; j < 16; ++j) { w0[j] = W0[(size_t)j * D]; w1[j] = W1[(size_t)j * D]; gt[j] = bf2f_(GT[(size_t)j * 4096]); }
#pragma unroll
        for (int j = 0; j < 16; ++j) { h0 = __expf(lo_bf(w0[j])) * h0 + hi_bf(w0[j]); b0[j] = h0; }
#pragma unroll
        for (int j = 15; j >= 0; --j) { h1 = __expf(lo_bf(w1[j])) * h1 + hi_bf(w1[j]); CAT[(size_t)(row0 + j) * D + c] = f2bf((b0[j] + h1) * geluf_(gt[j])); }
        if (s < 16) { if (q == ql) p->out[OUT_LRU + (size_t)(s * 2 + 0) * D + c] = h0; if (q == qs) p->out[OUT_LRU + (size_t)(s * 2 + 1) * D + c] = h1; }
    }
}

#ifndef PHMASK
#define PHMASK 0xFFFFFFFFu
#endif
#define PHON(k) ((PHMASK >> (k)) & 1u)
#ifndef DUPMASK
#define DUPMASK 0u
#endif
enum { K_PREP = 0, K_NORM, K_SWIGLU, K_RESID, K_F32, K_S5GLA, K_EVPOST, K_GLU, K_CONV, K_LRUG, K_LRUSCAN, K_LRUCOMB };
__global__ void __launch_bounds__(512, 2) mega(Params p) {
    extern __shared__ __attribute__((aligned(16))) unsigned char shm[];
    LAS unsigned char* lds = (LAS unsigned char*)shm;
    cg::grid_group grid = cg::this_grid();
    const int ph_lo = p.ph_lo, ph_hi = p.ph_hi;
    int rep = 0;
    volatile LAS unsigned* bst = (volatile LAS unsigned*)(lds + LDS_MAIN);
    if (threadIdx.x < 16) bst[threadIdx.x] = 0u;
    __syncthreads();
    XcdBarrier xbar = xcd_barrier_post((unsigned*)(p.ws + WS_BAR), bst);
    for (int ph = ph_lo; ph < ph_hi; ++ph) {
        PP pp = get_pp();
        unsigned char* ws = pp->ws;
        const float* MOD = (const float*)(ws + WS_MOD);
        int kind, l = 0, a0 = 0;
        if (ph == 0) kind = K_PREP;
        else if (ph == 24) { kind = K_NORM; a0 = -1; }
        else { l = ph > 12 ? 1 : 0; const int q = ph - 1 - 12 * l;
            if (q == 0) { kind = K_NORM; a0 = 0; }
            else if (q == 1) { kind = K_SWIGLU; a0 = 0; }
            else if (q == 2) { kind = K_RESID; a0 = 0; }
            else if (q == 3) { kind = K_NORM; a0 = 1; }
            else if (q == 4) kind = K_F32;
            else if (l == 0) { if (q == 5) kind = K_S5GLA; else if (q == 6) kind = K_EVPOST; else if (q == 7) kind = K_GLU; else if (q == 8) { kind = K_RESID; a0 = 2; } else if (q == 9) { kind = K_NORM; a0 = 2; } else if (q == 10) { kind = K_SWIGLU; a0 = 1; } else { kind = K_RESID; a0 = 1; } }
            else { if (q == 5) kind = K_LRUG; else if (q == 6) kind = K_LRUCOMB; else if (q == 7) { kind = K_RESID; a0 = 2; } else if (q == 8) { kind = K_NORM; a0 = 2; } else if (q == 9) { kind = K_SWIGLU; a0 = 1; } else { kind = K_RESID; a0 = 1; } }
        }
        const bf16_t* HM = (const bf16_t*)(ws + WS_HM);
        if (kind == K_PREP) { if (PHON(0)) phase_prep(pp, lds, rep); }
        else if (kind == K_NORM) { if (PHON(1)) phase_norm(pp, l, a0); }
        else if (kind == K_SWIGLU) { if (PHON(2)) { EpiSwiglu E{(bf16_t*)(ws + WS_H)}; pg8::gemm_phase<EpiSwiglu, false>(lds, HM, D, (const bf16_t*)(ws + WS_WFI) + (size_t)(l * 2 + a0) * 11264 * 2048, D, 24, 44, D, E); if (!rep) bg_convert(pp, lds, ph); } }
        else if (kind == K_RESID) { if (PHON(3)) {
            const bf16_t* A; const bf16_t* B; int K; int gj; float coef;
            if (a0 < 2) { A = (const bf16_t*)(ws + WS_H); B = (const bf16_t*)(ws + WS_WFO) + (size_t)(l * 2 + a0) * 2048 * 5632; K = DFF; gj = a0 == 0 ? 2 : 8; coef = 0.5f; }
            else { A = (const bf16_t*)(ws + WS_CAT); B = (const bf16_t*)(ws + (l == 0 ? WS_WEO : WS_WOO)); K = D; gj = 5; coef = 1.0f; }
            const bool first = (ph == 3);
            const float* xc_ = first ? pp->in[I_XP] : (const float*)(ws + WS_X); const float* xl_ = first ? pp->in[I_XS] - (size_t)TCTX * D : (const float*)(ws + WS_X);
            EpiResid E{(float*)(ws + WS_X), MOD + (size_t)(l * 3) * 18432 + gj * 2048, coef, xc_, xl_};
            if (a0 < 2) pg8::gemm_phase<EpiResid, false, true>(lds, A, K, B, K, 24, 8, K, E); else pg8::gemm_phase<EpiResid, false, false>(lds, A, K, B, K, 24, 8, K, E); if (!rep) bg_convert(pp, lds, ph); } }
        else if (kind == K_F32) { if (PHON(4)) {
            { const int nN = l == 0 ? 17 : 16; EpiBf16 E{(bf16_t*)(ws + WS_PROJ), nN * 256}; pg8::gemm_phase<EpiBf16, false>(lds, HM, D, (const bf16_t*)(ws + (l == 0 ? WS_WEI : WS_WOI)), D, 24, nN, D, E); }
            if (l == 1) {
                { const int gi = bidx() * 512 + tidx(); if (gi < 2 * D) ((float*)(ws + WS_SP))[gi] = -8.f * softplusf_(-pp->in[I_LLAM][gi]); }
                pg8::Order S; S.nM = 24; S.nN = 16; S.nwg = 384; S.G = gdim(); S.c = bidx(); Unit u;
                for (int i = 0; S.next(i, u); ++i) if (u.pn >= 8) conv_tile(pp, u.pm, u.pn - 8); }
            if (!rep) bg_convert(pp, lds, ph); } }
        else if (kind == K_S5GLA) { if (PHON(5)) phase_s5gla(pp, lds); }
        else if (kind == K_EVPOST) { if (PHON(6)) phase_evpost(pp); }
        else if (kind == K_GLU) { if (PHON(7)) { EpiGlu E{(bf16_t*)(ws + WS_CAT), (const bf16_t*)(ws + WS_YSB), pp->in[I_GLUB]}; pg8::gemm_phase<EpiGlu, false>(lds, (const bf16_t*)(ws + WS_YSB), 1024, (const bf16_t*)(ws + WS_WGLU), 1024, 24, 4, 1024, E); if (!rep) bg_convert(pp, lds, ph); } }
        else if (kind == K_CONV) { if (PHON(8)) phase_conv(pp); }
        else if (kind == K_LRUG) { if (PHON(9)) { EpiLru E{(unsigned*)(ws + WS_LA), (const bf16_t*)(ws + WS_XCB), pp->in[I_LBA], pp->in[I_LBX], (const float*)(ws + WS_SP)};
            int kk = 256; asm volatile("" : "+s"(kk));
            pg8::gemm_phase<EpiLru, true>(lds, (const bf16_t*)(ws + WS_XCB), D, (const bf16_t*)(ws + WS_WLRU), kk, 24, 32, kk, E);
            { pg8::Order S; S.nM = 24; S.nN = 32; S.nwg = 768; S.G = gdim(); S.c = bidx(); Unit u; for (int i = 0; S.next(i, u); ++i) scan1_tile(pp, u.pm, u.pn); } } }
        else if (kind == K_LRUSCAN) { if (PHON(10)) phase_lruscan1(pp); }
        else { if (PHON(11)) phase_lruscan2(pp); }
#if DUPMASK
        if (rep == 0 && ((DUPMASK >> kind) & 1u)) { xcd_barrier(xbar); rep = 1; --ph; continue; }
        rep = 0;
#endif
        if (ph + 1 < ph_hi) { if (ph == 0) grid.sync(); else xcd_barrier(xbar); }
    }
}

extern "C" void kernel_launch(void* const* d_in, const int* in_sizes, int n_in, void* d_out, int out_size, void* d_ws, size_t ws_size, hipStream_t stream) {
    static int grid = 0;
    if (grid == 0) {
        if (n_in != 38 || ws_size < WS_END) { fprintf(stderr, "kernel_launch: expected 38 inputs and >= %zu bytes of workspace (got %d, %zu)\n", (size_t)WS_END, n_in, ws_size); grid = -1; return; }
        int dev = 0, cus = 0, per_cu = 0;
        hipGetDevice(&dev); hipDeviceGetAttribute(&cus, hipDeviceAttributeMultiprocessorCount, dev);
        hipFuncSetAttribute((const void*)mega, hipFuncAttributeMaxDynamicSharedMemorySize, LDS_BYTES);
        hipOccupancyMaxActiveBlocksPerMultiprocessor(&per_cu, (const void*)mega, 512, LDS_BYTES);
        if (per_cu < 1) { fprintf(stderr, "kernel_launch: occupancy query says %d blocks per CU\n", per_cu); grid = -1; return; }
        grid = cus;
    }
    if (grid < 0) return;
    (void)hipMemsetAsync((char*)d_ws + WS_MOD, 0, ZERO_BYTES, stream);
    Params p{};
    for (int i = 0; i < 38; ++i) p.in[i] = (const float*)d_in[i];
    p.out = (float*)d_out; p.ws = (unsigned char*)d_ws;
#if MEGA
    p.ph_lo = 0; p.ph_hi = NPH;
    void* args[] = {&p};
    hipError_t e = hipLaunchCooperativeKernel((const void*)mega, dim3(grid), dim3(512), args, LDS_BYTES, stream);
    if (e != hipSuccess) fprintf(stderr, "cooperative launch failed: %s (grid %d)\n", hipGetErrorString(e), grid);
#else
    for (int ph = 0; ph < NPH; ++ph) { p.ph_lo = ph; p.ph_hi = ph + 1; hipLaunchKernelGGL(mega, dim3(grid), dim3(512), LDS_BYTES, stream, p); }
#endif
}
```

```cpp
#include <hip/hip_runtime.h>
#include <hip/hip_cooperative_groups.h>
#include <cstdio>
namespace cg = cooperative_groups;

#ifndef MEGA
#define MEGA 1
#endif

#define LAS __attribute__((address_space(3)))
typedef unsigned short bf16_t;
typedef short bf16x8 __attribute__((ext_vector_type(8)));
typedef float f32x4 __attribute__((ext_vector_type(4)));
typedef float f32x2 __attribute__((ext_vector_type(2)));

constexpr int D = 2048, DFF = 5632, MTOK = 6144, TCTX = 4096;
constexpr int EVINP = 4352;
constexpr int NPH = 25;
constexpr int LDS_MAIN = 131072;
constexpr int LDS_BYTES = LDS_MAIN + 64;
constexpr float EPS = 1e-6f;

constexpr size_t al256(size_t x) { return (x + 255) & ~(size_t)255; }
constexpr size_t WS_MOD = 0;
constexpr size_t MOD_BYTES = (size_t)2 * 3 * 9 * 2048 * 4;
constexpr size_t WS_BAR = al256(WS_MOD + MOD_BYTES);
constexpr size_t BAR_BYTES = 3456 * 4;
constexpr size_t ZERO_BYTES = WS_BAR + BAR_BYTES;
constexpr size_t WS_X = al256(WS_BAR + BAR_BYTES);
constexpr size_t WS_HM = WS_X + (size_t)MTOK * D * 4;
constexpr size_t WS_H = WS_HM + (size_t)MTOK * D * 2;
constexpr size_t WS_PROJ = WS_H + (size_t)MTOK * DFF * 2;
constexpr size_t WS_WFI = WS_PROJ + (size_t)MTOK * EVINP * 4;
constexpr size_t WS_WFO = WS_WFI + (size_t)4 * 11264 * 2048 * 2;
constexpr size_t WS_WEI = WS_WFO + (size_t)4 * 2048 * 5632 * 2;
constexpr size_t WS_WEO = WS_WEI + (size_t)EVINP * 2048 * 2;
constexpr size_t WS_WGLU = WS_WEO + (size_t)2048 * 2048 * 2;
constexpr size_t WS_WOI = WS_WGLU + (size_t)1024 * 1024 * 2;
constexpr size_t WS_WOO = WS_WOI + (size_t)4096 * 2048 * 2;
constexpr size_t WS_WLRU = WS_WOO + (size_t)2048 * 2048 * 2;
constexpr size_t WS_YS5 = WS_WLRU + (size_t)2 * 8 * 2 * 256 * 256 * 2;
constexpr size_t WS_OGLA = WS_YS5 + (size_t)2 * MTOK * 1024 * 4;
constexpr size_t WS_YS32 = WS_OGLA + (size_t)2 * MTOK * 1024 * 4;
constexpr size_t WS_YSB = WS_YS32 + (size_t)MTOK * 1024 * 4;
constexpr size_t WS_CAT = WS_YSB + (size_t)MTOK * 1024 * 2;
constexpr size_t WS_XC32 = WS_CAT + (size_t)MTOK * D * 2;
constexpr size_t WS_XCB = WS_XC32 + (size_t)MTOK * D * 4;
constexpr size_t WS_LA = WS_XCB + (size_t)MTOK * D * 2;
constexpr size_t WS_LB = WS_LA + (size_t)2 * MTOK * D * 4;
constexpr size_t WS_SP = WS_LB + (size_t)2 * MTOK * D * 4;
constexpr size_t WS_LSUM = WS_SP + (size_t)2 * D * 4;
constexpr size_t WS_END = WS_LSUM + (size_t)2 * 2 * 384 * D * 4;

constexpr size_t OUT_Y = 0;
constexpr size_t OUT_S5RE = (size_t)MTOK * D;
constexpr size_t OUT_S5IM = OUT_S5RE + 16 * 2 * 64 * 64;
constexpr size_t OUT_GLA = OUT_S5IM + 16 * 2 * 64 * 64;
constexpr size_t OUT_LRU = OUT_GLA + (size_t)16 * 2 * 4 * 128 * 256;

struct Params { const float* in[38]; float* out; unsigned char* ws; int ph_lo, ph_hi; };
typedef const __attribute__((address_space(4))) Params* PP;
__device__ __forceinline__ int tidx() { int t = threadIdx.x; asm volatile("" : "+v"(t)); return t; }
__device__ __forceinline__ int bidx() { int b = blockIdx.x; asm volatile("" : "+s"(b)); return b; }
__device__ __forceinline__ int gdim() { int g = gridDim.x; asm volatile("" : "+s"(g)); return g; }
__device__ __forceinline__ PP get_pp() { PP kp = (PP)__builtin_amdgcn_kernarg_segment_ptr(); asm volatile("" : "+s"(kp)); return kp; }
enum { I_XP = 0, I_XS, I_S5RE, I_S5IM, I_SGLA, I_SLRU, I_C, I_CCTX, I_NORMG, I_ADAW, I_ADAB, I_FWI, I_FWO, I_FNG, I_EVWI, I_EVWO,
       I_LAMRE, I_LAMIM, I_LOGSTEP, I_BRE, I_BIM, I_CRE, I_CIM, I_S5D, I_GLUW, I_GLUB, I_GW2, I_GB, I_GNG, I_ODWI, I_ODWO,
       I_CONVW, I_CONVB, I_LWA, I_LBA, I_LWX, I_LBX, I_LLAM };

__device__ __forceinline__ unsigned cvt_pk_bf16(float lo, float hi) { unsigned r; asm("v_cvt_pk_bf16_f32 %0, %1, %2" : "=v"(r) : "v"(lo), "v"(hi)); return r; }
__device__ __forceinline__ bf16_t f2bf(float x) { return (bf16_t)(cvt_pk_bf16(x, 0.f) & 0xffffu); }
__device__ __forceinline__ float bf2f_(bf16_t v) { return __builtin_bit_cast(float, (unsigned)v << 16); }
__device__ __forceinline__ float lo_bf(unsigned w) { return __builtin_bit_cast(float, w << 16); }
__device__ __forceinline__ float hi_bf(unsigned w) { return __builtin_bit_cast(float, w & 0xffff0000u); }
__device__ __forceinline__ f32x4 unpack4(uint2 w) { return (f32x4){lo_bf(w.x), hi_bf(w.x), lo_bf(w.y), hi_bf(w.y)}; }
__device__ __forceinline__ float sigmoidf_(float x) { return __builtin_amdgcn_rcpf(1.f + __expf(-x)); }
__device__ __forceinline__ float siluf_(float x) { return x * __builtin_amdgcn_rcpf(1.f + __expf(-x)); }
__device__ __forceinline__ float geluf_(float x) { return x * sigmoidf_(1.5957691216f * (x + 0.044715f * x * x * x)); }
__device__ __forceinline__ float softplusf_(float x) { return fmaxf(x, 0.f) + log1pf(__expf(-fabsf(x))); }
__device__ __forceinline__ float neg_expm1_(float x) {
    const float pl = -x * (1.f + x * (0.5f + x * (0.16666667f + x * (0.041666668f + x * (0.0083333338f + x * 0.0013888889f))))); return x > -0.25f ? pl : 1.f - __expf(x); }
__device__ __forceinline__ int cond_of_pm(int pm) { return pm < 16 ? 0 : 1 + ((pm - 16) >> 2); }
__device__ __forceinline__ int cond_of_row(int r) { return r < TCTX ? 0 : 1 + ((r - TCTX) >> 10); }
__device__ __forceinline__ bf16x8 pack8(f32x4 a, f32x4 b) {
    typedef unsigned u32x4 __attribute__((ext_vector_type(4)));
    u32x4 u; u[0] = cvt_pk_bf16(a[0], a[1]); u[1] = cvt_pk_bf16(a[2], a[3]); u[2] = cvt_pk_bf16(b[0], b[1]); u[3] = cvt_pk_bf16(b[2], b[3]);
    return __builtin_bit_cast(bf16x8, u);
}

#define XB_TMO      128
#define XB_XCNT(j)  (256  + 64 * (j))
#define XB_XSUB(j)  (1280 + 64 * (j))
#define XB_XGEN(j)  (2304 + 64 * (j))
#define XB_TOP      3328
#define XB_TOPGEN   3392
#define XCD_BAR_WORDS 3456
#define XB_SPIN_CAP (1u << 18)

__device__ __forceinline__ unsigned xb_ld(unsigned* p)              { return __hip_atomic_load(p, __ATOMIC_RELAXED, __HIP_MEMORY_SCOPE_AGENT); }
__device__ __forceinline__ unsigned xb_add(unsigned* p, unsigned v) { return __hip_atomic_fetch_add(p, v, __ATOMIC_RELAXED, __HIP_MEMORY_SCOPE_AGENT); }
__device__ __forceinline__ unsigned xb_xcc_id() { return (unsigned)__builtin_amdgcn_s_getreg((3 << 11) | 20) & 0xFu; }
#define XB_SPIN(cond, bar) do { unsigned _sp = 0; while (cond) { __builtin_amdgcn_s_sleep(1); \
    if ((++_sp & 255u) == 0u) { if (xb_ld(&(bar)[XB_TMO])) break; if (_sp > XB_SPIN_CAP) { atomicAdd(&(bar)[XB_TMO], 1u); break; } } } } while (0)

struct XcdBarrier {
    unsigned* bar; unsigned x;
    volatile LAS unsigned* st;
};

__device__ __forceinline__ XcdBarrier xcd_barrier_post(unsigned* bar, volatile LAS unsigned* st) {
    XcdBarrier b; b.bar = bar; b.x = xb_xcc_id(); b.st = st;
    if (threadIdx.x == 0) (void)xb_add(&bar[XB_XCNT(b.x)], 1u);
    return b;
}
__device__ __forceinline__ void xcd_barrier_complete(unsigned* bar, unsigned x, unsigned& nloc, unsigned& nx) {
    const unsigned G = gridDim.x * gridDim.y * gridDim.z;
    unsigned sum, cnt, mine, sp = 0u;
    for (;;) {
        sum = 0u; cnt = 0u; mine = 0u;
#pragma unroll
        for (unsigned j = 0; j < 16; ++j) { const unsigned c = xb_ld(&bar[XB_XCNT(j)]); sum += c; cnt += (c > 0u) ? 1u : 0u; mine = (j == x) ? c : mine; }
        if (sum == G) break;
        __builtin_amdgcn_s_sleep(1);
        if ((++sp & 255u) == 0u) { if (xb_ld(&bar[XB_TMO])) break; if (sp > XB_SPIN_CAP) { atomicAdd(&bar[XB_TMO], 1u); break; } }
    }
    nloc = mine > 0u ? mine : 1u; nx = cnt > 0u ? cnt : 1u;
}

__device__ __forceinline__ void xcd_barrier(const XcdBarrier& b) {
    asm volatile("s_waitcnt vmcnt(0)" ::: "memory");
    __syncthreads();
    if (threadIdx.x == 0) {
        unsigned* bar = b.bar;
        __builtin_amdgcn_s_waitcnt(0);
        unsigned nloc = b.st[0], nx = b.st[1];
        if (nloc == 0u) { xcd_barrier_complete(bar, b.x, nloc, nx); b.st[0] = nloc; b.st[1] = nx; }
        const unsigned old = xb_add(&bar[XB_XSUB(b.x)], 1u);
        const unsigned gen = old / nloc;
        if (old + 1u == (gen + 1u) * nloc) {
            __builtin_amdgcn_fence(__ATOMIC_RELEASE, "agent");
            asm volatile("s_waitcnt vmcnt(0)" ::: "memory");
            const unsigned og = xb_add(&bar[XB_TOP], 1u);
            const unsigned tg = og / nx;
            if (og + 1u == (tg + 1u) * nx) xb_add(&bar[XB_TOPGEN], 1u);
            else XB_SPIN(xb_ld(&bar[XB_TOPGEN]) == tg, bar);
            __builtin_amdgcn_fence(__ATOMIC_ACQUIRE, "agent");
            xb_add(&bar[XB_XGEN(b.x)], 1u);
            asm volatile("s_waitcnt vmcnt(0)" ::: "memory");
        } else {
            XB_SPIN(xb_ld(&bar[XB_XGEN(b.x)]) == gen, bar);
            __builtin_amdgcn_fence(__ATOMIC_ACQUIRE, "agent");
            asm volatile("s_waitcnt vmcnt(0)" ::: "memory");
        }
    }
    __syncthreads();
}


namespace pg8 {
constexpr int BM = 256, BK = 64, HALF = 128, HTB = HALF * BK * 2, NXCD = 8, WGM = 8;
__device__ __forceinline__ int lds_byte(int r, int c) { const int st = (r >> 4) * 2 + (c >> 5), rr = r & 15, cc = c & 31, ob = rr * 64 + cc * 2; return st * 1024 + (ob ^ (((ob >> 9) & 1) << 5)); }
__device__ __forceinline__ void stage_rc(int b, int& R, int& C) { const int st = b / 1024, sb = b % 1024, swz = sb ^ (((sb >> 9) & 1) << 5); R = (st >> 1) * 16 + swz / 64; C = (st & 1) * 32 + (swz % 64) / 2; }
struct Unit { int pm, pn; };
struct Order {
    int nM, nN, nwg, G, c;
    __device__ __forceinline__ bool next(int i, Unit& u) const {
        const long L = (long)i * G + c; if (L >= nwg) return false;
        int wgid = (int)L; { const int q = nwg / NXCD, r = nwg % NXCD, xcd = wgid % NXCD, off = wgid / NXCD; wgid = (xcd < r ? xcd * (q + 1) : r * (q + 1) + (xcd - r) * q) + off; }
        const int nig = WGM * nN, gid = wgid / nig, fm = gid * WGM, gsz = (nM - fm) < WGM ? (nM - fm) : WGM;
        u.pm = fm + ((wgid % nig) % gsz); u.pn = (wgid % nig) / gsz; return true;
    }
};

template <class Epi, bool LRU, bool BLK = false>
__device__ __forceinline__ void gemm_phase(LAS unsigned char* lds, const bf16_t* A, int lda, const bf16_t* Bt, int ldb, int nM, int nN, int K, const Epi& E) {
    const int tid = tidx(), wid = __builtin_amdgcn_readfirstlane(tid >> 6), lane = tid & 63, wr = wid >> 2, wc = wid & 3, fr = lane & 15, fq = lane >> 4;
    const int nt = K / BK;
    Order S; S.nM = nM; S.nN = nN; S.nwg = nM * nN; S.G = gdim(); S.c = bidx();
    unsigned voffA[2], voffB[2];
#pragma unroll
    for (int i = 0; i < 2; ++i) { int R, C; stage_rc(tid * 16 + i * 8192, R, C); voffA[i] = (unsigned)(R * (BLK ? 64 : lda) + C) * 2u; voffB[i] = (unsigned)(R * (BLK ? 64 : ldb) + C) * 2u; }
    const size_t kstep = BLK ? (size_t)32768 : (size_t)(BK * 2);
    const size_t hstepA = BLK ? (size_t)16384 : (size_t)HALF * lda * 2, hstepB = BLK ? (size_t)16384 : (size_t)HALF * ldb * 2;
    const size_t tstepA = BLK ? (size_t)nt * 32768 : 2 * hstepA, tstepB = BLK ? (size_t)nt * 32768 : 2 * hstepB;
    const unsigned ldsw = (unsigned)wid * 1024u;
    const int aoff = lds_byte(wr * 64 + fr, fq * 8), boff = lds_byte(wc * 32 + fr, fq * 8);
#define PG8_SA(b, h) (((b) * 2 + (h)) * HTB)
#define PG8_SB(b, h) ((4 + (b) * 2 + (h)) * HTB)
#define PG8_STAGE(bufoff, gbase, voff) do { _Pragma("unroll") for (int _i = 0; _i < 2; ++_i) \
        __builtin_amdgcn_global_load_lds((const unsigned*)((const char*)(gbase) + (voff)[_i]), (LAS unsigned*)(lds + (bufoff) + ldsw + _i * 8192), 16, 0, 0); } while (0)
#define PG8_LDA(dst, b, h) do { _Pragma("unroll") for (int m = 0; m < 4; ++m) _Pragma("unroll") for (int k = 0; k < 2; ++k) dst[m][k] = *(const LAS bf16x8*)(lds + PG8_SA(b, h) + aoff + m * 2048 + k * 1024); } while (0)
#define PG8_LDB(dst, b, h) do { _Pragma("unroll") for (int n = 0; n < 2; ++n) _Pragma("unroll") for (int k = 0; k < 2; ++k) dst[n][k] = *(const LAS bf16x8*)(lds + PG8_SB(b, h) + boff + n * 2048 + k * 1024); } while (0)
#define PG8_MMA(ai, bj, At, Bt_) do { __builtin_amdgcn_s_setprio(1); _Pragma("unroll") for (int m = 0; m < 4; ++m) _Pragma("unroll") for (int n = 0; n < 2; ++n) _Pragma("unroll") for (int k = 0; k < 2; ++k) \
        acc[ai][bj][m][n] = __builtin_amdgcn_mfma_f32_16x16x32_bf16(Bt_[n][k], At[m][k], acc[ai][bj][m][n], 0, 0, 0); __builtin_amdgcn_s_setprio(0); } while (0)
#define PG8_WAIT_V(n) asm volatile("s_waitcnt vmcnt(" #n ")" ::: "memory")
#define PG8_WAIT_L(n) asm volatile("s_waitcnt lgkmcnt(" #n ")" ::: "memory")
#define PG8_BAR __builtin_amdgcn_s_barrier()
#define PG8_SCHED __builtin_amdgcn_sched_barrier(0)
#define PG8_APTR(u) ((const char*)A + (size_t)(u).pm * tstepA + (LRU ? (size_t)((((u).pn >> 1) & 7) * 512) : (size_t)0))
#define PG8_BPTR(u) ((const char*)Bt + (size_t)(u).pn * tstepB)
    Unit cur, nxt; int ui = 0;
    if (!S.next(0, cur)) return;
    f32x4 acc[2][2][4][2];
#pragma unroll
    for (int a = 0; a < 2; ++a)
#pragma unroll
        for (int b = 0; b < 2; ++b)
#pragma unroll
            for (int m = 0; m < 4; ++m)
#pragma unroll
                for (int n = 0; n < 2; ++n) acc[a][b][m][n] = (f32x4){0.f, 0.f, 0.f, 0.f};
    bf16x8 At[4][2], B0[2][2], B1[2][2];
    const char* cA = PG8_APTR(cur); const char* cB = PG8_BPTR(cur);
    PG8_STAGE(PG8_SB(0, 0), cB, voffB); PG8_STAGE(PG8_SA(0, 0), cA, voffA); PG8_STAGE(PG8_SB(0, 1), cB + hstepB, voffB); PG8_STAGE(PG8_SA(0, 1), cA + hstepA, voffA);
    if (wr == 1) PG8_BAR;
    PG8_WAIT_V(4); PG8_BAR;
    PG8_STAGE(PG8_SB(1, 0), cB + kstep, voffB); PG8_STAGE(PG8_SA(1, 0), cA + kstep, voffA); PG8_STAGE(PG8_SB(1, 1), cB + hstepB + kstep, voffB);
    PG8_WAIT_V(6); PG8_BAR;
    for (;;) {
        const bool has_next = S.next(ui + 1, nxt);
        const char* nA = has_next ? PG8_APTR(nxt) : cA; const char* nB = has_next ? PG8_BPTR(nxt) : cB;
        for (int t = 0; t < nt; t += 2) {
            const bool last = (t == nt - 2);
            const char* a1 = cA + (size_t)(t + 1) * kstep;
            const char* a2 = last ? nA : cA + (size_t)(t + 2) * kstep; const char* b2 = last ? nB : cB + (size_t)(t + 2) * kstep;
            const char* a3 = a2 + kstep; const char* b3 = b2 + kstep;
            PG8_LDB(B0, 0, 0); PG8_SCHED; PG8_LDA(At, 0, 0); PG8_STAGE(PG8_SA(1, 1), a1 + hstepA, voffA);
            PG8_WAIT_L(8); PG8_BAR; PG8_WAIT_L(0); PG8_MMA(0, 0, At, B0); PG8_BAR; PG8_SCHED;
            PG8_LDB(B1, 0, 1); PG8_STAGE(PG8_SB(0, 0), b2, voffB);
            PG8_BAR; PG8_WAIT_L(0); PG8_MMA(0, 1, At, B1); PG8_BAR;
            PG8_LDA(At, 0, 1); PG8_STAGE(PG8_SA(0, 0), a2, voffA);
            PG8_BAR; PG8_WAIT_L(0); PG8_MMA(1, 0, At, B0); PG8_BAR; PG8_SCHED;
            PG8_STAGE(PG8_SB(0, 1), b2 + hstepB, voffB);
            PG8_WAIT_V(6); PG8_BAR; PG8_MMA(1, 1, At, B1); PG8_BAR;
            PG8_LDB(B0, 1, 0); PG8_SCHED; PG8_LDA(At, 1, 0); PG8_STAGE(PG8_SA(0, 1), a2 + hstepA, voffA);
            PG8_WAIT_L(8); PG8_BAR; PG8_WAIT_L(0); PG8_MMA(0, 0, At, B0); PG8_BAR; PG8_SCHED;
            PG8_LDB(B1, 1, 1); PG8_STAGE(PG8_SB(1, 0), b3, voffB);
            PG8_BAR; PG8_WAIT_L(0); PG8_MMA(0, 1, At, B1); PG8_BAR;
            PG8_LDA(At, 1, 1); PG8_STAGE(PG8_SA(1, 0), a3, voffA);
            PG8_BAR; PG8_WAIT_L(0); PG8_MMA(1, 0, At, B0); PG8_BAR; PG8_SCHED;
            PG8_STAGE(PG8_SB(1, 1), b3 + hstepB, voffB);
            PG8_WAIT_V(6); PG8_BAR; PG8_MMA(1, 1, At, B1); PG8_BAR;
        }
        E(acc, cur, wr, wc, fr, fq);
        if (!has_next) break;
#pragma unroll
        for (int a = 0; a < 2; ++a)
#pragma unroll
            for (int b = 0; b < 2; ++b)
#pragma unroll
                for (int m = 0; m < 4; ++m)
#pragma unroll
                    for (int n = 0; n < 2; ++n) acc[a][b][m][n] = (f32x4){0.f, 0.f, 0.f, 0.f};
        cur = nxt; cA = nA; cB = nB; ++ui;
    }
    PG8_WAIT_V(0);
    if (wr == 0) PG8_BAR;
    PG8_BAR;
#undef PG8_SA
#undef PG8_SB
#undef PG8_STAGE
#undef PG8_LDA
#undef PG8_LDB
#undef PG8_MMA
#undef PG8_WAIT_V
#undef PG8_WAIT_L
#undef PG8_BAR
#undef PG8_SCHED
#undef PG8_APTR
#undef PG8_BPTR
}
}
using pg8::Unit;

struct EpiSwiglu {
    bf16_t* H;
    __device__ __forceinline__ void operator()(const f32x4 (&acc)[2][2][4][2], const Unit& u, int wr, int wc, int fr, int fq) const {
        const int loff = (wr * 64 + fr) * 64 + (wc & 1) * 32 + 4 * fq;
        bf16_t* ub = H + ((size_t)(u.pm * 88 + u.pn * 2 + (wc >> 1)) * 256) * 64;
#pragma unroll
        for (int ai = 0; ai < 2; ++ai)
#pragma unroll
            for (int m = 0; m < 4; ++m) { bf16_t* rb = ub + (size_t)(ai * 128 + m * 16) * 64;
#pragma unroll
                for (int n = 0; n < 2; ++n) { const f32x4 a = acc[ai][0][m][n], b = acc[ai][1][m][n];
                    uint2 pk; pk.x = cvt_pk_bf16(siluf_(a[0]) * b[0], siluf_(a[1]) * b[1]); pk.y = cvt_pk_bf16(siluf_(a[2]) * b[2], siluf_(a[3]) * b[3]);
                    *(uint2*)(rb + loff + n * 16) = pk; } }
    }
};
struct EpiResid {
    float* X; const float* G; float coef; const float* XinC; const float* XinL;
    __device__ __forceinline__ void operator()(const f32x4 (&acc)[2][2][4][2], const Unit& u, int wr, int wc, int fr, int fq) const {
        const int lcol = wc * 32 + 4 * fq, loff = (wr * 64 + fr) * D + lcol;
        const float* g = G + (size_t)cond_of_pm(u.pm) * (9 * 2048) + u.pn * 256;
        float* ub = X + (size_t)u.pm * 256 * D + u.pn * 256;
        const float* ib = (u.pm < 16 ? XinC : XinL) + (size_t)u.pm * 256 * D + u.pn * 256;
        f32x4 gv[2][2];
#pragma unroll
        for (int bj = 0; bj < 2; ++bj)
#pragma unroll
            for (int n = 0; n < 2; ++n) gv[bj][n] = *(const f32x4*)(g + lcol + bj * 128 + n * 16) * coef;
#pragma unroll
        for (int ai = 0; ai < 2; ++ai)
#pragma unroll
            for (int mp = 0; mp < 4; mp += 2) { f32x4 xin[2][2][2];
#pragma unroll
                for (int m2 = 0; m2 < 2; ++m2) { const float* ir = ib + (size_t)(ai * 128 + (mp + m2) * 16) * D;
#pragma unroll
                    for (int bj = 0; bj < 2; ++bj)
#pragma unroll
                        for (int n = 0; n < 2; ++n) xin[m2][bj][n] = *(const f32x4*)(ir + loff + bj * 128 + n * 16); }
                __builtin_amdgcn_sched_barrier(0);
#pragma unroll
                for (int m2 = 0; m2 < 2; ++m2) { float* rb = ub + (size_t)(ai * 128 + (mp + m2) * 16) * D;
#pragma unroll
                    for (int bj = 0; bj < 2; ++bj)
#pragma unroll
                        for (int n = 0; n < 2; ++n) { *(f32x4*)(rb + loff + bj * 128 + n * 16) = xin[m2][bj][n] + gv[bj][n] * acc[ai][bj][mp + m2][n]; } }
                __builtin_amdgcn_sched_barrier(0); }
    }
};
struct EpiF32 {
    float* C; int ldc;
    __device__ __forceinline__ void operator()(const f32x4 (&acc)[2][2][4][2], const Unit& u, int wr, int wc, int fr, int fq) const {
        const int loff = (wr * 64 + fr) * ldc + wc * 32 + 4 * fq;
        float* ub = C + (size_t)u.pm * 256 * ldc + u.pn * 256;
#pragma unroll
        for (int ai = 0; ai < 2; ++ai)
#pragma unroll
            for (int m = 0; m < 4; ++m) { float* rb = ub + (size_t)(ai * 128 + m * 16) * ldc;
#pragma unroll
                for (int bj = 0; bj < 2; ++bj)
#pragma unroll
                    for (int n = 0; n < 2; ++n) *(f32x4*)(rb + loff + bj * 128 + n * 16) = acc[ai][bj][m][n]; }
    }
};
struct EpiBf16 {
    bf16_t* C; int ldc;
    __device__ __forceinline__ void operator()(const f32x4 (&acc)[2][2][4][2], const Unit& u, int wr, int wc, int fr, int fq) const {
        const int loff = (wr * 64 + fr) * ldc + wc * 32 + 4 * fq;
        bf16_t* ub = C + (size_t)u.pm * 256 * ldc + u.pn * 256;
#pragma unroll
        for (int ai = 0; ai < 2; ++ai)
#pragma unroll
            for (int m = 0; m < 4; ++m) { bf16_t* rb = ub + (size_t)(ai * 128 + m * 16) * ldc;
#pragma unroll
                for (int bj = 0; bj < 2; ++bj)
#pragma unroll
                    for (int n = 0; n < 2; ++n) { const f32x4 v = acc[ai][bj][m][n]; uint2 pk; pk.x = cvt_pk_bf16(v[0], v[1]); pk.y = cvt_pk_bf16(v[2], v[3]); *(uint2*)(rb + loff + bj * 128 + n * 16) = pk; } }
    }
};
struct EpiGlu {
    bf16_t* CAT; const bf16_t* YS; const float* bias;
    __device__ __forceinline__ void operator()(const f32x4 (&acc)[2][2][4][2], const Unit& u, int wr, int wc, int fr, int fq) const {
        const int lcol = wc * 32 + 4 * fq, loffY = (wr * 64 + fr) * 1024 + lcol, loffC = (wr * 64 + fr) * D + lcol;
        const float* bb = bias + u.pn * 256; const bf16_t* yb = YS + (size_t)u.pm * 256 * 1024 + u.pn * 256; bf16_t* cb = CAT + (size_t)u.pm * 256 * D + u.pn * 256;
        f32x4 bv[2][2];
#pragma unroll
        for (int bj = 0; bj < 2; ++bj)
#pragma unroll
            for (int n = 0; n < 2; ++n) bv[bj][n] = *(const f32x4*)(bb + lcol + bj * 128 + n * 16);
#pragma unroll
        for (int ai = 0; ai < 2; ++ai)
#pragma unroll
            for (int m = 0; m < 4; ++m) { const bf16_t* yr = yb + (size_t)(ai * 128 + m * 16) * 1024; bf16_t* cr = cb + (size_t)(ai * 128 + m * 16) * D;
#pragma unroll
                for (int bj = 0; bj < 2; ++bj)
#pragma unroll
                    for (int n = 0; n < 2; ++n) { const f32x4 ys = unpack4(*(const uint2*)(yr + loffY + bj * 128 + n * 16)); const f32x4 z = acc[ai][bj][m][n] + bv[bj][n];
                        uint2 pk; pk.x = cvt_pk_bf16(ys[0] * sigmoidf_(z[0]), ys[1] * sigmoidf_(z[1])); pk.y = cvt_pk_bf16(ys[2] * sigmoidf_(z[2]), ys[3] * sigmoidf_(z[3]));
                        *(uint2*)(cr + loffC + bj * 128 + n * 16) = pk; }
                __builtin_amdgcn_sched_barrier(0); }
    }
};
struct EpiLru {
    unsigned* LAB; const bf16_t* XC; const float* ba; const float* bx; const float* sp;
    __device__ __forceinline__ void operator()(const f32x4 (&acc)[2][2][4][2], const Unit& u, int wr, int wc, int fr, int fq) const {
        const int d = u.pn >> 4, h = (u.pn >> 1) & 7, half = u.pn & 1;
        const int chu = h * 256 + half * 128;
        const int lcol = wc * 32 + 4 * fq, loff = (wr * 64 + fr) * D + lcol;
        const bf16_t* xb = XC + (size_t)u.pm * 256 * D + chu; unsigned* lab = LAB + ((size_t)d * MTOK + u.pm * 256) * D + chu;
        f32x4 bav[2], bxv[2], spv[2];
#pragma unroll
        for (int n = 0; n < 2; ++n) { bav[n] = *(const f32x4*)(ba + d * D + chu + lcol + n * 16); bxv[n] = *(const f32x4*)(bx + d * D + chu + lcol + n * 16); spv[n] = *(const f32x4*)(sp + d * D + chu + lcol + n * 16); }
#pragma unroll
        for (int ai = 0; ai < 2; ++ai) { uint2 xw[4][2];
#pragma unroll
            for (int m = 0; m < 4; ++m)
#pragma unroll
                for (int n = 0; n < 2; ++n) xw[m][n] = *(const uint2*)(xb + (size_t)(ai * 128 + m * 16) * D + loff + n * 16);
            __builtin_amdgcn_sched_barrier(0);
#pragma unroll
            for (int m = 0; m < 4; ++m) { const size_t ro = (size_t)(ai * 128 + m * 16) * D;
#pragma unroll
                for (int n = 0; n < 2; ++n) { const f32x4 xc = unpack4(xw[m][n]);
                    const f32x4 rp = acc[ai][0][m][n] + bav[n], ip = acc[ai][1][m][n] + bxv[n]; uint4 w;
                    unsigned wv[4];
#pragma unroll
                    for (int e = 0; e < 4; ++e) { const float la = spv[n][e] * sigmoidf_(rp[e]); const float bb = __builtin_amdgcn_sqrtf(fmaxf(neg_expm1_(2.f * la), 0.f)) * (sigmoidf_(ip[e]) * xc[e]); wv[e] = cvt_pk_bf16(la, bb); }
                    w.x = wv[0]; w.y = wv[1]; w.z = wv[2]; w.w = wv[3];
                    *(uint4*)(lab + ro + loff + n * 16) = w; __builtin_amdgcn_sched_barrier(0); } } }
    }
};

struct CvtT { const float* src; bf16_t* dst; int K, ldsrc, Nsrc, n_dst0, n_src0, k0, blk; };
__device__ __forceinline__ void cvt_decode(PP p, unsigned char* ws, int t, int total, CvtT& c) {
    constexpr int T_FI = 176 * 32, T_FO = 32 * 88, T_EI = 68 * 32, T_EO = 32 * 32, T_GLU = 16 * 16, T_OI = 64 * 32, T_OO = 32 * 32, T_LRU = 4 * 4;
    c.blk = 0;
    if (t >= total) { c.src = nullptr; c.dst = nullptr; c.K = c.ldsrc = c.Nsrc = c.n_dst0 = c.n_src0 = c.k0 = 0; return; }
    if (t < 4 * T_FI) { const int w = t / T_FI; t %= T_FI; const int nt_ = t / 32, kt = t % 32; c.K = 2048; c.ldsrc = 11264; c.Nsrc = 11264; c.src = p->in[I_FWI] + (size_t)w * 2048 * 11264; c.dst = (bf16_t*)(ws + WS_WFI) + (size_t)w * 11264 * 2048;
        c.n_dst0 = nt_ * 64; const int j = c.n_dst0 >> 8, rr = c.n_dst0 & 255; c.n_src0 = rr < 128 ? j * 128 + rr : 5632 + j * 128 + (rr - 128); c.k0 = kt * 64; }
    else if ((t -= 4 * T_FI) < 4 * T_FO) { const int w = t / T_FO; t %= T_FO; const int nt_ = t / 88, kt = t % 88; c.K = 5632; c.ldsrc = 2048; c.Nsrc = 2048; c.src = p->in[I_FWO] + (size_t)w * 5632 * 2048; c.dst = (bf16_t*)(ws + WS_WFO) + (size_t)w * 2048 * 5632; c.n_dst0 = c.n_src0 = nt_ * 64; c.k0 = kt * 64; c.blk = 1; }
    else if ((t -= 4 * T_FO) < T_EI) { const int nt_ = t / 32, kt = t % 32; c.K = 2048; c.ldsrc = 4128; c.Nsrc = 4128; c.src = p->in[I_EVWI]; c.dst = (bf16_t*)(ws + WS_WEI); c.n_dst0 = c.n_src0 = nt_ * 64; c.k0 = kt * 64; }
    else if ((t -= T_EI) < T_EO) { const int nt_ = t / 32, kt = t % 32; c.K = 2048; c.ldsrc = 2048; c.Nsrc = 2048; c.src = p->in[I_EVWO]; c.dst = (bf16_t*)(ws + WS_WEO); c.n_dst0 = c.n_src0 = nt_ * 64; c.k0 = kt * 64; }
    else if ((t -= T_EO) < T_GLU) { const int nt_ = t / 16, kt = t % 16; c.K = 1024; c.ldsrc = 1024; c.Nsrc = 1024; c.src = p->in[I_GLUW]; c.dst = (bf16_t*)(ws + WS_WGLU); c.n_dst0 = c.n_src0 = nt_ * 64; c.k0 = kt * 64; }
    else if ((t -= T_GLU) < T_OI) { const int nt_ = t / 32, kt = t % 32; c.K = 2048; c.ldsrc = 4096; c.Nsrc = 4096; c.src = p->in[I_ODWI]; c.dst = (bf16_t*)(ws + WS_WOI); c.n_dst0 = c.n_src0 = nt_ * 64; c.k0 = kt * 64; }
    else if ((t -= T_OI) < T_OO) { const int nt_ = t / 32, kt = t % 32; c.K = 2048; c.ldsrc = 2048; c.Nsrc = 2048; c.src = p->in[I_ODWO]; c.dst = (bf16_t*)(ws + WS_WOO); c.n_dst0 = c.n_src0 = nt_ * 64; c.k0 = kt * 64; }
    else { t -= T_OO; const int mi = t / T_LRU; t %= T_LRU; const int which = mi >> 4, dh = mi & 15;
        const int nt_ = t / 4, kt = t % 4; c.K = 256; c.ldsrc = 256; c.Nsrc = 256; c.src = (which ? p->in[I_LWX] : p->in[I_LWA]) + (size_t)dh * 65536; c.dst = (bf16_t*)(ws + WS_WLRU) + (size_t)dh * 2 * 65536;
        c.n_src0 = nt_ * 64; const int half = c.n_src0 >> 7; c.n_dst0 = half * 256 + which * 128 + (c.n_src0 & 127); c.k0 = kt * 64; }
}
constexpr int CV_FI = 176 * 32, CV_FO = 32 * 88, CV_TOTAL = 4 * CV_FI + 4 * CV_FO + 68 * 32 + 32 * 32 + 16 * 16 + 64 * 32 + 32 * 32 + 32 * 16;
__device__ __forceinline__ void cvt_range(PP p, unsigned char* lds, int t_lo, int t_hi, int rank, int n) {
    const int tid = tidx(); unsigned char* ws = p->ws; float* tile = (float*)lds;
    for (int g0 = t_lo + rank * 4; g0 < t_hi; g0 += n * 4) {
        f32x4 v[4][2];
#pragma unroll
        for (int q = 0; q < 4; ++q) { CvtT c; cvt_decode(p, ws, g0 + q, t_hi, c);
#pragma unroll
            for (int h = 0; h < 2; ++h) { const int kk = (tid >> 4) + h * 32, n4 = (tid & 15) * 4; const int ns = c.n_src0 + n4;
                v[q][h] = (f32x4){0.f, 0.f, 0.f, 0.f}; if (ns < c.Nsrc) v[q][h] = __builtin_nontemporal_load((const f32x4*)(c.src + (size_t)(c.k0 + kk) * c.ldsrc + ns)); } }
        __syncthreads();
#pragma unroll
        for (int q = 0; q < 4; ++q)
#pragma unroll
            for (int h = 0; h < 2; ++h) { const int kk = (tid >> 4) + h * 32, n4 = (tid & 15) * 4; float* tp = tile + q * 4160 + kk * 65 + n4; tp[0] = v[q][h][0]; tp[1] = v[q][h][1]; tp[2] = v[q][h][2]; tp[3] = v[q][h][3]; }
        __syncthreads();
#pragma unroll
        for (int q = 0; q < 4; ++q) { CvtT c; cvt_decode(p, ws, g0 + q, t_hi, c);
            if (c.dst) { const int nn = tid >> 3, k8 = (tid & 7) * 8; f32x4 a, b2; const float* tp = tile + q * 4160;
#pragma unroll
                for (int j = 0; j < 4; ++j) { a[j] = tp[(k8 + j) * 65 + nn]; b2[j] = tp[(k8 + 4 + j) * 65 + nn]; }
                const int n_ = c.n_dst0 + nn; bf16_t* dp = c.blk ? c.dst + ((size_t)((n_ >> 8) * (c.K >> 6) + (c.k0 >> 6)) * 256 + (n_ & 255)) * 64 + k8 : c.dst + (size_t)n_ * c.K + c.k0 + k8;
                *(bf16x8*)dp = pack8(a, b2); } }
    }
}
__device__ __forceinline__ void mod_items(PP p, unsigned char* lds, int it_lo, int it_hi, int rank, int n) {
    const int tid = tidx(); unsigned char* ws = p->ws;
    float* sc = (float*)lds;
    __syncthreads();
    for (int i = tid; i < 3 * 2048; i += 512) { const int ci = i >> 11, k = i & 2047; const float v = ci == 0 ? p->in[I_CCTX][k] : p->in[I_C][(ci - 1) * 2048 + k]; sc[i] = siluf_(v); }
    __syncthreads();
    float* MOD = (float*)(ws + WS_MOD);
    for (int it = it_lo + rank; it < it_hi; it += n) { const int l = it / 288, r = it % 288, chunk = r / 32, ks = r % 32; const int col = chunk * 2048 + tid * 4;
        const float* W = p->in[I_ADAW] + (size_t)l * 2048 * 18432 + (size_t)(ks * 64) * 18432 + col;
        f32x4 a0 = (f32x4){0.f, 0.f, 0.f, 0.f}, a1 = a0, a2 = a0;
#pragma unroll 8
        for (int k = 0; k < 64; ++k) { const f32x4 w = __builtin_nontemporal_load((const f32x4*)(W + (size_t)k * 18432)); const int kk = ks * 64 + k; a0 += w * sc[kk]; a1 += w * sc[2048 + kk]; a2 += w * sc[4096 + kk]; }
        if (ks == 0) { const f32x4 bb = *(const f32x4*)(p->in[I_ADAB] + (size_t)l * 18432 + col); a0 += bb; a1 += bb; a2 += bb; }
        float* m0 = MOD + (size_t)(l * 3) * 18432 + col;
#pragma unroll
        for (int e = 0; e < 4; ++e) { atomicAdd(m0 + e, a0[e]); atomicAdd(m0 + 18432 + e, a1[e]); atomicAdd(m0 + 2 * 18432 + e, a2[e]); } }
    __syncthreads();
}
__device__ void phase_prep(PP p, LAS unsigned char* ldsr, int skip_mod) {
    unsigned char* lds = (unsigned char*)ldsr;
    const int tid = tidx(), bid = bidx(), nb = gdim();
    unsigned char* ws = p->ws;
    if (!skip_mod) mod_items(p, lds, 0, 288, bid, nb);
    cvt_range(p, lds, 0, CV_FI, bid, nb);
}
__device__ void bg_convert(PP p, LAS unsigned char* ldsr, int ph) {
    unsigned char* lds = (unsigned char*)ldsr; const int bid = bidx();
    constexpr int S0 = 4 * CV_FI + 4 * CV_FO, S_EI = S0, S_EO = S_EI + 2176, S_OI = S_EO + 1024 + 256, S_OO = S_OI + 2048;
    __syncthreads();
    if (ph == 2) { if (bid >= 32) { cvt_range(p, lds, 4 * CV_FI, 4 * CV_FI + CV_FO, bid - 32, 224); cvt_range(p, lds, S_EI, S_EO, bid - 32, 224); } }
    else if (ph == 3) { if (bid >= 192) cvt_range(p, lds, CV_FI, 2 * CV_FI, bid - 192, 64); }
    else if (ph == 5) { if (bid >= 152) cvt_range(p, lds, S_EO, S_OO, bid - 152, 104); }
    else if (ph == 8) { if (bid >= 96) cvt_range(p, lds, 4 * CV_FI + CV_FO, 4 * CV_FI + 2 * CV_FO, bid - 96, 160); }
    else if (ph == 9) { if (bid >= 192) cvt_range(p, lds, S_OO, CV_TOTAL, bid - 192, 64); }
    else if (ph == 11) { if (bid >= 32) cvt_range(p, lds, 2 * CV_FI, 3 * CV_FI, bid - 32, 224); }
    else if (ph == 12) { if (bid >= 192) { mod_items(p, lds, 288, 448, bid - 192, 64); cvt_range(p, lds, 4 * CV_FI + 2 * CV_FO, 4 * CV_FI + 3 * CV_FO, bid - 192, 64); } }
    else if (ph == 14) { if (bid >= 32) cvt_range(p, lds, 3 * CV_FI, 4 * CV_FI, bid - 32, 224); }
    else if (ph == 15) { if (bid >= 192) { cvt_range(p, lds, 4 * CV_FI + 3 * CV_FO, 4 * CV_FI + 4 * CV_FO, bid - 192, 64); mod_items(p, lds, 448, 576, bid - 192, 64); } }
}

__device__ void phase_norm(PP p, int l, int j  ) {
    const int tid = tidx(), lane = tid & 63, wid = tid >> 6; const int gw = bidx() * 8 + wid, nw = gdim() * 8;
    const float* X = (const float*)(p->ws + WS_X); bf16_t* HM = (bf16_t*)(p->ws + WS_HM);
    const float* g = j < 0 ? p->in[I_FNG] : p->in[I_NORMG] + (size_t)(l * 3 + j) * D;
    const bool from_in = (l == 0 && j == 0);
    for (int r = gw; r < MTOK; r += nw) {
        const float* xr = from_in ? (r < TCTX ? p->in[I_XP] + (size_t)r * D : p->in[I_XS] + (size_t)(r - TCTX) * D) : X + (size_t)r * D; f32x4 v[8]; float ss = 0.f;
#pragma unroll
        for (int i = 0; i < 8; ++i) { v[i] = *(const f32x4*)(xr + lane * 4 + i * 256); ss += v[i][0] * v[i][0] + v[i][1] * v[i][1] + v[i][2] * v[i][2] + v[i][3] * v[i][3]; }
#pragma unroll
        for (int o = 32; o >= 1; o >>= 1) ss += __shfl_xor(ss, o);
        const float rinv = rsqrtf(ss * (1.f / D) + EPS);
        if (j < 0) { float* o = p->out + OUT_Y + (size_t)r * D;
#pragma unroll
            for (int i = 0; i < 8; ++i) { const int c = lane * 4 + i * 256; const f32x4 gg = *(const f32x4*)(g + c); *(f32x4*)(o + c) = v[i] * rinv * gg; } }
        else { const float* mod = (const float*)(p->ws + WS_MOD) + (size_t)(l * 3 + cond_of_row(r)) * 18432; const float* sh = mod + (3 * j) * 2048; const float* scl = mod + (3 * j + 1) * 2048;
#pragma unroll
            for (int i = 0; i < 8; ++i) { const int c = lane * 4 + i * 256; const f32x4 gg = *(const f32x4*)(g + c), s1 = *(const f32x4*)(scl + c), s0 = *(const f32x4*)(sh + c);
                const f32x4 y = (v[i] * rinv * gg) * (s1 + 1.f) + s0; uint2 pk; pk.x = cvt_pk_bf16(y[0], y[1]); pk.y = cvt_pk_bf16(y[2], y[3]); *(uint2*)(HM + (size_t)r * D + c) = pk; } }
    }
}

__device__ __forceinline__ void seq_info(int s, int& L, int& row0) { if (s < 16) { L = 256; row0 = s * 256; } else { L = 1024; row0 = TCTX + (s - 16) * 1024; } }

#define WAVE_LDS_SYNC() asm volatile("s_waitcnt lgkmcnt(0)" ::: "memory")
__device__ __forceinline__ void s5_item(PP p, unsigned char* lds, int s, int d, int gg) {
    const int tid = tidx(), lane = tid & 63, wid = tid >> 6, fr = lane & 15, fq = lane >> 4; const int g = gg * 8 + wid;
    int L, row0; seq_info(s, L, row0);
    float* HS = (float*)(lds + wid * 8448);
    const bf16_t* PROJ = (const bf16_t*)(p->ws + WS_PROJ); float* Y = (float*)(p->ws + WS_YS5) + (size_t)d * MTOK * 1024;
    const int pg0 = (d * 64 + g) * 64, pg = pg0 + lane;
    const float lre = p->in[I_LAMRE][pg], lim = p->in[I_LAMIM][pg], dt = expf(p->in[I_LOGSTEP][d * 64 + g]);
    const float mag = expf(lre * dt); float sn, cs; sincosf(lim * dt, &sn, &cs);
    const float abr = mag * cs, abi = mag * sn, den = lre * lre + lim * lim, nre = abr - 1.f;
    const float fre = (nre * lre + abi * lim) / den, fim = (abi * lre - nre * lim) / den;
    bf16x8 af[8];
#pragma unroll
    for (int tq = 0; tq < 4; ++tq) { const int src = tq * 16 + fr; const float f_r = __shfl(fre, src), f_i = __shfl(fim, src);
        f32x4 r0 = (f32x4){0.f, 0.f, 0.f, 0.f}, r1 = r0, i0 = r0, i1 = r0;
        if (fq < 2) { const float* br = p->in[I_BRE] + (size_t)(pg0 + src) * 16 + fq * 8; const float* bi = p->in[I_BIM] + (size_t)(pg0 + src) * 16 + fq * 8;
            r0 = *(const f32x4*)br; r1 = *(const f32x4*)(br + 4); i0 = *(const f32x4*)bi; i1 = *(const f32x4*)(bi + 4); }
        af[tq] = pack8(r0 * f_r - i0 * f_i, r1 * f_r - i1 * f_i); af[tq + 4] = pack8(i0 * f_r + r0 * f_i, i1 * f_r + r1 * f_i); }
    bf16x8 cf[4];
#pragma unroll
    for (int kk = 0; kk < 4; ++kk) { const float* cp = (kk < 2 ? p->in[I_CRE] : p->in[I_CIM]) + ((size_t)(d * 64 + g) * 16 + fr) * 64 + (kk & 1) * 32 + fq * 8;
        f32x4 a = *(const f32x4*)cp, b = *(const f32x4*)(cp + 4); if (kk >= 2) { a = -a; b = -b; } cf[kk] = pack8(a, b); }
    float hr = 0.f, hi = 0.f;
    if (s >= 16) { const size_t o = ((size_t)((s - 16) * 2 + d) * 64 + g) * 64 + lane; hr = p->in[I_S5RE][o]; hi = p->in[I_S5IM][o]; }
    const f32x4 z4 = (f32x4){0.f, 0.f, 0.f, 0.f};
    bf16x8 un = (bf16x8){0, 0, 0, 0, 0, 0, 0, 0};
#define S5_LOADU(c0_) do { if (fq < 2) { const int row_ = row0 + (d ? L - 1 - ((c0_) + fr) : (c0_) + fr); un = *(const bf16x8*)(PROJ + (size_t)row_ * EVINP + g * 16 + fq * 8); } } while (0)
    S5_LOADU(0);
    __syncthreads();
    for (int c0 = 0; c0 < L; c0 += 16) {
        const bf16x8 ub = un;
        if (c0 + 16 < L) S5_LOADU(c0 + 16);
#pragma unroll
        for (int t8 = 0; t8 < 8; ++t8) { const f32x4 bu = __builtin_amdgcn_mfma_f32_16x16x32_bf16(af[t8], ub, z4, 0, 0, 0); *(f32x4*)(HS + fr * 132 + t8 * 16 + fq * 4) = bu; }
        WAVE_LDS_SYNC();
#pragma unroll
        for (int i = 0; i < 16; ++i) { const float bur = HS[i * 132 + lane], bui = HS[i * 132 + 64 + lane];
            const float nr = abr * hr - abi * hi + bur, ni = abr * hi + abi * hr + bui; hr = nr; hi = ni;
            HS[i * 132 + lane] = hr; HS[i * 132 + 64 + lane] = hi; }
        WAVE_LDS_SYNC();
        { f32x4 acc = z4;
#pragma unroll
          for (int kk = 0; kk < 4; ++kk) { const float* hp = HS + fr * 132 + kk * 32 + fq * 8; const bf16x8 hb = pack8(*(const f32x4*)hp, *(const f32x4*)(hp + 4));
              acc = __builtin_amdgcn_mfma_f32_16x16x32_bf16(cf[kk], hb, acc, 0, 0, 0); }
          const int row = row0 + (d ? L - 1 - (c0 + fr) : c0 + fr);
          *(f32x4*)(Y + (size_t)row * 1024 + g * 16 + fq * 4) = acc; }
        WAVE_LDS_SYNC();
    }
#undef S5_LOADU
    if (s < 16) { const size_t o = ((size_t)(s * 2 + d) * 64 + g) * 64 + lane; p->out[OUT_S5RE + o] = hr; p->out[OUT_S5IM + o] = hi; }
}

template <int NK32> __device__ __forceinline__ f32x4 mma_lds(f32x4 acc, const bf16_t* X, int ldx, const bf16_t* Y, int ldy, int lane) {
    const bf16_t* xp = X + (lane & 15) * ldx + (lane >> 4) * 8; const bf16_t* yp = Y + (lane & 15) * ldy + (lane >> 4) * 8;
#pragma unroll
    for (int kk = 0; kk < NK32; ++kk) acc = __builtin_amdgcn_mfma_f32_16x16x32_bf16(*(const bf16x8*)(xp + kk * 32), *(const bf16x8*)(yp + kk * 32), acc, 0, 0, 0);
    return acc;
}

__device__ __forceinline__ void gla_item(PP p, unsigned char* lds, int s, int h, int d, int vh) {
    const int tid = tidx(), lane = tid & 63, wid = tid >> 6, fr = lane & 15, fq = lane >> 4;
    int L, row0; seq_info(s, L, row0);
    bf16_t* QT = (bf16_t*)(lds);
    bf16_t* KT = (bf16_t*)(lds + 17408);
    bf16_t* KE = (bf16_t*)(lds + 34816);
    bf16_t* VT = (bf16_t*)(lds + 53248);
    bf16_t* ATT = (bf16_t*)(lds + 71680);
    bf16_t* ST = (bf16_t*)(lds + 80896);
    float* LOGA = (float*)(lds + 80896);
    float* SEG = (float*)(lds + 115712);
    float* GLR = (float*)(lds + 117760);
    float* W2S = (float*)(lds + 121856);
    float* GBS = (float*)(lds + 130048);
    float* DEC = (float*)(lds + 130560);
    const bf16_t* PROJ = (const bf16_t*)(p->ws + WS_PROJ); float* O = (float*)(p->ws + WS_OGLA) + (size_t)d * MTOK * 1024;
    __syncthreads();
    for (int i = tid; i < 16 * 128; i += 512) W2S[i] = p->in[I_GW2][(size_t)(d * 16 + (i >> 7)) * 512 + h * 128 + (i & 127)];
    if (tid < 128) GBS[tid] = p->in[I_GB][d * 512 + h * 128 + tid];
    f32x4 sacc[8];
#pragma unroll
    for (int tn = 0; tn < 8; ++tn) { sacc[tn] = (f32x4){0.f, 0.f, 0.f, 0.f};
        if (s >= 16) { const float* sp = p->in[I_SGLA] + ((size_t)(((s - 16) * 2 + d) * 4 + h) * 128 + wid * 16 + fq * 4) * 256 + vh * 128 + tn * 16 + fr;
#pragma unroll
            for (int e = 0; e < 4; ++e) sacc[tn][e] = sp[(size_t)e * 256]; } }
    const float qscale = 0.08838834764831845f;
    const int nch = L >> 6;
    const int c = tid & 127, ig = tid >> 7;
#define GROW(n_, i) (row0 + (d ? L - 1 - ((n_) * 64 + (i)) : (n_) * 64 + (i)))
    f32x4 glr4 = (f32x4){0.f, 0.f, 0.f, 0.f}; float qv[16], kv[16], vv[16];
#define GLA_PREFETCH(n_) do { \
        if (tid < 256) glr4 = unpack4(*(const uint2*)(PROJ + (size_t)GROW(n_, tid >> 2) * EVINP + 4096 + d * 16 + (tid & 3) * 4)); \
        _Pragma("unroll") for (int ii = 0; ii < 16; ++ii) { const size_t ro = (size_t)GROW(n_, ig * 16 + ii) * EVINP; \
            qv[ii] = bf2f_(PROJ[ro + 1024 + h * 128 + c]); kv[ii] = bf2f_(PROJ[ro + 1536 + h * 128 + c]); vv[ii] = bf2f_(PROJ[ro + 2048 + h * 256 + vh * 128 + c]); } } while (0)
    GLA_PREFETCH(0);
    for (int n = 0; n < nch; ++n) {
        __syncthreads();
        if (tid < 256) *(f32x4*)(GLR + (tid >> 2) * 16 + (tid & 3) * 4) = glr4;
        __syncthreads();
        { float run = 0.f; const float gb = GBS[c];
          float w2[16];
#pragma unroll
          for (int r = 0; r < 16; ++r) w2[r] = W2S[r * 128 + c];
          for (int ii = 0; ii < 16; ++ii) { const int i = ig * 16 + ii; float z = gb;
#pragma unroll
              for (int q = 0; q < 4; ++q) { const f32x4 g4 = *(const f32x4*)(GLR + i * 16 + q * 4);
#pragma unroll
                  for (int e = 0; e < 4; ++e) z += g4[e] * w2[q * 4 + e]; }
              run -= (fmaxf(-z, 0.f) + __logf(1.f + __expf(-fabsf(z)))) * (1.f / 16.f); LOGA[i * 128 + c] = run; }
          SEG[ig * 128 + c] = run; }
        __syncthreads();
        { float pre = 0.f, tot = 0.f;
#pragma unroll
          for (int q = 0; q < 4; ++q) { const float sg = SEG[q * 128 + c]; tot += sg; if (q < ig) pre += sg; }
          if (ig == 0) DEC[c] = __expf(tot);
#pragma unroll
          for (int ii = 0; ii < 16; ++ii) { const int i = ig * 16 + ii; const float bc = LOGA[i * 128 + c] + pre;
              QT[i * 136 + c] = f2bf(qv[ii] * qscale * __expf(bc)); KT[i * 136 + c] = f2bf(kv[ii] * __expf(-bc)); KE[c * 72 + i] = f2bf(kv[ii] * __expf(tot - bc)); VT[c * 72 + i] = f2bf(vv[ii]); } }
        __syncthreads();
        if (n + 1 < nch) GLA_PREFETCH(n + 1);
#pragma unroll
        for (int q = 0; q < 2; ++q) { const int tile = wid * 2 + q, ti = tile >> 2, tj = tile & 3; f32x4 a = (f32x4){0.f, 0.f, 0.f, 0.f};
            if (tj <= ti) a = mma_lds<4>(a, QT + ti * 16 * 136, 136, KT + tj * 16 * 136, 136, lane);
#pragma unroll
            for (int e = 0; e < 4; ++e) { const int i = ti * 16 + fq * 4 + e, jx = tj * 16 + fr; ATT[i * 72 + jx] = f2bf(jx <= i ? a[e] : 0.f); } }
#pragma unroll
        for (int tn = 0; tn < 8; ++tn) { uint2 pk; pk.x = cvt_pk_bf16(sacc[tn][0], sacc[tn][1]); pk.y = cvt_pk_bf16(sacc[tn][2], sacc[tn][3]); *(uint2*)(ST + (tn * 16 + fr) * 136 + wid * 16 + fq * 4) = pk; }
        __syncthreads();
#pragma unroll
        for (int ti = 0; ti < 4; ++ti) { f32x4 o = (f32x4){0.f, 0.f, 0.f, 0.f};
            o = mma_lds<2>(o, ATT + ti * 16 * 72, 72, VT + wid * 16 * 72, 72, lane);
            o = mma_lds<4>(o, QT + ti * 16 * 136, 136, ST + wid * 16 * 136, 136, lane);
#pragma unroll
            for (int e = 0; e < 4; ++e) { const int i = ti * 16 + fq * 4 + e; O[(size_t)GROW(n, i) * 1024 + h * 256 + vh * 128 + wid * 16 + fr] = o[e]; } }
        { f32x4 dc;
#pragma unroll
          for (int e = 0; e < 4; ++e) dc[e] = DEC[wid * 16 + fq * 4 + e];
#pragma unroll
          for (int tn = 0; tn < 8; ++tn) { sacc[tn] = sacc[tn] * dc; sacc[tn] = mma_lds<2>(sacc[tn], KE + wid * 16 * 72, 72, VT + tn * 16 * 72, 72, lane); } }
    }
#undef GROW
#undef GLA_PREFETCH
    if (s < 16) {
#pragma unroll
        for (int tn = 0; tn < 8; ++tn) { float* sp = p->out + OUT_GLA + ((size_t)((s * 2 + d) * 4 + h) * 128 + wid * 16 + fq * 4) * 256 + vh * 128 + tn * 16 + fr;
#pragma unroll
            for (int e = 0; e < 4; ++e) sp[(size_t)e * 256] = sacc[tn][e]; } }
}

__device__ void phase_s5gla(PP p, LAS unsigned char* ldsr) {
    unsigned char* lds = (unsigned char*)ldsr; const int bid = bidx(), nb = gdim();
    if (nb >= 64) {
        if (bid < 32) { gla_item(p, lds, 16 + (bid >> 4), (bid >> 2) & 3, (bid >> 1) & 1, bid & 1); return; }
        for (int it = bid - 32; it < 544; it += nb - 32) {
            if (it < 32) s5_item(p, lds, 16 + (it >> 4), (it >> 3) & 1, it & 7);
            else if (it < 288) { const int q = it - 32; s5_item(p, lds, q >> 4, (q >> 3) & 1, q & 7); }
            else { const int q = it - 288; gla_item(p, lds, q >> 4, (q >> 2) & 3, (q >> 1) & 1, q & 1); }
        }
    } else {
        for (int it = bid; it < 576; it += nb) {
            if (it < 32) { gla_item(p, lds, 16 + (it >> 4), (it >> 2) & 3, (it >> 1) & 1, it & 1); }
            else if (it < 64) { const int q = it - 32; s5_item(p, lds, 16 + (q >> 4), (q >> 3) & 1, q & 7); }
            else if (it < 320) { const int q = it - 64; s5_item(p, lds, q >> 4, (q >> 3) & 1, q & 7); }
            else { const int q = it - 320; gla_item(p, lds, q >> 4, (q >> 2) & 3, (q >> 1) & 1, q & 1); }
        }
    }
}

__device__ void phase_evpost(PP p) {
    const int tid = tidx(), lane = tid & 63, wid = tid >> 6; const int gw = bidx() * 8 + wid, nw = gdim() * 8;
    const bf16_t* PROJ = (const bf16_t*)(p->ws + WS_PROJ); const float* Y0 = (const float*)(p->ws + WS_YS5); const float* Y1 = Y0 + (size_t)MTOK * 1024;
    const float* O0 = (const float*)(p->ws + WS_OGLA); const float* O1 = O0 + (size_t)MTOK * 1024;
    bf16_t* YSB = (bf16_t*)(p->ws + WS_YSB); bf16_t* CAT = (bf16_t*)(p->ws + WS_CAT);
    for (int r = gw; r < MTOK; r += nw) {
        f32x4 y0[4], y1[4], o0[4], o1[4]; uint2 uw[4], gw4[4];
        const int c0 = lane * 16;
#pragma unroll
        for (int i = 0; i < 4; ++i) { const int c = lane * 4 + i * 256; y0[i] = *(const f32x4*)(Y0 + (size_t)r * 1024 + c); y1[i] = *(const f32x4*)(Y1 + (size_t)r * 1024 + c); uw[i] = *(const uint2*)(PROJ + (size_t)r * EVINP + c);
            o0[i] = *(const f32x4*)(O0 + (size_t)r * 1024 + c0 + i * 4); o1[i] = *(const f32x4*)(O1 + (size_t)r * 1024 + c0 + i * 4); gw4[i] = *(const uint2*)(PROJ + (size_t)r * EVINP + 3072 + c0 + i * 4); }
#pragma unroll
        for (int i = 0; i < 4; ++i) { const int c = lane * 4 + i * 256; const f32x4 u = unpack4(uw[i]), dd = *(const f32x4*)(p->in[I_S5D] + c); f32x4 v = y0[i] + y1[i] + dd * u;
#pragma unroll
            for (int e = 0; e < 4; ++e) v[e] = geluf_(v[e]);
            uint2 pk; pk.x = cvt_pk_bf16(v[0], v[1]); pk.y = cvt_pk_bf16(v[2], v[3]); *(uint2*)(YSB + (size_t)r * 1024 + c) = pk; }
        { f32x4 o[4]; float ss = 0.f;
#pragma unroll
          for (int i = 0; i < 4; ++i) { o[i] = o0[i] + o1[i]; ss += o[i][0] * o[i][0] + o[i][1] * o[i][1] + o[i][2] * o[i][2] + o[i][3] * o[i][3]; }
#pragma unroll
          for (int m = 8; m >= 1; m >>= 1) ss += __shfl_xor(ss, m);
          const float rinv = rsqrtf(ss * (1.f / 256.f) + EPS);
#pragma unroll
          for (int i = 0; i < 4; ++i) { const int c = c0 + i * 4; const f32x4 ng = *(const f32x4*)(p->in[I_GNG] + (c & 255)), gt = unpack4(gw4[i]); f32x4 v;
#pragma unroll
              for (int e = 0; e < 4; ++e) v[e] = o[i][e] * rinv * ng[e] * siluf_(gt[e]);
              uint2 pk; pk.x = cvt_pk_bf16(v[0], v[1]); pk.y = cvt_pk_bf16(v[2], v[3]); *(uint2*)(CAT + (size_t)r * D + 1024 + c) = pk; } }
    }
}

__device__ void phase_conv(PP p) {
    const bf16_t* PROJ = (const bf16_t*)(p->ws + WS_PROJ); bf16_t* XCB = (bf16_t*)(p->ws + WS_XCB);
    const float* cw = p->in[I_CONVW]; const float* cb = p->in[I_CONVB];
    const size_t total = (size_t)MTOK * 512;
    { const int gi = bidx() * 512 + tidx(); if (gi < 2 * D) ((float*)(p->ws + WS_SP))[gi] = -8.f * softplusf_(-p->in[I_LLAM][gi]); }
    for (size_t i = (size_t)bidx() * 512 + tidx(); i < total; i += (size_t)gdim() * 512) {
        const int r = (int)(i >> 9), c = (int)(i & 511) * 4; const int seg = r < TCTX ? 256 : 64; const int pos = r & (seg - 1);
        f32x4 acc = *(const f32x4*)(cb + c);
#pragma unroll
        for (int j = 0; j < 4; ++j) { const int pp = pos + j - 2; if (pp >= 0 && pp < seg) acc += *(const f32x4*)(cw + j * D + c) * unpack4(*(const uint2*)(PROJ + (size_t)(r + j - 2) * 4096 + 2048 + c)); }
        uint2 pk; pk.x = cvt_pk_bf16(acc[0], acc[1]); pk.y = cvt_pk_bf16(acc[2], acc[3]); *(uint2*)(XCB + (size_t)r * D + c) = pk;
    }
}
__device__ void phase_lruscan1(PP p) {
    const int tid = tidx(), lane = tid & 63, wid = tid >> 6; const int nb = gdim();
    float* SUM = (float*)(p->ws + WS_LSUM);
    for (int it = bidx() * 8 + wid; it < 384 * 64; it += 8 * nb) {
        const int q = it >> 6, d = (it >> 5) & 1, c = (it & 31) * 64 + lane; const int row0 = q * 16;
        const unsigned* LAB = (const unsigned*)(p->ws + WS_LA) + ((size_t)d * MTOK + row0) * D + c;
        unsigned wv[16];
#pragma unroll
        for (int j = 0; j < 16; ++j) wv[j] = LAB[(size_t)j * D];
        float S = 0.f, h = 0.f;
        if (d == 0) {
#pragma unroll
            for (int j = 0; j < 16; ++j) { const float la = lo_bf(wv[j]); h = __expf(la) * h + hi_bf(wv[j]); S += la; } }
        else {
#pragma unroll
            for (int j = 15; j >= 0; --j) { const float la = lo_bf(wv[j]); h = __expf(la) * h + hi_bf(wv[j]); S += la; } }
        SUM[((size_t)d * 384 + q) * D + c] = __expf(S); SUM[((size_t)(2 + d) * 384 + q) * D + c] = h;
    }
}
__device__ void conv_tile(PP p, int pm, int pnx) {
    const int tid = tidx();
    const bf16_t* PROJ = (const bf16_t*)(p->ws + WS_PROJ); bf16_t* XCB = (bf16_t*)(p->ws + WS_XCB); const float* cw = p->in[I_CONVW]; const float* cb = p->in[I_CONVB];
    const int c = pnx * 256 + (tid & 63) * 4; const int rl0 = tid >> 6;
    f32x4 w[4]; const f32x4 bias = *(const f32x4*)(cb + c);
#pragma unroll
    for (int j = 0; j < 4; ++j) w[j] = *(const f32x4*)(cw + j * D + c);
    for (int kb = 0; kb < 32; kb += 4) {
        uint2 t[4][4];
#pragma unroll
        for (int u = 0; u < 4; ++u) { const int r = pm * 256 + rl0 + 8 * (kb + u); const int seg = r < TCTX ? 256 : 64; const int pos = r & (seg - 1);
#pragma unroll
            for (int j = 0; j < 4; ++j) { const int pp = pos + j - 2; t[u][j] = (uint2){0u, 0u}; if (pp >= 0 && pp < seg) t[u][j] = *(const uint2*)(PROJ + (size_t)(r + j - 2) * 4096 + 2048 + c); } }
#pragma unroll
        for (int u = 0; u < 4; ++u) { const int r = pm * 256 + rl0 + 8 * (kb + u); f32x4 acc = bias;
#pragma unroll
            for (int j = 0; j < 4; ++j) acc += w[j] * unpack4(t[u][j]);
            uint2 pk; pk.x = cvt_pk_bf16(acc[0], acc[1]); pk.y = cvt_pk_bf16(acc[2], acc[3]); *(uint2*)(XCB + (size_t)r * D + c) = pk; } }
}
__device__ void scan1_tile(PP p, int pm, int pn) {
    const int tid = tidx(); const int d = pn >> 4, chu = ((pn >> 1) & 7) * 256 + (pn & 1) * 128; float* SUM = (float*)(p->ws + WS_LSUM);
    const int c = chu + (tid & 127);
    unsigned wv[4][16];
#pragma unroll
    for (int k = 0; k < 4; ++k) { const int q = pm * 16 + (tid >> 7) + 4 * k; const unsigned* LAB = (const unsigned*)(p->ws + WS_LA) + ((size_t)d * MTOK + q * 16) * D + c;
#pragma unroll
        for (int j = 0; j < 16; ++j) wv[k][j] = LAB[(size_t)j * D]; }
#pragma unroll
    for (int k = 0; k < 4; ++k) { const int q = pm * 16 + (tid >> 7) + 4 * k; float S = 0.f, h = 0.f;
        if (d == 0) {
#pragma unroll
            for (int j = 0; j < 16; ++j) { const float la = lo_bf(wv[k][j]); h = __expf(la) * h + hi_bf(wv[k][j]); S += la; } }
        else {
#pragma unroll
            for (int j = 15; j >= 0; --j) { const float la = lo_bf(wv[k][j]); h = __expf(la) * h + hi_bf(wv[k][j]); S += la; } }
        SUM[((size_t)d * 384 + q) * D + c] = __expf(S); SUM[((size_t)(2 + d) * 384 + q) * D + c] = h; }
}
__device__ void phase_lruscan2(PP p) {
    const int tid = tidx(), lane = tid & 63, wid = tid >> 6; const int nb = gdim();
    const float* SUM = (const float*)(p->ws + WS_LSUM); const bf16_t* PROJ = (const bf16_t*)(p->ws + WS_PROJ); bf16_t* CAT = (bf16_t*)(p->ws + WS_CAT);
    for (int it0 = bidx() * 8 + wid; it0 < 384 * 32; it0 += 8 * nb) {
        const int it = it0 < 128 * 32 ? it0 + 256 * 32 : it0 - 128 * 32;
        const int q = it >> 5, c = (it & 31) * 64 + lane; const int row0 = q * 16;
        int qs, ql, s; if (q < 256) { s = q >> 4; qs = s * 16; ql = qs + 15; } else { s = 16 + ((q - 256) >> 6); qs = 256 + (s - 16) * 64; ql = qs + 63; }
        float h0 = 0.f, h1 = 0.f;
        if (s >= 16) { h0 = p->in[I_SLRU][(size_t)((s - 16) * 2 + 0) * D + c]; h1 = p->in[I_SLRU][(size_t)((s - 16) * 2 + 1) * D + c]; }
        const float* P0 = SUM + c; const float* H0 = SUM + (size_t)2 * 384 * D + c; const float* P1 = SUM + (size_t)384 * D + c; const float* H1 = SUM + (size_t)3 * 384 * D + c;
        { int j = qs;
          for (; j + 8 <= q; j += 8) { float pv[8], hv[8];
#pragma unroll
              for (int e = 0; e < 8; ++e) { pv[e] = P0[(size_t)(j + e) * D]; hv[e] = H0[(size_t)(j + e) * D]; }
#pragma unroll
              for (int e = 0; e < 8; ++e) h0 = pv[e] * h0 + hv[e]; }
          for (; j < q; ++j) h0 = P0[(size_t)j * D] * h0 + H0[(size_t)j * D]; }
        { int j = ql;
          for (; j - 8 >= q; j -= 8) { float pv[8], hv[8];
#pragma unroll
              for (int e = 0; e < 8; ++e) { pv[e] = P1[(size_t)(j - e) * D]; hv[e] = H1[(size_t)(j - e) * D]; }
#pragma unroll
              for (int e = 0; e < 8; ++e) h1 = pv[e] * h1 + hv[e]; }
          for (; j > q; --j) h1 = P1[(size_t)j * D] * h1 + H1[(size_t)j * D]; }
        const unsigned* W0 = (const unsigned*)(p->ws + WS_LA) + (size_t)row0 * D + c; const unsigned* W1 = W0 + (size_t)MTOK * D; const bf16_t* GT = PROJ + (size_t)row0 * 4096 + c;
        unsigned w0[16], w1[16]; float b0[16], gt[16];
#pragma unroll
        for (int j = 0; j < 16; ++j) { w0[j] = W0[(size_t)j * D]; w1[j] = W1[(size_t)j * D]; gt[j] = bf2f_(GT[(size_t)j * 4096]); }
#pragma unroll
        for (int j = 0; j < 16; ++j) { h0 = __expf(lo_bf(w0[j])) * h0 + hi_bf(w0[j]); b0[j] = h0; }
#pragma unroll
        for (int j = 15; j >= 0; --j) { h1 = __expf(lo_bf(w1[j])) * h1 + hi_bf(w1[j]); CAT[(size_t)(row0 + j) * D + c] = f2bf((b0[j] + h1) * geluf_(gt[j])); }
        if (s < 16) { if (q == ql) p->out[OUT_LRU + (size_t)(s * 2 + 0) * D + c] = h0; if (q == qs) p->out[OUT_LRU + (size_t)(s * 2 + 1) * D + c] = h1; }
    }
}

#ifndef PHMASK
#define PHMASK 0xFFFFFFFFu
#endif
#define PHON(k) ((PHMASK >> (k)) & 1u)
#ifndef DUPMASK
#define DUPMASK 0u
#endif
enum { K_PREP = 0, K_NORM, K_SWIGLU, K_RESID, K_F32, K_S5GLA, K_EVPOST, K_GLU, K_CONV, K_LRUG, K_LRUSCAN, K_LRUCOMB };
__global__ void __launch_bounds__(512, 2) mega(Params p) {
    extern __shared__ __attribute__((aligned(16))) unsigned char shm[];
    LAS unsigned char* lds = (LAS unsigned char*)shm;
    cg::grid_group grid = cg::this_grid();
    const int ph_lo = p.ph_lo, ph_hi = p.ph_hi;
    int rep = 0;
    volatile LAS unsigned* bst = (volatile LAS unsigned*)(lds + LDS_MAIN);
    if (threadIdx.x < 16) bst[threadIdx.x] = 0u;
    __syncthreads();
    XcdBarrier xbar = xcd_barrier_post((unsigned*)(p.ws + WS_BAR), bst);
    for (int ph = ph_lo; ph < ph_hi; ++ph) {
        PP pp = get_pp();
        unsigned char* ws = pp->ws;
        const float* MOD = (const float*)(ws + WS_MOD);
        int kind, l = 0, a0 = 0;
        if (ph == 0) kind = K_PREP;
        else if (ph == 24) { kind = K_NORM; a0 = -1; }
        else { l = ph > 12 ? 1 : 0; const int q = ph - 1 - 12 * l;
            if (q == 0) { kind = K_NORM; a0 = 0; }
            else if (q == 1) { kind = K_SWIGLU; a0 = 0; }
            else if (q == 2) { kind = K_RESID; a0 = 0; }
            else if (q == 3) { kind = K_NORM; a0 = 1; }
            else if (q == 4) kind = K_F32;
            else if (l == 0) { if (q == 5) kind = K_S5GLA; else if (q == 6) kind = K_EVPOST; else if (q == 7) kind = K_GLU; else if (q == 8) { kind = K_RESID; a0 = 2; } else if (q == 9) { kind = K_NORM; a0 = 2; } else if (q == 10) { kind = K_SWIGLU; a0 = 1; } else { kind = K_RESID; a0 = 1; } }
            else { if (q == 5) kind = K_LRUG; else if (q == 6) kind = K_LRUCOMB; else if (q == 7) { kind = K_RESID; a0 = 2; } else if (q == 8) { kind = K_NORM; a0 = 2; } else if (q == 9) { kind = K_SWIGLU; a0 = 1; } else { kind = K_RESID; a0 = 1; } }
        }
        const bf16_t* HM = (const bf16_t*)(ws + WS_HM);
        if (kind == K_PREP) { if (PHON(0)) phase_prep(pp, lds, rep); }
        else if (kind == K_NORM) { if (PHON(1)) phase_norm(pp, l, a0); }
        else if (kind == K_SWIGLU) { if (PHON(2)) { EpiSwiglu E{(bf16_t*)(ws + WS_H)}; pg8::gemm_phase<EpiSwiglu, false>(lds, HM, D, (const bf16_t*)(ws + WS_WFI) + (size_t)(l * 2 + a0) * 11264 * 2048, D, 24, 44, D, E); if (!rep) bg_convert(pp, lds, ph); } }
        else if (kind == K_RESID) { if (PHON(3)) {
            const bf16_t* A; const bf16_t* B; int K; int gj; float coef;
            if (a0 < 2) { A = (const bf16_t*)(ws + WS_H); B = (const bf16_t*)(ws + WS_WFO) + (size_t)(l * 2 + a0) * 2048 * 5632; K = DFF; gj = a0 == 0 ? 2 : 8; coef = 0.5f; }
            else { A = (const bf16_t*)(ws + WS_CAT); B = (const bf16_t*)(ws + (l == 0 ? WS_WEO : WS_WOO)); K = D; gj = 5; coef = 1.0f; }
            const bool first = (ph == 3);
            const float* xc_ = first ? pp->in[I_XP] : (const float*)(ws + WS_X); const float* xl_ = first ? pp->in[I_XS] - (size_t)TCTX * D : (const float*)(ws + WS_X);
            EpiResid E{(float*)(ws + WS_X), MOD + (size_t)(l * 3) * 18432 + gj * 2048, coef, xc_, xl_};
            if (a0 < 2) pg8::gemm_phase<EpiResid, false, true>(lds, A, K, B, K, 24, 8, K, E); else pg8::gemm_phase<EpiResid, false, false>(lds, A, K, B, K, 24, 8, K, E); if (!rep) bg_convert(pp, lds, ph); } }
        else if (kind == K_F32) { if (PHON(4)) {
            { const int nN = l == 0 ? 17 : 16; EpiBf16 E{(bf16_t*)(ws + WS_PROJ), nN * 256}; pg8::gemm_phase<EpiBf16, false>(lds, HM, D, (const bf16_t*)(ws + (l == 0 ? WS_WEI : WS_WOI)), D, 24, nN, D, E); }
            if (l == 1) {
                { const int gi = bidx() * 512 + tidx(); if (gi < 2 * D) ((float*)(ws + WS_SP))[gi] = -8.f * softplusf_(-pp->in[I_LLAM][gi]); }
                pg8::Order S; S.nM = 24; S.nN = 16; S.nwg = 384; S.G = gdim(); S.c = bidx(); Unit u;
                for (int i = 0; S.next(i, u); ++i) if (u.pn >= 8) conv_tile(pp, u.pm, u.pn - 8); }
            if (!rep) bg_convert(pp, lds, ph); } }
        else if (kind == K_S5GLA) { if (PHON(5)) phase_s5gla(pp, lds); }
        else if (kind == K_EVPOST) { if (PHON(6)) phase_evpost(pp); }
        else if (kind == K_GLU) { if (PHON(7)) { EpiGlu E{(bf16_t*)(ws + WS_CAT), (const bf16_t*)(ws + WS_YSB), pp->in[I_GLUB]}; pg8::gemm_phase<EpiGlu, false>(lds, (const bf16_t*)(ws + WS_YSB), 1024, (const bf16_t*)(ws + WS_WGLU), 1024, 24, 4, 1024, E); if (!rep) bg_convert(pp, lds, ph); } }
        else if (kind == K_CONV) { if (PHON(8)) phase_conv(pp); }
        else if (kind == K_LRUG) { if (PHON(9)) { EpiLru E{(unsigned*)(ws + WS_LA), (const bf16_t*)(ws + WS_XCB), pp->in[I_LBA], pp->in[I_LBX], (const float*)(ws + WS_SP)};
            int kk = 256; asm volatile("" : "+s"(kk));
            pg8::gemm_phase<EpiLru, true>(lds, (const bf16_t*)(ws + WS_XCB), D, (const bf16_t*)(ws + WS_WLRU), kk, 24, 32, kk, E);
            { pg8::Order S; S.nM = 24; S.nN = 32; S.nwg = 768; S.G = gdim(); S.c = bidx(); Unit u; for (int i = 0; S.next(i, u); ++i) scan1_tile(pp, u.pm, u.pn); } } }
        else if (kind == K_LRUSCAN) { if (PHON(10)) phase_lruscan1(pp); }
        else { if (PHON(11)) phase_lruscan2(pp); }
#if DUPMASK
        if (rep == 0 && ((DUPMASK >> kind) & 1u)) { xcd_barrier(xbar); rep = 1; --ph; continue; }
        rep = 0;
#endif
        if (ph + 1 < ph_hi) { if (ph == 0) grid.sync(); else xcd_barrier(xbar); }
    }
}

extern "C" void kernel_launch(void* const* d_in, const int* in_sizes, int n_in, void* d_out, int out_size, void* d_ws, size_t ws_size, hipStream_t stream) {
    static int grid = 0;
    if (grid == 0) {
        if (n_in != 38 || ws_size < WS_END) { fprintf(stderr, "kernel_launch: expected 38 inputs and >= %zu bytes of workspace (got %d, %zu)\n", (size_t)WS_END, n_in, ws_size); grid = -1; return; }
        int dev = 0, cus = 0, per_cu = 0;
        hipGetDevice(&dev); hipDeviceGetAttribute(&cus, hipDeviceAttributeMultiprocessorCount, dev);
        hipFuncSetAttribute((const void*)mega, hipFuncAttributeMaxDynamicSharedMemorySize, LDS_BYTES);
        hipOccupancyMaxActiveBlocksPerMultiprocessor(&per_cu, (const void*)mega, 512, LDS_BYTES);
        if (per_cu < 1) { fprintf(stderr, "kernel_launch: occupancy query says %d blocks per CU\n", per_cu); grid = -1; return; }
        grid = cus;
    }
    if (grid < 0) return;
    (void)hipMemsetAsync((char*)d_ws + WS_MOD, 0, ZERO_BYTES, stream);
    Params p{};
    for (int i = 0; i < 38; ++i) p.in[i] = (const float*)d_in[i];
    p.out = (float*)d_out; p.ws = (unsigned char*)d_ws;
#if MEGA
    p.ph_lo = 0; p.ph_hi = NPH;
    void* args[] = {&p};
    hipError_t e = hipLaunchCooperativeKernel((const void*)mega, dim3(grid), dim3(512), args, LDS_BYTES, stream);
    if (e != hipSuccess) fprintf(stderr, "cooperative launch failed: %s (grid %d)\n", hipGetErrorString(e), grid);
#else
    for (int ph = 0; ph < NPH; ++ph) { p.ph_lo = ph; p.ph_hi = ph + 1; hipLaunchKernelGGL(mega, dim3(grid), dim3(512), LDS_BYTES, stream, p); }
#endif
}
```

```cpp
#include <hip/hip_runtime.h>
#include <hip/hip_cooperative_groups.h>
#include <cstdio>
namespace cg = cooperative_groups;

#ifndef MEGA
#define MEGA 1
#endif

#define LAS __attribute__((address_space(3)))
typedef unsigned short bf16_t;
typedef short bf16x8 __attribute__((ext_vector_type(8)));
typedef float f32x4 __attribute__((ext_vector_type(4)));
typedef float f32x2 __attribute__((ext_vector_type(2)));

constexpr int D = 2048, DFF = 5632, MTOK = 6144, TCTX = 4096;
constexpr int EVINP = 4352;
constexpr int NPH = 25;
constexpr int LDS_MAIN = 131072;
constexpr int LDS_BYTES = LDS_MAIN + 64;
constexpr float EPS = 1e-6f;

constexpr size_t al256(size_t x) { return (x + 255) & ~(size_t)255; }
constexpr size_t WS_MOD = 0;
constexpr size_t MOD_BYTES = (size_t)2 * 3 * 9 * 2048 * 4;
constexpr size_t WS_BAR = al256(WS_MOD + MOD_BYTES);
constexpr size_t BAR_BYTES = 3456 * 4;
constexpr size_t ZERO_BYTES = WS_BAR + BAR_BYTES;
constexpr size_t WS_X = al256(WS_BAR + BAR_BYTES);
constexpr size_t WS_HM = WS_X + (size_t)MTOK * D * 4;
constexpr size_t WS_H = WS_HM + (size_t)MTOK * D * 2;
constexpr size_t WS_PROJ = WS_H + (size_t)MTOK * DFF * 2;
constexpr size_t WS_WFI = WS_PROJ + (size_t)MTOK * EVINP * 4;
constexpr size_t WS_WFO = WS_WFI + (size_t)4 * 11264 * 2048 * 2;
constexpr size_t WS_WEI = WS_WFO + (size_t)4 * 2048 * 5632 * 2;
constexpr size_t WS_WEO = WS_WEI + (size_t)EVINP * 2048 * 2;
constexpr size_t WS_WGLU = WS_WEO + (size_t)2048 * 2048 * 2;
constexpr size_t WS_WOI = WS_WGLU + (size_t)1024 * 1024 * 2;
constexpr size_t WS_WOO = WS_WOI + (size_t)4096 * 2048 * 2;
constexpr size_t WS_WLRU = WS_WOO + (size_t)2048 * 2048 * 2;
constexpr size_t WS_YS5 = WS_WLRU + (size_t)2 * 8 * 2 * 256 * 256 * 2;
constexpr size_t WS_OGLA = WS_YS5 + (size_t)2 * MTOK * 1024 * 4;
constexpr size_t WS_YS32 = WS_OGLA + (size_t)2 * MTOK * 1024 * 4;
constexpr size_t WS_YSB = WS_YS32 + (size_t)MTOK * 1024 * 4;
constexpr size_t WS_CAT = WS_YSB + (size_t)MTOK * 1024 * 2;
constexpr size_t WS_XC32 = WS_CAT + (size_t)MTOK * D * 2;
constexpr size_t WS_XCB = WS_XC32 + (size_t)MTOK * D * 4;
constexpr size_t WS_LA = WS_XCB + (size_t)MTOK * D * 2;
constexpr size_t WS_LB = WS_LA + (size_t)2 * MTOK * D * 4;
constexpr size_t WS_SP = WS_LB + (size_t)2 * MTOK * D * 4;
constexpr size_t WS_LSUM = WS_SP + (size_t)2 * D * 4;
constexpr size_t WS_END = WS_LSUM + (size_t)2 * 2 * 384 * D * 4;

constexpr size_t OUT_Y = 0;
constexpr size_t OUT_S5RE = (size_t)MTOK * D;
constexpr size_t OUT_S5IM = OUT_S5RE + 16 * 2 * 64 * 64;
constexpr size_t OUT_GLA = OUT_S5IM + 16 * 2 * 64 * 64;
constexpr size_t OUT_LRU = OUT_GLA + (size_t)16 * 2 * 4 * 128 * 256;

struct Params { const float* in[38]; float* out; unsigned char* ws; int ph_lo, ph_hi; };
typedef const __attribute__((address_space(4))) Params* PP;
__device__ __forceinline__ int tidx() { int t = threadIdx.x; asm volatile("" : "+v"(t)); return t; }
__device__ __forceinline__ int bidx() { int b = blockIdx.x; asm volatile("" : "+s"(b)); return b; }
__device__ __forceinline__ int gdim() { int g = gridDim.x; asm volatile("" : "+s"(g)); return g; }
__device__ __forceinline__ PP get_pp() { PP kp = (PP)__builtin_amdgcn_kernarg_segment_ptr(); asm volatile("" : "+s"(kp)); return kp; }
enum { I_XP = 0, I_XS, I_S5RE, I_S5IM, I_SGLA, I_SLRU, I_C, I_CCTX, I_NORMG, I_ADAW, I_ADAB, I_FWI, I_FWO, I_FNG, I_EVWI, I_EVWO,
       I_LAMRE, I_LAMIM, I_LOGSTEP, I_BRE, I_BIM, I_CRE, I_CIM, I_S5D, I_GLUW, I_GLUB, I_GW2, I_GB, I_GNG, I_ODWI, I_ODWO,
       I_CONVW, I_CONVB, I_LWA, I_LBA, I_LWX, I_LBX, I_LLAM };

__device__ __forceinline__ unsigned cvt_pk_bf16(float lo, float hi) { unsigned r; asm("v_cvt_pk_bf16_f32 %0, %1, %2" : "=v"(r) : "v"(lo), "v"(hi)); return r; }
__device__ __forceinline__ bf16_t f2bf(float x) { return (bf16_t)(cvt_pk_bf16(x, 0.f) & 0xffffu); }
__device__ __forceinline__ float bf2f_(bf16_t v) { return __builtin_bit_cast(float, (unsigned)v << 16); }
__device__ __forceinline__ float lo_bf(unsigned w) { return __builtin_bit_cast(float, w << 16); }
__device__ __forceinline__ float hi_bf(unsigned w) { return __builtin_bit_cast(float, w & 0xffff0000u); }
__device__ __forceinline__ f32x4 unpack4(uint2 w) { return (f32x4){lo_bf(w.x), hi_bf(w.x), lo_bf(w.y), hi_bf(w.y)}; }
__device__ __forceinline__ float sigmoidf_(float x) { return __builtin_amdgcn_rcpf(1.f + __expf(-x)); }
__device__ __forceinline__ float siluf_(float x) { return x * __builtin_amdgcn_rcpf(1.f + __expf(-x)); }
__device__ __forceinline__ float geluf_(float x) { return x * sigmoidf_(1.5957691216f * (x + 0.044715f * x * x * x)); }
__device__ __forceinline__ float softplusf_(float x) { return fmaxf(x, 0.f) + log1pf(__expf(-fabsf(x))); }
__device__ __forceinline__ float neg_expm1_(float x) {
    const float pl = -x * (1.f + x * (0.5f + x * (0.16666667f + x * (0.041666668f + x * (0.0083333338f + x * 0.0013888889f))))); return x > -0.25f ? pl : 1.f - __expf(x); }
__device__ __forceinline__ int cond_of_pm(int pm) { return pm < 16 ? 0 : 1 + ((pm - 16) >> 2); }
__device__ __forceinline__ int cond_of_row(int r) { return r < TCTX ? 0 : 1 + ((r - TCTX) >> 10); }
__device__ __forceinline__ bf16x8 pack8(f32x4 a, f32x4 b) {
    typedef unsigned u32x4 __attribute__((ext_vector_type(4)));
    u32x4 u; u[0] = cvt_pk_bf16(a[0], a[1]); u[1] = cvt_pk_bf16(a[2], a[3]); u[2] = cvt_pk_bf16(b[0], b[1]); u[3] = cvt_pk_bf16(b[2], b[3]);
    return __builtin_bit_cast(bf16x8, u);
}

#define XB_TMO      128
#define XB_XCNT(j)  (256  + 64 * (j))
#define XB_XSUB(j)  (1280 + 64 * (j))
#define XB_XGEN(j)  (2304 + 64 * (j))
#define XB_TOP      3328
#define XB_TOPGEN   3392
#define XCD_BAR_WORDS 3456
#define XB_SPIN_CAP (1u << 18)

__device__ __forceinline__ unsigned xb_ld(unsigned* p)              { return __hip_atomic_load(p, __ATOMIC_RELAXED, __HIP_MEMORY_SCOPE_AGENT); }
__device__ __forceinline__ unsigned xb_add(unsigned* p, unsigned v) { return __hip_atomic_fetch_add(p, v, __ATOMIC_RELAXED, __HIP_MEMORY_SCOPE_AGENT); }
__device__ __forceinline__ unsigned xb_xcc_id() { return (unsigned)__builtin_amdgcn_s_getreg((3 << 11) | 20) & 0xFu; }
#define XB_SPIN(cond, bar) do { unsigned _sp = 0; while (cond) { __builtin_amdgcn_s_sleep(1); \
    if ((++_sp & 255u) == 0u) { if (xb_ld(&(bar)[XB_TMO])) break; if (_sp > XB_SPIN_CAP) { atomicAdd(&(bar)[XB_TMO], 1u); break; } } } } while (0)

struct XcdBarrier {
    unsigned* bar; unsigned x;
    volatile LAS unsigned* st;
};

__device__ __forceinline__ XcdBarrier xcd_barrier_post(unsigned* bar, volatile LAS unsigned* st) {
    XcdBarrier b; b.bar = bar; b.x = xb_xcc_id(); b.st = st;
    if (threadIdx.x == 0) (void)xb_add(&bar[XB_XCNT(b.x)], 1u);
    return b;
}
__device__ __forceinline__ void xcd_barrier_complete(unsigned* bar, unsigned x, unsigned& nloc, unsigned& nx) {
    const unsigned G = gridDim.x * gridDim.y * gridDim.z;
    unsigned sum, cnt, mine, sp = 0u;
    for (;;) {
        sum = 0u; cnt = 0u; mine = 0u;
#pragma unroll
        for (unsigned j = 0; j < 16; ++j) { const unsigned c = xb_ld(&bar[XB_XCNT(j)]); sum += c; cnt += (c > 0u) ? 1u : 0u; mine = (j == x) ? c : mine; }
        if (sum == G) break;
        __builtin_amdgcn_s_sleep(1);
        if ((++sp & 255u) == 0u) { if (xb_ld(&bar[XB_TMO])) break; if (sp > XB_SPIN_CAP) { atomicAdd(&bar[XB_TMO], 1u); break; } }
    }
    nloc = mine > 0u ? mine : 1u; nx = cnt > 0u ? cnt : 1u;
}

__device__ __forceinline__ void xcd_barrier(const XcdBarrier& b) {
    asm volatile("s_waitcnt vmcnt(0)" ::: "memory");
    __syncthreads();
    if (threadIdx.x == 0) {
        unsigned* bar = b.bar;
        __builtin_amdgcn_s_waitcnt(0);
        unsigned nloc = b.st[0], nx = b.st[1];
        if (nloc == 0u) { xcd_barrier_complete(bar, b.x, nloc, nx); b.st[0] = nloc; b.st[1] = nx; }
        const unsigned old = xb_add(&bar[XB_XSUB(b.x)], 1u);
        const unsigned gen = old / nloc;
        if (old + 1u == (gen + 1u) * nloc) {
            __builtin_amdgcn_fence(__ATOMIC_RELEASE, "agent");
            asm volatile("s_waitcnt vmcnt(0)" ::: "memory");
            const unsigned og = xb_add(&bar[XB_TOP], 1u);
            const unsigned tg = og / nx;
            if (og + 1u == (tg + 1u) * nx) xb_add(&bar[XB_TOPGEN], 1u);
            else XB_SPIN(xb_ld(&bar[XB_TOPGEN]) == tg, bar);
            __builtin_amdgcn_fence(__ATOMIC_ACQUIRE, "agent");
            xb_add(&bar[XB_XGEN(b.x)], 1u);
            asm volatile("s_waitcnt vmcnt(0)" ::: "memory");
        } else {
            XB_SPIN(xb_ld(&bar[XB_XGEN(b.x)]) == gen, bar);
            __builtin_amdgcn_fence(__ATOMIC_ACQUIRE, "agent");
            asm volatile("s_waitcnt vmcnt(0)" ::: "memory");
        }
    }
    __syncthreads();
}


namespace pg8 {
constexpr int BM = 256, BK = 64, HALF = 128, HTB = HALF * BK * 2, NXCD = 8, WGM = 8;
__device__ __forceinline__ int lds_byte(int r, int c) { const int st = (r >> 4) * 2 + (c >> 5), rr = r & 15, cc = c & 31, ob = rr * 64 + cc * 2; return st * 1024 + (ob ^ (((ob >> 9) & 1) << 5)); }
__device__ __forceinline__ void stage_rc(int b, int& R, int& C) { const int st = b / 1024, sb = b % 1024, swz = sb ^ (((sb >> 9) & 1) << 5); R = (st >> 1) * 16 + swz / 64; C = (st & 1) * 32 + (swz % 64) / 2; }
struct Unit { int pm, pn; };
struct Order {
    int nM, nN, nwg, G, c;
    __device__ __forceinline__ bool next(int i, Unit& u) const {
        const long L = (long)i * G + c; if (L >= nwg) return false;
        int wgid = (int)L; { const int q = nwg / NXCD, r = nwg % NXCD, xcd = wgid % NXCD, off = wgid / NXCD; wgid = (xcd < r ? xcd * (q + 1) : r * (q + 1) + (xcd - r) * q) + off; }
        const int nig = WGM * nN, gid = wgid / nig, fm = gid * WGM, gsz = (nM - fm) < WGM ? (nM - fm) : WGM;
        u.pm = fm + ((wgid % nig) % gsz); u.pn = (wgid % nig) / gsz; return true;
    }
};

template <class Epi, bool LRU, bool BLK = false>
__device__ __forceinline__ void gemm_phase(LAS unsigned char* lds, const bf16_t* A, int lda, const bf16_t* Bt, int ldb, int nM, int nN, int K, const Epi& E) {
    const int tid = tidx(), wid = __builtin_amdgcn_readfirstlane(tid >> 6), lane = tid & 63, wr = wid >> 2, wc = wid & 3, fr = lane & 15, fq = lane >> 4;
    const int nt = K / BK;
    Order S; S.nM = nM; S.nN = nN; S.nwg = nM * nN; S.G = gdim(); S.c = bidx();
    unsigned voffA[2], voffB[2];
#pragma unroll
    for (int i = 0; i < 2; ++i) { int R, C; stage_rc(tid * 16 + i * 8192, R, C); voffA[i] = (unsigned)(R * (BLK ? 64 : lda) + C) * 2u; voffB[i] = (unsigned)(R * (BLK ? 64 : ldb) + C) * 2u; }
    const size_t kstep = BLK ? (size_t)32768 : (size_t)(BK * 2);
    const size_t hstepA = BLK ? (size_t)16384 : (size_t)HALF * lda * 2, hstepB = BLK ? (size_t)16384 : (size_t)HALF * ldb * 2;
    const size_t tstepA = BLK ? (size_t)nt * 32768 : 2 * hstepA, tstepB = BLK ? (size_t)nt * 32768 : 2 * hstepB;
    const unsigned ldsw = (unsigned)wid * 1024u;
    const int aoff = lds_byte(wr * 64 + fr, fq * 8), boff = lds_byte(wc * 32 + fr, fq * 8);
#define PG8_SA(b, h) (((b) * 2 + (h)) * HTB)
#define PG8_SB(b, h) ((4 + (b) * 2 + (h)) * HTB)
#define PG8_STAGE(bufoff, gbase, voff) do { _Pragma("unroll") for (int _i = 0; _i < 2; ++_i) \
        __builtin_amdgcn_global_load_lds((const unsigned*)((const char*)(gbase) + (voff)[_i]), (LAS unsigned*)(lds + (bufoff) + ldsw + _i * 8192), 16, 0, 0); } while (0)
#define PG8_LDA(dst, b, h) do { _Pragma("unroll") for (int m = 0; m < 4; ++m) _Pragma("unroll") for (int k = 0; k < 2; ++k) dst[m][k] = *(const LAS bf16x8*)(lds + PG8_SA(b, h) + aoff + m * 2048 + k * 1024); } while (0)
#define PG8_LDB(dst, b, h) do { _Pragma("unroll") for (int n = 0; n < 2; ++n) _Pragma("unroll") for (int k = 0; k < 2; ++k) dst[n][k] = *(const LAS bf16x8*)(lds + PG8_SB(b, h) + boff + n * 2048 + k * 1024); } while (0)
#define PG8_MMA(ai, bj, At, Bt_) do { __builtin_amdgcn_s_setprio(1); _Pragma("unroll") for (int m = 0; m < 4; ++m) _Pragma("unroll") for (int n = 0; n < 2; ++n) _Pragma("unroll") for (int k = 0; k < 2; ++k) \
        acc[ai][bj][m][n] = __builtin_amdgcn_mfma_f32_16x16x32_bf16(Bt_[n][k], At[m][k], acc[ai][bj][m][n], 0, 0, 0); __builtin_amdgcn_s_setprio(0); } while (0)
#define PG8_WAIT_V(n) asm volatile("s_waitcnt vmcnt(" #n ")" ::: "memory")
#define PG8_WAIT_L(n) asm volatile("s_waitcnt lgkmcnt(" #n ")" ::: "memory")
#define PG8_BAR __builtin_amdgcn_s_barrier()
#define PG8_SCHED __builtin_amdgcn_sched_barrier(0)
#define PG8_APTR(u) ((const char*)A + (size_t)(u).pm * tstepA + (LRU ? (size_t)((((u).pn >> 1) & 7) * 512) : (size_t)0))
#define PG8_BPTR(u) ((const char*)Bt + (size_t)(u).pn * tstepB)
    Unit cur, nxt; int ui = 0;
    if (!S.next(0, cur)) return;
    f32x4 acc[2][2][4][2];
#pragma unroll
    for (int a = 0; a < 2; ++a)
#pragma unroll
        for (int b = 0; b < 2; ++b)
#pragma unroll
            for (int m = 0; m < 4; ++m)
#pragma unroll
                for (int n = 0; n < 2; ++n) acc[a][b][m][n] = (f32x4){0.f, 0.f, 0.f, 0.f};
    bf16x8 At[4][2], B0[2][2], B1[2][2];
    const char* cA = PG8_APTR(cur); const char* cB = PG8_BPTR(cur);
    PG8_STAGE(PG8_SB(0, 0), cB, voffB); PG8_STAGE(PG8_SA(0, 0), cA, voffA); PG8_STAGE(PG8_SB(0, 1), cB + hstepB, voffB); PG8_STAGE(PG8_SA(0, 1), cA + hstepA, voffA);
    if (wr == 1) PG8_BAR;
    PG8_WAIT_V(4); PG8_BAR;
    PG8_STAGE(PG8_SB(1, 0), cB + kstep, voffB); PG8_STAGE(PG8_SA(1, 0), cA + kstep, voffA); PG8_STAGE(PG8_SB(1, 1), cB + hstepB + kstep, voffB);
    PG8_WAIT_V(6); PG8_BAR;
    for (;;) {
        const bool has_next = S.next(ui + 1, nxt);
        const char* nA = has_next ? PG8_APTR(nxt) : cA; const char* nB = has_next ? PG8_BPTR(nxt) : cB;
        for (int t = 0; t < nt; t += 2) {
            const bool last = (t == nt - 2);
            const char* a1 = cA + (size_t)(t + 1) * kstep;
            const char* a2 = last ? nA : cA + (size_t)(t + 2) * kstep; const char* b2 = last ? nB : cB + (size_t)(t + 2) * kstep;
            const char* a3 = a2 + kstep; const char* b3 = b2 + kstep;
            PG8_LDB(B0, 0, 0); PG8_SCHED; PG8_LDA(At, 0, 0); PG8_STAGE(PG8_SA(1, 1), a1 + hstepA, voffA);
            PG8_WAIT_L(8); PG8_BAR; PG8_WAIT_L(0); PG8_MMA(0, 0, At, B0); PG8_BAR; PG8_SCHED;
            PG8_LDB(B1, 0, 1); PG8_STAGE(PG8_SB(0, 0), b2, voffB);
            PG8_BAR; PG8_WAIT_L(0); PG8_MMA(0, 1, At, B1); PG8_BAR;
            PG8_LDA(At, 0, 1); PG8_STAGE(PG8_SA(0, 0), a2, voffA);
            PG8_BAR; PG8_WAIT_L(0); PG8_MMA(1, 0, At, B0); PG8_BAR; PG8_SCHED;
            PG8_STAGE(PG8_SB(0, 1), b2 + hstepB, voffB);
            PG8_WAIT_V(6); PG8_BAR; PG8_MMA(1, 1, At, B1); PG8_BAR;
            PG8_LDB(B0, 1, 0); PG8_SCHED; PG8_LDA(At, 1, 0); PG8_STAGE(PG8_SA(0, 1), a2 + hstepA, voffA);
            PG8_WAIT_L(8); PG8_BAR; PG8_WAIT_L(0); PG8_MMA(0, 0, At, B0); PG8_BAR; PG8_SCHED;
            PG8_LDB(B1, 1, 1); PG8_STAGE(PG8_SB(1, 0), b3, voffB);
            PG8_BAR; PG8_WAIT_L(0); PG8_MMA(0, 1, At, B1); PG8_BAR;
            PG8_LDA(At, 1, 1); PG8_STAGE(PG8_SA(1, 0), a3, voffA);
            PG8_BAR; PG8_WAIT_L(0); PG8_MMA(1, 0, At, B0); PG8_BAR; PG8_SCHED;
            PG8_STAGE(PG8_SB(1, 1), b3 + hstepB, voffB);
            PG8_WAIT_V(6); PG8_BAR; PG8_MMA(1, 1, At, B1); PG8_BAR;
        }
        E(acc, cur, wr, wc, fr, fq);
        if (!has_next) break;
#pragma unroll
        for (int a = 0; a < 2; ++a)
#pragma unroll
            for (int b = 0; b < 2; ++b)
#pragma unroll
                for (int m = 0; m < 4; ++m)
#pragma unroll
                    for (int n = 0; n < 2; ++n) acc[a][b][m][n] = (f32x4){0.f, 0.f, 0.f, 0.f};
        cur = nxt; cA = nA; cB = nB; ++ui;
    }
    PG8_WAIT_V(0);
    if (wr == 0) PG8_BAR;
    PG8_BAR;
#undef PG8_SA
#undef PG8_SB
#undef PG8_STAGE
#undef PG8_LDA
#undef PG8_LDB
#undef PG8_MMA
#undef PG8_WAIT_V
#undef PG8_WAIT_L
#undef PG8_BAR
#undef PG8_SCHED
#undef PG8_APTR
#undef PG8_BPTR
}
}
using pg8::Unit;

struct EpiSwiglu {
    bf16_t* H;
    __device__ __forceinline__ void operator()(const f32x4 (&acc)[2][2][4][2], const Unit& u, int wr, int wc, int fr, int fq) const {
        const int loff = (wr * 64 + fr) * 64 + (wc & 1) * 32 + 4 * fq;
        bf16_t* ub = H + ((size_t)(u.pm * 88 + u.pn * 2 + (wc >> 1)) * 256) * 64;
#pragma unroll
        for (int ai = 0; ai < 2; ++ai)
#pragma unroll
            for (int m = 0; m < 4; ++m) { bf16_t* rb = ub + (size_t)(ai * 128 + m * 16) * 64;
#pragma unroll
                for (int n = 0; n < 2; ++n) { const f32x4 a = acc[ai][0][m][n], b = acc[ai][1][m][n];
                    uint2 pk; pk.x = cvt_pk_bf16(siluf_(a[0]) * b[0], siluf_(a[1]) * b[1]); pk.y = cvt_pk_bf16(siluf_(a[2]) * b[2], siluf_(a[3]) * b[3]);
                    *(uint2*)(rb + loff + n * 16) = pk; } }
    }
};
struct EpiResid {
    float* X; const float* G; float coef; const float* XinC; const float* XinL;
    __device__ __forceinline__ void operator()(const f32x4 (&acc)[2][2][4][2], const Unit& u, int wr, int wc, int fr, int fq) const {
        const int lcol = wc * 32 + 4 * fq, loff = (wr * 64 + fr) * D + lcol;
        const float* g = G + (size_t)cond_of_pm(u.pm) * (9 * 2048) + u.pn * 256;
        float* ub = X + (size_t)u.pm * 256 * D + u.pn * 256;
        const float* ib = (u.pm < 16 ? XinC : XinL) + (size_t)u.pm * 256 * D + u.pn * 256;
        f32x4 gv[2][2];
#pragma unroll
        for (int bj = 0; bj < 2; ++bj)
#pragma unroll
            for (int n = 0; n < 2; ++n) gv[bj][n] = *(const f32x4*)(g + lcol + bj * 128 + n * 16) * coef;
#pragma unroll
        for (int ai = 0; ai < 2; ++ai)
#pragma unroll
            for (int mp = 0; mp < 4; mp += 2) { f32x4 xin[2][2][2];
#pragma unroll
                for (int m2 = 0; m2 < 2; ++m2) { const float* ir = ib + (size_t)(ai * 128 + (mp + m2) * 16) * D;
#pragma unroll
                    for (int bj = 0; bj < 2; ++bj)
#pragma unroll
                        for (int n = 0; n < 2; ++n) xin[m2][bj][n] = *(const f32x4*)(ir + loff + bj * 128 + n * 16); }
                __builtin_amdgcn_sched_barrier(0);
#pragma unroll
                for (int m2 = 0; m2 < 2; ++m2) { float* rb = ub + (size_t)(ai * 128 + (mp + m2) * 16) * D;
#pragma unroll
                    for (int bj = 0; bj < 2; ++bj)
#pragma unroll
                        for (int n = 0; n < 2; ++n) { *(f32x4*)(rb + loff + bj * 128 + n * 16) = xin[m2][bj][n] + gv[bj][n] * acc[ai][bj][mp + m2][n]; } }
                __builtin_amdgcn_sched_barrier(0); }
    }
};
struct EpiF32 {
    float* C; int ldc;
    __device__ __forceinline__ void operator()(const f32x4 (&acc)[2][2][4][2], const Unit& u, int wr, int wc, int fr, int fq) const {
        const int loff = (wr * 64 + fr) * ldc + wc * 32 + 4 * fq;
        float* ub = C + (size_t)u.pm * 256 * ldc + u.pn * 256;
#pragma unroll
        for (int ai = 0; ai < 2; ++ai)
#pragma unroll
            for (int m = 0; m < 4; ++m) { float* rb = ub + (size_t)(ai * 128 + m * 16) * ldc;
#pragma unroll
                for (int bj = 0; bj < 2; ++bj)
#pragma unroll
                    for (int n = 0; n < 2; ++n) *(f32x4*)(rb + loff + bj * 128 + n * 16) = acc[ai][bj][m][n]; }
    }
};
struct EpiBf16 {
    bf16_t* C; int ldc;
    __device__ __forceinline__ void operator()(const f32x4 (&acc)[2][2][4][2], const Unit& u, int wr, int wc, int fr, int fq) const {
        const int loff = (wr * 64 + fr) * ldc + wc * 32 + 4 * fq;
        bf16_t* ub = C + (size_t)u.pm * 256 * ldc + u.pn * 256;
#pragma unroll
        for (int ai = 0; ai < 2; ++ai)
#pragma unroll
            for (int m = 0; m < 4; ++m) { bf16_t* rb = ub + (size_t)(ai * 128 + m * 16) * ldc;
#pragma unroll
                for (int bj = 0; bj < 2; ++bj)
#pragma unroll
                    for (int n = 0; n < 2; ++n) { const f32x4 v = acc[ai][bj][m][n]; uint2 pk; pk.x = cvt_pk_bf16(v[0], v[1]); pk.y = cvt_pk_bf16(v[2], v[3]); *(uint2*)(rb + loff + bj * 128 + n * 16) = pk; } }
    }
};
struct EpiGlu {
    bf16_t* CAT; const bf16_t* YS; const float* bias;
    __device__ __forceinline__ void operator()(const f32x4 (&acc)[2][2][4][2], const Unit& u, int wr, int wc, int fr, int fq) const {
        const int lcol = wc * 32 + 4 * fq, loffY = (wr * 64 + fr) * 1024 + lcol, loffC = (wr * 64 + fr) * D + lcol;
        const float* bb = bias + u.pn * 256; const bf16_t* yb = YS + (size_t)u.pm * 256 * 1024 + u.pn * 256; bf16_t* cb = CAT + (size_t)u.pm * 256 * D + u.pn * 256;
        f32x4 bv[2][2];
#pragma unroll
        for (int bj = 0; bj < 2; ++bj)
#pragma unroll
            for (int n = 0; n < 2; ++n) bv[bj][n] = *(const f32x4*)(bb + lcol + bj * 128 + n * 16);
#pragma unroll
        for (int ai = 0; ai < 2; ++ai)
#pragma unroll
            for (int m = 0; m < 4; ++m) { const bf16_t* yr = yb + (size_t)(ai * 128 + m * 16) * 1024; bf16_t* cr = cb + (size_t)(ai * 128 + m * 16) * D;
#pragma unroll
                for (int bj = 0; bj < 2; ++bj)
#pragma unroll
                    for (int n = 0; n < 2; ++n) { const f32x4 ys = unpack4(*(const uint2*)(yr + loffY + bj * 128 + n * 16)); const f32x4 z = acc[ai][bj][m][n] + bv[bj][n];
                        uint2 pk; pk.x = cvt_pk_bf16(ys[0] * sigmoidf_(z[0]), ys[1] * sigmoidf_(z[1])); pk.y = cvt_pk_bf16(ys[2] * sigmoidf_(z[2]), ys[3] * sigmoidf_(z[3]));
                        *(uint2*)(cr + loffC + bj * 128 + n * 16) = pk; }
                __builtin_amdgcn_sched_barrier(0); }
    }
};
struct EpiLru {
    unsigned* LAB; const bf16_t* XC; const float* ba; const float* bx; const float* sp;
    __device__ __forceinline__ void operator()(const f32x4 (&acc)[2][2][4][2], const Unit& u, int wr, int wc, int fr, int fq) const {
        const int d = u.pn >> 4, h = (u.pn >> 1) & 7, half = u.pn & 1;
        const int chu = h * 256 + half * 128;
        const int lcol = wc * 32 + 4 * fq, loff = (wr * 64 + fr) * D + lcol;
        const bf16_t* xb = XC + (size_t)u.pm * 256 * D + chu; unsigned* lab = LAB + ((size_t)d * MTOK + u.pm * 256) * D + chu;
        f32x4 bav[2], bxv[2], spv[2];
#pragma unroll
        for (int n = 0; n < 2; ++n) { bav[n] = *(const f32x4*)(ba + d * D + chu + lcol + n * 16); bxv[n] = *(const f32x4*)(bx + d * D + chu + lcol + n * 16); spv[n] = *(const f32x4*)(sp + d * D + chu + lcol + n * 16); }
#pragma unroll
        for (int ai = 0; ai < 2; ++ai) { uint2 xw[4][2];
#pragma unroll
            for (int m = 0; m < 4; ++m)
#pragma unroll
                for (int n = 0; n < 2; ++n) xw[m][n] = *(const uint2*)(xb + (size_t)(ai * 128 + m * 16) * D + loff + n * 16);
            __builtin_amdgcn_sched_barrier(0);
#pragma unroll
            for (int m = 0; m < 4; ++m) { const size_t ro = (size_t)(ai * 128 + m * 16) * D;
#pragma unroll
                for (int n = 0; n < 2; ++n) { const f32x4 xc = unpack4(xw[m][n]);
                    const f32x4 rp = acc[ai][0][m][n] + bav[n], ip = acc[ai][1][m][n] + bxv[n]; uint4 w;
                    unsigned wv[4];
#pragma unroll
                    for (int e = 0; e < 4; ++e) { const float la = spv[n][e] * sigmoidf_(rp[e]); const float bb = __builtin_amdgcn_sqrtf(fmaxf(neg_expm1_(2.f * la), 0.f)) * (sigmoidf_(ip[e]) * xc[e]); wv[e] = cvt_pk_bf16(la, bb); }
                    w.x = wv[0]; w.y = wv[1]; w.z = wv[2]; w.w = wv[3];
                    *(uint4*)(lab + ro + loff + n * 16) = w; __builtin_amdgcn_sched_barrier(0); } } }
    }
};

struct CvtT { const float* src; bf16_t* dst; int K, ldsrc, Nsrc, n_dst0, n_src0, k0, blk; };
__device__ __forceinline__ void cvt_decode(PP p, unsigned char* ws, int t, int total, CvtT& c) {
    constexpr int T_FI = 176 * 32, T_FO = 32 * 88, T_EI = 68 * 32, T_EO = 32 * 32, T_GLU = 16 * 16, T_OI = 64 * 32, T_OO = 32 * 32, T_LRU = 4 * 4;
    c.blk = 0;
    if (t >= total) { c.src = nullptr; c.dst = nullptr; c.K = c.ldsrc = c.Nsrc = c.n_dst0 = c.n_src0 = c.k0 = 0; return; }
    if (t < 4 * T_FI) { const int w = t / T_FI; t %= T_FI; const int nt_ = t / 32, kt = t % 32; c.K = 2048; c.ldsrc = 11264; c.Nsrc = 11264; c.src = p->in[I_FWI] + (size_t)w * 2048 * 11264; c.dst = (bf16_t*)(ws + WS_WFI) + (size_t)w * 11264 * 2048;
        c.n_dst0 = nt_ * 64; const int j = c.n_dst0 >> 8, rr = c.n_dst0 & 255; c.n_src0 = rr < 128 ? j * 128 + rr : 5632 + j * 128 + (rr - 128); c.k0 = kt * 64; }
    else if ((t -= 4 * T_FI) < 4 * T_FO) { const int w = t / T_FO; t %= T_FO; const int nt_ = t / 88, kt = t % 88; c.K = 5632; c.ldsrc = 2048; c.Nsrc = 2048; c.src = p->in[I_FWO] + (size_t)w * 5632 * 2048; c.dst = (bf16_t*)(ws + WS_WFO) + (size_t)w * 2048 * 5632; c.n_dst0 = c.n_src0 = nt_ * 64; c.k0 = kt * 64; c.blk = 1; }
    else if ((t -= 4 * T_FO) < T_EI) { const int nt_ = t / 32, kt = t % 32; c.K = 2048; c.ldsrc = 4128; c.Nsrc = 4128; c.src = p->in[I_EVWI]; c.dst = (bf16_t*)(ws + WS_WEI); c.n_dst0 = c.n_src0 = nt_ * 64; c.k0 = kt * 64; }
    else if ((t -= T_EI) < T_EO) { const int nt_ = t / 32, kt = t % 32; c.K = 2048; c.ldsrc = 2048; c.Nsrc = 2048; c.src = p->in[I_EVWO]; c.dst = (bf16_t*)(ws + WS_WEO); c.n_dst0 = c.n_src0 = nt_ * 64; c.k0 = kt * 64; }
    else if ((t -= T_EO) < T_GLU) { const int nt_ = t / 16, kt = t % 16; c.K = 1024; c.ldsrc = 1024; c.Nsrc = 1024; c.src = p->in[I_GLUW]; c.dst = (bf16_t*)(ws + WS_WGLU); c.n_dst0 = c.n_src0 = nt_ * 64; c.k0 = kt * 64; }
    else if ((t -= T_GLU) < T_OI) { const int nt_ = t / 32, kt = t % 32; c.K = 2048; c.ldsrc = 4096; c.Nsrc = 4096; c.src = p->in[I_ODWI]; c.dst = (bf16_t*)(ws + WS_WOI); c.n_dst0 = c.n_src0 = nt_ * 64; c.k0 = kt * 64; }
    else if ((t -= T_OI) < T_OO) { const int nt_ = t / 32, kt = t % 32; c.K = 2048; c.ldsrc = 2048; c.Nsrc = 2048; c.src = p->in[I_ODWO]; c.dst = (bf16_t*)(ws + WS_WOO); c.n_dst0 = c.n_src0 = nt_ * 64; c.k0 = kt * 64; }
    else { t -= T_OO; const int mi = t / T_LRU; t %= T_LRU; const int which = mi >> 4, dh = mi & 15;
        const int nt_ = t / 4, kt = t % 4; c.K = 256; c.ldsrc = 256; c.Nsrc = 256; c.src = (which ? p->in[I_LWX] : p->in[I_LWA]) + (size_t)dh * 65536; c.dst = (bf16_t*)(ws + WS_WLRU) + (size_t)dh * 2 * 65536;
        c.n_src0 = nt_ * 64; const int half = c.n_src0 >> 7; c.n_dst0 = half * 256 + which * 128 + (c.n_src0 & 127); c.k0 = kt * 64; }
}
constexpr int CV_FI = 176 * 32, CV_FO = 32 * 88, CV_TOTAL = 4 * CV_FI + 4 * CV_FO + 68 * 32 + 32 * 32 + 16 * 16 + 64 * 32 + 32 * 32 + 32 * 16;
__device__ __forceinline__ void cvt_range(PP p, unsigned char* lds, int t_lo, int t_hi, int rank, int n) {
    const int tid = tidx(); unsigned char* ws = p->ws; float* tile = (float*)lds;
    for (int g0 = t_lo + rank * 4; g0 < t_hi; g0 += n * 4) {
        f32x4 v[4][2];
#pragma unroll
        for (int q = 0; q < 4; ++q) { CvtT c; cvt_decode(p, ws, g0 + q, t_hi, c);
#pragma unroll
            for (int h = 0; h < 2; ++h) { const int kk = (tid >> 4) + h * 32, n4 = (tid & 15) * 4; const int ns = c.n_src0 + n4;
                v[q][h] = (f32x4){0.f, 0.f, 0.f, 0.f}; if (ns < c.Nsrc) v[q][h] = __builtin_nontemporal_load((const f32x4*)(c.src + (size_t)(c.k0 + kk) * c.ldsrc + ns)); } }
        __syncthreads();
#pragma unroll
        for (int q = 0; q < 4; ++q)
#pragma unroll
            for (int h = 0; h < 2; ++h) { const int kk = (tid >> 4) + h * 32, n4 = (tid & 15) * 4; float* tp = tile + q * 4160 + kk * 65 + n4; tp[0] = v[q][h][0]; tp[1] = v[q][h][1]; tp[2] = v[q][h][2]; tp[3] = v[q][h][3]; }
        __syncthreads();
#pragma unroll
        for (int q = 0; q < 4; ++q) { CvtT c; cvt_decode(p, ws, g0 + q, t_hi, c);
            if (c.dst) { const int nn = tid >> 3, k8 = (tid & 7) * 8; f32x4 a, b2; const float* tp = tile + q * 4160;
#pragma unroll
                for (int j = 0; j < 4; ++j) { a[j] = tp[(k8 + j) * 65 + nn]; b2[j] = tp[(k8 + 4 + j) * 65 + nn]; }
                const int n_ = c.n_dst0 + nn; bf16_t* dp = c.blk ? c.dst + ((size_t)((n_ >> 8) * (c.K >> 6) + (c.k0 >> 6)) * 256 + (n_ & 255)) * 64 + k8 : c.dst + (size_t)n_ * c.K + c.k0 + k8;
                *(bf16x8*)dp = pack8(a, b2); } }
    }
}
__device__ __forceinline__ void mod_items(PP p, unsigned char* lds, int it_lo, int it_hi, int rank, int n) {
    const int tid = tidx(); unsigned char* ws = p->ws;
    float* sc = (float*)lds;
    __syncthreads();
    for (int i = tid; i < 3 * 2048; i += 512) { const int ci = i >> 11, k = i & 2047; const float v = ci == 0 ? p->in[I_CCTX][k] : p->in[I_C][(ci - 1) * 2048 + k]; sc[i] = siluf_(v); }
    __syncthreads();
    float* MOD = (float*)(ws + WS_MOD);
    for (int it = it_lo + rank; it < it_hi; it += n) { const int l = it / 288, r = it % 288, chunk = r / 32, ks = r % 32; const int col = chunk * 2048 + tid * 4;
        const float* W = p->in[I_ADAW] + (size_t)l * 2048 * 18432 + (size_t)(ks * 64) * 18432 + col;
        f32x4 a0 = (f32x4){0.f, 0.f, 0.f, 0.f}, a1 = a0, a2 = a0;
#pragma unroll 8
        for (int k = 0; k < 64; ++k) { const f32x4 w = __builtin_nontemporal_load((const f32x4*)(W + (size_t)k * 18432)); const int kk = ks * 64 + k; a0 += w * sc[kk]; a1 += w * sc[2048 + kk]; a2 += w * sc[4096 + kk]; }
        if (ks == 0) { const f32x4 bb = *(const f32x4*)(p->in[I_ADAB] + (size_t)l * 18432 + col); a0 += bb; a1 += bb; a2 += bb; }
        float* m0 = MOD + (size_t)(l * 3) * 18432 + col;
#pragma unroll
        for (int e = 0; e < 4; ++e) { atomicAdd(m0 + e, a0[e]); atomicAdd(m0 + 18432 + e, a1[e]); atomicAdd(m0 + 2 * 18432 + e, a2[e]); } }
    __syncthreads();
}
__device__ void phase_prep(PP p, LAS unsigned char* ldsr, int skip_mod) {
    unsigned char* lds = (unsigned char*)ldsr;
    const int tid = tidx(), bid = bidx(), nb = gdim();
    unsigned char* ws = p->ws;
    if (!skip_mod) mod_items(p, lds, 0, 288, bid, nb);
    cvt_range(p, lds, 0, CV_FI, bid, nb);
}
__device__ void bg_convert(PP p, LAS unsigned char* ldsr, int ph) {
    unsigned char* lds = (unsigned char*)ldsr; const int bid = bidx();
    constexpr int S0 = 4 * CV_FI + 4 * CV_FO, S_EI = S0, S_EO = S_EI + 2176, S_OI = S_EO + 1024 + 256, S_OO = S_OI + 2048;
    __syncthreads();
    if (ph == 2) { if (bid >= 32) { cvt_range(p, lds, 4 * CV_FI, 4 * CV_FI + CV_FO, bid - 32, 224); cvt_range(p, lds, S_EI, S_EO, bid - 32, 224); } }
    else if (ph == 3) { if (bid >= 192) cvt_range(p, lds, CV_FI, 2 * CV_FI, bid - 192, 64); }
    else if (ph == 5) { if (bid >= 152) cvt_range(p, lds, S_EO, S_OO, bid - 152, 104); }
    else if (ph == 8) { if (bid >= 96) cvt_range(p, lds, 4 * CV_FI + CV_FO, 4 * CV_FI + 2 * CV_FO, bid - 96, 160); }
    else if (ph == 9) { if (bid >= 192) cvt_range(p, lds, S_OO, CV_TOTAL, bid - 192, 64); }
    else if (ph == 11) { if (bid >= 32) cvt_range(p, lds, 2 * CV_FI, 3 * CV_FI, bid - 32, 224); }
    else if (ph == 12) { if (bid >= 192) { mod_items(p, lds, 288, 448, bid - 192, 64); cvt_range(p, lds, 4 * CV_FI + 2 * CV_FO, 4 * CV_FI + 3 * CV_FO, bid - 192, 64); } }
    else if (ph == 14) { if (bid >= 32) cvt_range(p, lds, 3 * CV_FI, 4 * CV_FI, bid - 32, 224); }
    else if (ph == 15) { if (bid >= 192) { cvt_range(p, lds, 4 * CV_FI + 3 * CV_FO, 4 * CV_FI + 4 * CV_FO, bid - 192, 64); mod_items(p, lds, 448, 576, bid - 192, 64); } }
}

__device__ void phase_norm(PP p, int l, int j  ) {
    const int tid = tidx(), lane = tid & 63, wid = tid >> 6; const int gw = bidx() * 8 + wid, nw = gdim() * 8;
    const float* X = (const float*)(p->ws + WS_X); bf16_t* HM = (bf16_t*)(p->ws + WS_HM);
    const float* g = j < 0 ? p->in[I_FNG] : p->in[I_NORMG] + (size_t)(l * 3 + j) * D;
    const bool from_in = (l == 0 && j == 0);
    for (int r = gw; r < MTOK; r += nw) {
        const float* xr = from_in ? (r < TCTX ? p->in[I_XP] + (size_t)r * D : p->in[I_XS] + (size_t)(r - TCTX) * D) : X + (size_t)r * D; f32x4 v[8]; float ss = 0.f;
#pragma unroll
        for (int i = 0; i < 8; ++i) { v[i] = *(const f32x4*)(xr + lane * 4 + i * 256); ss += v[i][0] * v[i][0] + v[i][1] * v[i][1] + v[i][2] * v[i][2] + v[i][3] * v[i][3]; }
#pragma unroll
        for (int o = 32; o >= 1; o >>= 1) ss += __shfl_xor(ss, o);
        const float rinv = rsqrtf(ss * (1.f / D) + EPS);
        if (j < 0) { float* o = p->out + OUT_Y + (size_t)r * D;
#pragma unroll
            for (int i = 0; i < 8; ++i) { const int c = lane * 4 + i * 256; const f32x4 gg = *(const f32x4*)(g + c); *(f32x4*)(o + c) = v[i] * rinv * gg; } }
        else { const float* mod = (const float*)(p->ws + WS_MOD) + (size_t)(l * 3 + cond_of_row(r)) * 18432; const float* sh = mod + (3 * j) * 2048; const float* scl = mod + (3 * j + 1) * 2048;
#pragma unroll
            for (int i = 0; i < 8; ++i) { const int c = lane * 4 + i * 256; const f32x4 gg = *(const f32x4*)(g + c), s1 = *(const f32x4*)(scl + c), s0 = *(const f32x4*)(sh + c);
                const f32x4 y = (v[i] * rinv * gg) * (s1 + 1.f) + s0; uint2 pk; pk.x = cvt_pk_bf16(y[0], y[1]); pk.y = cvt_pk_bf16(y[2], y[3]); *(uint2*)(HM + (size_t)r * D + c) = pk; } }
    }
}

__device__ __forceinline__ void seq_info(int s, int& L, int& row0) { if (s < 16) { L = 256; row0 = s * 256; } else { L = 1024; row0 = TCTX + (s - 16) * 1024; } }

#define WAVE_LDS_SYNC() asm volatile("s_waitcnt lgkmcnt(0)" ::: "memory")
__device__ __forceinline__ void s5_item(PP p, unsigned char* lds, int s, int d, int gg) {
    const int tid = tidx(), lane = tid & 63, wid = tid >> 6, fr = lane & 15, fq = lane >> 4; const int g = gg * 8 + wid;
    int L, row0; seq_info(s, L, row0);
    float* HS = (float*)(lds + wid * 8448);
    const bf16_t* PROJ = (const bf16_t*)(p->ws + WS_PROJ); float* Y = (float*)(p->ws + WS_YS5) + (size_t)d * MTOK * 1024;
    const int pg0 = (d * 64 + g) * 64, pg = pg0 + lane;
    const float lre = p->in[I_LAMRE][pg], lim = p->in[I_LAMIM][pg], dt = expf(p->in[I_LOGSTEP][d * 64 + g]);
    const float mag = expf(lre * dt); float sn, cs; sincosf(lim * dt, &sn, &cs);
    const float abr = mag * cs, abi = mag * sn, den = lre * lre + lim * lim, nre = abr - 1.f;
    const float fre = (nre * lre + abi * lim) / den, fim = (abi * lre - nre * lim) / den;
    bf16x8 af[8];
#pragma unroll
    for (int tq = 0; tq < 4; ++tq) { const int src = tq * 16 + fr; const float f_r = __shfl(fre, src), f_i = __shfl(fim, src);
        f32x4 r0 = (f32x4){0.f, 0.f, 0.f, 0.f}, r1 = r0, i0 = r0, i1 = r0;
        if (fq < 2) { const float* br = p->in[I_BRE] + (size_t)(pg0 + src) * 16 + fq * 8; const float* bi = p->in[I_BIM] + (size_t)(pg0 + src) * 16 + fq * 8;
            r0 = *(const f32x4*)br; r1 = *(const f32x4*)(br + 4); i0 = *(const f32x4*)bi; i1 = *(const f32x4*)(bi + 4); }
        af[tq] = pack8(r0 * f_r - i0 * f_i, r1 * f_r - i1 * f_i); af[tq + 4] = pack8(i0 * f_r + r0 * f_i, i1 * f_r + r1 * f_i); }
    bf16x8 cf[4];
#pragma unroll
    for (int kk = 0; kk < 4; ++kk) { const float* cp = (kk < 2 ? p->in[I_CRE] : p->in[I_CIM]) + ((size_t)(d * 64 + g) * 16 + fr) * 64 + (kk & 1) * 32 + fq * 8;
        f32x4 a = *(const f32x4*)cp, b = *(const f32x4*)(cp + 4); if (kk >= 2) { a = -a; b = -b; } cf[kk] = pack8(a, b); }
    float hr = 0.f, hi = 0.f;
    if (s >= 16) { const size_t o = ((size_t)((s - 16) * 2 + d) * 64 + g) * 64 + lane; hr = p->in[I_S5RE][o]; hi = p->in[I_S5IM][o]; }
    const f32x4 z4 = (f32x4){0.f, 0.f, 0.f, 0.f};
    bf16x8 un = (bf16x8){0, 0, 0, 0, 0, 0, 0, 0};
#define S5_LOADU(c0_) do { if (fq < 2) { const int row_ = row0 + (d ? L - 1 - ((c0_) + fr) : (c0_) + fr); un = *(const bf16x8*)(PROJ + (size_t)row_ * EVINP + g * 16 + fq * 8); } } while (0)
    S5_LOADU(0);
    __syncthreads();
    for (int c0 = 0; c0 < L; c0 += 16) {
        const bf16x8 ub = un;
        if (c0 + 16 < L) S5_LOADU(c0 + 16);
#pragma unroll
        for (int t8 = 0; t8 < 8; ++t8) { const f32x4 bu = __builtin_amdgcn_mfma_f32_16x16x32_bf16(af[t8], ub, z4, 0, 0, 0); *(f32x4*)(HS + fr * 132 + t8 * 16 + fq * 4) = bu; }
        WAVE_LDS_SYNC();
#pragma unroll
        for (int i = 0; i < 16; ++i) { const float bur = HS[i * 132 + lane], bui = HS[i * 132 + 64 + lane];
            const float nr = abr * hr - abi * hi + bur, ni = abr * hi + abi * hr + bui; hr = nr; hi = ni;
            HS[i * 132 + lane] = hr; HS[i * 132 + 64 + lane] = hi; }
        WAVE_LDS_SYNC();
        { f32x4 acc = z4;
#pragma unroll
          for (int kk = 0; kk < 4; ++kk) { const float* hp = HS + fr * 132 + kk * 32 + fq * 8; const bf16x8 hb = pack8(*(const f32x4*)hp, *(const f32x4*)(hp + 4));
              acc = __builtin_amdgcn_mfma_f32_16x16x32_bf16(cf[kk], hb, acc, 0, 0, 0); }
          const int row = row0 + (d ? L - 1 - (c0 + fr) : c0 + fr);
          *(f32x4*)(Y + (size_t)row * 1024 + g * 16 + fq * 4) = acc; }
        WAVE_LDS_SYNC();
    }
#undef S5_LOADU
    if (s < 16) { const size_t o = ((size_t)(s * 2 + d) * 64 + g) * 64 + lane; p->out[OUT_S5RE + o] = hr; p->out[OUT_S5IM + o] = hi; }
}

template <int NK32> __device__ __forceinline__ f32x4 mma_lds(f32x4 acc, const bf16_t* X, int ldx, const bf16_t* Y, int ldy, int lane) {
    const bf16_t* xp = X + (lane & 15) * ldx + (lane >> 4) * 8; const bf16_t* yp = Y + (lane & 15) * ldy + (lane >> 4) * 8;
#pragma unroll
    for (int kk = 0; kk < NK32; ++kk) acc = __builtin_amdgcn_mfma_f32_16x16x32_bf16(*(const bf16x8*)(xp + kk * 32), *(const bf16x8*)(yp + kk * 32), acc, 0, 0, 0);
    return acc;
}

__device__ __forceinline__ void gla_item(PP p, unsigned char* lds, int s, int h, int d, int vh) {
    const int tid = tidx(), lane = tid & 63, wid = tid >> 6, fr = lane & 15, fq = lane >> 4;
    int L, row0; seq_info(s, L, row0);
    bf16_t* QT = (bf16_t*)(lds);
    bf16_t* KT = (bf16_t*)(lds + 17408);
    bf16_t* KE = (bf16_t*)(lds + 34816);
    bf16_t* VT = (bf16_t*)(lds + 53248);
    bf16_t* ATT = (bf16_t*)(lds + 71680);
    bf16_t* ST = (bf16_t*)(lds + 80896);
    float* LOGA = (float*)(lds + 80896);
    float* SEG = (float*)(lds + 115712);
    float* GLR = (float*)(lds + 117760);
    float* W2S = (float*)(lds + 121856);
    float* GBS = (float*)(lds + 130048);
    float* DEC = (float*)(lds + 130560);
    const bf16_t* PROJ = (const bf16_t*)(p->ws + WS_PROJ); float* O = (float*)(p->ws + WS_OGLA) + (size_t)d * MTOK * 1024;
    __syncthreads();
    for (int i = tid; i < 16 * 128; i += 512) W2S[i] = p->in[I_GW2][(size_t)(d * 16 + (i >> 7)) * 512 + h * 128 + (i & 127)];
    if (tid < 128) GBS[tid] = p->in[I_GB][d * 512 + h * 128 + tid];
    f32x4 sacc[8];
#pragma unroll
    for (int tn = 0; tn < 8; ++tn) { sacc[tn] = (f32x4){0.f, 0.f, 0.f, 0.f};
        if (s >= 16) { const float* sp = p->in[I_SGLA] + ((size_t)(((s - 16) * 2 + d) * 4 + h) * 128 + wid * 16 + fq * 4) * 256 + vh * 128 + tn * 16 + fr;
#pragma unroll
            for (int e = 0; e < 4; ++e) sacc[tn][e] = sp[(size_t)e * 256]; } }
    const float qscale = 0.08838834764831845f;
    const int nch = L >> 6;
    const int c = tid & 127, ig = tid >> 7;
#define GROW(n_, i) (row0 + (d ? L - 1 - ((n_) * 64 + (i)) : (n_) * 64 + (i)))
    f32x4 glr4 = (f32x4){0.f, 0.f, 0.f, 0.f}; float qv[16], kv[16], vv[16];
#define GLA_PREFETCH(n_) do { \
        if (tid < 256) glr4 = unpack4(*(const uint2*)(PROJ + (size_t)GROW(n_, tid >> 2) * EVINP + 4096 + d * 16 + (tid & 3) * 4)); \
        _Pragma("unroll") for (int ii = 0; ii < 16; ++ii) { const size_t ro = (size_t)GROW(n_, ig * 16 + ii) * EVINP; \
            qv[ii] = bf2f_(PROJ[ro + 1024 + h * 128 + c]); kv[ii] = bf2f_(PROJ[ro + 1536 + h * 128 + c]); vv[ii] = bf2f_(PROJ[ro + 2048 + h * 256 + vh * 128 + c]); } } while (0)
    GLA_PREFETCH(0);
    for (int n = 0; n < nch; ++n) {
        __syncthreads();
        if (tid < 256) *(f32x4*)(GLR + (tid >> 2) * 16 + (tid & 3) * 4) = glr4;
        __syncthreads();
        { float run = 0.f; const float gb = GBS[c];
          float w2[16];
#pragma unroll
          for (int r = 0; r < 16; ++r) w2[r] = W2S[r * 128 + c];
          for (int ii = 0; ii < 16; ++ii) { const int i = ig * 16 + ii; float z = gb;
#pragma unroll
              for (int q = 0; q < 4; ++q) { const f32x4 g4 = *(const f32x4*)(GLR + i * 16 + q * 4);
#pragma unroll
                  for (int e = 0; e < 4; ++e) z += g4[e] * w2[q * 4 + e]; }
              run -= (fmaxf(-z, 0.f) + __logf(1.f + __expf(-fabsf(z)))) * (1.f / 16.f); LOGA[i * 128 + c] = run; }
          SEG[ig * 128 + c] = run; }
        __syncthreads();
        { float pre = 0.f, tot = 0.f;
#pragma unroll
          for (int q = 0; q < 4; ++q) { const float sg = SEG[q * 128 + c]; tot += sg; if (q < ig) pre += sg; }
          if (ig == 0) DEC[c] = __expf(tot);
#pragma unroll
          for (int ii = 0; ii < 16; ++ii) { const int i = ig * 16 + ii; const float bc = LOGA[i * 128 + c] + pre;
              QT[i * 136 + c] = f2bf(qv[ii] * qscale * __expf(bc)); KT[i * 136 + c] = f2bf(kv[ii] * __expf(-bc)); KE[c * 72 + i] = f2bf(kv[ii] * __expf(tot - bc)); VT[c * 72 + i] = f2bf(vv[ii]); } }
        __syncthreads();
        if (n + 1 < nch) GLA_PREFETCH(n + 1);
#pragma unroll
        for (int q = 0; q < 2; ++q) { const int tile = wid * 2 + q, ti = tile >> 2, tj = tile & 3; f32x4 a = (f32x4){0.f, 0.f, 0.f, 0.f};
            if (tj <= ti) a = mma_lds<4>(a, QT + ti * 16 * 136, 136, KT + tj * 16 * 136, 136, lane);
#pragma unroll
            for (int e = 0; e < 4; ++e) { const int i = ti * 16 + fq * 4 + e, jx = tj * 16 + fr; ATT[i * 72 + jx] = f2bf(jx <= i ? a[e] : 0.f); } }
#pragma unroll
        for (int tn = 0; tn < 8; ++tn) { uint2 pk; pk.x = cvt_pk_bf16(sacc[tn][0], sacc[tn][1]); pk.y = cvt_pk_bf16(sacc[tn][2], sacc[tn][3]); *(uint2*)(ST + (tn * 16 + fr) * 136 + wid * 16 + fq * 4) = pk; }
        __syncthreads();
#pragma unroll
        for (int ti = 0; ti < 4; ++ti) { f32x4 o = (f32x4){0.f, 0.f, 0.f, 0.f};
            o = mma_lds<2>(o, ATT + ti * 16 * 72, 72, VT + wid * 16 * 72, 72, lane);
            o = mma_lds<4>(o, QT + ti * 16 * 136, 136, ST + wid * 16 * 136, 136, lane);
#pragma unroll
            for (int e = 0; e < 4; ++e) { const int i = ti * 16 + fq * 4 + e; O[(size_t)GROW(n, i) * 1024 + h * 256 + vh * 128 + wid * 16 + fr] = o[e]; } }
        { f32x4 dc;
#pragma unroll
          for (int e = 0; e < 4; ++e) dc[e] = DEC[wid * 16 + fq * 4 + e];
#pragma unroll
          for (int tn = 0; tn < 8; ++tn) { sacc[tn] = sacc[tn] * dc; sacc[tn] = mma_lds<2>(sacc[tn], KE + wid * 16 * 72, 72, VT + tn * 16 * 72, 72, lane); } }
    }
#undef GROW
#undef GLA_PREFETCH
    if (s < 16) {
#pragma unroll
        for (int tn = 0; tn < 8; ++tn) { float* sp = p->out + OUT_GLA + ((size_t)((s * 2 + d) * 4 + h) * 128 + wid * 16 + fq * 4) * 256 + vh * 128 + tn * 16 + fr;
#pragma unroll
            for (int e = 0; e < 4; ++e) sp[(size_t)e * 256] = sacc[tn][e]; } }
}

__device__ void phase_s5gla(PP p, LAS unsigned char* ldsr) {
    unsigned char* lds = (unsigned char*)ldsr; const int bid = bidx(), nb = gdim();
    if (nb >= 64) {
        if (bid < 32) { gla_item(p, lds, 16 + (bid >> 4), (bid >> 2) & 3, (bid >> 1) & 1, bid & 1); return; }
        for (int it = bid - 32; it < 544; it += nb - 32) {
            if (it < 32) s5_item(p, lds, 16 + (it >> 4), (it >> 3) & 1, it & 7);
            else if (it < 288) { const int q = it - 32; s5_item(p, lds, q >> 4, (q >> 3) & 1, q & 7); }
            else { const int q = it - 288; gla_item(p, lds, q >> 4, (q >> 2) & 3, (q >> 1) & 1, q & 1); }
        }
    } else {
        for (int it = bid; it < 576; it += nb) {
            if (it < 32) { gla_item(p, lds, 16 + (it >> 4), (it >> 2) & 3, (it >> 1) & 1, it & 1); }
            else if (it < 64) { const int q = it - 32; s5_item(p, lds, 16 + (q >> 4), (q >> 3) & 1, q & 7); }
            else if (it < 320) { const int q = it - 64; s5_item(p, lds, q >> 4, (q >> 3) & 1, q & 7); }
            else { const int q = it - 320; gla_item(p, lds, q >> 4, (q >> 2) & 3, (q >> 1) & 1, q & 1); }
        }
    }
}

__device__ void phase_evpost(PP p) {
    const int tid = tidx(), lane = tid & 63, wid = tid >> 6; const int gw = bidx() * 8 + wid, nw = gdim() * 8;
    const bf16_t* PROJ = (const bf16_t*)(p->ws + WS_PROJ); const float* Y0 = (const float*)(p->ws + WS_YS5); const float* Y1 = Y0 + (size_t)MTOK * 1024;
    const float* O0 = (const float*)(p->ws + WS_OGLA); const float* O1 = O0 + (size_t)MTOK * 1024;
    bf16_t* YSB = (bf16_t*)(p->ws + WS_YSB); bf16_t* CAT = (bf16_t*)(p->ws + WS_CAT);
    for (int r = gw; r < MTOK; r += nw) {
        f32x4 y0[4], y1[4], o0[4], o1[4]; uint2 uw[4], gw4[4];
        const int c0 = lane * 16;
#pragma unroll
        for (int i = 0; i < 4; ++i) { const int c = lane * 4 + i * 256; y0[i] = *(const f32x4*)(Y0 + (size_t)r * 1024 + c); y1[i] = *(const f32x4*)(Y1 + (size_t)r * 1024 + c); uw[i] = *(const uint2*)(PROJ + (size_t)r * EVINP + c);
            o0[i] = *(const f32x4*)(O0 + (size_t)r * 1024 + c0 + i * 4); o1[i] = *(const f32x4*)(O1 + (size_t)r * 1024 + c0 + i * 4); gw4[i] = *(const uint2*)(PROJ + (size_t)r * EVINP + 3072 + c0 + i * 4); }
#pragma unroll
        for (int i = 0; i < 4; ++i) { const int c = lane * 4 + i * 256; const f32x4 u = unpack4(uw[i]), dd = *(const f32x4*)(p->in[I_S5D] + c); f32x4 v = y0[i] + y1[i] + dd * u;
#pragma unroll
            for (int e = 0; e < 4; ++e) v[e] = geluf_(v[e]);
            uint2 pk; pk.x = cvt_pk_bf16(v[0], v[1]); pk.y = cvt_pk_bf16(v[2], v[3]); *(uint2*)(YSB + (size_t)r * 1024 + c) = pk; }
        { f32x4 o[4]; float ss = 0.f;
#pragma unroll
          for (int i = 0; i < 4; ++i) { o[i] = o0[i] + o1[i]; ss += o[i][0] * o[i][0] + o[i][1] * o[i][1] + o[i][2] * o[i][2] + o[i][3] * o[i][3]; }
#pragma unroll
          for (int m = 8; m >= 1; m >>= 1) ss += __shfl_xor(ss, m);
          const float rinv = rsqrtf(ss * (1.f / 256.f) + EPS);
#pragma unroll
          for (int i = 0; i < 4; ++i) { const int c = c0 + i * 4; const f32x4 ng = *(const f32x4*)(p->in[I_GNG] + (c & 255)), gt = unpack4(gw4[i]); f32x4 v;
#pragma unroll
              for (int e = 0; e < 4; ++e) v[e] = o[i][e] * rinv * ng[e] * siluf_(gt[e]);
              uint2 pk; pk.x = cvt_pk_bf16(v[0], v[1]); pk.y = cvt_pk_bf16(v[2], v[3]); *(uint2*)(CAT + (size_t)r * D + 1024 + c) = pk; } }
    }
}

__device__ void phase_conv(PP p) {
    const bf16_t* PROJ = (const bf16_t*)(p->ws + WS_PROJ); bf16_t* XCB = (bf16_t*)(p->ws + WS_XCB);
    const float* cw = p->in[I_CONVW]; const float* cb = p->in[I_CONVB];
    const size_t total = (size_t)MTOK * 512;
    { const int gi = bidx() * 512 + tidx(); if (gi < 2 * D) ((float*)(p->ws + WS_SP))[gi] = -8.f * softplusf_(-p->in[I_LLAM][gi]); }
    for (size_t i = (size_t)bidx() * 512 + tidx(); i < total; i += (size_t)gdim() * 512) {
        const int r = (int)(i >> 9), c = (int)(i & 511) * 4; const int seg = r < TCTX ? 256 : 64; const int pos = r & (seg - 1);
        f32x4 acc = *(const f32x4*)(cb + c);
#pragma unroll
        for (int j = 0; j < 4; ++j) { const int pp = pos + j - 2; if (pp >= 0 && pp < seg) acc += *(const f32x4*)(cw + j * D + c) * unpack4(*(const uint2*)(PROJ + (size_t)(r + j - 2) * 4096 + 2048 + c)); }
        uint2 pk; pk.x = cvt_pk_bf16(acc[0], acc[1]); pk.y = cvt_pk_bf16(acc[2], acc[3]); *(uint2*)(XCB + (size_t)r * D + c) = pk;
    }
}
__device__ void phase_lruscan1(PP p) {
    const int tid = tidx(), lane = tid & 63, wid = tid >> 6; const int nb = gdim();
    float* SUM = (float*)(p->ws + WS_LSUM);
    for (int it = bidx() * 8 + wid; it < 384 * 64; it += 8 * nb) {
        const int q = it >> 6, d = (it >> 5) & 1, c = (it & 31) * 64 + lane; const int row0 = q * 16;
        const unsigned* LAB = (const unsigned*)(p->ws + WS_LA) + ((size_t)d * MTOK + row0) * D + c;
        unsigned wv[16];
#pragma unroll
        for (int j = 0; j < 16; ++j) wv[j] = LAB[(size_t)j * D];
        float S = 0.f, h = 0.f;
        if (d == 0) {
#pragma unroll
            for (int j = 0; j < 16; ++j) { const float la = lo_bf(wv[j]); h = __expf(la) * h + hi_bf(wv[j]); S += la; } }
        else {
#pragma unroll
            for (int j = 15; j >= 0; --j) { const float la = lo_bf(wv[j]); h = __expf(la) * h + hi_bf(wv[j]); S += la; } }
        SUM[((size_t)d * 384 + q) * D + c] = __expf(S); SUM[((size_t)(2 + d) * 384 + q) * D + c] = h;
    }
}
__device__ void conv_tile(PP p, int pm, int pnx) {
    const int tid = tidx();
    const bf16_t* PROJ = (const bf16_t*)(p->ws + WS_PROJ); bf16_t* XCB = (bf16_t*)(p->ws + WS_XCB); const float* cw = p->in[I_CONVW]; const float* cb = p->in[I_CONVB];
    const int c = pnx * 256 + (tid & 63) * 4; const int rl0 = tid >> 6;
    f32x4 w[4]; const f32x4 bias = *(const f32x4*)(cb + c);
#pragma unroll
    for (int j = 0; j < 4; ++j) w[j] = *(const f32x4*)(cw + j * D + c);
    for (int kb = 0; kb < 32; kb += 4) {
        uint2 t[4][4];
#pragma unroll
        for (int u = 0; u < 4; ++u) { const int r = pm * 256 + rl0 + 8 * (kb + u); const int seg = r < TCTX ? 256 : 64; const int pos = r & (seg - 1);
#pragma unroll
            for (int j = 0; j < 4; ++j) { const int pp = pos + j - 2; t[u][j] = (uint2){0u, 0u}; if (pp >= 0 && pp < seg) t[u][j] = *(const uint2*)(PROJ + (size_t)(r + j - 2) * 4096 + 2048 + c); } }
#pragma unroll
        for (int u = 0; u < 4; ++u) { const int r = pm * 256 + rl0 + 8 * (kb + u); f32x4 acc = bias;
#pragma unroll
            for (int j = 0; j < 4; ++j) acc += w[j] * unpack4(t[u][j]);
            uint2 pk; pk.x = cvt_pk_bf16(acc[0], acc[1]); pk.y = cvt_pk_bf16(acc[2], acc[3]); *(uint2*)(XCB + (size_t)r * D + c) = pk; } }
}
__device__ void scan1_tile(PP p, int pm, int pn) {
    const int tid = tidx(); const int d = pn >> 4, chu = ((pn >> 1) & 7) * 256 + (pn & 1) * 128; float* SUM = (float*)(p->ws + WS_LSUM);
    const int c = chu + (tid & 127);
    unsigned wv[4][16];
#pragma unroll
    for (int k = 0; k < 4; ++k) { const int q = pm * 16 + (tid >> 7) + 4 * k; const unsigned* LAB = (const unsigned*)(p->ws + WS_LA) + ((size_t)d * MTOK + q * 16) * D + c;
#pragma unroll
        for (int j = 0; j < 16; ++j) wv[k][j] = LAB[(size_t)j * D]; }
#pragma unroll
    for (int k = 0; k < 4; ++k) { const int q = pm * 16 + (tid >> 7) + 4 * k; float S = 0.f, h = 0.f;
        if (d == 0) {
#pragma unroll
            for (int j = 0; j < 16; ++j) { const float la = lo_bf(wv[k][j]); h = __expf(la) * h + hi_bf(wv[k][j]); S += la; } }
        else {
#pragma unroll
            for (int j = 15; j >= 0; --j) { const float la = lo_bf(wv[k][j]); h = __expf(la) * h + hi_bf(wv[k][j]); S += la; } }
        SUM[((size_t)d * 384 + q) * D + c] = __expf(S); SUM[((size_t)(2 + d) * 384 + q) * D + c] = h; }
}
__device__ void phase_lruscan2(PP p) {
    const int tid = tidx(), lane = tid & 63, wid = tid >> 6; const int nb = gdim();
    const float* SUM = (const float*)(p->ws + WS_LSUM); const bf16_t* PROJ = (const bf16_t*)(p->ws + WS_PROJ); bf16_t* CAT = (bf16_t*)(p->ws + WS_CAT);
    for (int it0 = bidx() * 8 + wid; it0 < 384 * 32; it0 += 8 * nb) {
        const int it = it0 < 128 * 32 ? it0 + 256 * 32 : it0 - 128 * 32;
        const int q = it >> 5, c = (it & 31) * 64 + lane; const int row0 = q * 16;
        int qs, ql, s; if (q < 256) { s = q >> 4; qs = s * 16; ql = qs + 15; } else { s = 16 + ((q - 256) >> 6); qs = 256 + (s - 16) * 64; ql = qs + 63; }
        float h0 = 0.f, h1 = 0.f;
        if (s >= 16) { h0 = p->in[I_SLRU][(size_t)((s - 16) * 2 + 0) * D + c]; h1 = p->in[I_SLRU][(size_t)((s - 16) * 2 + 1) * D + c]; }
        const float* P0 = SUM + c; const float* H0 = SUM + (size_t)2 * 384 * D + c; const float* P1 = SUM + (size_t)384 * D + c; const float* H1 = SUM + (size_t)3 * 384 * D + c;
        for (int j = qs; j < q; j += 8) { float pv[8], hv[8];
#pragma unroll
            for (int e = 0; e < 8; ++e) { const bool ok = j + e < q; pv[e] = ok ? P0[(size_t)(j + e) * D] : 1.f; hv[e] = ok ? H0[(size_t)(j + e) * D] : 0.f; }
#pragma unroll
            for (int e = 0; e < 8; ++e) h0 = pv[e] * h0 + hv[e]; }
        for (int j = ql; j > q; j -= 8) { float pv[8], hv[8];
#pragma unroll
            for (int e = 0; e < 8; ++e) { const bool ok = j - e > q; pv[e] = ok ? P1[(size_t)(j - e) * D] : 1.f; hv[e] = ok ? H1[(size_t)(j - e) * D] : 0.f; }
#pragma unroll
            for (int e = 0; e < 8; ++e) h1 = pv[e] * h1 + hv[e]; }
        const unsigned* W0 = (const unsigned*)(p->ws + WS_LA) + (size_t)row0 * D + c; const unsigned* W1 = W0 + (size_t)MTOK * D; const bf16_t* GT = PROJ + (size_t)row0 * 4096 + c;
        unsigned w0[16], w1[16]; float b0[16], gt[16];
#pragma unroll
        for (int j = 0; j < 16; ++j) { w0[j] = W0[(size_t)j * D]; w1[j] = W1[(size_t)j * D]; gt[j] = bf2f_(GT[(size_t)j * 4096]); }
#pragma unroll
        for (int j = 0; j < 16; ++j) { h0 = __expf(lo_bf(w0[j])) * h0 + hi_bf(w0[j]); b0[j] = h0; }
#pragma unroll
        for (int j = 15; j >= 0; --j) { h1 = __expf(lo_bf(w1[j])) * h1 + hi_bf(w1[j]); CAT[(size_t)(row0 + j) * D + c] = f2bf((b0[j] + h1) * geluf_(gt[j])); }
        if (s < 16) { if (q == ql) p->out[OUT_LRU + (size_t)(s * 2 + 0) * D + c] = h0; if (q == qs) p->out[OUT_LRU + (size_t)(s * 2 + 1) * D + c] = h1; }
    }
}

#ifndef PHMASK
#define PHMASK 0xFFFFFFFFu
#endif
#define PHON(k) ((PHMASK >> (k)) & 1u)
#ifndef DUPMASK
#define DUPMASK 0u
#endif
enum { K_PREP = 0, K_NORM, K_SWIGLU, K_RESID, K_F32, K_S5GLA, K_EVPOST, K_GLU, K_CONV, K_LRUG, K_LRUSCAN, K_LRUCOMB };
__global__ void __launch_bounds__(512, 2) mega(Params p) {
    extern __shared__ __attribute__((aligned(16))) unsigned char shm[];
    LAS unsigned char* lds = (LAS unsigned char*)shm;
    cg::grid_group grid = cg::this_grid();
    const int ph_lo = p.ph_lo, ph_hi = p.ph_hi;
    int rep = 0;
    volatile LAS unsigned* bst = (volatile LAS unsigned*)(lds + LDS_MAIN);
    if (threadIdx.x < 16) bst[threadIdx.x] = 0u;
    __syncthreads();
    XcdBarrier xbar = xcd_barrier_post((unsigned*)(p.ws + WS_BAR), bst);
    for (int ph = ph_lo; ph < ph_hi; ++ph) {
        PP pp = get_pp();
        unsigned char* ws = pp->ws;
        const float* MOD = (const float*)(ws + WS_MOD);
        int kind, l = 0, a0 = 0;
        if (ph == 0) kind = K_PREP;
        else if (ph == 24) { kind = K_NORM; a0 = -1; }
        else { l = ph > 12 ? 1 : 0; const int q = ph - 1 - 12 * l;
            if (q == 0) { kind = K_NORM; a0 = 0; }
            else if (q == 1) { kind = K_SWIGLU; a0 = 0; }
            else if (q == 2) { kind = K_RESID; a0 = 0; }
            else if (q == 3) { kind = K_NORM; a0 = 1; }
            else if (q == 4) kind = K_F32;
            else if (l == 0) { if (q == 5) kind = K_S5GLA; else if (q == 6) kind = K_EVPOST; else if (q == 7) kind = K_GLU; else if (q == 8) { kind = K_RESID; a0 = 2; } else if (q == 9) { kind = K_NORM; a0 = 2; } else if (q == 10) { kind = K_SWIGLU; a0 = 1; } else { kind = K_RESID; a0 = 1; } }
            else { if (q == 5) kind = K_LRUG; else if (q == 6) kind = K_LRUCOMB; else if (q == 7) { kind = K_RESID; a0 = 2; } else if (q == 8) { kind = K_NORM; a0 = 2; } else if (q == 9) { kind = K_SWIGLU; a0 = 1; } else { kind = K_RESID; a0 = 1; } }
        }
        const bf16_t* HM = (const bf16_t*)(ws + WS_HM);
        if (kind == K_PREP) { if (PHON(0)) phase_prep(pp, lds, rep); }
        else if (kind == K_NORM) { if (PHON(1)) phase_norm(pp, l, a0); }
        else if (kind == K_SWIGLU) { if (PHON(2)) { EpiSwiglu E{(bf16_t*)(ws + WS_H)}; pg8::gemm_phase<EpiSwiglu, false>(lds, HM, D, (const bf16_t*)(ws + WS_WFI) + (size_t)(l * 2 + a0) * 11264 * 2048, D, 24, 44, D, E); if (!rep) bg_convert(pp, lds, ph); } }
        else if (kind == K_RESID) { if (PHON(3)) {
            const bf16_t* A; const bf16_t* B; int K; int gj; float coef;
            if (a0 < 2) { A = (const bf16_t*)(ws + WS_H); B = (const bf16_t*)(ws + WS_WFO) + (size_t)(l * 2 + a0) * 2048 * 5632; K = DFF; gj = a0 == 0 ? 2 : 8; coef = 0.5f; }
            else { A = (const bf16_t*)(ws + WS_CAT); B = (const bf16_t*)(ws + (l == 0 ? WS_WEO : WS_WOO)); K = D; gj = 5; coef = 1.0f; }
            const bool first = (ph == 3);
            const float* xc_ = first ? pp->in[I_XP] : (const float*)(ws + WS_X); const float* xl_ = first ? pp->in[I_XS] - (size_t)TCTX * D : (const float*)(ws + WS_X);
            EpiResid E{(float*)(ws + WS_X), MOD + (size_t)(l * 3) * 18432 + gj * 2048, coef, xc_, xl_};
            if (a0 < 2) pg8::gemm_phase<EpiResid, false, true>(lds, A, K, B, K, 24, 8, K, E); else pg8::gemm_phase<EpiResid, false, false>(lds, A, K, B, K, 24, 8, K, E); if (!rep) bg_convert(pp, lds, ph); } }
        else if (kind == K_F32) { if (PHON(4)) {
            { const int nN = l == 0 ? 17 : 16; EpiBf16 E{(bf16_t*)(ws + WS_PROJ), nN * 256}; pg8::gemm_phase<EpiBf16, false>(lds, HM, D, (const bf16_t*)(ws + (l == 0 ? WS_WEI : WS_WOI)), D, 24, nN, D, E); }
            if (l == 1) {
                { const int gi = bidx() * 512 + tidx(); if (gi < 2 * D) ((float*)(ws + WS_SP))[gi] = -8.f * softplusf_(-pp->in[I_LLAM][gi]); }
                pg8::Order S; S.nM = 24; S.nN = 16; S.nwg = 384; S.G = gdim(); S.c = bidx(); Unit u;
                for (int i = 0; S.next(i, u); ++i) if (u.pn >= 8) conv_tile(pp, u.pm, u.pn - 8); }
            if (!rep) bg_convert(pp, lds, ph); } }
        else if (kind == K_S5GLA) { if (PHON(5)) phase_s5gla(pp, lds); }
        else if (kind == K_EVPOST) { if (PHON(6)) phase_evpost(pp); }
        else if (kind == K_GLU) { if (PHON(7)) { EpiGlu E{(bf16_t*)(ws + WS_CAT), (const bf16_t*)(ws + WS_YSB), pp->in[I_GLUB]}; pg8::gemm_phase<EpiGlu, false>(lds, (const bf16_t*)(ws + WS_YSB), 1024, (const bf16_t*)(ws + WS_WGLU), 1024, 24, 4, 1024, E); if (!rep) bg_convert(pp, lds, ph); } }
        else if (kind == K_CONV) { if (PHON(8)) phase_conv(pp); }
        else if (kind == K_LRUG) { if (PHON(9)) { EpiLru E{(unsigned*)(ws + WS_LA), (const bf16_t*)(ws + WS_XCB), pp->in[I_LBA], pp->in[I_LBX], (const float*)(ws + WS_SP)};
            int kk = 256; asm volatile("" : "+s"(kk));
            pg8::gemm_phase<EpiLru, true>(lds, (const bf16_t*)(ws + WS_XCB), D, (const bf16_t*)(ws + WS_WLRU), kk, 24, 32, kk, E);
            { pg8::Order S; S.nM = 24; S.nN = 32; S.nwg = 768; S.G = gdim(); S.c = bidx(); Unit u; for (int i = 0; S.next(i, u); ++i) scan1_tile(pp, u.pm, u.pn); } } }
        else if (kind == K_LRUSCAN) { if (PHON(10)) phase_lruscan1(pp); }
        else { if (PHON(11)) phase_lruscan2(pp); }
#if DUPMASK
        if (rep == 0 && ((DUPMASK >> kind) & 1u)) { xcd_barrier(xbar); rep = 1; --ph; continue; }
        rep = 0;
#endif
        if (ph + 1 < ph_hi) { if (ph == 0) grid.sync(); else xcd_barrier(xbar); }
    }
}

extern "C" void kernel_launch(void* const* d_in, const int* in_sizes, int n_in, void* d_out, int out_size, void* d_ws, size_t ws_size, hipStream_t stream) {
    static int grid = 0;
    if (grid == 0) {
        if (n_in != 38 || ws_size < WS_END) { fprintf(stderr, "kernel_launch: expected 38 inputs and >= %zu bytes of workspace (got %d, %zu)\n", (size_t)WS_END, n_in, ws_size); grid = -1; return; }
        int dev = 0, cus = 0, per_cu = 0;
        hipGetDevice(&dev); hipDeviceGetAttribute(&cus, hipDeviceAttributeMultiprocessorCount, dev);
        hipFuncSetAttribute((const void*)mega, hipFuncAttributeMaxDynamicSharedMemorySize, LDS_BYTES);
        hipOccupancyMaxActiveBlocksPerMultiprocessor(&per_cu, (const void*)mega, 512, LDS_BYTES);
        if (per_cu < 1) { fprintf(stderr, "kernel_launch: occupancy query says %d blocks per CU\n", per_cu); grid = -1; return; }
        grid = cus;
    }
    if (grid < 0) return;
    (void)hipMemsetAsync((char*)d_ws + WS_MOD, 0, ZERO_BYTES, stream);
    Params p{};
    for (int i = 0; i < 38; ++i) p.in[i] = (const float*)d_in[i];
    p.out = (float*)d_out; p.ws = (unsigned char*)d_ws;
#if MEGA
    p.ph_lo = 0; p.ph_hi = NPH;
    void* args[] = {&p};
    hipError_t e = hipLaunchCooperativeKernel((const void*)mega, dim3(grid), dim3(512), args, LDS_BYTES, stream);
    if (e != hipSuccess) fprintf(stderr, "cooperative launch failed: %s (grid %d)\n", hipGetErrorString(e), grid);
#else
    for (int ph = 0; ph < NPH; ++ph) { p.ph_lo = ph; p.ph_hi = ph + 1; hipLaunchKernelGGL(mega, dim3(grid), dim3(512), LDS_BYTES, stream, p); }
#endif
}
```

```cpp
#include <hip/hip_runtime.h>
#include <hip/hip_cooperative_groups.h>
#include <cstdio>
namespace cg = cooperative_groups;

#ifndef MEGA
#define MEGA 1
#endif

#define LAS __attribute__((address_space(3)))
typedef unsigned short bf16_t;
typedef short bf16x8 __attribute__((ext_vector_type(8)));
typedef float f32x4 __attribute__((ext_vector_type(4)));
typedef float f32x2 __attribute__((ext_vector_type(2)));

constexpr int D = 2048, DFF = 5632, MTOK = 6144, TCTX = 4096;
constexpr int EVINP = 4352;
constexpr int NPH = 25;
constexpr int LDS_MAIN = 131072;
constexpr int LDS_BYTES = LDS_MAIN + 64;
constexpr float EPS = 1e-6f;

constexpr size_t al256(size_t x) { return (x + 255) & ~(size_t)255; }
constexpr size_t WS_MOD = 0;
constexpr size_t MOD_BYTES = (size_t)2 * 3 * 9 * 2048 * 4;
constexpr size_t WS_BAR = al256(WS_MOD + MOD_BYTES);
constexpr size_t BAR_BYTES = 3456 * 4;
constexpr size_t ZERO_BYTES = WS_BAR + BAR_BYTES;
constexpr size_t WS_X = al256(WS_BAR + BAR_BYTES);
constexpr size_t WS_HM = WS_X + (size_t)MTOK * D * 4;
constexpr size_t WS_H = WS_HM + (size_t)MTOK * D * 2;
constexpr size_t WS_PROJ = WS_H + (size_t)MTOK * DFF * 2;
constexpr size_t WS_WFI = WS_PROJ + (size_t)MTOK * EVINP * 4;
constexpr size_t WS_WFO = WS_WFI + (size_t)4 * 11264 * 2048 * 2;
constexpr size_t WS_WEI = WS_WFO + (size_t)4 * 2048 * 5632 * 2;
constexpr size_t WS_WEO = WS_WEI + (size_t)EVINP * 2048 * 2;
constexpr size_t WS_WGLU = WS_WEO + (size_t)2048 * 2048 * 2;
constexpr size_t WS_WOI = WS_WGLU + (size_t)1024 * 1024 * 2;
constexpr size_t WS_WOO = WS_WOI + (size_t)4096 * 2048 * 2;
constexpr size_t WS_WLRU = WS_WOO + (size_t)2048 * 2048 * 2;
constexpr size_t WS_YS5 = WS_WLRU + (size_t)2 * 8 * 2 * 256 * 256 * 2;
constexpr size_t WS_OGLA = WS_YS5 + (size_t)2 * MTOK * 1024 * 4;
constexpr size_t WS_YS32 = WS_OGLA + (size_t)2 * MTOK * 1024 * 4;
constexpr size_t WS_YSB = WS_YS32 + (size_t)MTOK * 1024 * 4;
constexpr size_t WS_CAT = WS_YSB + (size_t)MTOK * 1024 * 2;
constexpr size_t WS_XC32 = WS_CAT + (size_t)MTOK * D * 2;
constexpr size_t WS_XCB = WS_XC32 + (size_t)MTOK * D * 4;
constexpr size_t WS_LA = WS_XCB + (size_t)MTOK * D * 2;
constexpr size_t WS_LB = WS_LA + (size_t)2 * MTOK * D * 4;
constexpr size_t WS_SP = WS_LB + (size_t)2 * MTOK * D * 4;
constexpr size_t WS_LSUM = WS_SP + (size_t)2 * D * 4;
constexpr size_t WS_END = WS_LSUM + (size_t)2 * 2 * 384 * D * 4;

constexpr size_t OUT_Y = 0;
constexpr size_t OUT_S5RE = (size_t)MTOK * D;
constexpr size_t OUT_S5IM = OUT_S5RE + 16 * 2 * 64 * 64;
constexpr size_t OUT_GLA = OUT_S5IM + 16 * 2 * 64 * 64;
constexpr size_t OUT_LRU = OUT_GLA + (size_t)16 * 2 * 4 * 128 * 256;

struct Params { const float* in[38]; float* out; unsigned char* ws; int ph_lo, ph_hi; };
typedef const __attribute__((address_space(4))) Params* PP;
__device__ __forceinline__ int tidx() { int t = threadIdx.x; asm volatile("" : "+v"(t)); return t; }
__device__ __forceinline__ int bidx() { int b = blockIdx.x; asm volatile("" : "+s"(b)); return b; }
__device__ __forceinline__ int gdim() { int g = gridDim.x; asm volatile("" : "+s"(g)); return g; }
__device__ __forceinline__ PP get_pp() { PP kp = (PP)__builtin_amdgcn_kernarg_segment_ptr(); asm volatile("" : "+s"(kp)); return kp; }
enum { I_XP = 0, I_XS, I_S5RE, I_S5IM, I_SGLA, I_SLRU, I_C, I_CCTX, I_NORMG, I_ADAW, I_ADAB, I_FWI, I_FWO, I_FNG, I_EVWI, I_EVWO,
       I_LAMRE, I_LAMIM, I_LOGSTEP, I_BRE, I_BIM, I_CRE, I_CIM, I_S5D, I_GLUW, I_GLUB, I_GW2, I_GB, I_GNG, I_ODWI, I_ODWO,
       I_CONVW, I_CONVB, I_LWA, I_LBA, I_LWX, I_LBX, I_LLAM };

__device__ __forceinline__ unsigned cvt_pk_bf16(float lo, float hi) { unsigned r; asm("v_cvt_pk_bf16_f32 %0, %1, %2" : "=v"(r) : "v"(lo), "v"(hi)); return r; }
__device__ __forceinline__ bf16_t f2bf(float x) { return (bf16_t)(cvt_pk_bf16(x, 0.f) & 0xffffu); }
__device__ __forceinline__ float bf2f_(bf16_t v) { return __builtin_bit_cast(float, (unsigned)v << 16); }
__device__ __forceinline__ float lo_bf(unsigned w) { return __builtin_bit_cast(float, w << 16); }
__device__ __forceinline__ float hi_bf(unsigned w) { return __builtin_bit_cast(float, w & 0xffff0000u); }
__device__ __forceinline__ f32x4 unpack4(uint2 w) { return (f32x4){lo_bf(w.x), hi_bf(w.x), lo_bf(w.y), hi_bf(w.y)}; }
__device__ __forceinline__ float sigmoidf_(float x) { return __builtin_amdgcn_rcpf(1.f + __expf(-x)); }
__device__ __forceinline__ float siluf_(float x) { return x * __builtin_amdgcn_rcpf(1.f + __expf(-x)); }
__device__ __forceinline__ float geluf_(float x) { return x * sigmoidf_(1.5957691216f * (x + 0.044715f * x * x * x)); }
__device__ __forceinline__ float softplusf_(float x) { return fmaxf(x, 0.f) + log1pf(__expf(-fabsf(x))); }
__device__ __forceinline__ float neg_expm1_(float x) {
    const float pl = -x * (1.f + x * (0.5f + x * (0.16666667f + x * (0.041666668f + x * (0.0083333338f + x * 0.0013888889f))))); return x > -0.25f ? pl : 1.f - __expf(x); }
__device__ __forceinline__ int cond_of_pm(int pm) { return pm < 16 ? 0 : 1 + ((pm - 16) >> 2); }
__device__ __forceinline__ int cond_of_row(int r) { return r < TCTX ? 0 : 1 + ((r - TCTX) >> 10); }
__device__ __forceinline__ bf16x8 pack8(f32x4 a, f32x4 b) {
    typedef unsigned u32x4 __attribute__((ext_vector_type(4)));
    u32x4 u; u[0] = cvt_pk_bf16(a[0], a[1]); u[1] = cvt_pk_bf16(a[2], a[3]); u[2] = cvt_pk_bf16(b[0], b[1]); u[3] = cvt_pk_bf16(b[2], b[3]);
    return __builtin_bit_cast(bf16x8, u);
}

#define XB_TMO      128
#define XB_XCNT(j)  (256  + 64 * (j))
#define XB_XSUB(j)  (1280 + 64 * (j))
#define XB_XGEN(j)  (2304 + 64 * (j))
#define XB_TOP      3328
#define XB_TOPGEN   3392
#define XCD_BAR_WORDS 3456
#define XB_SPIN_CAP (1u << 18)

__device__ __forceinline__ unsigned xb_ld(unsigned* p)              { return __hip_atomic_load(p, __ATOMIC_RELAXED, __HIP_MEMORY_SCOPE_AGENT); }
__device__ __forceinline__ unsigned xb_add(unsigned* p, unsigned v) { return __hip_atomic_fetch_add(p, v, __ATOMIC_RELAXED, __HIP_MEMORY_SCOPE_AGENT); }
__device__ __forceinline__ unsigned xb_xcc_id() { return (unsigned)__builtin_amdgcn_s_getreg((3 << 11) | 20) & 0xFu; }
#define XB_SPIN(cond, bar) do { unsigned _sp = 0; while (cond) { __builtin_amdgcn_s_sleep(1); \
    if ((++_sp & 255u) == 0u) { if (xb_ld(&(bar)[XB_TMO])) break; if (_sp > XB_SPIN_CAP) { atomicAdd(&(bar)[XB_TMO], 1u); break; } } } } while (0)

struct XcdBarrier {
    unsigned* bar; unsigned x;
    volatile LAS unsigned* st;
};

__device__ __forceinline__ XcdBarrier xcd_barrier_post(unsigned* bar, volatile LAS unsigned* st) {
    XcdBarrier b; b.bar = bar; b.x = xb_xcc_id(); b.st = st;
    if (threadIdx.x == 0) (void)xb_add(&bar[XB_XCNT(b.x)], 1u);
    return b;
}
__device__ __forceinline__ void xcd_barrier_complete(unsigned* bar, unsigned x, unsigned& nloc, unsigned& nx) {
    const unsigned G = gridDim.x * gridDim.y * gridDim.z;
    unsigned sum, cnt, mine, sp = 0u;
    for (;;) {
        sum = 0u; cnt = 0u; mine = 0u;
#pragma unroll
        for (unsigned j = 0; j < 16; ++j) { const unsigned c = xb_ld(&bar[XB_XCNT(j)]); sum += c; cnt += (c > 0u) ? 1u : 0u; mine = (j == x) ? c : mine; }
        if (sum == G) break;
        __builtin_amdgcn_s_sleep(1);
        if ((++sp & 255u) == 0u) { if (xb_ld(&bar[XB_TMO])) break; if (sp > XB_SPIN_CAP) { atomicAdd(&bar[XB_TMO], 1u); break; } }
    }
    nloc = mine > 0u ? mine : 1u; nx = cnt > 0u ? cnt : 1u;
}

__device__ __forceinline__ void xcd_barrier(const XcdBarrier& b) {
    asm volatile("s_waitcnt vmcnt(0)" ::: "memory");
    __syncthreads();
    if (threadIdx.x == 0) {
        unsigned* bar = b.bar;
        __builtin_amdgcn_s_waitcnt(0);
        unsigned nloc = b.st[0], nx = b.st[1];
        if (nloc == 0u) { xcd_barrier_complete(bar, b.x, nloc, nx); b.st[0] = nloc; b.st[1] = nx; }
        const unsigned old = xb_add(&bar[XB_XSUB(b.x)], 1u);
        const unsigned gen = old / nloc;
        if (old + 1u == (gen + 1u) * nloc) {
            __builtin_amdgcn_fence(__ATOMIC_RELEASE, "agent");
            asm volatile("s_waitcnt vmcnt(0)" ::: "memory");
            const unsigned og = xb_add(&bar[XB_TOP], 1u);
            const unsigned tg = og / nx;
            if (og + 1u == (tg + 1u) * nx) xb_add(&bar[XB_TOPGEN], 1u);
            else XB_SPIN(xb_ld(&bar[XB_TOPGEN]) == tg, bar);
            __builtin_amdgcn_fence(__ATOMIC_ACQUIRE, "agent");
            xb_add(&bar[XB_XGEN(b.x)], 1u);
            asm volatile("s_waitcnt vmcnt(0)" ::: "memory");
        } else {
            XB_SPIN(xb_ld(&bar[XB_XGEN(b.x)]) == gen, bar);
            __builtin_amdgcn_fence(__ATOMIC_ACQUIRE, "agent");
            asm volatile("s_waitcnt vmcnt(0)" ::: "memory");
        }
    }
    __syncthreads();
}


namespace pg8 {
constexpr int BM = 256, BK = 64, HALF = 128, HTB = HALF * BK * 2, NXCD = 8, WGM = 8;
__device__ __forceinline__ int lds_byte(int r, int c) { const int st = (r >> 4) * 2 + (c >> 5), rr = r & 15, cc = c & 31, ob = rr * 64 + cc * 2; return st * 1024 + (ob ^ (((ob >> 9) & 1) << 5)); }
__device__ __forceinline__ void stage_rc(int b, int& R, int& C) { const int st = b / 1024, sb = b % 1024, swz = sb ^ (((sb >> 9) & 1) << 5); R = (st >> 1) * 16 + swz / 64; C = (st & 1) * 32 + (swz % 64) / 2; }
struct Unit { int pm, pn; };
struct Order {
    int nM, nN, nwg, G, c;
    __device__ __forceinline__ bool next(int i, Unit& u) const {
        const long L = (long)i * G + c; if (L >= nwg) return false;
        int wgid = (int)L; { const int q = nwg / NXCD, r = nwg % NXCD, xcd = wgid % NXCD, off = wgid / NXCD; wgid = (xcd < r ? xcd * (q + 1) : r * (q + 1) + (xcd - r) * q) + off; }
        const int nig = WGM * nN, gid = wgid / nig, fm = gid * WGM, gsz = (nM - fm) < WGM ? (nM - fm) : WGM;
        u.pm = fm + ((wgid % nig) % gsz); u.pn = (wgid % nig) / gsz; return true;
    }
};

template <class Epi, bool LRU, bool BLK = false>
__device__ __forceinline__ void gemm_phase(LAS unsigned char* lds, const bf16_t* A, int lda, const bf16_t* Bt, int ldb, int nM, int nN, int K, const Epi& E) {
    const int tid = tidx(), wid = __builtin_amdgcn_readfirstlane(tid >> 6), lane = tid & 63, wr = wid >> 2, wc = wid & 3, fr = lane & 15, fq = lane >> 4;
    const int nt = K / BK;
    Order S; S.nM = nM; S.nN = nN; S.nwg = nM * nN; S.G = gdim(); S.c = bidx();
    unsigned voffA[2], voffB[2];
#pragma unroll
    for (int i = 0; i < 2; ++i) { int R, C; stage_rc(tid * 16 + i * 8192, R, C); voffA[i] = (unsigned)(R * (BLK ? 64 : lda) + C) * 2u; voffB[i] = (unsigned)(R * (BLK ? 64 : ldb) + C) * 2u; }
    const size_t kstep = BLK ? (size_t)32768 : (size_t)(BK * 2);
    const size_t hstepA = BLK ? (size_t)16384 : (size_t)HALF * lda * 2, hstepB = BLK ? (size_t)16384 : (size_t)HALF * ldb * 2;
    const size_t tstepA = BLK ? (size_t)nt * 32768 : 2 * hstepA, tstepB = BLK ? (size_t)nt * 32768 : 2 * hstepB;
    const unsigned ldsw = (unsigned)wid * 1024u;
    const int aoff = lds_byte(wr * 64 + fr, fq * 8), boff = lds_byte(wc * 32 + fr, fq * 8);
#define PG8_SA(b, h) (((b) * 2 + (h)) * HTB)
#define PG8_SB(b, h) ((4 + (b) * 2 + (h)) * HTB)
#define PG8_STAGE(bufoff, gbase, voff) do { _Pragma("unroll") for (int _i = 0; _i < 2; ++_i) \
        __builtin_amdgcn_global_load_lds((const unsigned*)((const char*)(gbase) + (voff)[_i]), (LAS unsigned*)(lds + (bufoff) + ldsw + _i * 8192), 16, 0, 0); } while (0)
#define PG8_LDA(dst, b, h) do { _Pragma("unroll") for (int m = 0; m < 4; ++m) _Pragma("unroll") for (int k = 0; k < 2; ++k) dst[m][k] = *(const LAS bf16x8*)(lds + PG8_SA(b, h) + aoff + m * 2048 + k * 1024); } while (0)
#define PG8_LDB(dst, b, h) do { _Pragma("unroll") for (int n = 0; n < 2; ++n) _Pragma("unroll") for (int k = 0; k < 2; ++k) dst[n][k] = *(const LAS bf16x8*)(lds + PG8_SB(b, h) + boff + n * 2048 + k * 1024); } while (0)
#define PG8_MMA(ai, bj, At, Bt_) do { __builtin_amdgcn_s_setprio(1); _Pragma("unroll") for (int m = 0; m < 4; ++m) _Pragma("unroll") for (int n = 0; n < 2; ++n) _Pragma("unroll") for (int k = 0; k < 2; ++k) \
        acc[ai][bj][m][n] = __builtin_amdgcn_mfma_f32_16x16x32_bf16(Bt_[n][k], At[m][k], acc[ai][bj][m][n], 0, 0, 0); __builtin_amdgcn_s_setprio(0); } while (0)
#define PG8_WAIT_V(n) asm volatile("s_waitcnt vmcnt(" #n ")" ::: "memory")
#define PG8_WAIT_L(n) asm volatile("s_waitcnt lgkmcnt(" #n ")" ::: "memory")
#define PG8_BAR __builtin_amdgcn_s_barrier()
#define PG8_SCHED __builtin_amdgcn_sched_barrier(0)
#define PG8_APTR(u) ((const char*)A + (size_t)(u).pm * tstepA + (LRU ? (size_t)((((u).pn >> 1) & 7) * 512) : (size_t)0))
#define PG8_BPTR(u) ((const char*)Bt + (size_t)(u).pn * tstepB)
    Unit cur, nxt; int ui = 0;
    if (!S.next(0, cur)) return;
    f32x4 acc[2][2][4][2];
#pragma unroll
    for (int a = 0; a < 2; ++a)
#pragma unroll
        for (int b = 0; b < 2; ++b)
#pragma unroll
            for (int m = 0; m < 4; ++m)
#pragma unroll
                for (int n = 0; n < 2; ++n) acc[a][b][m][n] = (f32x4){0.f, 0.f, 0.f, 0.f};
    bf16x8 At[4][2], B0[2][2], B1[2][2];
    const char* cA = PG8_APTR(cur); const char* cB = PG8_BPTR(cur);
    PG8_STAGE(PG8_SB(0, 0), cB, voffB); PG8_STAGE(PG8_SA(0, 0), cA, voffA); PG8_STAGE(PG8_SB(0, 1), cB + hstepB, voffB); PG8_STAGE(PG8_SA(0, 1), cA + hstepA, voffA);
    if (wr == 1) PG8_BAR;
    PG8_WAIT_V(4); PG8_BAR;
    PG8_STAGE(PG8_SB(1, 0), cB + kstep, voffB); PG8_STAGE(PG8_SA(1, 0), cA + kstep, voffA); PG8_STAGE(PG8_SB(1, 1), cB + hstepB + kstep, voffB);
    PG8_WAIT_V(6); PG8_BAR;
    for (;;) {
        const bool has_next = S.next(ui + 1, nxt);
        const char* nA = has_next ? PG8_APTR(nxt) : cA; const char* nB = has_next ? PG8_BPTR(nxt) : cB;
        for (int t = 0; t < nt; t += 2) {
            const bool last = (t == nt - 2);
            const char* a1 = cA + (size_t)(t + 1) * kstep;
            const char* a2 = last ? nA : cA + (size_t)(t + 2) * kstep; const char* b2 = last ? nB : cB + (size_t)(t + 2) * kstep;
            const char* a3 = a2 + kstep; const char* b3 = b2 + kstep;
            PG8_LDB(B0, 0, 0); PG8_SCHED; PG8_LDA(At, 0, 0); PG8_STAGE(PG8_SA(1, 1), a1 + hstepA, voffA);
            PG8_WAIT_L(8); PG8_BAR; PG8_WAIT_L(0); PG8_MMA(0, 0, At, B0); PG8_BAR; PG8_SCHED;
            PG8_LDB(B1, 0, 1); PG8_STAGE(PG8_SB(0, 0), b2, voffB);
            PG8_BAR; PG8_WAIT_L(0); PG8_MMA(0, 1, At, B1); PG8_BAR;
            PG8_LDA(At, 0, 1); PG8_STAGE(PG8_SA(0, 0), a2, voffA);
            PG8_BAR; PG8_WAIT_L(0); PG8_MMA(1, 0, At, B0); PG8_BAR; PG8_SCHED;
            PG8_STAGE(PG8_SB(0, 1), b2 + hstepB, voffB);
            PG8_WAIT_V(6); PG8_BAR; PG8_MMA(1, 1, At, B1); PG8_BAR;
            PG8_LDB(B0, 1, 0); PG8_SCHED; PG8_LDA(At, 1, 0); PG8_STAGE(PG8_SA(0, 1), a2 + hstepA, voffA);
            PG8_WAIT_L(8); PG8_BAR; PG8_WAIT_L(0); PG8_MMA(0, 0, At, B0); PG8_BAR; PG8_SCHED;
            PG8_LDB(B1, 1, 1); PG8_STAGE(PG8_SB(1, 0), b3, voffB);
            PG8_BAR; PG8_WAIT_L(0); PG8_MMA(0, 1, At, B1); PG8_BAR;
            PG8_LDA(At, 1, 1); PG8_STAGE(PG8_SA(1, 0), a3, voffA);
            PG8_BAR; PG8_WAIT_L(0); PG8_MMA(1, 0, At, B0); PG8_BAR; PG8_SCHED;
            PG8_STAGE(PG8_SB(1, 1), b3 + hstepB, voffB);
            PG8_WAIT_V(6); PG8_BAR; PG8_MMA(1, 1, At, B1); PG8_BAR;
        }
        E(acc, cur, wr, wc, fr, fq);
        if (!has_next) break;
#pragma unroll
        for (int a = 0; a < 2; ++a)
#pragma unroll
            for (int b = 0; b < 2; ++b)
#pragma unroll
                for (int m = 0; m < 4; ++m)
#pragma unroll
                    for (int n = 0; n < 2; ++n) acc[a][b][m][n] = (f32x4){0.f, 0.f, 0.f, 0.f};
        cur = nxt; cA = nA; cB = nB; ++ui;
    }
    PG8_WAIT_V(0);
    if (wr == 0) PG8_BAR;
    PG8_BAR;
#undef PG8_SA
#undef PG8_SB
#undef PG8_STAGE
#undef PG8_LDA
#undef PG8_LDB
#undef PG8_MMA
#undef PG8_WAIT_V
#undef PG8_WAIT_L
#undef PG8_BAR
#undef PG8_SCHED
#undef PG8_APTR
#undef PG8_BPTR
}
}
using pg8::Unit;

struct EpiSwiglu {
    bf16_t* H;
    __device__ __forceinline__ void operator()(const f32x4 (&acc)[2][2][4][2], const Unit& u, int wr, int wc, int fr, int fq) const {
        const int loff = (wr * 64 + fr) * 64 + (wc & 1) * 32 + 4 * fq;
        bf16_t* ub = H + ((size_t)(u.pm * 88 + u.pn * 2 + (wc >> 1)) * 256) * 64;
#pragma unroll
        for (int ai = 0; ai < 2; ++ai)
#pragma unroll
            for (int m = 0; m < 4; ++m) { bf16_t* rb = ub + (size_t)(ai * 128 + m * 16) * 64;
#pragma unroll
                for (int n = 0; n < 2; ++n) { const f32x4 a = acc[ai][0][m][n], b = acc[ai][1][m][n];
                    uint2 pk; pk.x = cvt_pk_bf16(siluf_(a[0]) * b[0], siluf_(a[1]) * b[1]); pk.y = cvt_pk_bf16(siluf_(a[2]) * b[2], siluf_(a[3]) * b[3]);
                    *(uint2*)(rb + loff + n * 16) = pk; } }
    }
};
struct EpiResid {
    float* X; const float* G; float coef; const float* XinC; const float* XinL;
    __device__ __forceinline__ void operator()(const f32x4 (&acc)[2][2][4][2], const Unit& u, int wr, int wc, int fr, int fq) const {
        const int lcol = wc * 32 + 4 * fq, loff = (wr * 64 + fr) * D + lcol;
        const float* g = G + (size_t)cond_of_pm(u.pm) * (9 * 2048) + u.pn * 256;
        float* ub = X + (size_t)u.pm * 256 * D + u.pn * 256;
        const float* ib = (u.pm < 16 ? XinC : XinL) + (size_t)u.pm * 256 * D + u.pn * 256;
        f32x4 gv[2][2];
#pragma unroll
        for (int bj = 0; bj < 2; ++bj)
#pragma unroll
            for (int n = 0; n < 2; ++n) gv[bj][n] = *(const f32x4*)(g + lcol + bj * 128 + n * 16) * coef;
#pragma unroll
        for (int ai = 0; ai < 2; ++ai)
#pragma unroll
            for (int mp = 0; mp < 4; mp += 2) { f32x4 xin[2][2][2];
#pragma unroll
                for (int m2 = 0; m2 < 2; ++m2) { const float* ir = ib + (size_t)(ai * 128 + (mp + m2) * 16) * D;
#pragma unroll
                    for (int bj = 0; bj < 2; ++bj)
#pragma unroll
                        for (int n = 0; n < 2; ++n) xin[m2][bj][n] = *(const f32x4*)(ir + loff + bj * 128 + n * 16); }
                __builtin_amdgcn_sched_barrier(0);
#pragma unroll
                for (int m2 = 0; m2 < 2; ++m2) { float* rb = ub + (size_t)(ai * 128 + (mp + m2) * 16) * D;
#pragma unroll
                    for (int bj = 0; bj < 2; ++bj)
#pragma unroll
                        for (int n = 0; n < 2; ++n) { *(f32x4*)(rb + loff + bj * 128 + n * 16) = xin[m2][bj][n] + gv[bj][n] * acc[ai][bj][mp + m2][n]; } }
                __builtin_amdgcn_sched_barrier(0); }
    }
};
struct EpiF32 {
    float* C; int ldc;
    __device__ __forceinline__ void operator()(const f32x4 (&acc)[2][2][4][2], const Unit& u, int wr, int wc, int fr, int fq) const {
        const int loff = (wr * 64 + fr) * ldc + wc * 32 + 4 * fq;
        float* ub = C + (size_t)u.pm * 256 * ldc + u.pn * 256;
#pragma unroll
        for (int ai = 0; ai < 2; ++ai)
#pragma unroll
            for (int m = 0; m < 4; ++m) { float* rb = ub + (size_t)(ai * 128 + m * 16) * ldc;
#pragma unroll
                for (int bj = 0; bj < 2; ++bj)
#pragma unroll
                    for (int n = 0; n < 2; ++n) *(f32x4*)(rb + loff + bj * 128 + n * 16) = acc[ai][bj][m][n]; }
    }
};
struct EpiBf16 {
    bf16_t* C; int ldc;
    __device__ __forceinline__ void operator()(const f32x4 (&acc)[2][2][4][2], const Unit& u, int wr, int wc, int fr, int fq) const {
        const int loff = (wr * 64 + fr) * ldc + wc * 32 + 4 * fq;
        bf16_t* ub = C + (size_t)u.pm * 256 * ldc + u.pn * 256;
#pragma unroll
        for (int ai = 0; ai < 2; ++ai)
#pragma unroll
            for (int m = 0; m < 4; ++m) { bf16_t* rb = ub + (size_t)(ai * 128 + m * 16) * ldc;
#pragma unroll
                for (int bj = 0; bj < 2; ++bj)
#pragma unroll
                    for (int n = 0; n < 2; ++n) { const f32x4 v = acc[ai][bj][m][n]; uint2 pk; pk.x = cvt_pk_bf16(v[0], v[1]); pk.y = cvt_pk_bf16(v[2], v[3]); *(uint2*)(rb + loff + bj * 128 + n * 16) = pk; } }
    }
};
struct EpiGlu {
    bf16_t* CAT; const bf16_t* YS; const float* bias;
    __device__ __forceinline__ void operator()(const f32x4 (&acc)[2][2][4][2], const Unit& u, int wr, int wc, int fr, int fq) const {
        const int lcol = wc * 32 + 4 * fq, loffY = (wr * 64 + fr) * 1024 + lcol, loffC = (wr * 64 + fr) * D + lcol;
        const float* bb = bias + u.pn * 256; const bf16_t* yb = YS + (size_t)u.pm * 256 * 1024 + u.pn * 256; bf16_t* cb = CAT + (size_t)u.pm * 256 * D + u.pn * 256;
        f32x4 bv[2][2];
#pragma unroll
        for (int bj = 0; bj < 2; ++bj)
#pragma unroll
            for (int n = 0; n < 2; ++n) bv[bj][n] = *(const f32x4*)(bb + lcol + bj * 128 + n * 16);
#pragma unroll
        for (int ai = 0; ai < 2; ++ai) { uint2 yw[4][2][2];
#pragma unroll
            for (int m = 0; m < 4; ++m)
#pragma unroll
                for (int bj = 0; bj < 2; ++bj)
#pragma unroll
                    for (int n = 0; n < 2; ++n) yw[m][bj][n] = *(const uint2*)(yb + (size_t)(ai * 128 + m * 16) * 1024 + loffY + bj * 128 + n * 16);
            __builtin_amdgcn_sched_barrier(0);
#pragma unroll
            for (int m = 0; m < 4; ++m) { bf16_t* cr = cb + (size_t)(ai * 128 + m * 16) * D;
#pragma unroll
                for (int bj = 0; bj < 2; ++bj)
#pragma unroll
                    for (int n = 0; n < 2; ++n) { const f32x4 ys = unpack4(yw[m][bj][n]); const f32x4 z = acc[ai][bj][m][n] + bv[bj][n];
                        uint2 pk; pk.x = cvt_pk_bf16(ys[0] * sigmoidf_(z[0]), ys[1] * sigmoidf_(z[1])); pk.y = cvt_pk_bf16(ys[2] * sigmoidf_(z[2]), ys[3] * sigmoidf_(z[3]));
                        *(uint2*)(cr + loffC + bj * 128 + n * 16) = pk; }
                __builtin_amdgcn_sched_barrier(0); } }
    }
};
struct EpiLru {
    unsigned* LAB; const bf16_t* XC; const float* ba; const float* bx; const float* sp;
    __device__ __forceinline__ void operator()(const f32x4 (&acc)[2][2][4][2], const Unit& u, int wr, int wc, int fr, int fq) const {
        const int d = u.pn >> 4, h = (u.pn >> 1) & 7, half = u.pn & 1;
        const int chu = h * 256 + half * 128;
        const int lcol = wc * 32 + 4 * fq, loff = (wr * 64 + fr) * D + lcol;
        const bf16_t* xb = XC + (size_t)u.pm * 256 * D + chu; unsigned* lab = LAB + ((size_t)d * MTOK + u.pm * 256) * D + chu;
        f32x4 bav[2], bxv[2], spv[2];
#pragma unroll
        for (int n = 0; n < 2; ++n) { bav[n] = *(const f32x4*)(ba + d * D + chu + lcol + n * 16); bxv[n] = *(const f32x4*)(bx + d * D + chu + lcol + n * 16); spv[n] = *(const f32x4*)(sp + d * D + chu + lcol + n * 16); }
#pragma unroll
        for (int ai = 0; ai < 2; ++ai) { uint2 xw[4][2];
#pragma unroll
            for (int m = 0; m < 4; ++m)
#pragma unroll
                for (int n = 0; n < 2; ++n) xw[m][n] = *(const uint2*)(xb + (size_t)(ai * 128 + m * 16) * D + loff + n * 16);
            __builtin_amdgcn_sched_barrier(0);
#pragma unroll
            for (int m = 0; m < 4; ++m) { const size_t ro = (size_t)(ai * 128 + m * 16) * D;
#pragma unroll
                for (int n = 0; n < 2; ++n) { const f32x4 xc = unpack4(xw[m][n]);
                    const f32x4 rp = acc[ai][0][m][n] + bav[n], ip = acc[ai][1][m][n] + bxv[n]; uint4 w;
                    unsigned wv[4];
#pragma unroll
                    for (int e = 0; e < 4; ++e) { const float la = spv[n][e] * sigmoidf_(rp[e]); const float bb = __builtin_amdgcn_sqrtf(fmaxf(neg_expm1_(2.f * la), 0.f)) * (sigmoidf_(ip[e]) * xc[e]); wv[e] = cvt_pk_bf16(la, bb); }
                    w.x = wv[0]; w.y = wv[1]; w.z = wv[2]; w.w = wv[3];
                    *(uint4*)(lab + ro + loff + n * 16) = w; __builtin_amdgcn_sched_barrier(0); } } }
    }
};

struct CvtT { const float* src; bf16_t* dst; int K, ldsrc, Nsrc, n_dst0, n_src0, k0, blk; };
__device__ __forceinline__ void cvt_decode(PP p, unsigned char* ws, int t, int total, CvtT& c) {
    constexpr int T_FI = 176 * 32, T_FO = 32 * 88, T_EI = 68 * 32, T_EO = 32 * 32, T_GLU = 16 * 16, T_OI = 64 * 32, T_OO = 32 * 32, T_LRU = 4 * 4;
    c.blk = 0;
    if (t >= total) { c.src = nullptr; c.dst = nullptr; c.K = c.ldsrc = c.Nsrc = c.n_dst0 = c.n_src0 = c.k0 = 0; return; }
    if (t < 4 * T_FI) { const int w = t / T_FI; t %= T_FI; const int nt_ = t / 32, kt = t % 32; c.K = 2048; c.ldsrc = 11264; c.Nsrc = 11264; c.src = p->in[I_FWI] + (size_t)w * 2048 * 11264; c.dst = (bf16_t*)(ws + WS_WFI) + (size_t)w * 11264 * 2048;
        c.n_dst0 = nt_ * 64; const int j = c.n_dst0 >> 8, rr = c.n_dst0 & 255; c.n_src0 = rr < 128 ? j * 128 + rr : 5632 + j * 128 + (rr - 128); c.k0 = kt * 64; }
    else if ((t -= 4 * T_FI) < 4 * T_FO) { const int w = t / T_FO; t %= T_FO; const int nt_ = t / 88, kt = t % 88; c.K = 5632; c.ldsrc = 2048; c.Nsrc = 2048; c.src = p->in[I_FWO] + (size_t)w * 5632 * 2048; c.dst = (bf16_t*)(ws + WS_WFO) + (size_t)w * 2048 * 5632; c.n_dst0 = c.n_src0 = nt_ * 64; c.k0 = kt * 64; c.blk = 1; }
    else if ((t -= 4 * T_FO) < T_EI) { const int nt_ = t / 32, kt = t % 32; c.K = 2048; c.ldsrc = 4128; c.Nsrc = 4128; c.src = p->in[I_EVWI]; c.dst = (bf16_t*)(ws + WS_WEI); c.n_dst0 = c.n_src0 = nt_ * 64; c.k0 = kt * 64; }
    else if ((t -= T_EI) < T_EO) { const int nt_ = t / 32, kt = t % 32; c.K = 2048; c.ldsrc = 2048; c.Nsrc = 2048; c.src = p->in[I_EVWO]; c.dst = (bf16_t*)(ws + WS_WEO); c.n_dst0 = c.n_src0 = nt_ * 64; c.k0 = kt * 64; }
    else if ((t -= T_EO) < T_GLU) { const int nt_ = t / 16, kt = t % 16; c.K = 1024; c.ldsrc = 1024; c.Nsrc = 1024; c.src = p->in[I_GLUW]; c.dst = (bf16_t*)(ws + WS_WGLU); c.n_dst0 = c.n_src0 = nt_ * 64; c.k0 = kt * 64; }
    else if ((t -= T_GLU) < T_OI) { const int nt_ = t / 32, kt = t % 32; c.K = 2048; c.ldsrc = 4096; c.Nsrc = 4096; c.src = p->in[I_ODWI]; c.dst = (bf16_t*)(ws + WS_WOI); c.n_dst0 = c.n_src0 = nt_ * 64; c.k0 = kt * 64; }
    else if ((t -= T_OI) < T_OO) { const int nt_ = t / 32, kt = t % 32; c.K = 2048; c.ldsrc = 2048; c.Nsrc = 2048; c.src = p->in[I_ODWO]; c.dst = (bf16_t*)(ws + WS_WOO); c.n_dst0 = c.n_src0 = nt_ * 64; c.k0 = kt * 64; }
    else { t -= T_OO; const int mi = t / T_LRU; t %= T_LRU; const int which = mi >> 4, dh = mi & 15;
        const int nt_ = t / 4, kt = t % 4; c.K = 256; c.ldsrc = 256; c.Nsrc = 256; c.src = (which ? p->in[I_LWX] : p->in[I_LWA]) + (size_t)dh * 65536; c.dst = (bf16_t*)(ws + WS_WLRU) + (size_t)dh * 2 * 65536;
        c.n_src0 = nt_ * 64; const int half = c.n_src0 >> 7; c.n_dst0 = half * 256 + which * 128 + (c.n_src0 & 127); c.k0 = kt * 64; }
}
constexpr int CV_FI = 176 * 32, CV_FO = 32 * 88, CV_TOTAL = 4 * CV_FI + 4 * CV_FO + 68 * 32 + 32 * 32 + 16 * 16 + 64 * 32 + 32 * 32 + 32 * 16;
__device__ __forceinline__ void cvt_range(PP p, unsigned char* lds, int t_lo, int t_hi, int rank, int n) {
    const int tid = tidx(); unsigned char* ws = p->ws; float* tile = (float*)lds;
    constexpr int CT = 4;
    for (int g0 = t_lo + rank * CT; g0 < t_hi; g0 += n * CT) {
        f32x4 v[CT][2];
#pragma unroll
        for (int q = 0; q < CT; ++q) { CvtT c; cvt_decode(p, ws, g0 + q, t_hi, c);
#pragma unroll
            for (int h = 0; h < 2; ++h) { const int kk = (tid >> 4) + h * 32, n4 = (tid & 15) * 4; const int ns = c.n_src0 + n4;
                v[q][h] = (f32x4){0.f, 0.f, 0.f, 0.f}; if (ns < c.Nsrc) v[q][h] = __builtin_nontemporal_load((const f32x4*)(c.src + (size_t)(c.k0 + kk) * c.ldsrc + ns)); } }
        __syncthreads();
#pragma unroll
        for (int q = 0; q < CT; ++q)
#pragma unroll
            for (int h = 0; h < 2; ++h) { const int kk = (tid >> 4) + h * 32, n4 = (tid & 15) * 4; float* tp = tile + q * 4160 + kk * 65 + n4; tp[0] = v[q][h][0]; tp[1] = v[q][h][1]; tp[2] = v[q][h][2]; tp[3] = v[q][h][3]; }
        __syncthreads();
#pragma unroll
        for (int q = 0; q < CT; ++q) { CvtT c; cvt_decode(p, ws, g0 + q, t_hi, c);
            if (c.dst) { const int nn = tid >> 3, k8 = (tid & 7) * 8; f32x4 a, b2; const float* tp = tile + q * 4160;
#pragma unroll
                for (int j = 0; j < 4; ++j) { a[j] = tp[(k8 + j) * 65 + nn]; b2[j] = tp[(k8 + 4 + j) * 65 + nn]; }
                const int n_ = c.n_dst0 + nn; bf16_t* dp = c.blk ? c.dst + ((size_t)((n_ >> 8) * (c.K >> 6) + (c.k0 >> 6)) * 256 + (n_ & 255)) * 64 + k8 : c.dst + (size_t)n_ * c.K + c.k0 + k8;
                *(bf16x8*)dp = pack8(a, b2); } }
    }
}
__device__ __forceinline__ void mod_items(PP p, unsigned char* lds, int it_lo, int it_hi, int rank, int n) {
    const int tid = tidx(); unsigned char* ws = p->ws;
    float* sc = (float*)lds;
    __syncthreads();
    for (int i = tid; i < 3 * 2048; i += 512) { const int ci = i >> 11, k = i & 2047; const float v = ci == 0 ? p->in[I_CCTX][k] : p->in[I_C][(ci - 1) * 2048 + k]; sc[i] = siluf_(v); }
    __syncthreads();
    float* MOD = (float*)(ws + WS_MOD);
    for (int it = it_lo + rank; it < it_hi; it += n) { const int l = it / 288, r = it % 288, chunk = r / 32, ks = r % 32; const int col = chunk * 2048 + tid * 4;
        const float* W = p->in[I_ADAW] + (size_t)l * 2048 * 18432 + (size_t)(ks * 64) * 18432 + col;
        f32x4 a0 = (f32x4){0.f, 0.f, 0.f, 0.f}, a1 = a0, a2 = a0;
#pragma unroll 16
        for (int k = 0; k < 64; ++k) { const f32x4 w = __builtin_nontemporal_load((const f32x4*)(W + (size_t)k * 18432)); const int kk = ks * 64 + k; a0 += w * sc[kk]; a1 += w * sc[2048 + kk]; a2 += w * sc[4096 + kk]; }
        if (ks == 0) { const f32x4 bb = *(const f32x4*)(p->in[I_ADAB] + (size_t)l * 18432 + col); a0 += bb; a1 += bb; a2 += bb; }
        float* m0 = MOD + (size_t)(l * 3) * 18432 + col;
#pragma unroll
        for (int e = 0; e < 4; ++e) { atomicAdd(m0 + e, a0[e]); atomicAdd(m0 + 18432 + e, a1[e]); atomicAdd(m0 + 2 * 18432 + e, a2[e]); } }
    __syncthreads();
}
__device__ void phase_prep(PP p, LAS unsigned char* ldsr, int skip_mod) {
    unsigned char* lds = (unsigned char*)ldsr;
    const int tid = tidx(), bid = bidx(), nb = gdim();
    unsigned char* ws = p->ws;
    if (!skip_mod) mod_items(p, lds, 0, 288, bid, nb);
    cvt_range(p, lds, 0, CV_FI, bid, nb);
}
__device__ void bg_convert(PP p, LAS unsigned char* ldsr, int ph) {
    unsigned char* lds = (unsigned char*)ldsr; const int bid = bidx();
    constexpr int S0 = 4 * CV_FI + 4 * CV_FO, S_EI = S0, S_EO = S_EI + 2176, S_OI = S_EO + 1024 + 256, S_OO = S_OI + 2048;
    __syncthreads();
    if (ph == 2) { if (bid >= 32) { cvt_range(p, lds, 4 * CV_FI, 4 * CV_FI + CV_FO, bid - 32, 224); cvt_range(p, lds, S_EI, S_EO, bid - 32, 224); } }
    else if (ph == 3) { if (bid >= 192) cvt_range(p, lds, CV_FI, 2 * CV_FI, bid - 192, 64); }
    else if (ph == 5) { if (bid >= 152) cvt_range(p, lds, S_EO, S_OO, bid - 152, 104); }
    else if (ph == 8) { if (bid >= 96) cvt_range(p, lds, 4 * CV_FI + CV_FO, 4 * CV_FI + 2 * CV_FO, bid - 96, 160); }
    else if (ph == 9) { if (bid >= 192) cvt_range(p, lds, S_OO, CV_TOTAL, bid - 192, 64); }
    else if (ph == 11) { if (bid >= 32) cvt_range(p, lds, 2 * CV_FI, 3 * CV_FI, bid - 32, 224); }
    else if (ph == 12) { if (bid >= 192) { mod_items(p, lds, 288, 448, bid - 192, 64); cvt_range(p, lds, 4 * CV_FI + 2 * CV_FO, 4 * CV_FI + 3 * CV_FO, bid - 192, 64); } }
    else if (ph == 14) { if (bid >= 32) cvt_range(p, lds, 3 * CV_FI, 4 * CV_FI, bid - 32, 224); }
    else if (ph == 15) { if (bid >= 192) { cvt_range(p, lds, 4 * CV_FI + 3 * CV_FO, 4 * CV_FI + 4 * CV_FO, bid - 192, 64); mod_items(p, lds, 448, 576, bid - 192, 64); } }
}

__device__ void phase_norm(PP p, int l, int j  ) {
    const int tid = tidx(), lane = tid & 63, wid = tid >> 6; const int gw = bidx() * 8 + wid, nw = gdim() * 8;
    const float* X = (const float*)(p->ws + WS_X); bf16_t* HM = (bf16_t*)(p->ws + WS_HM);
    const float* g = j < 0 ? p->in[I_FNG] : p->in[I_NORMG] + (size_t)(l * 3 + j) * D;
    const bool from_in = (l == 0 && j == 0);
    for (int r = gw; r < MTOK; r += nw) {
        const float* xr = from_in ? (r < TCTX ? p->in[I_XP] + (size_t)r * D : p->in[I_XS] + (size_t)(r - TCTX) * D) : X + (size_t)r * D; f32x4 v[8]; float ss = 0.f;
#pragma unroll
        for (int i = 0; i < 8; ++i) { v[i] = *(const f32x4*)(xr + lane * 4 + i * 256); ss += v[i][0] * v[i][0] + v[i][1] * v[i][1] + v[i][2] * v[i][2] + v[i][3] * v[i][3]; }
#pragma unroll
        for (int o = 32; o >= 1; o >>= 1) ss += __shfl_xor(ss, o);
        const float rinv = rsqrtf(ss * (1.f / D) + EPS);
        if (j < 0) { float* o = p->out + OUT_Y + (size_t)r * D;
#pragma unroll
            for (int i = 0; i < 8; ++i) { const int c = lane * 4 + i * 256; const f32x4 gg = *(const f32x4*)(g + c); *(f32x4*)(o + c) = v[i] * rinv * gg; } }
        else { const float* mod = (const float*)(p->ws + WS_MOD) + (size_t)(l * 3 + cond_of_row(r)) * 18432; const float* sh = mod + (3 * j) * 2048; const float* scl = mod + (3 * j + 1) * 2048;
#pragma unroll
            for (int i = 0; i < 8; ++i) { const int c = lane * 4 + i * 256; const f32x4 gg = *(const f32x4*)(g + c), s1 = *(const f32x4*)(scl + c), s0 = *(const f32x4*)(sh + c);
                const f32x4 y = (v[i] * rinv * gg) * (s1 + 1.f) + s0; uint2 pk; pk.x = cvt_pk_bf16(y[0], y[1]); pk.y = cvt_pk_bf16(y[2], y[3]); *(uint2*)(HM + (size_t)r * D + c) = pk; } }
    }
}

__device__ __forceinline__ void seq_info(int s, int& L, int& row0) { if (s < 16) { L = 256; row0 = s * 256; } else { L = 1024; row0 = TCTX + (s - 16) * 1024; } }

#define WAVE_LDS_SYNC() asm volatile("s_waitcnt lgkmcnt(0)" ::: "memory")
__device__ __forceinline__ void s5_item(PP p, unsigned char* lds, int s, int d, int gg) {
    const int tid = tidx(), lane = tid & 63, wid = tid >> 6, fr = lane & 15, fq = lane >> 4; const int g = gg * 8 + wid;
    int L, row0; seq_info(s, L, row0);
    float* HS = (float*)(lds + wid * 8448);
    const bf16_t* PROJ = (const bf16_t*)(p->ws + WS_PROJ); float* Y = (float*)(p->ws + WS_YS5) + (size_t)d * MTOK * 1024;
    const int pg0 = (d * 64 + g) * 64, pg = pg0 + lane;
    const float lre = p->in[I_LAMRE][pg], lim = p->in[I_LAMIM][pg], dt = expf(p->in[I_LOGSTEP][d * 64 + g]);
    const float mag = expf(lre * dt); float sn, cs; sincosf(lim * dt, &sn, &cs);
    const float abr = mag * cs, abi = mag * sn, den = lre * lre + lim * lim, nre = abr - 1.f;
    const float fre = (nre * lre + abi * lim) / den, fim = (abi * lre - nre * lim) / den;
    bf16x8 af[8];
#pragma unroll
    for (int tq = 0; tq < 4; ++tq) { const int src = tq * 16 + fr; const float f_r = __shfl(fre, src), f_i = __shfl(fim, src);
        f32x4 r0 = (f32x4){0.f, 0.f, 0.f, 0.f}, r1 = r0, i0 = r0, i1 = r0;
        if (fq < 2) { const float* br = p->in[I_BRE] + (size_t)(pg0 + src) * 16 + fq * 8; const float* bi = p->in[I_BIM] + (size_t)(pg0 + src) * 16 + fq * 8;
            r0 = *(const f32x4*)br; r1 = *(const f32x4*)(br + 4); i0 = *(const f32x4*)bi; i1 = *(const f32x4*)(bi + 4); }
        af[tq] = pack8(r0 * f_r - i0 * f_i, r1 * f_r - i1 * f_i); af[tq + 4] = pack8(i0 * f_r + r0 * f_i, i1 * f_r + r1 * f_i); }
    bf16x8 cf[4];
#pragma unroll
    for (int kk = 0; kk < 4; ++kk) { const float* cp = (kk < 2 ? p->in[I_CRE] : p->in[I_CIM]) + ((size_t)(d * 64 + g) * 16 + fr) * 64 + (kk & 1) * 32 + fq * 8;
        f32x4 a = *(const f32x4*)cp, b = *(const f32x4*)(cp + 4); if (kk >= 2) { a = -a; b = -b; } cf[kk] = pack8(a, b); }
    float hr = 0.f, hi = 0.f;
    if (s >= 16) { const size_t o = ((size_t)((s - 16) * 2 + d) * 64 + g) * 64 + lane; hr = p->in[I_S5RE][o]; hi = p->in[I_S5IM][o]; }
    const f32x4 z4 = (f32x4){0.f, 0.f, 0.f, 0.f};
    bf16x8 un = (bf16x8){0, 0, 0, 0, 0, 0, 0, 0};
#define S5_LOADU(c0_) do { if (fq < 2) { const int row_ = row0 + (d ? L - 1 - ((c0_) + fr) : (c0_) + fr); un = *(const bf16x8*)(PROJ + (size_t)row_ * EVINP + g * 16 + fq * 8); } } while (0)
    S5_LOADU(0);
    __syncthreads();
    for (int c0 = 0; c0 < L; c0 += 16) {
        const bf16x8 ub = un;
        if (c0 + 16 < L) S5_LOADU(c0 + 16);
#pragma unroll
        for (int t8 = 0; t8 < 8; ++t8) { const f32x4 bu = __builtin_amdgcn_mfma_f32_16x16x32_bf16(af[t8], ub, z4, 0, 0, 0); *(f32x4*)(HS + fr * 132 + t8 * 16 + fq * 4) = bu; }
        WAVE_LDS_SYNC();
#pragma unroll
        for (int i = 0; i < 16; ++i) { const float bur = HS[i * 132 + lane], bui = HS[i * 132 + 64 + lane];
            const float nr = abr * hr - abi * hi + bur, ni = abr * hi + abi * hr + bui; hr = nr; hi = ni;
            HS[i * 132 + lane] = hr; HS[i * 132 + 64 + lane] = hi; }
        WAVE_LDS_SYNC();
        { f32x4 acc = z4;
#pragma unroll
          for (int kk = 0; kk < 4; ++kk) { const float* hp = HS + fr * 132 + kk * 32 + fq * 8; const bf16x8 hb = pack8(*(const f32x4*)hp, *(const f32x4*)(hp + 4));
              acc = __builtin_amdgcn_mfma_f32_16x16x32_bf16(cf[kk], hb, acc, 0, 0, 0); }
          const int row = row0 + (d ? L - 1 - (c0 + fr) : c0 + fr);
          *(f32x4*)(Y + (size_t)row * 1024 + g * 16 + fq * 4) = acc; }
        WAVE_LDS_SYNC();
    }
#undef S5_LOADU
    if (s < 16) { const size_t o = ((size_t)(s * 2 + d) * 64 + g) * 64 + lane; p->out[OUT_S5RE + o] = hr; p->out[OUT_S5IM + o] = hi; }
}

template <int NK32> __device__ __forceinline__ f32x4 mma_lds(f32x4 acc, const bf16_t* X, int ldx, const bf16_t* Y, int ldy, int lane) {
    const bf16_t* xp = X + (lane & 15) * ldx + (lane >> 4) * 8; const bf16_t* yp = Y + (lane & 15) * ldy + (lane >> 4) * 8;
#pragma unroll
    for (int kk = 0; kk < NK32; ++kk) acc = __builtin_amdgcn_mfma_f32_16x16x32_bf16(*(const bf16x8*)(xp + kk * 32), *(const bf16x8*)(yp + kk * 32), acc, 0, 0, 0);
    return acc;
}

__device__ __forceinline__ void gla_item(PP p, unsigned char* lds, int s, int h, int d, int vh) {
    const int tid = tidx(), lane = tid & 63, wid = tid >> 6, fr = lane & 15, fq = lane >> 4;
    int L, row0; seq_info(s, L, row0);
    bf16_t* QT = (bf16_t*)(lds);
    bf16_t* KT = (bf16_t*)(lds + 17408);
    bf16_t* KE = (bf16_t*)(lds + 34816);
    bf16_t* VT = (bf16_t*)(lds + 53248);
    bf16_t* ATT = (bf16_t*)(lds + 71680);
    bf16_t* ST = (bf16_t*)(lds + 80896);
    float* LOGA = (float*)(lds + 80896);
    float* SEG = (float*)(lds + 115712);
    float* GLR = (float*)(lds + 117760);
    float* W2S = (float*)(lds + 121856);
    float* GBS = (float*)(lds + 130048);
    float* DEC = (float*)(lds + 130560);
    const bf16_t* PROJ = (const bf16_t*)(p->ws + WS_PROJ); float* O = (float*)(p->ws + WS_OGLA) + (size_t)d * MTOK * 1024;
    __syncthreads();
    for (int i = tid; i < 16 * 128; i += 512) W2S[i] = p->in[I_GW2][(size_t)(d * 16 + (i >> 7)) * 512 + h * 128 + (i & 127)];
    if (tid < 128) GBS[tid] = p->in[I_GB][d * 512 + h * 128 + tid];
    f32x4 sacc[8];
#pragma unroll
    for (int tn = 0; tn < 8; ++tn) { sacc[tn] = (f32x4){0.f, 0.f, 0.f, 0.f};
        if (s >= 16) { const float* sp = p->in[I_SGLA] + ((size_t)(((s - 16) * 2 + d) * 4 + h) * 128 + wid * 16 + fq * 4) * 256 + vh * 128 + tn * 16 + fr;
#pragma unroll
            for (int e = 0; e < 4; ++e) sacc[tn][e] = sp[(size_t)e * 256]; } }
    const float qscale = 0.08838834764831845f;
    const int nch = L >> 6;
    const int c = tid & 127, ig = tid >> 7;
#define GROW(n_, i) (row0 + (d ? L - 1 - ((n_) * 64 + (i)) : (n_) * 64 + (i)))
    f32x4 glr4 = (f32x4){0.f, 0.f, 0.f, 0.f}; float qv[16], kv[16], vv[16];
#define GLA_PREFETCH(n_) do { \
        if (tid < 256) glr4 = unpack4(*(const uint2*)(PROJ + (size_t)GROW(n_, tid >> 2) * EVINP + 4096 + d * 16 + (tid & 3) * 4)); \
        _Pragma("unroll") for (int ii = 0; ii < 16; ++ii) { const size_t ro = (size_t)GROW(n_, ig * 16 + ii) * EVINP; \
            qv[ii] = bf2f_(PROJ[ro + 1024 + h * 128 + c]); kv[ii] = bf2f_(PROJ[ro + 1536 + h * 128 + c]); vv[ii] = bf2f_(PROJ[ro + 2048 + h * 256 + vh * 128 + c]); } } while (0)
    GLA_PREFETCH(0);
    for (int n = 0; n < nch; ++n) {
        __syncthreads();
        if (tid < 256) *(f32x4*)(GLR + (tid >> 2) * 16 + (tid & 3) * 4) = glr4;
        __syncthreads();
        { float run = 0.f; const float gb = GBS[c];
          float w2[16];
#pragma unroll
          for (int r = 0; r < 16; ++r) w2[r] = W2S[r * 128 + c];
          for (int ii = 0; ii < 16; ++ii) { const int i = ig * 16 + ii; float z = gb;
#pragma unroll
              for (int q = 0; q < 4; ++q) { const f32x4 g4 = *(const f32x4*)(GLR + i * 16 + q * 4);
#pragma unroll
                  for (int e = 0; e < 4; ++e) z += g4[e] * w2[q * 4 + e]; }
              run -= (fmaxf(-z, 0.f) + __logf(1.f + __expf(-fabsf(z)))) * (1.f / 16.f); LOGA[i * 128 + c] = run; }
          SEG[ig * 128 + c] = run; }
        __syncthreads();
        { float pre = 0.f, tot = 0.f;
#pragma unroll
          for (int q = 0; q < 4; ++q) { const float sg = SEG[q * 128 + c]; tot += sg; if (q < ig) pre += sg; }
          if (ig == 0) DEC[c] = __expf(tot);
#pragma unroll
          for (int ii = 0; ii < 16; ++ii) { const int i = ig * 16 + ii; const float bc = LOGA[i * 128 + c] + pre;
              QT[i * 136 + c] = f2bf(qv[ii] * qscale * __expf(bc)); KT[i * 136 + c] = f2bf(kv[ii] * __expf(-bc)); KE[c * 72 + i] = f2bf(kv[ii] * __expf(tot - bc)); VT[c * 72 + i] = f2bf(vv[ii]); } }
        __syncthreads();
        if (n + 1 < nch) GLA_PREFETCH(n + 1);
#pragma unroll
        for (int q = 0; q < 2; ++q) { const int tile = wid * 2 + q, ti = tile >> 2, tj = tile & 3; f32x4 a = (f32x4){0.f, 0.f, 0.f, 0.f};
            if (tj <= ti) a = mma_lds<4>(a, QT + ti * 16 * 136, 136, KT + tj * 16 * 136, 136, lane);
#pragma unroll
            for (int e = 0; e < 4; ++e) { const int i = ti * 16 + fq * 4 + e, jx = tj * 16 + fr; ATT[i * 72 + jx] = f2bf(jx <= i ? a[e] : 0.f); } }
#pragma unroll
        for (int tn = 0; tn < 8; ++tn) { uint2 pk; pk.x = cvt_pk_bf16(sacc[tn][0], sacc[tn][1]); pk.y = cvt_pk_bf16(sacc[tn][2], sacc[tn][3]); *(uint2*)(ST + (tn * 16 + fr) * 136 + wid * 16 + fq * 4) = pk; }
        __syncthreads();
#pragma unroll
        for (int ti = 0; ti < 4; ++ti) { f32x4 o = (f32x4){0.f, 0.f, 0.f, 0.f};
            o = mma_lds<2>(o, ATT + ti * 16 * 72, 72, VT + wid * 16 * 72, 72, lane);
            o = mma_lds<4>(o, QT + ti * 16 * 136, 136, ST + wid * 16 * 136, 136, lane);
#pragma unroll
            for (int e = 0; e < 4; ++e) { const int i = ti * 16 + fq * 4 + e; O[(size_t)GROW(n, i) * 1024 + h * 256 + vh * 128 + wid * 16 + fr] = o[e]; } }
        { f32x4 dc;
#pragma unroll
          for (int e = 0; e < 4; ++e) dc[e] = DEC[wid * 16 + fq * 4 + e];
#pragma unroll
          for (int tn = 0; tn < 8; ++tn) { sacc[tn] = sacc[tn] * dc; sacc[tn] = mma_lds<2>(sacc[tn], KE + wid * 16 * 72, 72, VT + tn * 16 * 72, 72, lane); } }
    }
#undef GROW
#undef GLA_PREFETCH
    if (s < 16) {
#pragma unroll
        for (int tn = 0; tn < 8; ++tn) { float* sp = p->out + OUT_GLA + ((size_t)((s * 2 + d) * 4 + h) * 128 + wid * 16 + fq * 4) * 256 + vh * 128 + tn * 16 + fr;
#pragma unroll
            for (int e = 0; e < 4; ++e) sp[(size_t)e * 256] = sacc[tn][e]; } }
}

__device__ void phase_s5gla(PP p, LAS unsigned char* ldsr) {
    unsigned char* lds = (unsigned char*)ldsr; const int bid = bidx(), nb = gdim();
    if (nb >= 64) {
        if (bid < 32) { gla_item(p, lds, 16 + (bid >> 4), (bid >> 2) & 3, (bid >> 1) & 1, bid & 1); return; }
        for (int it = bid - 32; it < 544; it += nb - 32) {
            if (it < 32) s5_item(p, lds, 16 + (it >> 4), (it >> 3) & 1, it & 7);
            else if (it < 288) { const int q = it - 32; s5_item(p, lds, q >> 4, (q >> 3) & 1, q & 7); }
            else { const int q = it - 288; gla_item(p, lds, q >> 4, (q >> 2) & 3, (q >> 1) & 1, q & 1); }
        }
    } else {
        for (int it = bid; it < 576; it += nb) {
            if (it < 32) { gla_item(p, lds, 16 + (it >> 4), (it >> 2) & 3, (it >> 1) & 1, it & 1); }
            else if (it < 64) { const int q = it - 32; s5_item(p, lds, 16 + (q >> 4), (q >> 3) & 1, q & 7); }
            else if (it < 320) { const int q = it - 64; s5_item(p, lds, q >> 4, (q >> 3) & 1, q & 7); }
            else { const int q = it - 320; gla_item(p, lds, q >> 4, (q >> 2) & 3, (q >> 1) & 1, q & 1); }
        }
    }
}

__device__ void phase_evpost(PP p) {
    const int tid = tidx(), lane = tid & 63, wid = tid >> 6; const int gw = bidx() * 8 + wid, nw = gdim() * 8;
    const bf16_t* PROJ = (const bf16_t*)(p->ws + WS_PROJ); const float* Y0 = (const float*)(p->ws + WS_YS5); const float* Y1 = Y0 + (size_t)MTOK * 1024;
    const float* O0 = (const float*)(p->ws + WS_OGLA); const float* O1 = O0 + (size_t)MTOK * 1024;
    bf16_t* YSB = (bf16_t*)(p->ws + WS_YSB); bf16_t* CAT = (bf16_t*)(p->ws + WS_CAT);
    for (int r = gw; r < MTOK; r += nw) {
        f32x4 y0[4], y1[4], o0[4], o1[4]; uint2 uw[4], gw4[4];
        const int c0 = lane * 16;
#pragma unroll
        for (int i = 0; i < 4; ++i) { const int c = lane * 4 + i * 256; y0[i] = *(const f32x4*)(Y0 + (size_t)r * 1024 + c); y1[i] = *(const f32x4*)(Y1 + (size_t)r * 1024 + c); uw[i] = *(const uint2*)(PROJ + (size_t)r * EVINP + c);
            o0[i] = *(const f32x4*)(O0 + (size_t)r * 1024 + c0 + i * 4); o1[i] = *(const f32x4*)(O1 + (size_t)r * 1024 + c0 + i * 4); gw4[i] = *(const uint2*)(PROJ + (size_t)r * EVINP + 3072 + c0 + i * 4); }
#pragma unroll
        for (int i = 0; i < 4; ++i) { const int c = lane * 4 + i * 256; const f32x4 u = unpack4(uw[i]), dd = *(const f32x4*)(p->in[I_S5D] + c); f32x4 v = y0[i] + y1[i] + dd * u;
#pragma unroll
            for (int e = 0; e < 4; ++e) v[e] = geluf_(v[e]);
            uint2 pk; pk.x = cvt_pk_bf16(v[0], v[1]); pk.y = cvt_pk_bf16(v[2], v[3]); *(uint2*)(YSB + (size_t)r * 1024 + c) = pk; }
        { f32x4 o[4]; float ss = 0.f;
#pragma unroll
          for (int i = 0; i < 4; ++i) { o[i] = o0[i] + o1[i]; ss += o[i][0] * o[i][0] + o[i][1] * o[i][1] + o[i][2] * o[i][2] + o[i][3] * o[i][3]; }
#pragma unroll
          for (int m = 8; m >= 1; m >>= 1) ss += __shfl_xor(ss, m);
          const float rinv = rsqrtf(ss * (1.f / 256.f) + EPS);
#pragma unroll
          for (int i = 0; i < 4; ++i) { const int c = c0 + i * 4; const f32x4 ng = *(const f32x4*)(p->in[I_GNG] + (c & 255)), gt = unpack4(gw4[i]); f32x4 v;
#pragma unroll
              for (int e = 0; e < 4; ++e) v[e] = o[i][e] * rinv * ng[e] * siluf_(gt[e]);
              uint2 pk; pk.x = cvt_pk_bf16(v[0], v[1]); pk.y = cvt_pk_bf16(v[2], v[3]); *(uint2*)(CAT + (size_t)r * D + 1024 + c) = pk; } }
    }
}

__device__ void phase_conv(PP p) {
    const bf16_t* PROJ = (const bf16_t*)(p->ws + WS_PROJ); bf16_t* XCB = (bf16_t*)(p->ws + WS_XCB);
    const float* cw = p->in[I_CONVW]; const float* cb = p->in[I_CONVB];
    const size_t total = (size_t)MTOK * 512;
    { const int gi = bidx() * 512 + tidx(); if (gi < 2 * D) ((float*)(p->ws + WS_SP))[gi] = -8.f * softplusf_(-p->in[I_LLAM][gi]); }
    for (size_t i = (size_t)bidx() * 512 + tidx(); i < total; i += (size_t)gdim() * 512) {
        const int r = (int)(i >> 9), c = (int)(i & 511) * 4; const int seg = r < TCTX ? 256 : 64; const int pos = r & (seg - 1);
        f32x4 acc = *(const f32x4*)(cb + c);
#pragma unroll
        for (int j = 0; j < 4; ++j) { const int pp = pos + j - 2; if (pp >= 0 && pp < seg) acc += *(const f32x4*)(cw + j * D + c) * unpack4(*(const uint2*)(PROJ + (size_t)(r + j - 2) * 4096 + 2048 + c)); }
        uint2 pk; pk.x = cvt_pk_bf16(acc[0], acc[1]); pk.y = cvt_pk_bf16(acc[2], acc[3]); *(uint2*)(XCB + (size_t)r * D + c) = pk;
    }
}
__device__ void phase_lruscan1(PP p) {
    const int tid = tidx(), lane = tid & 63, wid = tid >> 6; const int nb = gdim();
    float* SUM = (float*)(p->ws + WS_LSUM);
    for (int it = bidx() * 8 + wid; it < 384 * 64; it += 8 * nb) {
        const int q = it >> 6, d = (it >> 5) & 1, c = (it & 31) * 64 + lane; const int row0 = q * 16;
        const unsigned* LAB = (const unsigned*)(p->ws + WS_LA) + ((size_t)d * MTOK + row0) * D + c;
        unsigned wv[16];
#pragma unroll
        for (int j = 0; j < 16; ++j) wv[j] = LAB[(size_t)j * D];
        float S = 0.f, h = 0.f;
        if (d == 0) {
#pragma unroll
            for (int j = 0; j < 16; ++j) { const float la = lo_bf(wv[j]); h = __expf(la) * h + hi_bf(wv[j]); S += la; } }
        else {
#pragma unroll
            for (int j = 15; j >= 0; --j) { const float la = lo_bf(wv[j]); h = __expf(la) * h + hi_bf(wv[j]); S += la; } }
        SUM[((size_t)d * 384 + q) * D + c] = __expf(S); SUM[((size_t)(2 + d) * 384 + q) * D + c] = h;
    }
}
__device__ void conv_tile(PP p, int pm, int pnx) {
    const int tid = tidx();
    const bf16_t* PROJ = (const bf16_t*)(p->ws + WS_PROJ); bf16_t* XCB = (bf16_t*)(p->ws + WS_XCB); const float* cw = p->in[I_CONVW]; const float* cb = p->in[I_CONVB];
    const int c = pnx * 256 + (tid & 63) * 4; const int rl0 = tid >> 6;
    f32x4 w[4]; const f32x4 bias = *(const f32x4*)(cb + c);
#pragma unroll
    for (int j = 0; j < 4; ++j) w[j] = *(const f32x4*)(cw + j * D + c);
    for (int kb = 0; kb < 32; kb += 4) {
        uint2 t[4][4];
#pragma unroll
        for (int u = 0; u < 4; ++u) { const int r = pm * 256 + rl0 + 8 * (kb + u); const int seg = r < TCTX ? 256 : 64; const int pos = r & (seg - 1);
#pragma unroll
            for (int j = 0; j < 4; ++j) { const int pp = pos + j - 2; t[u][j] = (uint2){0u, 0u}; if (pp >= 0 && pp < seg) t[u][j] = *(const uint2*)(PROJ + (size_t)(r + j - 2) * 4096 + 2048 + c); } }
#pragma unroll
        for (int u = 0; u < 4; ++u) { const int r = pm * 256 + rl0 + 8 * (kb + u); f32x4 acc = bias;
#pragma unroll
            for (int j = 0; j < 4; ++j) acc += w[j] * unpack4(t[u][j]);
            uint2 pk; pk.x = cvt_pk_bf16(acc[0], acc[1]); pk.y = cvt_pk_bf16(acc[2], acc[3]); *(uint2*)(XCB + (size_t)r * D + c) = pk; } }
}
__device__ void scan1_tile(PP p, int pm, int pn) {
    const int tid = tidx(); const int d = pn >> 4, chu = ((pn >> 1) & 7) * 256 + (pn & 1) * 128; float* SUM = (float*)(p->ws + WS_LSUM);
    const int c = chu + (tid & 127);
    unsigned wv[4][16];
#pragma unroll
    for (int k = 0; k < 4; ++k) { const int q = pm * 16 + (tid >> 7) + 4 * k; const unsigned* LAB = (const unsigned*)(p->ws + WS_LA) + ((size_t)d * MTOK + q * 16) * D + c;
#pragma unroll
        for (int j = 0; j < 16; ++j) wv[k][j] = LAB[(size_t)j * D]; }
#pragma unroll
    for (int k = 0; k < 4; ++k) { const int q = pm * 16 + (tid >> 7) + 4 * k; float S = 0.f, h = 0.f;
        if (d == 0) {
#pragma unroll
            for (int j = 0; j < 16; ++j) { const float la = lo_bf(wv[k][j]); h = __expf(la) * h + hi_bf(wv[k][j]); S += la; } }
        else {
#pragma unroll
            for (int j = 15; j >= 0; --j) { const float la = lo_bf(wv[k][j]); h = __expf(la) * h + hi_bf(wv[k][j]); S += la; } }
        SUM[((size_t)d * 384 + q) * D + c] = __expf(S); SUM[((size_t)(2 + d) * 384 + q) * D + c] = h; }
}
__device__ void phase_lruscan2(PP p) {
    const int tid = tidx(), lane = tid & 63, wid = tid >> 6; const int nb = gdim();
    const float* SUM = (const float*)(p->ws + WS_LSUM); const bf16_t* PROJ = (const bf16_t*)(p->ws + WS_PROJ); bf16_t* CAT = (bf16_t*)(p->ws + WS_CAT);
    for (int it0 = bidx() * 8 + wid; it0 < 384 * 32; it0 += 8 * nb) {
        const int it = it0 < 128 * 32 ? it0 + 256 * 32 : it0 - 128 * 32;
        const int q = it >> 5, c = (it & 31) * 64 + lane; const int row0 = q * 16;
        int qs, ql, s; if (q < 256) { s = q >> 4; qs = s * 16; ql = qs + 15; } else { s = 16 + ((q - 256) >> 6); qs = 256 + (s - 16) * 64; ql = qs + 63; }
        float h0 = 0.f, h1 = 0.f;
        if (s >= 16) { h0 = p->in[I_SLRU][(size_t)((s - 16) * 2 + 0) * D + c]; h1 = p->in[I_SLRU][(size_t)((s - 16) * 2 + 1) * D + c]; }
        const float* P0 = SUM + c; const float* H0 = SUM + (size_t)2 * 384 * D + c; const float* P1 = SUM + (size_t)384 * D + c; const float* H1 = SUM + (size_t)3 * 384 * D + c;
        for (int j = qs; j < q; j += 8) { float pv[8], hv[8];
#pragma unroll
            for (int e = 0; e < 8; ++e) { const bool ok = j + e < q; pv[e] = ok ? P0[(size_t)(j + e) * D] : 1.f; hv[e] = ok ? H0[(size_t)(j + e) * D] : 0.f; }
#pragma unroll
            for (int e = 0; e < 8; ++e) h0 = pv[e] * h0 + hv[e]; }
        for (int j = ql; j > q; j -= 8) { float pv[8], hv[8];
#pragma unroll
            for (int e = 0; e < 8; ++e) { const bool ok = j - e > q; pv[e] = ok ? P1[(size_t)(j - e) * D] : 1.f; hv[e] = ok ? H1[(size_t)(j - e) * D] : 0.f; }
#pragma unroll
            for (int e = 0; e < 8; ++e) h1 = pv[e] * h1 + hv[e]; }
        const unsigned* W0 = (const unsigned*)(p->ws + WS_LA) + (size_t)row0 * D + c; const unsigned* W1 = W0 + (size_t)MTOK * D; const bf16_t* GT = PROJ + (size_t)row0 * 4096 + c;
        unsigned w0[16], w1[16]; float b0[16], gt[16];
#pragma unroll
        for (int j = 0; j < 16; ++j) { w0[j] = W0[(size_t)j * D]; w1[j] = W1[(size_t)j * D]; gt[j] = bf2f_(GT[(size_t)j * 4096]); }
#pragma unroll
        for (int j = 0; j < 16; ++j) { h0 = __expf(lo_bf(w0[j])) * h0 + hi_bf(w0[j]); b0[j] = h0; }
#pragma unroll
        for (int j = 15; j >= 0; --j) { h1 = __expf(lo_bf(w1[j])) * h1 + hi_bf(w1[j]); CAT[(size_t)(row0 + j) * D + c] = f2bf((b0[j] + h1) * geluf_(gt[j])); }
        if (s < 16) { if (q == ql) p->out[OUT_LRU + (size_t)(s * 2 + 0) * D + c] = h0; if (q == qs) p->out[OUT_LRU + (size_t)(s * 2 + 1) * D + c] = h1; }
    }
}

#ifndef PHMASK
#define PHMASK 0xFFFFFFFFu
#endif
#define PHON(k) ((PHMASK >> (k)) & 1u)
#ifndef DUPMASK
#define DUPMASK 0u
#endif
enum { K_PREP = 0, K_NORM, K_SWIGLU, K_RESID, K_F32, K_S5GLA, K_EVPOST, K_GLU, K_CONV, K_LRUG, K_LRUSCAN, K_LRUCOMB };
__global__ void __launch_bounds__(512, 2) mega(Params p) {
    extern __shared__ __attribute__((aligned(16))) unsigned char shm[];
    LAS unsigned char* lds = (LAS unsigned char*)shm;
    cg::grid_group grid = cg::this_grid();
    const int ph_lo = p.ph_lo, ph_hi = p.ph_hi;
    int rep = 0;
    volatile LAS unsigned* bst = (volatile LAS unsigned*)(lds + LDS_MAIN);
    if (threadIdx.x < 16) bst[threadIdx.x] = 0u;
    __syncthreads();
    XcdBarrier xbar = xcd_barrier_post((unsigned*)(p.ws + WS_BAR), bst);
    for (int ph = ph_lo; ph < ph_hi; ++ph) {
        PP pp = get_pp();
        unsigned char* ws = pp->ws;
        const float* MOD = (const float*)(ws + WS_MOD);
        int kind, l = 0, a0 = 0;
        if (ph == 0) kind = K_PREP;
        else if (ph == 24) { kind = K_NORM; a0 = -1; }
        else { l = ph > 12 ? 1 : 0; const int q = ph - 1 - 12 * l;
            if (q == 0) { kind = K_NORM; a0 = 0; }
            else if (q == 1) { kind = K_SWIGLU; a0 = 0; }
            else if (q == 2) { kind = K_RESID; a0 = 0; }
            else if (q == 3) { kind = K_NORM; a0 = 1; }
            else if (q == 4) kind = K_F32;
            else if (l == 0) { if (q == 5) kind = K_S5GLA; else if (q == 6) kind = K_EVPOST; else if (q == 7) kind = K_GLU; else if (q == 8) { kind = K_RESID; a0 = 2; } else if (q == 9) { kind = K_NORM; a0 = 2; } else if (q == 10) { kind = K_SWIGLU; a0 = 1; } else { kind = K_RESID; a0 = 1; } }
            else { if (q == 5) kind = K_LRUG; else if (q == 6) kind = K_LRUCOMB; else if (q == 7) { kind = K_RESID; a0 = 2; } else if (q == 8) { kind = K_NORM; a0 = 2; } else if (q == 9) { kind = K_SWIGLU; a0 = 1; } else { kind = K_RESID; a0 = 1; } }
        }
        const bf16_t* HM = (const bf16_t*)(ws + WS_HM);
        if (kind == K_PREP) { if (PHON(0)) phase_prep(pp, lds, rep); }
        else if (kind == K_NORM) { if (PHON(1)) phase_norm(pp, l, a0); }
        else if (kind == K_SWIGLU) { if (PHON(2)) { EpiSwiglu E{(bf16_t*)(ws + WS_H)}; pg8::gemm_phase<EpiSwiglu, false>(lds, HM, D, (const bf16_t*)(ws + WS_WFI) + (size_t)(l * 2 + a0) * 11264 * 2048, D, 24, 44, D, E); if (!rep) bg_convert(pp, lds, ph); } }
        else if (kind == K_RESID) { if (PHON(3)) {
            const bf16_t* A; const bf16_t* B; int K; int gj; float coef;
            if (a0 < 2) { A = (const bf16_t*)(ws + WS_H); B = (const bf16_t*)(ws + WS_WFO) + (size_t)(l * 2 + a0) * 2048 * 5632; K = DFF; gj = a0 == 0 ? 2 : 8; coef = 0.5f; }
            else { A = (const bf16_t*)(ws + WS_CAT); B = (const bf16_t*)(ws + (l == 0 ? WS_WEO : WS_WOO)); K = D; gj = 5; coef = 1.0f; }
            const bool first = (ph == 3);
            const float* xc_ = first ? pp->in[I_XP] : (const float*)(ws + WS_X); const float* xl_ = first ? pp->in[I_XS] - (size_t)TCTX * D : (const float*)(ws + WS_X);
            EpiResid E{(float*)(ws + WS_X), MOD + (size_t)(l * 3) * 18432 + gj * 2048, coef, xc_, xl_};
            if (a0 < 2) pg8::gemm_phase<EpiResid, false, true>(lds, A, K, B, K, 24, 8, K, E); else pg8::gemm_phase<EpiResid, false, false>(lds, A, K, B, K, 24, 8, K, E); if (!rep) bg_convert(pp, lds, ph); } }
        else if (kind == K_F32) { if (PHON(4)) {
            { const int nN = l == 0 ? 17 : 16; EpiBf16 E{(bf16_t*)(ws + WS_PROJ), nN * 256}; pg8::gemm_phase<EpiBf16, false>(lds, HM, D, (const bf16_t*)(ws + (l == 0 ? WS_WEI : WS_WOI)), D, 24, nN, D, E); }
            if (l == 1) {
                { const int gi = bidx() * 512 + tidx(); if (gi < 2 * D) ((float*)(ws + WS_SP))[gi] = -8.f * softplusf_(-pp->in[I_LLAM][gi]); }
                pg8::Order S; S.nM = 24; S.nN = 16; S.nwg = 384; S.G = gdim(); S.c = bidx(); Unit u;
                for (int i = 0; S.next(i, u); ++i) if (u.pn >= 8) conv_tile(pp, u.pm, u.pn - 8); }
            if (!rep) bg_convert(pp, lds, ph); } }
        else if (kind == K_S5GLA) { if (PHON(5)) phase_s5gla(pp, lds); }
        else if (kind == K_EVPOST) { if (PHON(6)) phase_evpost(pp); }
        else if (kind == K_GLU) { if (PHON(7)) { EpiGlu E{(bf16_t*)(ws + WS_CAT), (const bf16_t*)(ws + WS_YSB), pp->in[I_GLUB]}; pg8::gemm_phase<EpiGlu, false>(lds, (const bf16_t*)(ws + WS_YSB), 1024, (const bf16_t*)(ws + WS_WGLU), 1024, 24, 4, 1024, E); if (!rep) bg_convert(pp, lds, ph); } }
        else if (kind == K_CONV) { if (PHON(8)) phase_conv(pp); }
        else if (kind == K_LRUG) { if (PHON(9)) { EpiLru E{(unsigned*)(ws + WS_LA), (const bf16_t*)(ws + WS_XCB), pp->in[I_LBA], pp->in[I_LBX], (const float*)(ws + WS_SP)};
            int kk = 256; asm volatile("" : "+s"(kk));
            pg8::gemm_phase<EpiLru, true>(lds, (const bf16_t*)(ws + WS_XCB), D, (const bf16_t*)(ws + WS_WLRU), kk, 24, 32, kk, E);
            { pg8::Order S; S.nM = 24; S.nN = 32; S.nwg = 768; S.G = gdim(); S.c = bidx(); Unit u; for (int i = 0; S.next(i, u); ++i) scan1_tile(pp, u.pm, u.pn); } } }
        else if (kind == K_LRUSCAN) { if (PHON(10)) phase_lruscan1(pp); }
        else { if (PHON(11)) phase_lruscan2(pp); }
#if DUPMASK
        if (rep == 0 && ((DUPMASK >> kind) & 1u)) { xcd_barrier(xbar); rep = 1; --ph; continue; }
        rep = 0;
#endif
        if (ph + 1 < ph_hi) { if (ph == 0) grid.sync(); else xcd_barrier(xbar); }
    }
}

extern "C" void kernel_launch(void* const* d_in, const int* in_sizes, int n_in, void* d_out, int out_size, void* d_ws, size_t ws_size, hipStream_t stream) {
    static int grid = 0;
    if (grid == 0) {
        if (n_in != 38 || ws_size < WS_END) { fprintf(stderr, "kernel_launch: expected 38 inputs and >= %zu bytes of workspace (got %d, %zu)\n", (size_t)WS_END, n_in, ws_size); grid = -1; return; }
        int dev = 0, cus = 0, per_cu = 0;
        hipGetDevice(&dev); hipDeviceGetAttribute(&cus, hipDeviceAttributeMultiprocessorCount, dev);
        hipFuncSetAttribute((const void*)mega, hipFuncAttributeMaxDynamicSharedMemorySize, LDS_BYTES);
        hipOccupancyMaxActiveBlocksPerMultiprocessor(&per_cu, (const void*)mega, 512, LDS_BYTES);
        if (per_cu < 1) { fprintf(stderr, "kernel_launch: occupancy query says %d blocks per CU\n", per_cu); grid = -1; return; }
        grid = cus;
    }
    if (grid < 0) return;
    (void)hipMemsetAsync((char*)d_ws + WS_MOD, 0, ZERO_BYTES, stream);
    Params p{};
    for (int i = 0; i < 38; ++i) p.in[i] = (const float*)d_in[i];
    p.out = (float*)d_out; p.ws = (unsigned char*)d_ws;
#if MEGA
    p.ph_lo = 0; p.ph_hi = NPH;
    void* args[] = {&p};
    hipError_t e = hipLaunchCooperativeKernel((const void*)mega, dim3(grid), dim3(512), args, LDS_BYTES, stream);
    if (e != hipSuccess) fprintf(stderr, "cooperative launch failed: %s (grid %d)\n", hipGetErrorString(e), grid);
#else
    for (int ph = 0; ph < NPH; ++ph) { p.ph_lo = ph; p.ph_hi = ph + 1; hipLaunchKernelGGL(mega, dim3(grid), dim3(512), LDS_BYTES, stream, p); }
#endif
}
```

```cpp
#include <hip/hip_runtime.h>
#include <hip/hip_cooperative_groups.h>
#include <cstdio>
namespace cg = cooperative_groups;

#ifndef MEGA
#define MEGA 1
#endif

#define LAS __attribute__((address_space(3)))
typedef unsigned short bf16_t;
typedef short bf16x8 __attribute__((ext_vector_type(8)));
typedef float f32x4 __attribute__((ext_vector_type(4)));
typedef float f32x2 __attribute__((ext_vector_type(2)));

constexpr int D = 2048, DFF = 5632, MTOK = 6144, TCTX = 4096;
constexpr int EVINP = 4352;
constexpr int NPH = 25;
constexpr int LDS_MAIN = 131072;
constexpr int LDS_BYTES = LDS_MAIN + 64;
constexpr float EPS = 1e-6f;

constexpr size_t al256(size_t x) { return (x + 255) & ~(size_t)255; }
constexpr size_t WS_MOD = 0;
constexpr size_t MOD_BYTES = (size_t)2 * 3 * 9 * 2048 * 4;
constexpr size_t WS_BAR = al256(WS_MOD + MOD_BYTES);
constexpr size_t BAR_BYTES = 3456 * 4;
constexpr size_t ZERO_BYTES = WS_BAR + BAR_BYTES;
constexpr size_t WS_X = al256(WS_BAR + BAR_BYTES);
constexpr size_t WS_HM = WS_X + (size_t)MTOK * D * 4;
constexpr size_t WS_H = WS_HM + (size_t)MTOK * D * 2;
constexpr size_t WS_PROJ = WS_H + (size_t)MTOK * DFF * 2;
constexpr size_t WS_WFI = WS_PROJ + (size_t)MTOK * EVINP * 4;
constexpr size_t WS_WFO = WS_WFI + (size_t)4 * 11264 * 2048 * 2;
constexpr size_t WS_WEI = WS_WFO + (size_t)4 * 2048 * 5632 * 2;
constexpr size_t WS_WEO = WS_WEI + (size_t)EVINP * 2048 * 2;
constexpr size_t WS_WGLU = WS_WEO + (size_t)2048 * 2048 * 2;
constexpr size_t WS_WOI = WS_WGLU + (size_t)1024 * 1024 * 2;
constexpr size_t WS_WOO = WS_WOI + (size_t)4096 * 2048 * 2;
constexpr size_t WS_WLRU = WS_WOO + (size_t)2048 * 2048 * 2;
constexpr size_t WS_YS5 = WS_WLRU + (size_t)2 * 8 * 2 * 256 * 256 * 2;
constexpr size_t WS_OGLA = WS_YS5 + (size_t)2 * MTOK * 1024 * 4;
constexpr size_t WS_YS32 = WS_OGLA + (size_t)2 * MTOK * 1024 * 4;
constexpr size_t WS_YSB = WS_YS32 + (size_t)MTOK * 1024 * 4;
constexpr size_t WS_CAT = WS_YSB + (size_t)MTOK * 1024 * 2;
constexpr size_t WS_XC32 = WS_CAT + (size_t)MTOK * D * 2;
constexpr size_t WS_XCB = WS_XC32 + (size_t)MTOK * D * 4;
constexpr size_t WS_LA = WS_XCB + (size_t)MTOK * D * 2;
constexpr size_t WS_LB = WS_LA + (size_t)2 * MTOK * D * 4;
constexpr size_t WS_SP = WS_LB + (size_t)2 * MTOK * D * 4;
constexpr size_t WS_LSUM = WS_SP + (size_t)2 * D * 4;
constexpr size_t WS_END = WS_LSUM + (size_t)2 * 2 * 384 * D * 4;

constexpr size_t OUT_Y = 0;
constexpr size_t OUT_S5RE = (size_t)MTOK * D;
constexpr size_t OUT_S5IM = OUT_S5RE + 16 * 2 * 64 * 64;
constexpr size_t OUT_GLA = OUT_S5IM + 16 * 2 * 64 * 64;
constexpr size_t OUT_LRU = OUT_GLA + (size_t)16 * 2 * 4 * 128 * 256;

struct Params { const float* in[38]; float* out; unsigned char* ws; int ph_lo, ph_hi; };
typedef const __attribute__((address_space(4))) Params* PP;
__device__ __forceinline__ int tidx() { int t = threadIdx.x; asm volatile("" : "+v"(t)); return t; }
__device__ __forceinline__ int bidx() { int b = blockIdx.x; asm volatile("" : "+s"(b)); return b; }
__device__ __forceinline__ int gdim() { int g = gridDim.x; asm volatile("" : "+s"(g)); return g; }
__device__ __forceinline__ PP get_pp() { PP kp = (PP)__builtin_amdgcn_kernarg_segment_ptr(); asm volatile("" : "+s"(kp)); return kp; }
enum { I_XP = 0, I_XS, I_S5RE, I_S5IM, I_SGLA, I_SLRU, I_C, I_CCTX, I_NORMG, I_ADAW, I_ADAB, I_FWI, I_FWO, I_FNG, I_EVWI, I_EVWO,
       I_LAMRE, I_LAMIM, I_LOGSTEP, I_BRE, I_BIM, I_CRE, I_CIM, I_S5D, I_GLUW, I_GLUB, I_GW2, I_GB, I_GNG, I_ODWI, I_ODWO,
       I_CONVW, I_CONVB, I_LWA, I_LBA, I_LWX, I_LBX, I_LLAM };

__device__ __forceinline__ unsigned cvt_pk_bf16(float lo, float hi) { unsigned r; asm("v_cvt_pk_bf16_f32 %0, %1, %2" : "=v"(r) : "v"(lo), "v"(hi)); return r; }
__device__ __forceinline__ bf16_t f2bf(float x) { return (bf16_t)(cvt_pk_bf16(x, 0.f) & 0xffffu); }
__device__ __forceinline__ float bf2f_(bf16_t v) { return __builtin_bit_cast(float, (unsigned)v << 16); }
__device__ __forceinline__ float lo_bf(unsigned w) { return __builtin_bit_cast(float, w << 16); }
__device__ __forceinline__ float hi_bf(unsigned w) { return __builtin_bit_cast(float, w & 0xffff0000u); }
__device__ __forceinline__ f32x4 unpack4(uint2 w) { return (f32x4){lo_bf(w.x), hi_bf(w.x), lo_bf(w.y), hi_bf(w.y)}; }
__device__ __forceinline__ float sigmoidf_(float x) { return __builtin_amdgcn_rcpf(1.f + __expf(-x)); }
__device__ __forceinline__ float siluf_(float x) { return x * __builtin_amdgcn_rcpf(1.f + __expf(-x)); }
__device__ __forceinline__ float geluf_(float x) { return x * sigmoidf_(1.5957691216f * (x + 0.044715f * x * x * x)); }
__device__ __forceinline__ float softplusf_(float x) { return fmaxf(x, 0.f) + log1pf(__expf(-fabsf(x))); }
__device__ __forceinline__ float neg_expm1_(float x) {
    const float pl = -x * (1.f + x * (0.5f + x * (0.16666667f + x * (0.041666668f + x * (0.0083333338f + x * 0.0013888889f))))); return x > -0.25f ? pl : 1.f - __expf(x); }
__device__ __forceinline__ int cond_of_pm(int pm) { return pm < 16 ? 0 : 1 + ((pm - 16) >> 2); }
__device__ __forceinline__ int cond_of_row(int r) { return r < TCTX ? 0 : 1 + ((r - TCTX) >> 10); }
__device__ __forceinline__ bf16x8 pack8(f32x4 a, f32x4 b) {
    typedef unsigned u32x4 __attribute__((ext_vector_type(4)));
    u32x4 u; u[0] = cvt_pk_bf16(a[0], a[1]); u[1] = cvt_pk_bf16(a[2], a[3]); u[2] = cvt_pk_bf16(b[0], b[1]); u[3] = cvt_pk_bf16(b[2], b[3]);
    return __builtin_bit_cast(bf16x8, u);
}

#define XB_TMO      128
#define XB_XCNT(j)  (256  + 64 * (j))
#define XB_XSUB(j)  (1280 + 64 * (j))
#define XB_XGEN(j)  (2304 + 64 * (j))
#define XB_TOP      3328
#define XB_TOPGEN   3392
#define XCD_BAR_WORDS 3456
#define XB_SPIN_CAP (1u << 18)

__device__ __forceinline__ unsigned xb_ld(unsigned* p)              { return __hip_atomic_load(p, __ATOMIC_RELAXED, __HIP_MEMORY_SCOPE_AGENT); }
__device__ __forceinline__ unsigned xb_add(unsigned* p, unsigned v) { return __hip_atomic_fetch_add(p, v, __ATOMIC_RELAXED, __HIP_MEMORY_SCOPE_AGENT); }
__device__ __forceinline__ unsigned xb_xcc_id() { return (unsigned)__builtin_amdgcn_s_getreg((3 << 11) | 20) & 0xFu; }
#define XB_SPIN(cond, bar) do { unsigned _sp = 0; while (cond) { __builtin_amdgcn_s_sleep(1); \
    if ((++_sp & 255u) == 0u) { if (xb_ld(&(bar)[XB_TMO])) break; if (_sp > XB_SPIN_CAP) { atomicAdd(&(bar)[XB_TMO], 1u); break; } } } } while (0)

struct XcdBarrier {
    unsigned* bar; unsigned x;
    volatile LAS unsigned* st;
};

__device__ __forceinline__ XcdBarrier xcd_barrier_post(unsigned* bar, volatile LAS unsigned* st) {
    XcdBarrier b; b.bar = bar; b.x = xb_xcc_id(); b.st = st;
    if (threadIdx.x == 0) (void)xb_add(&bar[XB_XCNT(b.x)], 1u);
    return b;
}
__device__ __forceinline__ void xcd_barrier_complete(unsigned* bar, unsigned x, unsigned& nloc, unsigned& nx) {
    const unsigned G = gridDim.x * gridDim.y * gridDim.z;
    unsigned sum, cnt, mine, sp = 0u;
    for (;;) {
        sum = 0u; cnt = 0u; mine = 0u;
#pragma unroll
        for (unsigned j = 0; j < 16; ++j) { const unsigned c = xb_ld(&bar[XB_XCNT(j)]); sum += c; cnt += (c > 0u) ? 1u : 0u; mine = (j == x) ? c : mine; }
        if (sum == G) break;
        __builtin_amdgcn_s_sleep(1);
        if ((++sp & 255u) == 0u) { if (xb_ld(&bar[XB_TMO])) break; if (sp > XB_SPIN_CAP) { atomicAdd(&bar[XB_TMO], 1u); break; } }
    }
    nloc = mine > 0u ? mine : 1u; nx = cnt > 0u ? cnt : 1u;
}

__device__ __forceinline__ void xcd_barrier(const XcdBarrier& b) {
    asm volatile("s_waitcnt vmcnt(0)" ::: "memory");
    __syncthreads();
    if (threadIdx.x == 0) {
        unsigned* bar = b.bar;
        __builtin_amdgcn_s_waitcnt(0);
        unsigned nloc = b.st[0], nx = b.st[1];
        if (nloc == 0u) { xcd_barrier_complete(bar, b.x, nloc, nx); b.st[0] = nloc; b.st[1] = nx; }
        const unsigned old = xb_add(&bar[XB_XSUB(b.x)], 1u);
        const unsigned gen = old / nloc;
        if (old + 1u == (gen + 1u) * nloc) {
            __builtin_amdgcn_fence(__ATOMIC_RELEASE, "agent");
            asm volatile("s_waitcnt vmcnt(0)" ::: "memory");
            const unsigned og = xb_add(&bar[XB_TOP], 1u);
            const unsigned tg = og / nx;
            if (og + 1u == (tg + 1u) * nx) xb_add(&bar[XB_TOPGEN], 1u);
            else XB_SPIN(xb_ld(&bar[XB_TOPGEN]) == tg, bar);
            __builtin_amdgcn_fence(__ATOMIC_ACQUIRE, "agent");
            xb_add(&bar[XB_XGEN(b.x)], 1u);
            asm volatile("s_waitcnt vmcnt(0)" ::: "memory");
        } else {
            XB_SPIN(xb_ld(&bar[XB_XGEN(b.x)]) == gen, bar);
            __builtin_amdgcn_fence(__ATOMIC_ACQUIRE, "agent");
            asm volatile("s_waitcnt vmcnt(0)" ::: "memory");
        }
    }
    __syncthreads();
}


namespace pg8 {
constexpr int BM = 256, BK = 64, HALF = 128, HTB = HALF * BK * 2, NXCD = 8, WGM = 8;
__device__ __forceinline__ int lds_byte(int r, int c) { const int st = (r >> 4) * 2 + (c >> 5), rr = r & 15, cc = c & 31, ob = rr * 64 + cc * 2; return st * 1024 + (ob ^ (((ob >> 9) & 1) << 5)); }
__device__ __forceinline__ void stage_rc(int b, int& R, int& C) { const int st = b / 1024, sb = b % 1024, swz = sb ^ (((sb >> 9) & 1) << 5); R = (st >> 1) * 16 + swz / 64; C = (st & 1) * 32 + (swz % 64) / 2; }
struct Unit { int pm, pn; };
struct Order {
    int nM, nN, nwg, G, c;
    __device__ __forceinline__ bool next(int i, Unit& u) const {
        const long L = (long)i * G + c; if (L >= nwg) return false;
        int wgid = (int)L; { const int q = nwg / NXCD, r = nwg % NXCD, xcd = wgid % NXCD, off = wgid / NXCD; wgid = (xcd < r ? xcd * (q + 1) : r * (q + 1) + (xcd - r) * q) + off; }
        const int nig = WGM * nN, gid = wgid / nig, fm = gid * WGM, gsz = (nM - fm) < WGM ? (nM - fm) : WGM;
        u.pm = fm + ((wgid % nig) % gsz); u.pn = (wgid % nig) / gsz; return true;
    }
};

template <class Epi, bool LRU, bool BLK = false>
__device__ __forceinline__ void gemm_phase(LAS unsigned char* lds, const bf16_t* A, int lda, const bf16_t* Bt, int ldb, int nM, int nN, int K, const Epi& E) {
    const int tid = tidx(), wid = __builtin_amdgcn_readfirstlane(tid >> 6), lane = tid & 63, wr = wid >> 2, wc = wid & 3, fr = lane & 15, fq = lane >> 4;
    const int nt = K / BK;
    Order S; S.nM = nM; S.nN = nN; S.nwg = nM * nN; S.G = gdim(); S.c = bidx();
    unsigned voffA[2], voffB[2];
#pragma unroll
    for (int i = 0; i < 2; ++i) { int R, C; stage_rc(tid * 16 + i * 8192, R, C); voffA[i] = (unsigned)(R * (BLK ? 64 : lda) + C) * 2u; voffB[i] = (unsigned)(R * (BLK ? 64 : ldb) + C) * 2u; }
    const size_t kstep = BLK ? (size_t)32768 : (size_t)(BK * 2);
    const size_t hstepA = BLK ? (size_t)16384 : (size_t)HALF * lda * 2, hstepB = BLK ? (size_t)16384 : (size_t)HALF * ldb * 2;
    const size_t tstepA = BLK ? (size_t)nt * 32768 : 2 * hstepA, tstepB = BLK ? (size_t)nt * 32768 : 2 * hstepB;
    const unsigned ldsw = (unsigned)wid * 1024u;
    const int aoff = lds_byte(wr * 64 + fr, fq * 8), boff = lds_byte(wc * 32 + fr, fq * 8);
#define PG8_SA(b, h) (((b) * 2 + (h)) * HTB)
#define PG8_SB(b, h) ((4 + (b) * 2 + (h)) * HTB)
#define PG8_STAGE(bufoff, gbase, voff) do { _Pragma("unroll") for (int _i = 0; _i < 2; ++_i) \
        __builtin_amdgcn_global_load_lds((const unsigned*)((const char*)(gbase) + (voff)[_i]), (LAS unsigned*)(lds + (bufoff) + ldsw + _i * 8192), 16, 0, 0); } while (0)
#define PG8_LDA(dst, b, h) do { _Pragma("unroll") for (int m = 0; m < 4; ++m) _Pragma("unroll") for (int k = 0; k < 2; ++k) dst[m][k] = *(const LAS bf16x8*)(lds + PG8_SA(b, h) + aoff + m * 2048 + k * 1024); } while (0)
#define PG8_LDB(dst, b, h) do { _Pragma("unroll") for (int n = 0; n < 2; ++n) _Pragma("unroll") for (int k = 0; k < 2; ++k) dst[n][k] = *(const LAS bf16x8*)(lds + PG8_SB(b, h) + boff + n * 2048 + k * 1024); } while (0)
#define PG8_MMA(ai, bj, At, Bt_) do { __builtin_amdgcn_s_setprio(1); _Pragma("unroll") for (int m = 0; m < 4; ++m) _Pragma("unroll") for (int n = 0; n < 2; ++n) _Pragma("unroll") for (int k = 0; k < 2; ++k) \
        acc[ai][bj][m][n] = __builtin_amdgcn_mfma_f32_16x16x32_bf16(Bt_[n][k], At[m][k], acc[ai][bj][m][n], 0, 0, 0); __builtin_amdgcn_s_setprio(0); } while (0)
#define PG8_WAIT_V(n) asm volatile("s_waitcnt vmcnt(" #n ")" ::: "memory")
#define PG8_WAIT_L(n) asm volatile("s_waitcnt lgkmcnt(" #n ")" ::: "memory")
#define PG8_BAR __builtin_amdgcn_s_barrier()
#define PG8_SCHED __builtin_amdgcn_sched_barrier(0)
#define PG8_APTR(u) ((const char*)A + (size_t)(u).pm * tstepA + (LRU ? (size_t)((((u).pn >> 1) & 7) * 512) : (size_t)0))
#define PG8_BPTR(u) ((const char*)Bt + (size_t)(u).pn * tstepB)
    Unit cur, nxt; int ui = 0;
    if (!S.next(0, cur)) return;
    f32x4 acc[2][2][4][2];
#pragma unroll
    for (int a = 0; a < 2; ++a)
#pragma unroll
        for (int b = 0; b < 2; ++b)
#pragma unroll
            for (int m = 0; m < 4; ++m)
#pragma unroll
                for (int n = 0; n < 2; ++n) acc[a][b][m][n] = (f32x4){0.f, 0.f, 0.f, 0.f};
    bf16x8 At[4][2], B0[2][2], B1[2][2];
    const char* cA = PG8_APTR(cur); const char* cB = PG8_BPTR(cur);
    PG8_STAGE(PG8_SB(0, 0), cB, voffB); PG8_STAGE(PG8_SA(0, 0), cA, voffA); PG8_STAGE(PG8_SB(0, 1), cB + hstepB, voffB); PG8_STAGE(PG8_SA(0, 1), cA + hstepA, voffA);
    if (wr == 1) PG8_BAR;
    PG8_WAIT_V(4); PG8_BAR;
    PG8_STAGE(PG8_SB(1, 0), cB + kstep, voffB); PG8_STAGE(PG8_SA(1, 0), cA + kstep, voffA); PG8_STAGE(PG8_SB(1, 1), cB + hstepB + kstep, voffB);
    PG8_WAIT_V(6); PG8_BAR;
    for (;;) {
        const bool has_next = S.next(ui + 1, nxt);
        const char* nA = has_next ? PG8_APTR(nxt) : cA; const char* nB = has_next ? PG8_BPTR(nxt) : cB;
        for (int t = 0; t < nt; t += 2) {
            const bool last = (t == nt - 2);
            const char* a1 = cA + (size_t)(t + 1) * kstep;
            const char* a2 = last ? nA : cA + (size_t)(t + 2) * kstep; const char* b2 = last ? nB : cB + (size_t)(t + 2) * kstep;
            const char* a3 = a2 + kstep; const char* b3 = b2 + kstep;
            PG8_LDB(B0, 0, 0); PG8_SCHED; PG8_LDA(At, 0, 0); PG8_STAGE(PG8_SA(1, 1), a1 + hstepA, voffA);
            PG8_WAIT_L(8); PG8_BAR; PG8_WAIT_L(0); PG8_MMA(0, 0, At, B0); PG8_BAR; PG8_SCHED;
            PG8_LDB(B1, 0, 1); PG8_STAGE(PG8_SB(0, 0), b2, voffB);
            PG8_BAR; PG8_WAIT_L(0); PG8_MMA(0, 1, At, B1); PG8_BAR;
            PG8_LDA(At, 0, 1); PG8_STAGE(PG8_SA(0, 0), a2, voffA);
            PG8_BAR; PG8_WAIT_L(0); PG8_MMA(1, 0, At, B0); PG8_BAR; PG8_SCHED;
            PG8_STAGE(PG8_SB(0, 1), b2 + hstepB, voffB);
            PG8_WAIT_V(6); PG8_BAR; PG8_MMA(1, 1, At, B1); PG8_BAR;
            PG8_LDB(B0, 1, 0); PG8_SCHED; PG8_LDA(At, 1, 0); PG8_STAGE(PG8_SA(0, 1), a2 + hstepA, voffA);
            PG8_WAIT_L(8); PG8_BAR; PG8_WAIT_L(0); PG8_MMA(0, 0, At, B0); PG8_BAR; PG8_SCHED;
            PG8_LDB(B1, 1, 1); PG8_STAGE(PG8_SB(1, 0), b3, voffB);
            PG8_BAR; PG8_WAIT_L(0); PG8_MMA(0, 1, At, B1); PG8_BAR;
            PG8_LDA(At, 1, 1); PG8_STAGE(PG8_SA(1, 0), a3, voffA);
            PG8_BAR; PG8_WAIT_L(0); PG8_MMA(1, 0, At, B0); PG8_BAR; PG8_SCHED;
            PG8_STAGE(PG8_SB(1, 1), b3 + hstepB, voffB);
            PG8_WAIT_V(6); PG8_BAR; PG8_MMA(1, 1, At, B1); PG8_BAR;
        }
        E(acc, cur, wr, wc, fr, fq);
        if (!has_next) break;
#pragma unroll
        for (int a = 0; a < 2; ++a)
#pragma unroll
            for (int b = 0; b < 2; ++b)
#pragma unroll
                for (int m = 0; m < 4; ++m)
#pragma unroll
                    for (int n = 0; n < 2; ++n) acc[a][b][m][n] = (f32x4){0.f, 0.f, 0.f, 0.f};
        cur = nxt; cA = nA; cB = nB; ++ui;
    }
    PG8_WAIT_V(0);
    if (wr == 0) PG8_BAR;
    PG8_BAR;
#undef PG8_SA
#undef PG8_SB
#undef PG8_STAGE
#undef PG8_LDA
#undef PG8_LDB
#undef PG8_MMA
#undef PG8_WAIT_V
#undef PG8_WAIT_L
#undef PG8_BAR
#undef PG8_SCHED
#undef PG8_APTR
#undef PG8_BPTR
}
}
using pg8::Unit;

struct EpiSwiglu {
    bf16_t* H;
    __device__ __forceinline__ void operator()(const f32x4 (&acc)[2][2][4][2], const Unit& u, int wr, int wc, int fr, int fq) const {
        const int loff = (wr * 64 + fr) * 64 + (wc & 1) * 32 + 4 * fq;
        bf16_t* ub = H + ((size_t)(u.pm * 88 + u.pn * 2 + (wc >> 1)) * 256) * 64;
#pragma unroll
        for (int ai = 0; ai < 2; ++ai)
#pragma unroll
            for (int m = 0; m < 4; ++m) { bf16_t* rb = ub + (size_t)(ai * 128 + m * 16) * 64;
#pragma unroll
                for (int n = 0; n < 2; ++n) { const f32x4 a = acc[ai][0][m][n], b = acc[ai][1][m][n];
                    uint2 pk; pk.x = cvt_pk_bf16(siluf_(a[0]) * b[0], siluf_(a[1]) * b[1]); pk.y = cvt_pk_bf16(siluf_(a[2]) * b[2], siluf_(a[3]) * b[3]);
                    *(uint2*)(rb + loff + n * 16) = pk; } }
    }
};
struct EpiResid {
    float* X; const float* G; float coef; const float* XinC; const float* XinL;
    __device__ __forceinline__ void operator()(const f32x4 (&acc)[2][2][4][2], const Unit& u, int wr, int wc, int fr, int fq) const {
        const int lcol = wc * 32 + 4 * fq, loff = (wr * 64 + fr) * D + lcol;
        const float* g = G + (size_t)cond_of_pm(u.pm) * (9 * 2048) + u.pn * 256;
        float* ub = X + (size_t)u.pm * 256 * D + u.pn * 256;
        const float* ib = (u.pm < 16 ? XinC : XinL) + (size_t)u.pm * 256 * D + u.pn * 256;
        f32x4 gv[2][2];
#pragma unroll
        for (int bj = 0; bj < 2; ++bj)
#pragma unroll
            for (int n = 0; n < 2; ++n) gv[bj][n] = *(const f32x4*)(g + lcol + bj * 128 + n * 16) * coef;
#pragma unroll
        for (int ai = 0; ai < 2; ++ai)
#pragma unroll
            for (int mp = 0; mp < 4; mp += 2) { f32x4 xin[2][2][2];
#pragma unroll
                for (int m2 = 0; m2 < 2; ++m2) { const float* ir = ib + (size_t)(ai * 128 + (mp + m2) * 16) * D;
#pragma unroll
                    for (int bj = 0; bj < 2; ++bj)
#pragma unroll
                        for (int n = 0; n < 2; ++n) xin[m2][bj][n] = *(const f32x4*)(ir + loff + bj * 128 + n * 16); }
                __builtin_amdgcn_sched_barrier(0);
#pragma unroll
                for (int m2 = 0; m2 < 2; ++m2) { float* rb = ub + (size_t)(ai * 128 + (mp + m2) * 16) * D;
#pragma unroll
                    for (int bj = 0; bj < 2; ++bj)
#pragma unroll
                        for (int n = 0; n < 2; ++n) { *(f32x4*)(rb + loff + bj * 128 + n * 16) = xin[m2][bj][n] + gv[bj][n] * acc[ai][bj][mp + m2][n]; } }
                __builtin_amdgcn_sched_barrier(0); }
    }
};
struct EpiF32 {
    float* C; int ldc;
    __device__ __forceinline__ void operator()(const f32x4 (&acc)[2][2][4][2], const Unit& u, int wr, int wc, int fr, int fq) const {
        const int loff = (wr * 64 + fr) * ldc + wc * 32 + 4 * fq;
        float* ub = C + (size_t)u.pm * 256 * ldc + u.pn * 256;
#pragma unroll
        for (int ai = 0; ai < 2; ++ai)
#pragma unroll
            for (int m = 0; m < 4; ++m) { float* rb = ub + (size_t)(ai * 128 + m * 16) * ldc;
#pragma unroll
                for (int bj = 0; bj < 2; ++bj)
#pragma unroll
                    for (int n = 0; n < 2; ++n) *(f32x4*)(rb + loff + bj * 128 + n * 16) = acc[ai][bj][m][n]; }
    }
};
struct EpiBf16 {
    bf16_t* C; int ldc;
    __device__ __forceinline__ void operator()(const f32x4 (&acc)[2][2][4][2], const Unit& u, int wr, int wc, int fr, int fq) const {
        const int loff = (wr * 64 + fr) * ldc + wc * 32 + 4 * fq;
        bf16_t* ub = C + (size_t)u.pm * 256 * ldc + u.pn * 256;
#pragma unroll
        for (int ai = 0; ai < 2; ++ai)
#pragma unroll
            for (int m = 0; m < 4; ++m) { bf16_t* rb = ub + (size_t)(ai * 128 + m * 16) * ldc;
#pragma unroll
                for (int bj = 0; bj < 2; ++bj)
#pragma unroll
                    for (int n = 0; n < 2; ++n) { const f32x4 v = acc[ai][bj][m][n]; uint2 pk; pk.x = cvt_pk_bf16(v[0], v[1]); pk.y = cvt_pk_bf16(v[2], v[3]); *(uint2*)(rb + loff + bj * 128 + n * 16) = pk; } }
    }
};
struct EpiGlu {
    bf16_t* CAT; const bf16_t* YS; const float* bias;
    __device__ __forceinline__ void operator()(const f32x4 (&acc)[2][2][4][2], const Unit& u, int wr, int wc, int fr, int fq) const {
        const int lcol = wc * 32 + 4 * fq, loffY = (wr * 64 + fr) * 1024 + lcol, loffC = (wr * 64 + fr) * D + lcol;
        const float* bb = bias + u.pn * 256; const bf16_t* yb = YS + (size_t)u.pm * 256 * 1024 + u.pn * 256; bf16_t* cb = CAT + (size_t)u.pm * 256 * D + u.pn * 256;
        f32x4 bv[2][2];
#pragma unroll
        for (int bj = 0; bj < 2; ++bj)
#pragma unroll
            for (int n = 0; n < 2; ++n) bv[bj][n] = *(const f32x4*)(bb + lcol + bj * 128 + n * 16);
#pragma unroll
        for (int ai = 0; ai < 2; ++ai) { uint2 yw[4][2][2];
#pragma unroll
            for (int m = 0; m < 4; ++m)
#pragma unroll
                for (int bj = 0; bj < 2; ++bj)
#pragma unroll
                    for (int n = 0; n < 2; ++n) yw[m][bj][n] = *(const uint2*)(yb + (size_t)(ai * 128 + m * 16) * 1024 + loffY + bj * 128 + n * 16);
            __builtin_amdgcn_sched_barrier(0);
#pragma unroll
            for (int m = 0; m < 4; ++m) { bf16_t* cr = cb + (size_t)(ai * 128 + m * 16) * D;
#pragma unroll
                for (int bj = 0; bj < 2; ++bj)
#pragma unroll
                    for (int n = 0; n < 2; ++n) { const f32x4 ys = unpack4(yw[m][bj][n]); const f32x4 z = acc[ai][bj][m][n] + bv[bj][n];
                        uint2 pk; pk.x = cvt_pk_bf16(ys[0] * sigmoidf_(z[0]), ys[1] * sigmoidf_(z[1])); pk.y = cvt_pk_bf16(ys[2] * sigmoidf_(z[2]), ys[3] * sigmoidf_(z[3]));
                        *(uint2*)(cr + loffC + bj * 128 + n * 16) = pk; }
                __builtin_amdgcn_sched_barrier(0); } }
    }
};
struct EpiLru {
    unsigned* LAB; const bf16_t* XC; const float* ba; const float* bx; const float* sp;
    __device__ __forceinline__ void operator()(const f32x4 (&acc)[2][2][4][2], const Unit& u, int wr, int wc, int fr, int fq) const {
        const int d = u.pn >> 4, h = (u.pn >> 1) & 7, half = u.pn & 1;
        const int chu = h * 256 + half * 128;
        const int lcol = wc * 32 + 4 * fq, loff = (wr * 64 + fr) * D + lcol;
        const bf16_t* xb = XC + (size_t)u.pm * 256 * D + chu; unsigned* lab = LAB + ((size_t)d * MTOK + u.pm * 256) * D + chu;
        f32x4 bav[2], bxv[2], spv[2];
#pragma unroll
        for (int n = 0; n < 2; ++n) { bav[n] = *(const f32x4*)(ba + d * D + chu + lcol + n * 16); bxv[n] = *(const f32x4*)(bx + d * D + chu + lcol + n * 16); spv[n] = *(const f32x4*)(sp + d * D + chu + lcol + n * 16); }
#pragma unroll
        for (int ai = 0; ai < 2; ++ai) { uint2 xw[4][2];
#pragma unroll
            for (int m = 0; m < 4; ++m)
#pragma unroll
                for (int n = 0; n < 2; ++n) xw[m][n] = *(const uint2*)(xb + (size_t)(ai * 128 + m * 16) * D + loff + n * 16);
            __builtin_amdgcn_sched_barrier(0);
#pragma unroll
            for (int m = 0; m < 4; ++m) { const size_t ro = (size_t)(ai * 128 + m * 16) * D;
#pragma unroll
                for (int n = 0; n < 2; ++n) { const f32x4 xc = unpack4(xw[m][n]);
                    const f32x4 rp = acc[ai][0][m][n] + bav[n], ip = acc[ai][1][m][n] + bxv[n]; uint4 w;
                    unsigned wv[4];
#pragma unroll
                    for (int e = 0; e < 4; ++e) { const float la = spv[n][e] * sigmoidf_(rp[e]); const float bb = __builtin_amdgcn_sqrtf(fmaxf(neg_expm1_(2.f * la), 0.f)) * (sigmoidf_(ip[e]) * xc[e]); wv[e] = cvt_pk_bf16(la, bb); }
                    w.x = wv[0]; w.y = wv[1]; w.z = wv[2]; w.w = wv[3];
                    *(uint4*)(lab + ro + loff + n * 16) = w; __builtin_amdgcn_sched_barrier(0); } } }
    }
};

struct CvtT { const float* src; bf16_t* dst; int K, ldsrc, Nsrc, n_dst0, n_src0, k0, blk; };
__device__ __forceinline__ void cvt_decode(PP p, unsigned char* ws, int t, int total, CvtT& c) {
    constexpr int T_FI = 176 * 32, T_FO = 32 * 88, T_EI = 68 * 32, T_EO = 32 * 32, T_GLU = 16 * 16, T_OI = 64 * 32, T_OO = 32 * 32, T_LRU = 4 * 4;
    c.blk = 0;
    if (t >= total) { c.src = nullptr; c.dst = nullptr; c.K = c.ldsrc = c.Nsrc = c.n_dst0 = c.n_src0 = c.k0 = 0; return; }
    if (t < 4 * T_FI) { const int w = t / T_FI; t %= T_FI; const int nt_ = t / 32, kt = t % 32; c.K = 2048; c.ldsrc = 11264; c.Nsrc = 11264; c.src = p->in[I_FWI] + (size_t)w * 2048 * 11264; c.dst = (bf16_t*)(ws + WS_WFI) + (size_t)w * 11264 * 2048;
        c.n_dst0 = nt_ * 64; const int j = c.n_dst0 >> 8, rr = c.n_dst0 & 255; c.n_src0 = rr < 128 ? j * 128 + rr : 5632 + j * 128 + (rr - 128); c.k0 = kt * 64; }
    else if ((t -= 4 * T_FI) < 4 * T_FO) { const int w = t / T_FO; t %= T_FO; const int nt_ = t / 88, kt = t % 88; c.K = 5632; c.ldsrc = 2048; c.Nsrc = 2048; c.src = p->in[I_FWO] + (size_t)w * 5632 * 2048; c.dst = (bf16_t*)(ws + WS_WFO) + (size_t)w * 2048 * 5632; c.n_dst0 = c.n_src0 = nt_ * 64; c.k0 = kt * 64; c.blk = 1; }
    else if ((t -= 4 * T_FO) < T_EI) { const int nt_ = t / 32, kt = t % 32; c.K = 2048; c.ldsrc = 4128; c.Nsrc = 4128; c.src = p->in[I_EVWI]; c.dst = (bf16_t*)(ws + WS_WEI); c.n_dst0 = c.n_src0 = nt_ * 64; c.k0 = kt * 64; }
    else if ((t -= T_EI) < T_EO) { const int nt_ = t / 32, kt = t % 32; c.K = 2048; c.ldsrc = 2048; c.Nsrc = 2048; c.src = p->in[I_EVWO]; c.dst = (bf16_t*)(ws + WS_WEO); c.n_dst0 = c.n_src0 = nt_ * 64; c.k0 = kt * 64; }
    else if ((t -= T_EO) < T_GLU) { const int nt_ = t / 16, kt = t % 16; c.K = 1024; c.ldsrc = 1024; c.Nsrc = 1024; c.src = p->in[I_GLUW]; c.dst = (bf16_t*)(ws + WS_WGLU); c.n_dst0 = c.n_src0 = nt_ * 64; c.k0 = kt * 64; }
    else if ((t -= T_GLU) < T_OI) { const int nt_ = t / 32, kt = t % 32; c.K = 2048; c.ldsrc = 4096; c.Nsrc = 4096; c.src = p->in[I_ODWI]; c.dst = (bf16_t*)(ws + WS_WOI); c.n_dst0 = c.n_src0 = nt_ * 64; c.k0 = kt * 64; }
    else if ((t -= T_OI) < T_OO) { const int nt_ = t / 32, kt = t % 32; c.K = 2048; c.ldsrc = 2048; c.Nsrc = 2048; c.src = p->in[I_ODWO]; c.dst = (bf16_t*)(ws + WS_WOO); c.n_dst0 = c.n_src0 = nt_ * 64; c.k0 = kt * 64; }
    else { t -= T_OO; const int mi = t / T_LRU; t %= T_LRU; const int which = mi >> 4, dh = mi & 15;
        const int nt_ = t / 4, kt = t % 4; c.K = 256; c.ldsrc = 256; c.Nsrc = 256; c.src = (which ? p->in[I_LWX] : p->in[I_LWA]) + (size_t)dh * 65536; c.dst = (bf16_t*)(ws + WS_WLRU) + (size_t)dh * 2 * 65536;
        c.n_src0 = nt_ * 64; const int half = c.n_src0 >> 7; c.n_dst0 = half * 256 + which * 128 + (c.n_src0 & 127); c.k0 = kt * 64; }
}
constexpr int CV_FI = 176 * 32, CV_FO = 32 * 88, CV_TOTAL = 4 * CV_FI + 4 * CV_FO + 68 * 32 + 32 * 32 + 16 * 16 + 64 * 32 + 32 * 32 + 32 * 16;
__device__ __forceinline__ void cvt_range(PP p, unsigned char* lds, int t_lo, int t_hi, int rank, int n) {
    const int tid = tidx(); unsigned char* ws = p->ws; float* tile = (float*)lds;
    constexpr int CT = 4;
    for (int g0 = t_lo + rank * CT; g0 < t_hi; g0 += n * CT) {
        f32x4 v[CT][2];
#pragma unroll
        for (int q = 0; q < CT; ++q) { CvtT c; cvt_decode(p, ws, g0 + q, t_hi, c);
#pragma unroll
            for (int h = 0; h < 2; ++h) { const int kk = (tid >> 4) + h * 32, n4 = (tid & 15) * 4; const int ns = c.n_src0 + n4;
                v[q][h] = (f32x4){0.f, 0.f, 0.f, 0.f}; if (ns < c.Nsrc) v[q][h] = __builtin_nontemporal_load((const f32x4*)(c.src + (size_t)(c.k0 + kk) * c.ldsrc + ns)); } }
        __syncthreads();
#pragma unroll
        for (int q = 0; q < CT; ++q)
#pragma unroll
            for (int h = 0; h < 2; ++h) { const int kk = (tid >> 4) + h * 32, n4 = (tid & 15) * 4; float* tp = tile + q * 4160 + kk * 65 + n4; tp[0] = v[q][h][0]; tp[1] = v[q][h][1]; tp[2] = v[q][h][2]; tp[3] = v[q][h][3]; }
        __syncthreads();
#pragma unroll
        for (int q = 0; q < CT; ++q) { CvtT c; cvt_decode(p, ws, g0 + q, t_hi, c);
            if (c.dst) { const int nn = tid >> 3, k8 = (tid & 7) * 8; f32x4 a, b2; const float* tp = tile + q * 4160;
#pragma unroll
                for (int j = 0; j < 4; ++j) { a[j] = tp[(k8 + j) * 65 + nn]; b2[j] = tp[(k8 + 4 + j) * 65 + nn]; }
                const int n_ = c.n_dst0 + nn; bf16_t* dp = c.blk ? c.dst + ((size_t)((n_ >> 8) * (c.K >> 6) + (c.k0 >> 6)) * 256 + (n_ & 255)) * 64 + k8 : c.dst + (size_t)n_ * c.K + c.k0 + k8;
                *(bf16x8*)dp = pack8(a, b2); } }
    }
}
__device__ __forceinline__ void mod_items(PP p, unsigned char* lds, int it_lo, int it_hi, int rank, int n) {
    const int tid = tidx(); unsigned char* ws = p->ws;
    float* sc = (float*)lds;
    __syncthreads();
    for (int i = tid; i < 3 * 2048; i += 512) { const int ci = i >> 11, k = i & 2047; const float v = ci == 0 ? p->in[I_CCTX][k] : p->in[I_C][(ci - 1) * 2048 + k]; sc[i] = siluf_(v); }
    __syncthreads();
    float* MOD = (float*)(ws + WS_MOD);
    for (int it = it_lo + rank; it < it_hi; it += n) { const int l = it / 288, r = it % 288, chunk = r / 32, ks = r % 32; const int col = chunk * 2048 + tid * 4;
        const float* W = p->in[I_ADAW] + (size_t)l * 2048 * 18432 + (size_t)(ks * 64) * 18432 + col;
        f32x4 a0 = (f32x4){0.f, 0.f, 0.f, 0.f}, a1 = a0, a2 = a0;
#pragma unroll 32
        for (int k = 0; k < 64; ++k) { const f32x4 w = __builtin_nontemporal_load((const f32x4*)(W + (size_t)k * 18432)); const int kk = ks * 64 + k; a0 += w * sc[kk]; a1 += w * sc[2048 + kk]; a2 += w * sc[4096 + kk]; }
        if (ks == 0) { const f32x4 bb = *(const f32x4*)(p->in[I_ADAB] + (size_t)l * 18432 + col); a0 += bb; a1 += bb; a2 += bb; }
        float* m0 = MOD + (size_t)(l * 3) * 18432 + col;
#pragma unroll
        for (int e = 0; e < 4; ++e) { atomicAdd(m0 + e, a0[e]); atomicAdd(m0 + 18432 + e, a1[e]); atomicAdd(m0 + 2 * 18432 + e, a2[e]); } }
    __syncthreads();
}
__device__ void phase_prep(PP p, LAS unsigned char* ldsr, int skip_mod) {
    unsigned char* lds = (unsigned char*)ldsr;
    const int tid = tidx(), bid = bidx(), nb = gdim();
    unsigned char* ws = p->ws;
    if (!skip_mod) mod_items(p, lds, 0, 288, bid, nb);
    cvt_range(p, lds, 0, CV_FI, bid, nb);
}
__device__ void bg_convert(PP p, LAS unsigned char* ldsr, int ph) {
    unsigned char* lds = (unsigned char*)ldsr; const int bid = bidx();
    constexpr int S0 = 4 * CV_FI + 4 * CV_FO, S_EI = S0, S_EO = S_EI + 2176, S_OI = S_EO + 1024 + 256, S_OO = S_OI + 2048;
    __syncthreads();
    if (ph == 2) { if (bid >= 32) { cvt_range(p, lds, 4 * CV_FI, 4 * CV_FI + CV_FO, bid - 32, 224); cvt_range(p, lds, S_EI, S_EO, bid - 32, 224); } }
    else if (ph == 3) { if (bid >= 192) cvt_range(p, lds, CV_FI, 2 * CV_FI, bid - 192, 64); }
    else if (ph == 5) { if (bid >= 152) cvt_range(p, lds, S_EO, S_OO, bid - 152, 104); }
    else if (ph == 8) { if (bid >= 96) cvt_range(p, lds, 4 * CV_FI + CV_FO, 4 * CV_FI + 2 * CV_FO, bid - 96, 160); }
    else if (ph == 9) { if (bid >= 192) cvt_range(p, lds, S_OO, CV_TOTAL, bid - 192, 64); }
    else if (ph == 11) { if (bid >= 32) cvt_range(p, lds, 2 * CV_FI, 3 * CV_FI, bid - 32, 224); }
    else if (ph == 12) { if (bid >= 192) { mod_items(p, lds, 288, 448, bid - 192, 64); cvt_range(p, lds, 4 * CV_FI + 2 * CV_FO, 4 * CV_FI + 3 * CV_FO, bid - 192, 64); } }
    else if (ph == 14) { if (bid >= 32) cvt_range(p, lds, 3 * CV_FI, 4 * CV_FI, bid - 32, 224); }
    else if (ph == 15) { if (bid >= 192) { cvt_range(p, lds, 4 * CV_FI + 3 * CV_FO, 4 * CV_FI + 4 * CV_FO, bid - 192, 64); mod_items(p, lds, 448, 576, bid - 192, 64); } }
}

__device__ void phase_norm(PP p, int l, int j  ) {
    const int tid = tidx(), lane = tid & 63, wid = tid >> 6; const int gw = bidx() * 8 + wid, nw = gdim() * 8;
    const float* X = (const float*)(p->ws + WS_X); bf16_t* HM = (bf16_t*)(p->ws + WS_HM);
    const float* g = j < 0 ? p->in[I_FNG] : p->in[I_NORMG] + (size_t)(l * 3 + j) * D;
    const bool from_in = (l == 0 && j == 0);
    for (int r = gw; r < MTOK; r += nw) {
        const float* xr = from_in ? (r < TCTX ? p->in[I_XP] + (size_t)r * D : p->in[I_XS] + (size_t)(r - TCTX) * D) : X + (size_t)r * D; f32x4 v[8]; float ss = 0.f;
#pragma unroll
        for (int i = 0; i < 8; ++i) { v[i] = *(const f32x4*)(xr + lane * 4 + i * 256); ss += v[i][0] * v[i][0] + v[i][1] * v[i][1] + v[i][2] * v[i][2] + v[i][3] * v[i][3]; }
#pragma unroll
        for (int o = 32; o >= 1; o >>= 1) ss += __shfl_xor(ss, o);
        const float rinv = rsqrtf(ss * (1.f / D) + EPS);
        if (j < 0) { float* o = p->out + OUT_Y + (size_t)r * D;
#pragma unroll
            for (int i = 0; i < 8; ++i) { const int c = lane * 4 + i * 256; const f32x4 gg = *(const f32x4*)(g + c); *(f32x4*)(o + c) = v[i] * rinv * gg; } }
        else { const float* mod = (const float*)(p->ws + WS_MOD) + (size_t)(l * 3 + cond_of_row(r)) * 18432; const float* sh = mod + (3 * j) * 2048; const float* scl = mod + (3 * j + 1) * 2048;
#pragma unroll
            for (int i = 0; i < 8; ++i) { const int c = lane * 4 + i * 256; const f32x4 gg = *(const f32x4*)(g + c), s1 = *(const f32x4*)(scl + c), s0 = *(const f32x4*)(sh + c);
                const f32x4 y = (v[i] * rinv * gg) * (s1 + 1.f) + s0; uint2 pk; pk.x = cvt_pk_bf16(y[0], y[1]); pk.y = cvt_pk_bf16(y[2], y[3]); *(uint2*)(HM + (size_t)r * D + c) = pk; } }
    }
}

__device__ __forceinline__ void seq_info(int s, int& L, int& row0) { if (s < 16) { L = 256; row0 = s * 256; } else { L = 1024; row0 = TCTX + (s - 16) * 1024; } }

#define WAVE_LDS_SYNC() asm volatile("s_waitcnt lgkmcnt(0)" ::: "memory")
__device__ __forceinline__ void s5_item(PP p, unsigned char* lds, int s, int d, int gg) {
    const int tid = tidx(), lane = tid & 63, wid = tid >> 6, fr = lane & 15, fq = lane >> 4; const int g = gg * 8 + wid;
    int L, row0; seq_info(s, L, row0);
    float* HS = (float*)(lds + wid * 8448);
    const bf16_t* PROJ = (const bf16_t*)(p->ws + WS_PROJ); float* Y = (float*)(p->ws + WS_YS5) + (size_t)d * MTOK * 1024;
    const int pg0 = (d * 64 + g) * 64, pg = pg0 + lane;
    const float lre = p->in[I_LAMRE][pg], lim = p->in[I_LAMIM][pg], dt = expf(p->in[I_LOGSTEP][d * 64 + g]);
    const float mag = expf(lre * dt); float sn, cs; sincosf(lim * dt, &sn, &cs);
    const float abr = mag * cs, abi = mag * sn, den = lre * lre + lim * lim, nre = abr - 1.f;
    const float fre = (nre * lre + abi * lim) / den, fim = (abi * lre - nre * lim) / den;
    bf16x8 af[8];
#pragma unroll
    for (int tq = 0; tq < 4; ++tq) { const int src = tq * 16 + fr; const float f_r = __shfl(fre, src), f_i = __shfl(fim, src);
        f32x4 r0 = (f32x4){0.f, 0.f, 0.f, 0.f}, r1 = r0, i0 = r0, i1 = r0;
        if (fq < 2) { const float* br = p->in[I_BRE] + (size_t)(pg0 + src) * 16 + fq * 8; const float* bi = p->in[I_BIM] + (size_t)(pg0 + src) * 16 + fq * 8;
            r0 = *(const f32x4*)br; r1 = *(const f32x4*)(br + 4); i0 = *(const f32x4*)bi; i1 = *(const f32x4*)(bi + 4); }
        af[tq] = pack8(r0 * f_r - i0 * f_i, r1 * f_r - i1 * f_i); af[tq + 4] = pack8(i0 * f_r + r0 * f_i, i1 * f_r + r1 * f_i); }
    bf16x8 cf[4];
#pragma unroll
    for (int kk = 0; kk < 4; ++kk) { const float* cp = (kk < 2 ? p->in[I_CRE] : p->in[I_CIM]) + ((size_t)(d * 64 + g) * 16 + fr) * 64 + (kk & 1) * 32 + fq * 8;
        f32x4 a = *(const f32x4*)cp, b = *(const f32x4*)(cp + 4); if (kk >= 2) { a = -a; b = -b; } cf[kk] = pack8(a, b); }
    float hr = 0.f, hi = 0.f;
    if (s >= 16) { const size_t o = ((size_t)((s - 16) * 2 + d) * 64 + g) * 64 + lane; hr = p->in[I_S5RE][o]; hi = p->in[I_S5IM][o]; }
    const f32x4 z4 = (f32x4){0.f, 0.f, 0.f, 0.f};
    bf16x8 un = (bf16x8){0, 0, 0, 0, 0, 0, 0, 0};
#define S5_LOADU(c0_) do { if (fq < 2) { const int row_ = row0 + (d ? L - 1 - ((c0_) + fr) : (c0_) + fr); un = *(const bf16x8*)(PROJ + (size_t)row_ * EVINP + g * 16 + fq * 8); } } while (0)
    S5_LOADU(0);
    __syncthreads();
    for (int c0 = 0; c0 < L; c0 += 16) {
        const bf16x8 ub = un;
        if (c0 + 16 < L) S5_LOADU(c0 + 16);
#pragma unroll
        for (int t8 = 0; t8 < 8; ++t8) { const f32x4 bu = __builtin_amdgcn_mfma_f32_16x16x32_bf16(af[t8], ub, z4, 0, 0, 0); *(f32x4*)(HS + fr * 132 + t8 * 16 + fq * 4) = bu; }
        WAVE_LDS_SYNC();
#pragma unroll
        for (int i = 0; i < 16; ++i) { const float bur = HS[i * 132 + lane], bui = HS[i * 132 + 64 + lane];
            const float nr = abr * hr - abi * hi + bur, ni = abr * hi + abi * hr + bui; hr = nr; hi = ni;
            HS[i * 132 + lane] = hr; HS[i * 132 + 64 + lane] = hi; }
        WAVE_LDS_SYNC();
        { f32x4 acc = z4;
#pragma unroll
          for (int kk = 0; kk < 4; ++kk) { const float* hp = HS + fr * 132 + kk * 32 + fq * 8; const bf16x8 hb = pack8(*(const f32x4*)hp, *(const f32x4*)(hp + 4));
              acc = __builtin_amdgcn_mfma_f32_16x16x32_bf16(cf[kk], hb, acc, 0, 0, 0); }
          const int row = row0 + (d ? L - 1 - (c0 + fr) : c0 + fr);
          *(f32x4*)(Y + (size_t)row * 1024 + g * 16 + fq * 4) = acc; }
        WAVE_LDS_SYNC();
    }
#undef S5_LOADU
    if (s < 16) { const size_t o = ((size_t)(s * 2 + d) * 64 + g) * 64 + lane; p->out[OUT_S5RE + o] = hr; p->out[OUT_S5IM + o] = hi; }
}

template <int NK32> __device__ __forceinline__ f32x4 mma_lds(f32x4 acc, const bf16_t* X, int ldx, const bf16_t* Y, int ldy, int lane) {
    const bf16_t* xp = X + (lane & 15) * ldx + (lane >> 4) * 8; const bf16_t* yp = Y + (lane & 15) * ldy + (lane >> 4) * 8;
#pragma unroll
    for (int kk = 0; kk < NK32; ++kk) acc = __builtin_amdgcn_mfma_f32_16x16x32_bf16(*(const bf16x8*)(xp + kk * 32), *(const bf16x8*)(yp + kk * 32), acc, 0, 0, 0);
    return acc;
}

__device__ __forceinline__ void gla_item(PP p, unsigned char* lds, int s, int h, int d, int vh) {
    const int tid = tidx(), lane = tid & 63, wid = tid >> 6, fr = lane & 15, fq = lane >> 4;
    int L, row0; seq_info(s, L, row0);
    bf16_t* QT = (bf16_t*)(lds);
    bf16_t* KT = (bf16_t*)(lds + 17408);
    bf16_t* KE = (bf16_t*)(lds + 34816);
    bf16_t* VT = (bf16_t*)(lds + 53248);
    bf16_t* ATT = (bf16_t*)(lds + 71680);
    bf16_t* ST = (bf16_t*)(lds + 80896);
    float* LOGA = (float*)(lds + 80896);
    float* SEG = (float*)(lds + 115712);
    float* GLR = (float*)(lds + 117760);
    float* W2S = (float*)(lds + 121856);
    float* GBS = (float*)(lds + 130048);
    float* DEC = (float*)(lds + 130560);
    const bf16_t* PROJ = (const bf16_t*)(p->ws + WS_PROJ); float* O = (float*)(p->ws + WS_OGLA) + (size_t)d * MTOK * 1024;
    __syncthreads();
    for (int i = tid; i < 16 * 128; i += 512) W2S[i] = p->in[I_GW2][(size_t)(d * 16 + (i >> 7)) * 512 + h * 128 + (i & 127)];
    if (tid < 128) GBS[tid] = p->in[I_GB][d * 512 + h * 128 + tid];
    f32x4 sacc[8];
#pragma unroll
    for (int tn = 0; tn < 8; ++tn) { sacc[tn] = (f32x4){0.f, 0.f, 0.f, 0.f};
        if (s >= 16) { const float* sp = p->in[I_SGLA] + ((size_t)(((s - 16) * 2 + d) * 4 + h) * 128 + wid * 16 + fq * 4) * 256 + vh * 128 + tn * 16 + fr;
#pragma unroll
            for (int e = 0; e < 4; ++e) sacc[tn][e] = sp[(size_t)e * 256]; } }
    const float qscale = 0.08838834764831845f;
    const int nch = L >> 6;
    const int c = tid & 127, ig = tid >> 7;
#define GROW(n_, i) (row0 + (d ? L - 1 - ((n_) * 64 + (i)) : (n_) * 64 + (i)))
    f32x4 glr4 = (f32x4){0.f, 0.f, 0.f, 0.f}; float qv[16], kv[16], vv[16];
#define GLA_PREFETCH(n_) do { \
        if (tid < 256) glr4 = unpack4(*(const uint2*)(PROJ + (size_t)GROW(n_, tid >> 2) * EVINP + 4096 + d * 16 + (tid & 3) * 4)); \
        _Pragma("unroll") for (int ii = 0; ii < 16; ++ii) { const size_t ro = (size_t)GROW(n_, ig * 16 + ii) * EVINP; \
            qv[ii] = bf2f_(PROJ[ro + 1024 + h * 128 + c]); kv[ii] = bf2f_(PROJ[ro + 1536 + h * 128 + c]); vv[ii] = bf2f_(PROJ[ro + 2048 + h * 256 + vh * 128 + c]); } } while (0)
    GLA_PREFETCH(0);
    for (int n = 0; n < nch; ++n) {
        __syncthreads();
        if (tid < 256) *(f32x4*)(GLR + (tid >> 2) * 16 + (tid & 3) * 4) = glr4;
        __syncthreads();
        { float run = 0.f; const float gb = GBS[c];
          float w2[16];
#pragma unroll
          for (int r = 0; r < 16; ++r) w2[r] = W2S[r * 128 + c];
          for (int ii = 0; ii < 16; ++ii) { const int i = ig * 16 + ii; float z = gb;
#pragma unroll
              for (int q = 0; q < 4; ++q) { const f32x4 g4 = *(const f32x4*)(GLR + i * 16 + q * 4);
#pragma unroll
                  for (int e = 0; e < 4; ++e) z += g4[e] * w2[q * 4 + e]; }
              run -= (fmaxf(-z, 0.f) + __logf(1.f + __expf(-fabsf(z)))) * (1.f / 16.f); LOGA[i * 128 + c] = run; }
          SEG[ig * 128 + c] = run; }
        __syncthreads();
        { float pre = 0.f, tot = 0.f;
#pragma unroll
          for (int q = 0; q < 4; ++q) { const float sg = SEG[q * 128 + c]; tot += sg; if (q < ig) pre += sg; }
          if (ig == 0) DEC[c] = __expf(tot);
#pragma unroll
          for (int ii = 0; ii < 16; ++ii) { const int i = ig * 16 + ii; const float bc = LOGA[i * 128 + c] + pre;
              QT[i * 136 + c] = f2bf(qv[ii] * qscale * __expf(bc)); KT[i * 136 + c] = f2bf(kv[ii] * __expf(-bc)); KE[c * 72 + i] = f2bf(kv[ii] * __expf(tot - bc)); VT[c * 72 + i] = f2bf(vv[ii]); } }
        __syncthreads();
        if (n + 1 < nch) GLA_PREFETCH(n + 1);
#pragma unroll
        for (int q = 0; q < 2; ++q) { const int tile = wid * 2 + q, ti = tile >> 2, tj = tile & 3; f32x4 a = (f32x4){0.f, 0.f, 0.f, 0.f};
            if (tj <= ti) a = mma_lds<4>(a, QT + ti * 16 * 136, 136, KT + tj * 16 * 136, 136, lane);
#pragma unroll
            for (int e = 0; e < 4; ++e) { const int i = ti * 16 + fq * 4 + e, jx = tj * 16 + fr; ATT[i * 72 + jx] = f2bf(jx <= i ? a[e] : 0.f); } }
#pragma unroll
        for (int tn = 0; tn < 8; ++tn) { uint2 pk; pk.x = cvt_pk_bf16(sacc[tn][0], sacc[tn][1]); pk.y = cvt_pk_bf16(sacc[tn][2], sacc[tn][3]); *(uint2*)(ST + (tn * 16 + fr) * 136 + wid * 16 + fq * 4) = pk; }
        __syncthreads();
#pragma unroll
        for (int ti = 0; ti < 4; ++ti) { f32x4 o = (f32x4){0.f, 0.f, 0.f, 0.f};
            o = mma_lds<2>(o, ATT + ti * 16 * 72, 72, VT + wid * 16 * 72, 72, lane);
            o = mma_lds<4>(o, QT + ti * 16 * 136, 136, ST + wid * 16 * 136, 136, lane);
#pragma unroll
            for (int e = 0; e < 4; ++e) { const int i = ti * 16 + fq * 4 + e; O[(size_t)GROW(n, i) * 1024 + h * 256 + vh * 128 + wid * 16 + fr] = o[e]; } }
        { f32x4 dc;
#pragma unroll
          for (int e = 0; e < 4; ++e) dc[e] = DEC[wid * 16 + fq * 4 + e];
#pragma unroll
          for (int tn = 0; tn < 8; ++tn) { sacc[tn] = sacc[tn] * dc; sacc[tn] = mma_lds<2>(sacc[tn], KE + wid * 16 * 72, 72, VT + tn * 16 * 72, 72, lane); } }
    }
#undef GROW
#undef GLA_PREFETCH
    if (s < 16) {
#pragma unroll
        for (int tn = 0; tn < 8; ++tn) { float* sp = p->out + OUT_GLA + ((size_t)((s * 2 + d) * 4 + h) * 128 + wid * 16 + fq * 4) * 256 + vh * 128 + tn * 16 + fr;
#pragma unroll
            for (int e = 0; e < 4; ++e) sp[(size_t)e * 256] = sacc[tn][e]; } }
}

__device__ void phase_s5gla(PP p, LAS unsigned char* ldsr) {
    unsigned char* lds = (unsigned char*)ldsr; const int bid = bidx(), nb = gdim();
    if (nb >= 64) {
        if (bid < 32) { gla_item(p, lds, 16 + (bid >> 4), (bid >> 2) & 3, (bid >> 1) & 1, bid & 1); return; }
        for (int it = bid - 32; it < 544; it += nb - 32) {
            if (it < 32) s5_item(p, lds, 16 + (it >> 4), (it >> 3) & 1, it & 7);
            else if (it < 288) { const int q = it - 32; s5_item(p, lds, q >> 4, (q >> 3) & 1, q & 7); }
            else { const int q = it - 288; gla_item(p, lds, q >> 4, (q >> 2) & 3, (q >> 1) & 1, q & 1); }
        }
    } else {
        for (int it = bid; it < 576; it += nb) {
            if (it < 32) { gla_item(p, lds, 16 + (it >> 4), (it >> 2) & 3, (it >> 1) & 1, it & 1); }
            else if (it < 64) { const int q = it - 32; s5_item(p, lds, 16 + (q >> 4), (q >> 3) & 1, q & 7); }
            else if (it < 320) { const int q = it - 64; s5_item(p, lds, q >> 4, (q >> 3) & 1, q & 7); }
            else { const int q = it - 320; gla_item(p, lds, q >> 4, (q >> 2) & 3, (q >> 1) & 1, q & 1); }
        }
    }
}

__device__ void phase_evpost(PP p) {
    const int tid = tidx(), lane = tid & 63, wid = tid >> 6; const int gw = bidx() * 8 + wid, nw = gdim() * 8;
    const bf16_t* PROJ = (const bf16_t*)(p->ws + WS_PROJ); const float* Y0 = (const float*)(p->ws + WS_YS5); const float* Y1 = Y0 + (size_t)MTOK * 1024;
    const float* O0 = (const float*)(p->ws + WS_OGLA); const float* O1 = O0 + (size_t)MTOK * 1024;
    bf16_t* YSB = (bf16_t*)(p->ws + WS_YSB); bf16_t* CAT = (bf16_t*)(p->ws + WS_CAT);
    for (int r = gw; r < MTOK; r += nw) {
        f32x4 y0[4], y1[4], o0[4], o1[4]; uint2 uw[4], gw4[4];
        const int c0 = lane * 16;
#pragma unroll
        for (int i = 0; i < 4; ++i) { const int c = lane * 4 + i * 256; y0[i] = *(const f32x4*)(Y0 + (size_t)r * 1024 + c); y1[i] = *(const f32x4*)(Y1 + (size_t)r * 1024 + c); uw[i] = *(const uint2*)(PROJ + (size_t)r * EVINP + c);
            o0[i] = *(const f32x4*)(O0 + (size_t)r * 1024 + c0 + i * 4); o1[i] = *(const f32x4*)(O1 + (size_t)r * 1024 + c0 + i * 4); gw4[i] = *(const uint2*)(PROJ + (size_t)r * EVINP + 3072 + c0 + i * 4); }
#pragma unroll
        for (int i = 0; i < 4; ++i) { const int c = lane * 4 + i * 256; const f32x4 u = unpack4(uw[i]), dd = *(const f32x4*)(p->in[I_S5D] + c); f32x4 v = y0[i] + y1[i] + dd * u;
#pragma unroll
            for (int e = 0; e < 4; ++e) v[e] = geluf_(v[e]);
            uint2 pk; pk.x = cvt_pk_bf16(v[0], v[1]); pk.y = cvt_pk_bf16(v[2], v[3]); *(uint2*)(YSB + (size_t)r * 1024 + c) = pk; }
        { f32x4 o[4]; float ss = 0.f;
#pragma unroll
          for (int i = 0; i < 4; ++i) { o[i] = o0[i] + o1[i]; ss += o[i][0] * o[i][0] + o[i][1] * o[i][1] + o[i][2] * o[i][2] + o[i][3] * o[i][3]; }
#pragma unroll
          for (int m = 8; m >= 1; m >>= 1) ss += __shfl_xor(ss, m);
          const float rinv = rsqrtf(ss * (1.f / 256.f) + EPS);
#pragma unroll
          for (int i = 0; i < 4; ++i) { const int c = c0 + i * 4; const f32x4 ng = *(const f32x4*)(p->in[I_GNG] + (c & 255)), gt = unpack4(gw4[i]); f32x4 v;
#pragma unroll
              for (int e = 0; e < 4; ++e) v[e] = o[i][e] * rinv * ng[e] * siluf_(gt[e]);
              uint2 pk; pk.x = cvt_pk_bf16(v[0], v[1]); pk.y = cvt_pk_bf16(v[2], v[3]); *(uint2*)(CAT + (size_t)r * D + 1024 + c) = pk; } }
    }
}

__device__ void phase_conv(PP p) {
    const bf16_t* PROJ = (const bf16_t*)(p->ws + WS_PROJ); bf16_t* XCB = (bf16_t*)(p->ws + WS_XCB);
    const float* cw = p->in[I_CONVW]; const float* cb = p->in[I_CONVB];
    const size_t total = (size_t)MTOK * 512;
    { const int gi = bidx() * 512 + tidx(); if (gi < 2 * D) ((float*)(p->ws + WS_SP))[gi] = -8.f * softplusf_(-p->in[I_LLAM][gi]); }
    for (size_t i = (size_t)bidx() * 512 + tidx(); i < total; i += (size_t)gdim() * 512) {
        const int r = (int)(i >> 9), c = (int)(i & 511) * 4; const int seg = r < TCTX ? 256 : 64; const int pos = r & (seg - 1);
        f32x4 acc = *(const f32x4*)(cb + c);
#pragma unroll
        for (int j = 0; j < 4; ++j) { const int pp = pos + j - 2; if (pp >= 0 && pp < seg) acc += *(const f32x4*)(cw + j * D + c) * unpack4(*(const uint2*)(PROJ + (size_t)(r + j - 2) * 4096 + 2048 + c)); }
        uint2 pk; pk.x = cvt_pk_bf16(acc[0], acc[1]); pk.y = cvt_pk_bf16(acc[2], acc[3]); *(uint2*)(XCB + (size_t)r * D + c) = pk;
    }
}
__device__ void phase_lruscan1(PP p) {
    const int tid = tidx(), lane = tid & 63, wid = tid >> 6; const int nb = gdim();
    float* SUM = (float*)(p->ws + WS_LSUM);
    for (int it = bidx() * 8 + wid; it < 384 * 64; it += 8 * nb) {
        const int q = it >> 6, d = (it >> 5) & 1, c = (it & 31) * 64 + lane; const int row0 = q * 16;
        const unsigned* LAB = (const unsigned*)(p->ws + WS_LA) + ((size_t)d * MTOK + row0) * D + c;
        unsigned wv[16];
#pragma unroll
        for (int j = 0; j < 16; ++j) wv[j] = LAB[(size_t)j * D];
        float S = 0.f, h = 0.f;
        if (d == 0) {
#pragma unroll
            for (int j = 0; j < 16; ++j) { const float la = lo_bf(wv[j]); h = __expf(la) * h + hi_bf(wv[j]); S += la; } }
        else {
#pragma unroll
            for (int j = 15; j >= 0; --j) { const float la = lo_bf(wv[j]); h = __expf(la) * h + hi_bf(wv[j]); S += la; } }
        SUM[((size_t)d * 384 + q) * D + c] = __expf(S); SUM[((size_t)(2 + d) * 384 + q) * D + c] = h;
    }
}
__device__ void conv_tile(PP p, int pm, int pnx) {
    const int tid = tidx();
    const bf16_t* PROJ = (const bf16_t*)(p->ws + WS_PROJ); bf16_t* XCB = (bf16_t*)(p->ws + WS_XCB); const float* cw = p->in[I_CONVW]; const float* cb = p->in[I_CONVB];
    const int c = pnx * 256 + (tid & 63) * 4; const int rl0 = tid >> 6;
    f32x4 w[4]; const f32x4 bias = *(const f32x4*)(cb + c);
#pragma unroll
    for (int j = 0; j < 4; ++j) w[j] = *(const f32x4*)(cw + j * D + c);
    for (int kb = 0; kb < 32; kb += 4) {
        uint2 t[4][4];
#pragma unroll
        for (int u = 0; u < 4; ++u) { const int r = pm * 256 + rl0 + 8 * (kb + u); const int seg = r < TCTX ? 256 : 64; const int pos = r & (seg - 1);
#pragma unroll
            for (int j = 0; j < 4; ++j) { const int pp = pos + j - 2; t[u][j] = (uint2){0u, 0u}; if (pp >= 0 && pp < seg) t[u][j] = *(const uint2*)(PROJ + (size_t)(r + j - 2) * 4096 + 2048 + c); } }
#pragma unroll
        for (int u = 0; u < 4; ++u) { const int r = pm * 256 + rl0 + 8 * (kb + u); f32x4 acc = bias;
#pragma unroll
            for (int j = 0; j < 4; ++j) acc += w[j] * unpack4(t[u][j]);
            uint2 pk; pk.x = cvt_pk_bf16(acc[0], acc[1]); pk.y = cvt_pk_bf16(acc[2], acc[3]); *(uint2*)(XCB + (size_t)r * D + c) = pk; } }
}
__device__ void scan1_tile(PP p, int pm, int pn) {
    const int tid = tidx(); const int d = pn >> 4, chu = ((pn >> 1) & 7) * 256 + (pn & 1) * 128; float* SUM = (float*)(p->ws + WS_LSUM);
    const int c = chu + (tid & 127);
    unsigned wv[4][16];
#pragma unroll
    for (int k = 0; k < 4; ++k) { const int q = pm * 16 + (tid >> 7) + 4 * k; const unsigned* LAB = (const unsigned*)(p->ws + WS_LA) + ((size_t)d * MTOK + q * 16) * D + c;
#pragma unroll
        for (int j = 0; j < 16; ++j) wv[k][j] = LAB[(size_t)j * D]; }
#pragma unroll
    for (int k = 0; k < 4; ++k) { const int q = pm * 16 + (tid >> 7) + 4 * k; float S = 0.f, h = 0.f;
        if (d == 0) {
#pragma unroll
            for (int j = 0; j < 16; ++j) { const float la = lo_bf(wv[k][j]); h = __expf(la) * h + hi_bf(wv[k][j]); S += la; } }
        else {
#pragma unroll
            for (int j = 15; j >= 0; --j) { const float la = lo_bf(wv[k][j]); h = __expf(la) * h + hi_bf(wv[k][j]); S += la; } }
        SUM[((size_t)d * 384 + q) * D + c] = __expf(S); SUM[((size_t)(2 + d) * 384 + q) * D + c] = h; }
}
__device__ void phase_lruscan2(PP p) {
    const int tid = tidx(), lane = tid & 63, wid = tid >> 6; const int nb = gdim();
    const float* SUM = (const float*)(p->ws + WS_LSUM); const bf16_t* PROJ = (const bf16_t*)(p->ws + WS_PROJ); bf16_t* CAT = (bf16_t*)(p->ws + WS_CAT);
    for (int it0 = bidx() * 8 + wid; it0 < 384 * 32; it0 += 8 * nb) {
        const int it = it0 < 128 * 32 ? it0 + 256 * 32 : it0 - 128 * 32;
        const int q = it >> 5, c = (it & 31) * 64 + lane; const int row0 = q * 16;
        int qs, ql, s; if (q < 256) { s = q >> 4; qs = s * 16; ql = qs + 15; } else { s = 16 + ((q - 256) >> 6); qs = 256 + (s - 16) * 64; ql = qs + 63; }
        float h0 = 0.f, h1 = 0.f;
        if (s >= 16) { h0 = p->in[I_SLRU][(size_t)((s - 16) * 2 + 0) * D + c]; h1 = p->in[I_SLRU][(size_t)((s - 16) * 2 + 1) * D + c]; }
        const float* P0 = SUM + c; const float* H0 = SUM + (size_t)2 * 384 * D + c; const float* P1 = SUM + (size_t)384 * D + c; const float* H1 = SUM + (size_t)3 * 384 * D + c;
        const unsigned* W0 = (const unsigned*)(p->ws + WS_LA) + (size_t)row0 * D + c; const unsigned* W1 = W0 + (size_t)MTOK * D; const bf16_t* GT = PROJ + (size_t)row0 * 4096 + c;
        unsigned w0[16], w1[16]; float b0[16], gt[16];
#pragma unroll
        for (int j = 0; j < 16; ++j) { w0[j] = W0[(size_t)j * D]; w1[j] = W1[(size_t)j * D]; gt[j] = bf2f_(GT[(size_t)j * 4096]); }
        for (int j = qs; j < q; j += 8) { float pv[8], hv[8];
#pragma unroll
            for (int e = 0; e < 8; ++e) { const bool ok = j + e < q; pv[e] = ok ? P0[(size_t)(j + e) * D] : 1.f; hv[e] = ok ? H0[(size_t)(j + e) * D] : 0.f; }
#pragma unroll
            for (int e = 0; e < 8; ++e) h0 = pv[e] * h0 + hv[e]; }
        for (int j = ql; j > q; j -= 8) { float pv[8], hv[8];
#pragma unroll
            for (int e = 0; e < 8; ++e) { const bool ok = j - e > q; pv[e] = ok ? P1[(size_t)(j - e) * D] : 1.f; hv[e] = ok ? H1[(size_t)(j - e) * D] : 0.f; }
#pragma unroll
            for (int e = 0; e < 8; ++e) h1 = pv[e] * h1 + hv[e]; }
#pragma unroll
        for (int j = 0; j < 16; ++j) { h0 = __expf(lo_bf(w0[j])) * h0 + hi_bf(w0[j]); b0[j] = h0; }
#pragma unroll
        for (int j = 15; j >= 0; --j) { h1 = __expf(lo_bf(w1[j])) * h1 + hi_bf(w1[j]); CAT[(size_t)(row0 + j) * D + c] = f2bf((b0[j] + h1) * geluf_(gt[j])); }
        if (s < 16) { if (q == ql) p->out[OUT_LRU + (size_t)(s * 2 + 0) * D + c] = h0; if (q == qs) p->out[OUT_LRU + (size_t)(s * 2 + 1) * D + c] = h1; }
    }
}

#ifndef PHMASK
#define PHMASK 0xFFFFFFFFu
#endif
#define PHON(k) ((PHMASK >> (k)) & 1u)
#ifndef DUPMASK
#define DUPMASK 0u
#endif
enum { K_PREP = 0, K_NORM, K_SWIGLU, K_RESID, K_F32, K_S5GLA, K_EVPOST, K_GLU, K_CONV, K_LRUG, K_LRUSCAN, K_LRUCOMB };
__global__ void __launch_bounds__(512, 2) mega(Params p) {
    extern __shared__ __attribute__((aligned(16))) unsigned char shm[];
    LAS unsigned char* lds = (LAS unsigned char*)shm;
    cg::grid_group grid = cg::this_grid();
    const int ph_lo = p.ph_lo, ph_hi = p.ph_hi;
    int rep = 0;
    volatile LAS unsigned* bst = (volatile LAS unsigned*)(lds + LDS_MAIN);
    if (threadIdx.x < 16) bst[threadIdx.x] = 0u;
    __syncthreads();
    XcdBarrier xbar = xcd_barrier_post((unsigned*)(p.ws + WS_BAR), bst);
    for (int ph = ph_lo; ph < ph_hi; ++ph) {
        PP pp = get_pp();
        unsigned char* ws = pp->ws;
        const float* MOD = (const float*)(ws + WS_MOD);
        int kind, l = 0, a0 = 0;
        if (ph == 0) kind = K_PREP;
        else if (ph == 24) { kind = K_NORM; a0 = -1; }
        else { l = ph > 12 ? 1 : 0; const int q = ph - 1 - 12 * l;
            if (q == 0) { kind = K_NORM; a0 = 0; }
            else if (q == 1) { kind = K_SWIGLU; a0 = 0; }
            else if (q == 2) { kind = K_RESID; a0 = 0; }
            else if (q == 3) { kind = K_NORM; a0 = 1; }
            else if (q == 4) kind = K_F32;
            else if (l == 0) { if (q == 5) kind = K_S5GLA; else if (q == 6) kind = K_EVPOST; else if (q == 7) kind = K_GLU; else if (q == 8) { kind = K_RESID; a0 = 2; } else if (q == 9) { kind = K_NORM; a0 = 2; } else if (q == 10) { kind = K_SWIGLU; a0 = 1; } else { kind = K_RESID; a0 = 1; } }
            else { if (q == 5) kind = K_LRUG; else if (q == 6) kind = K_LRUCOMB; else if (q == 7) { kind = K_RESID; a0 = 2; } else if (q == 8) { kind = K_NORM; a0 = 2; } else if (q == 9) { kind = K_SWIGLU; a0 = 1; } else { kind = K_RESID; a0 = 1; } }
        }
        const bf16_t* HM = (const bf16_t*)(ws + WS_HM);
        if (kind == K_PREP) { if (PHON(0)) phase_prep(pp, lds, rep); }
        else if (kind == K_NORM) { if (PHON(1)) phase_norm(pp, l, a0); }
        else if (kind == K_SWIGLU) { if (PHON(2)) { EpiSwiglu E{(bf16_t*)(ws + WS_H)}; pg8::gemm_phase<EpiSwiglu, false>(lds, HM, D, (const bf16_t*)(ws + WS_WFI) + (size_t)(l * 2 + a0) * 11264 * 2048, D, 24, 44, D, E); if (!rep) bg_convert(pp, lds, ph); } }
        else if (kind == K_RESID) { if (PHON(3)) {
            const bf16_t* A; const bf16_t* B; int K; int gj; float coef;
            if (a0 < 2) { A = (const bf16_t*)(ws + WS_H); B = (const bf16_t*)(ws + WS_WFO) + (size_t)(l * 2 + a0) * 2048 * 5632; K = DFF; gj = a0 == 0 ? 2 : 8; coef = 0.5f; }
            else { A = (const bf16_t*)(ws + WS_CAT); B = (const bf16_t*)(ws + (l == 0 ? WS_WEO : WS_WOO)); K = D; gj = 5; coef = 1.0f; }
            const bool first = (ph == 3);
            const float* xc_ = first ? pp->in[I_XP] : (const float*)(ws + WS_X); const float* xl_ = first ? pp->in[I_XS] - (size_t)TCTX * D : (const float*)(ws + WS_X);
            EpiResid E{(float*)(ws + WS_X), MOD + (size_t)(l * 3) * 18432 + gj * 2048, coef, xc_, xl_};
            if (a0 < 2) pg8::gemm_phase<EpiResid, false, true>(lds, A, K, B, K, 24, 8, K, E); else pg8::gemm_phase<EpiResid, false, false>(lds, A, K, B, K, 24, 8, K, E); if (!rep) bg_convert(pp, lds, ph); } }
        else if (kind == K_F32) { if (PHON(4)) {
            { const int nN = l == 0 ? 17 : 16; EpiBf16 E{(bf16_t*)(ws + WS_PROJ), nN * 256}; pg8::gemm_phase<EpiBf16, false>(lds, HM, D, (const bf16_t*)(ws + (l == 0 ? WS_WEI : WS_WOI)), D, 24, nN, D, E); }
            if (l == 1) {
                { const int gi = bidx() * 512 + tidx(); if (gi < 2 * D) ((float*)(ws + WS_SP))[gi] = -8.f * softplusf_(-pp->in[I_LLAM][gi]); }
                pg8::Order S; S.nM = 24; S.nN = 16; S.nwg = 384; S.G = gdim(); S.c = bidx(); Unit u;
                for (int i = 0; S.next(i, u); ++i) if (u.pn >= 8) conv_tile(pp, u.pm, u.pn - 8); }
            if (!rep) bg_convert(pp, lds, ph); } }
        else if (kind == K_S5GLA) { if (PHON(5)) phase_s5gla(pp, lds); }
        else if (kind == K_EVPOST) { if (PHON(6)) phase_evpost(pp); }
        else if (kind == K_GLU) { if (PHON(7)) { EpiGlu E{(bf16_t*)(ws + WS_CAT), (const bf16_t*)(ws + WS_YSB), pp->in[I_GLUB]}; pg8::gemm_phase<EpiGlu, false>(lds, (const bf16_t*)(ws + WS_YSB), 1024, (const bf16_t*)(ws + WS_WGLU), 1024, 24, 4, 1024, E); if (!rep) bg_convert(pp, lds, ph); } }
        else if (kind == K_CONV) { if (PHON(8)) phase_conv(pp); }
        else if (kind == K_LRUG) { if (PHON(9)) { EpiLru E{(unsigned*)(ws + WS_LA), (const bf16_t*)(ws + WS_XCB), pp->in[I_LBA], pp->in[I_LBX], (const float*)(ws + WS_SP)};
            int kk = 256; asm volatile("" : "+s"(kk));
            pg8::gemm_phase<EpiLru, true>(lds, (const bf16_t*)(ws + WS_XCB), D, (const bf16_t*)(ws + WS_WLRU), kk, 24, 32, kk, E);
            { pg8::Order S; S.nM = 24; S.nN = 32; S.nwg = 768; S.G = gdim(); S.c = bidx(); Unit u; for (int i = 0; S.next(i, u); ++i) scan1_tile(pp, u.pm, u.pn); } } }
        else if (kind == K_LRUSCAN) { if (PHON(10)) phase_lruscan1(pp); }
        else { if (PHON(11)) phase_lruscan2(pp); }
#if DUPMASK
        if (rep == 0 && ((DUPMASK >> kind) & 1u)) { xcd_barrier(xbar); rep = 1; --ph; continue; }
        rep = 0;
#endif
        if (ph + 1 < ph_hi) { if (ph == 0) grid.sync(); else xcd_barrier(xbar); }
    }
}

extern "C" void kernel_launch(void* const* d_in, const int* in_sizes, int n_in, void* d_out, int out_size, void* d_ws, size_t ws_size, hipStream_t stream) {
    static int grid = 0;
    if (grid == 0) {
        if (n_in != 38 || ws_size < WS_END) { fprintf(stderr, "kernel_launch: expected 38 inputs and >= %zu bytes of workspace (got %d, %zu)\n", (size_t)WS_END, n_in, ws_size); grid = -1; return; }
        int dev = 0, cus = 0, per_cu = 0;
        hipGetDevice(&dev); hipDeviceGetAttribute(&cus, hipDeviceAttributeMultiprocessorCount, dev);
        hipFuncSetAttribute((const void*)mega, hipFuncAttributeMaxDynamicSharedMemorySize, LDS_BYTES);
        hipOccupancyMaxActiveBlocksPerMultiprocessor(&per_cu, (const void*)mega, 512, LDS_BYTES);
        if (per_cu < 1) { fprintf(stderr, "kernel_launch: occupancy query says %d blocks per CU\n", per_cu); grid = -1; return; }
        grid = cus;
    }
    if (grid < 0) return;
    (void)hipMemsetAsync((char*)d_ws + WS_MOD, 0, ZERO_BYTES, stream);
    Params p{};
    for (int i = 0; i < 38; ++i) p.in[i] = (const float*)d_in[i];
    p.out = (float*)d_out; p.ws = (unsigned char*)d_ws;
#if MEGA
    p.ph_lo = 0; p.ph_hi = NPH;
    void* args[] = {&p};
    hipError_t e = hipLaunchCooperativeKernel((const void*)mega, dim3(grid), dim3(512), args, LDS_BYTES, stream);
    if (e != hipSuccess) fprintf(stderr, "cooperative launch failed: %s (grid %d)\n", hipGetErrorString(e), grid);
#else
    for (int ph = 0; ph < NPH; ++ph) { p.ph_lo = ph; p.ph_hi = ph + 1; hipLaunchKernelGGL(mega, dim3(grid), dim3(512), LDS_BYTES, stream, p); }
#endif
}
```
